# Optimizing an MI355X kernel written in HIP

```python
import math
import jax
import jax.numpy as jnp
from jax import lax
import numpy as np

D_MODEL = 1024
BATCH = 8
SEQ = 4096
DEPTH = 1

EPS = 1e-6
MLA_HEADS = 8
MLA_NOPE = 64
MLA_ROPE = 32
MLA_V = 64
MLA_QK = MLA_NOPE + MLA_ROPE
MLA_Q_LORA = 384
MLA_KV_LORA = 256
ROPE_THETA = 10000.0
Q_BLOCK = 128
GDN_HEADS = 8
GDN_DK = 64
GDN_DV = 64
CONV_WIDTH = 4
CHUNK = 64
MLA_OUT = MLA_HEADS * MLA_V
GDN_OUT = GDN_HEADS * GDN_DV
D_MIX = MLA_OUT + GDN_OUT
IN_SIZES = (MLA_Q_LORA, MLA_KV_LORA, MLA_ROPE,
            GDN_HEADS * GDN_DK, GDN_HEADS * GDN_DK, GDN_HEADS * GDN_DV,
            GDN_HEADS * GDN_DV, GDN_HEADS, GDN_HEADS)
IN_DIM = sum(IN_SIZES)
CONV_CH = 2 * GDN_HEADS * GDN_DK + GDN_HEADS * GDN_DV
N_EXPERTS = 32
TOP_K = 4
D_EXPERT = D_MODEL
SWIGLU_ALPHA = 1.702
SWIGLU_LIMIT = 7.0
EXPERT_BLOCK = 256

kernel_name = 'hybrid_mla_gdn_moe_adaln_block'


def rms_norm(x, gain):
    xf = x.astype(jnp.float32)
    y = xf * lax.rsqrt(jnp.mean(xf * xf, axis=-1, keepdims=True) + EPS)
    return (y * gain.astype(jnp.float32)).astype(x.dtype)


def l2_normalize(x):
    xf = x.astype(jnp.float32)
    return (xf * lax.rsqrt(jnp.sum(xf * xf, axis=-1, keepdims=True) + EPS)).astype(x.dtype)


def rope_tables(positions):
    half = MLA_ROPE // 2
    inv_freq = ROPE_THETA ** (-jnp.arange(half, dtype=jnp.float32) / half)
    ang = positions.astype(jnp.float32)[..., None] * inv_freq
    return jnp.cos(ang), jnp.sin(ang)


def apply_rope(x, cos, sin):
    half = MLA_ROPE // 2
    xf = x.astype(jnp.float32)
    x1, x2 = xf[..., :half], xf[..., half:]
    return jnp.concatenate([x1 * cos - x2 * sin, x2 * cos + x1 * sin], axis=-1).astype(x.dtype)


def mla_group(q_lat, kv_lat, k_pe, positions, q_norm_g, w_q_b, kv_norm_g, w_kv_b, out_g):
    b, s, _ = q_lat.shape
    n_blocks = s // Q_BLOCK
    q = (rms_norm(q_lat, q_norm_g) @ w_q_b).reshape(b, s, MLA_HEADS, MLA_QK)
    kv = (rms_norm(kv_lat, kv_norm_g) @ w_kv_b).reshape(b, s, MLA_HEADS, MLA_NOPE + MLA_V)
    k_nope, v = kv[..., :MLA_NOPE], kv[..., MLA_NOPE:]
    cos, sin = rope_tables(positions)
    q_pe = apply_rope(q[..., MLA_NOPE:], cos[:, :, None, :], sin[:, :, None, :])
    k_pe = apply_rope(k_pe, cos, sin)
    q = jnp.concatenate([q[..., :MLA_NOPE], q_pe], axis=-1) * (MLA_QK ** -0.5)
    k = jnp.concatenate(
        [k_nope, jnp.broadcast_to(k_pe[:, :, None, :], (b, s, MLA_HEADS, MLA_ROPE))], axis=-1)
    q_blocks = jnp.moveaxis(q.reshape(b, n_blocks, Q_BLOCK, MLA_HEADS, MLA_QK), 1, 0)
    key_pos = jnp.arange(s, dtype=jnp.int32)

    def attend(args):
        q_blk, blk = args
        scores = jnp.einsum('bqhd,bkhd->bhqk', q_blk, k, preferred_element_type=jnp.float32)
        q_pos = blk * Q_BLOCK + jnp.arange(Q_BLOCK, dtype=jnp.int32)
        causal = key_pos[None, :] <= q_pos[:, None]
        probs = jax.nn.softmax(jnp.where(causal, scores, -jnp.inf), axis=-1).astype(v.dtype)
        return jnp.einsum('bhqk,bkhd->bqhd', probs, v)

    o = lax.map(attend, (q_blocks, jnp.arange(n_blocks, dtype=jnp.int32)))
    o = jnp.moveaxis(o, 0, 1).reshape(b, s, MLA_OUT)
    return rms_norm(o, out_g)


def causal_conv(x, w):
    ch = x.shape[-1]
    y = lax.conv_general_dilated(
        x, w[:, None, :].astype(x.dtype), window_strides=(1,),
        padding=((CONV_WIDTH - 1, 0),), dimension_numbers=('NWC', 'WIO', 'NWC'),
        feature_group_count=ch)
    return jax.nn.silu(y)


def gated_delta_rule(q, k, v, g, beta):
    b, s, h, dk = q.shape
    dv = v.shape[-1]
    n = s // CHUNK
    f32 = jnp.float32

    def to_chunks(t):
        return t.astype(f32).reshape(b, n, CHUNK, h, -1).transpose(0, 3, 1, 2, 4)

    qc = to_chunks(q) * (dk ** -0.5)
    kc = to_chunks(k)
    vc = to_chunks(v)
    gc = g.astype(f32).reshape(b, n, CHUNK, h).transpose(0, 3, 1, 2)
    bc = beta.astype(f32).reshape(b, n, CHUNK, h).transpose(0, 3, 1, 2)
    g_cum = jnp.cumsum(gc, axis=-1)
    tri_incl = jnp.tril(jnp.ones((CHUNK, CHUNK), dtype=bool))
    tri_strict = jnp.tril(jnp.ones((CHUNK, CHUNK), dtype=bool), -1)
    diff = g_cum[..., :, None] - g_cum[..., None, :]
    decay = jnp.where(tri_incl, jnp.exp(jnp.where(tri_incl, diff, 0.0)), 0.0)
    k_beta = kc * bc[..., None]
    a_low = jnp.where(tri_strict, jnp.einsum('bhnid,bhnjd->bhnij', k_beta, kc) * decay, 0.0)
    eye = jnp.eye(CHUNK, dtype=f32)
    rhs = jnp.concatenate([vc * bc[..., None], k_beta * jnp.exp(g_cum)[..., None]], axis=-1)
    sol = lax.linalg.triangular_solve(eye + a_low, rhs, left_side=True, lower=True,
                                      unit_diagonal=True)
    u, w = sol[..., :dv], sol[..., dv:]
    qk = jnp.where(tri_incl, jnp.einsum('bhnid,bhnjd->bhnij', qc, kc) * decay, 0.0)
    q_decay = qc * jnp.exp(g_cum)[..., None]
    k_tail = kc * jnp.exp(g_cum[..., -1:] - g_cum)[..., None]
    chunk_decay = jnp.exp(g_cum[..., -1])

    def step(state, xs):
        u_c, w_c, qk_c, qd_c, kt_c, cd_c = xs
        v_new = u_c - jnp.einsum('bhcd,bhde->bhce', w_c, state)
        o_c = (jnp.einsum('bhcd,bhde->bhce', qd_c, state)
               + jnp.einsum('bhij,bhje->bhie', qk_c, v_new))
        state = state * cd_c[..., None, None] + jnp.einsum('bhcd,bhce->bhde', kt_c, v_new)
        return state, o_c

    xs = tuple(jnp.moveaxis(t, 2, 0) for t in (u, w, qk, q_decay, k_tail, chunk_decay))
    _, o = lax.scan(step, jnp.zeros((b, h, dk, dv), f32), xs)
    return o.transpose(1, 0, 3, 2, 4).reshape(b, s, h, dv)


def gdn_group(q_in, k_in, v_in, z, a_in, b_in, conv_w, A_log, dt_bias, norm_g):
    b, s, _ = q_in.shape
    nk = GDN_HEADS * GDN_DK
    qkv = causal_conv(jnp.concatenate([q_in, k_in, v_in], axis=-1), conv_w)
    q = l2_normalize(qkv[..., :nk].reshape(b, s, GDN_HEADS, GDN_DK))
    k = l2_normalize(qkv[..., nk:2 * nk].reshape(b, s, GDN_HEADS, GDN_DK))
    v = qkv[..., 2 * nk:].reshape(b, s, GDN_HEADS, GDN_DV)
    beta = jax.nn.sigmoid(b_in.astype(jnp.float32))
    g = -jnp.exp(A_log.astype(jnp.float32)) * jax.nn.softplus(
        a_in.astype(jnp.float32) + dt_bias.astype(jnp.float32))
    o = gated_delta_rule(q, k, v, g, beta).astype(q_in.dtype)
    o = rms_norm(o, norm_g) * jax.nn.silu(z.reshape(b, s, GDN_HEADS, GDN_DV))
    return o.reshape(b, s, GDN_OUT)


def hybrid_mixer(h, positions, w_in, q_norm_g, w_q_b, kv_norm_g, w_kv_b, mla_out_g,
                 conv_w, A_log, dt_bias, gdn_norm_g, w_out):
    proj = h @ w_in
    cuts = [int(i) for i in np.cumsum(IN_SIZES)[:-1]]
    q_lat, kv_lat, k_pe, g_q, g_k, g_v, g_z, g_a, g_b = jnp.split(proj, cuts, axis=-1)
    mla_o = mla_group(q_lat, kv_lat, k_pe, positions, q_norm_g, w_q_b, kv_norm_g, w_kv_b,
                      mla_out_g)
    gdn_o = gdn_group(g_q, g_k, g_v, g_z, g_a, g_b, conv_w, A_log, dt_bias, gdn_norm_g)
    return jnp.concatenate([mla_o, gdn_o], axis=-1) @ w_out


def moe_ffn(h, router_w, router_b, w_gate_up, b_gate_up, w_down, b_down):
    b, s, d = h.shape
    t = b * s
    m = t * TOP_K
    xf = h.reshape(t, d)
    logits = (xf @ router_w + router_b).astype(jnp.float32)
    top_val, top_idx = lax.top_k(logits, TOP_K)
    weights = jax.nn.softmax(top_val, axis=-1)
    e_flat = top_idx.reshape(m).astype(jnp.int32)
    tok_flat = jnp.arange(m, dtype=jnp.int32) // TOP_K
    w_flat = weights.reshape(m)
    order = jnp.argsort(e_flat)
    e_sorted = e_flat[order]
    counts = jnp.zeros((N_EXPERTS,), jnp.int32).at[e_flat].add(1)
    padded = ((counts + EXPERT_BLOCK - 1) // EXPERT_BLOCK) * EXPERT_BLOCK
    start = jnp.cumsum(counts) - counts
    pstart = jnp.cumsum(padded) - padded
    dest = pstart[e_sorted] + (jnp.arange(m, dtype=jnp.int32) - start[e_sorted])
    n_blocks = (m + N_EXPERTS * (EXPERT_BLOCK - 1) + EXPERT_BLOCK - 1) // EXPERT_BLOCK
    rows = n_blocks * EXPERT_BLOCK
    row_tok = jnp.full((rows,), t, jnp.int32).at[dest].set(tok_flat[order])
    row_w = jnp.zeros((rows,), jnp.float32).at[dest].set(w_flat[order])
    row_e = jnp.full((rows,), N_EXPERTS - 1, jnp.int32).at[dest].set(e_sorted)
    blk_tok = row_tok.reshape(n_blocks, EXPERT_BLOCK)
    blk_e = row_e[::EXPERT_BLOCK]
    x_pad = jnp.concatenate([xf, jnp.zeros((1, d), xf.dtype)], axis=0)

    def expert_block(args):
        tok, e = args
        xb = x_pad[tok]
        gu = xb @ w_gate_up[e] + b_gate_up[e]
        gate = jnp.minimum(gu[:, :D_EXPERT], SWIGLU_LIMIT)
        up = jnp.clip(gu[:, D_EXPERT:], -SWIGLU_LIMIT, SWIGLU_LIMIT)
        act = (up + 1.0) * (gate * jax.nn.sigmoid(SWIGLU_ALPHA * gate))
        return act @ w_down[e] + b_down[e]

    y_rows = lax.map(expert_block, (blk_tok, blk_e)).reshape(rows, d)
    y_rows = y_rows * row_w[:, None].astype(y_rows.dtype)
    y = jnp.zeros((t + 1, d), y_rows.dtype).at[row_tok].add(y_rows)
    return y[:t].reshape(b, s, d)


def setup_inputs(seed: int = 0) -> dict:
    key = jax.random.key(seed)
    ks = jax.random.split(key, 24)

    def nrm(k, shape, scale):
        return jax.random.normal(k, shape, jnp.float32) * scale

    x = nrm(ks[0], (BATCH, SEQ, D_MODEL), 1.0)
    c = nrm(ks[1], (BATCH, D_MODEL), 1.0)
    positions = jnp.broadcast_to(jnp.arange(SEQ, dtype=jnp.int32), (BATCH, SEQ))
    ada_w = nrm(ks[2], (DEPTH, D_MODEL, 6 * D_MODEL), 0.5 * D_MODEL ** -0.5)
    ada_b = nrm(ks[3], (DEPTH, 6 * D_MODEL), 0.02)
    norm1_g = 1.0 + nrm(ks[4], (DEPTH, D_MODEL), 0.1)
    w_in = nrm(ks[5], (DEPTH, D_MODEL, IN_DIM), D_MODEL ** -0.5)
    q_norm_g = 1.0 + nrm(ks[6], (DEPTH, MLA_Q_LORA), 0.1)
    w_q_b = nrm(ks[7], (DEPTH, MLA_Q_LORA, MLA_HEADS * MLA_QK), MLA_Q_LORA ** -0.5)
    kv_norm_g = 1.0 + nrm(ks[8], (DEPTH, MLA_KV_LORA), 0.1)
    w_kv_b = nrm(ks[9], (DEPTH, MLA_KV_LORA, MLA_HEADS * (MLA_NOPE + MLA_V)), MLA_KV_LORA ** -0.5)
    mla_out_g = 1.0 + nrm(ks[10], (DEPTH, MLA_OUT), 0.1)
    conv_w = nrm(ks[11], (DEPTH, CONV_WIDTH, CONV_CH), CONV_WIDTH ** -0.5)
    A_log = jnp.log(jax.random.uniform(ks[12], (DEPTH, GDN_HEADS), jnp.float32, 1.0, 16.0))
    dt = jnp.exp(jax.random.uniform(ks[13], (DEPTH, GDN_HEADS), jnp.float32,
                                    math.log(1e-3), math.log(1e-1)))
    dt_bias = dt + jnp.log(-jnp.expm1(-dt))
    gdn_norm_g = 1.0 + nrm(ks[14], (DEPTH, GDN_DV), 0.1)
    w_out = nrm(ks[15], (DEPTH, D_MIX, D_MODEL), D_MIX ** -0.5)
    norm2_g = 1.0 + nrm(ks[16], (DEPTH, D_MODEL), 0.1)
    router_w = nrm(ks[17], (DEPTH, D_MODEL, N_EXPERTS), D_MODEL ** -0.5)
    router_b = nrm(ks[18], (DEPTH, N_EXPERTS), 0.01)
    w_gate_up = nrm(ks[19], (DEPTH, N_EXPERTS, D_MODEL, 2 * D_EXPERT), D_MODEL ** -0.5)
    b_gate_up = nrm(ks[20], (DEPTH, N_EXPERTS, 2 * D_EXPERT), 0.01)
    w_down = nrm(ks[21], (DEPTH, N_EXPERTS, D_EXPERT, D_MODEL), D_EXPERT ** -0.5)
    b_down = nrm(ks[22], (DEPTH, N_EXPERTS, D_MODEL), 0.01)
    final_g = 1.0 + nrm(ks[23], (D_MODEL,), 0.1)
    return {'x': x, 'c': c, 'positions': positions, 'ada_w': ada_w, 'ada_b': ada_b,
            'norm1_g': norm1_g, 'w_in': w_in, 'q_norm_g': q_norm_g, 'w_q_b': w_q_b,
            'kv_norm_g': kv_norm_g, 'w_kv_b': w_kv_b, 'mla_out_g': mla_out_g,
            'conv_w': conv_w, 'A_log': A_log, 'dt_bias': dt_bias, 'gdn_norm_g': gdn_norm_g,
            'w_out': w_out, 'norm2_g': norm2_g, 'router_w': router_w, 'router_b': router_b,
            'w_gate_up': w_gate_up, 'b_gate_up': b_gate_up, 'w_down': w_down,
            'b_down': b_down, 'final_g': final_g}


def reference(x, c, positions, ada_w, ada_b, norm1_g, w_in, q_norm_g, w_q_b, kv_norm_g,
              w_kv_b, mla_out_g, conv_w, A_log, dt_bias, gdn_norm_g, w_out, norm2_g,
              router_w, router_b, w_gate_up, b_gate_up, w_down, b_down, final_g):
    c_act = jax.nn.silu(c)
    for l in range(DEPTH):
        mod = (c_act @ ada_w[l] + ada_b[l])[:, None, :]
        sh1, sc1, gt1, sh2, sc2, gt2 = jnp.split(mod, 6, axis=-1)
        h = rms_norm(x, norm1_g[l]) * (1.0 + sc1) + sh1
        mix = hybrid_mixer(h, positions, w_in[l], q_norm_g[l], w_q_b[l], kv_norm_g[l],
                           w_kv_b[l], mla_out_g[l], conv_w[l], A_log[l], dt_bias[l],
                           gdn_norm_g[l], w_out[l])
        x = x + gt1 * mix
        h = rms_norm(x, norm2_g[l]) * (1.0 + sc2) + sh2
        ffn = moe_ffn(h, router_w[l], router_b[l], w_gate_up[l], b_gate_up[l], w_down[l],
                      b_down[l])
        x = x + gt2 * ffn
    return rms_norm(x, final_g)
```

```cpp
#include <hip/hip_runtime.h>
#include <cstdio>
#include <cstdint>


#define DBG_SUB 0
#ifndef N_LAUNCH_PER_PHASE
#define N_LAUNCH_PER_PHASE 0
#endif

#define GAS __attribute__((address_space(1)))
#define LAS __attribute__((address_space(3)))
typedef unsigned short bf16_t;
typedef short bf16x8 __attribute__((ext_vector_type(8)));
typedef short s16x4 __attribute__((ext_vector_type(4)));
typedef float f32x4 __attribute__((ext_vector_type(4)));
typedef float f32x2 __attribute__((ext_vector_type(2)));
typedef float f32x16 __attribute__((ext_vector_type(16)));
typedef unsigned u32x4 __attribute__((ext_vector_type(4)));
typedef unsigned u32x2 __attribute__((ext_vector_type(2)));
typedef __bf16 bf16x2_t __attribute__((ext_vector_type(2)));

constexpr int BATCH = 8, SEQ = 4096, DM = 1024, T = BATCH * SEQ;
constexpr int NH = 8, QK = 96, NOPE = 64, ROPE = 32, VD = 64, QLORA = 384, KVLORA = 256;
constexpr int GH = 8, GDK = 64, GDV = 64;
constexpr int IN_DIM = 2736, NPROJ = 2816;
constexpr int C_QLAT = 0, C_KVLAT = 384, C_KPE = 640, C_GQ = 672, C_GK = 1184, C_GV = 1696, C_GZ = 2208, C_GA = 2720, C_GB = 2728;
constexpr int NE = 32, TOPK = 4, DE = 1024;
constexpr float EPS = 1e-6f;
constexpr int GC = 32, NCH = SEQ / GC;
constexpr int MAXROWS = T * TOPK + NE * 256;

constexpr size_t MiB = 1u << 20;
constexpr size_t WS_CTL = 0, CTL_BYTES = 1 * MiB;
constexpr size_t WS_MOD = 1 * MiB;
constexpr size_t WS_RSQ = 2 * MiB;
constexpr size_t WS_RSKV = WS_RSQ + 128 * 1024;
constexpr size_t WS_CS = 3 * MiB;
constexpr size_t WS_TKE = 7 * MiB;
constexpr size_t WS_TKW = WS_TKE + 512 * 1024;
constexpr size_t WS_TKP = WS_TKW + 512 * 1024;
constexpr size_t WS_LIST = 9 * MiB;
constexpr size_t WS_RWT = 13 * MiB;
constexpr size_t WS_WIN = 16 * MiB;
constexpr size_t WS_WQ = WS_WIN + (size_t)NPROJ * DM * 2;
constexpr size_t WS_WKV = WS_WQ + (size_t)768 * 384 * 2;
constexpr size_t WS_WO = WS_WKV + (size_t)1024 * 256 * 2;
constexpr size_t WS_WGU = 32 * MiB;
constexpr size_t WS_WDN = WS_WGU + (size_t)NE * 2048 * 1024 * 2;
constexpr size_t WS_H = 224 * MiB;
constexpr size_t WS_X1 = 288 * MiB;
constexpr size_t WS_PROJ = 416 * MiB;
constexpr size_t WS_Q = 592 * MiB;
constexpr size_t WS_K = 640 * MiB;
constexpr size_t WS_V = 688 * MiB;
constexpr size_t WS_OA = 720 * MiB;
constexpr size_t WS_OG = 752 * MiB;
constexpr size_t WS_GD = 784 * MiB;
constexpr size_t WS_ACT = 416 * MiB;
constexpr size_t WS_Y = 688 * MiB;
constexpr size_t WS_END = 976 * MiB;
static_assert(WS_WO + (size_t)1024 * 1024 * 2 <= WS_WGU && WS_WDN + (size_t)NE * 1024 * 1024 * 2 <= WS_H, "weights");
static_assert(WS_ACT + (size_t)MAXROWS * 1024 * 2 <= WS_Y && WS_Y + (size_t)MAXROWS * 1024 * 2 <= WS_END, "moe rows");
static_assert(WS_GD + (size_t)BATCH * GH * NCH * 24576 <= WS_END, "gdn");
constexpr int CW_BAR = 4096;
constexpr int CW_Q = 8192;
constexpr int CW_CNT = 12288;

constexpr int RING_BYTES = 131072;
constexpr int MISC_OFF = RING_BYTES;
constexpr int LDS_BYTES = 147456;

#define LDS_WAIT() asm volatile("s_waitcnt lgkmcnt(0)" ::: "memory")
#define VM_WAIT() asm volatile("s_waitcnt vmcnt(0)" ::: "memory")
#define RLX_AGENT __ATOMIC_RELAXED, __HIP_MEMORY_SCOPE_AGENT

__device__ __forceinline__ unsigned cvtpk(float lo, float hi) { f32x2 v = {lo, hi}; bf16x2_t b = __builtin_convertvector(v, bf16x2_t); return __builtin_bit_cast(unsigned, b); }
__device__ __forceinline__ bf16_t f2bf(float f) { return (bf16_t)(cvtpk(f, 0.f) & 0xffffu); }
__device__ __forceinline__ float bf2f(unsigned short h) { return __uint_as_float((unsigned)h << 16); }
__device__ __forceinline__ float bflo(unsigned w) { return __uint_as_float(w << 16); }
__device__ __forceinline__ float bfhi(unsigned w) { return __uint_as_float(w & 0xffff0000u); }
__device__ __forceinline__ float wave_sum(float v) {
#pragma unroll
    for (int o = 1; o < 64; o <<= 1) v += __shfl_xor(v, o);
    return v;
}
__device__ __forceinline__ float siluf(float x) { return x / (1.f + __expf(-x)); }

#define XB_TMO      128
#define XB_XCNT(j)  (256  + 64 * (j))
#define XB_XSUB(j)  (1280 + 64 * (j))
#define XB_XGEN(j)  (2304 + 64 * (j))
#define XB_TOP      3328
#define XB_TOPGEN   3392
#define XCD_BAR_WORDS 3456
#define XB_SPIN_CAP (1u << 18)
__device__ __forceinline__ unsigned xb_ld(unsigned* p)              { return __hip_atomic_load(p, __ATOMIC_RELAXED, __HIP_MEMORY_SCOPE_AGENT); }
__device__ __forceinline__ unsigned xb_add(unsigned* p, unsigned v) { return __hip_atomic_fetch_add(p, v, __ATOMIC_RELAXED, __HIP_MEMORY_SCOPE_AGENT); }
__device__ __forceinline__ unsigned xb_xcc_id() { return (unsigned)__builtin_amdgcn_s_getreg((3 << 11) | 20) & 0xFu; }
#define XB_SPIN(cond, bar) do { unsigned _sp = 0; while (cond) { __builtin_amdgcn_s_sleep(1); \
    if ((++_sp & 255u) == 0u) { if (xb_ld(&(bar)[XB_TMO])) break; if (_sp > XB_SPIN_CAP) { atomicAdd(&(bar)[XB_TMO], 1u); break; } } } } while (0)
struct XcdBarrier { unsigned* bar; unsigned x; volatile LAS unsigned* st; };
__device__ __forceinline__ XcdBarrier xcd_barrier_post(unsigned* bar, volatile LAS unsigned* st) {
    XcdBarrier b; b.bar = bar; b.x = xb_xcc_id(); b.st = st;
    if (threadIdx.x == 0) (void)xb_add(&bar[XB_XCNT(b.x)], 1u);
    return b;
}
__device__ __forceinline__ void xcd_barrier_complete(unsigned* bar, unsigned x, unsigned& nloc, unsigned& nx) {
    const unsigned G = gridDim.x * gridDim.y * gridDim.z;
    unsigned sum, cnt, mine, sp = 0u;
    for (;;) {
        sum = 0u; cnt = 0u; mine = 0u;
#pragma unroll
        for (unsigned j = 0; j < 16; ++j) { const unsigned c = xb_ld(&bar[XB_XCNT(j)]); sum += c; cnt += (c > 0u) ? 1u : 0u; mine = (j == x) ? c : mine; }
        if (sum == G) break;
        __builtin_amdgcn_s_sleep(1);
        if ((++sp & 255u) == 0u) { if (xb_ld(&bar[XB_TMO])) break; if (sp > XB_SPIN_CAP) { atomicAdd(&bar[XB_TMO], 1u); break; } }
    }
    nloc = mine > 0u ? mine : 1u; nx = cnt > 0u ? cnt : 1u;
}
__device__ __forceinline__ void xcd_barrier(const XcdBarrier& b) {
    asm volatile("s_waitcnt vmcnt(0)" ::: "memory");
    __syncthreads();
    if (threadIdx.x == 0) {
        unsigned* bar = b.bar;
        __builtin_amdgcn_s_waitcnt(0);
        unsigned nloc = b.st[0], nx = b.st[1];
        if (nloc == 0u) { xcd_barrier_complete(bar, b.x, nloc, nx); b.st[0] = nloc; b.st[1] = nx; }
        const unsigned old = xb_add(&bar[XB_XSUB(b.x)], 1u);
        const unsigned gen = old / nloc;
        if (old + 1u == (gen + 1u) * nloc) {
            __builtin_amdgcn_fence(__ATOMIC_RELEASE, "agent");
            asm volatile("s_waitcnt vmcnt(0)" ::: "memory");
            const unsigned og = xb_add(&bar[XB_TOP], 1u);
            const unsigned tg = og / nx;
            if (og + 1u == (tg + 1u) * nx) xb_add(&bar[XB_TOPGEN], 1u);
            else XB_SPIN(xb_ld(&bar[XB_TOPGEN]) == tg, bar);
            __builtin_amdgcn_fence(__ATOMIC_ACQUIRE, "agent");
            xb_add(&bar[XB_XGEN(b.x)], 1u);
            asm volatile("s_waitcnt vmcnt(0)" ::: "memory");
        } else {
            XB_SPIN(xb_ld(&bar[XB_XGEN(b.x)]) == gen, bar);
            __builtin_amdgcn_fence(__ATOMIC_ACQUIRE, "agent");
            asm volatile("s_waitcnt vmcnt(0)" ::: "memory");
        }
    }
    __syncthreads();
}

namespace pg {
constexpr int BM = 256, BK = 64, HALF = 128, HTB = HALF * BK * 2, STAGE_BYTES = 8 * HTB, NXCD = 8, WGM = 8;
__host__ __device__ __forceinline__ int lds_byte(int r, int c) { const int st = (r >> 4) * 2 + (c >> 5), rr = r & 15, cc = c & 31, ob = rr * 64 + cc * 2; return st * 1024 + (ob ^ (((ob >> 9) & 1) << 5)); }
__host__ __device__ __forceinline__ void stage_rc(int b, int& R, int& C) { const int st = b / 1024, sb = b % 1024, swz = sb ^ (((sb >> 9) & 1) << 5); R = (st >> 1) * 16 + swz / 64; C = (st & 1) * 32 + (swz % 64) / 2; }
__host__ __device__ __forceinline__ int perm32(int rho) { const int n = rho >> 4, i = rho & 15; return 8 * (i >> 2) + 4 * n + (i & 3); }

struct Unit { int pm, pn, arow, brow, nvalid, e; };
struct Gemm { const bf16_t* A; const bf16_t* Bt; int lda, K; const int* list; };

struct StaticOrder {
    int nM, nN, nwg, G, c;
    __device__ __forceinline__ void init(int M, int N, int G_, int c_) { nM = M / BM; nN = N / BM; nwg = nM * nN; G = G_; c = c_; }
    __device__ __forceinline__ bool next(int i, Unit& u) const {
        const long L = (long)i * G + c; if (L >= nwg) return false;
        int wgid = (int)L; { const int q = nwg / NXCD, r = nwg % NXCD, xcd = wgid % NXCD, off = wgid / NXCD; wgid = (xcd < r ? xcd * (q + 1) : r * (q + 1) + (xcd - r) * q) + off; }
        const int nig = WGM * nN, gid = wgid / nig, fm = gid * WGM, gsz = (nM - fm) < WGM ? (nM - fm) : WGM;
        u.pm = fm + ((wgid % nig) % gsz); u.pn = (wgid % nig) / gsz; u.arow = u.pm * BM; u.brow = u.pn * BM; u.nvalid = BM; u.e = 0; return true;
    }
};
struct MoeOrder {
    const LAS int* pre;
    const LAS int* cnt;
    int NT, Nrows, G, c, contig;
    __device__ __forceinline__ bool next(int i, Unit& u) const {
        const int xcd = c & 7, j = c >> 3, q = i * (G >> 3) + j, mq = q / NT, nt = q - mq * NT, mt = mq * 8 + xcd;
        if (mt >= pre[32]) return false;
        int e = 0;
#pragma unroll 1
        while (pre[e + 1] <= mt) ++e;
        const int row0 = (mt - pre[e]) * BM;
        u.pm = mt; u.pn = nt; u.e = e; u.nvalid = cnt[e] - row0; u.arow = contig ? mt * BM : row0; u.brow = e * Nrows + nt * BM; return true;
    }
};

template <class Epi, class Sched, bool GATHER, bool ALIGN_EPI>
__device__ __forceinline__ void gemm_phase(LAS unsigned char* lds, const Gemm g, const Sched& S, const Epi& E) {
    const int tid = threadIdx.x, wid = __builtin_amdgcn_readfirstlane(tid >> 6), lane = tid & 63, wr = wid >> 2, wc = wid & 3, fr = lane & 15, fq = lane >> 4;
    const int K = g.K, nt = K / BK, lda = g.lda;
    int Rr[2], Cc[2]; unsigned voffB[2];
#pragma unroll
    for (int i = 0; i < 2; ++i) { int R, C; stage_rc(tid * 16 + i * 8192, R, C); Rr[i] = R; Cc[i] = C; const int Rb = Epi::PERM ? ((R & ~31) + perm32(R & 31)) : R; voffB[i] = (unsigned)(Rb * K + C) * 2u; }
    const size_t kstep = (size_t)(BK * 2);
    const size_t hstep = (size_t)HALF * K * 2;
    const unsigned ldsw = (unsigned)wid * 1024u;
    const int aoff = lds_byte(wr * 64 + fr, fq * 8), boff = lds_byte(wc * 32 + fr, fq * 8);
#define PG_SA(b, h) (((b) * 2 + (h)) * HTB)
#define PG_SB(b, h) ((4 + (b) * 2 + (h)) * HTB)
#define PG_STAGE(bufoff, gbase, voff) do { _Pragma("unroll") for (int _i = 0; _i < 2; ++_i) \
        __builtin_amdgcn_global_load_lds((const unsigned*)((const char*)(gbase) + (voff)[_i]), (LAS unsigned*)(lds + (bufoff) + ldsw + _i * 8192), 16, 0, 0); } while (0)
#define PG_LDA(dst, b, h) do { _Pragma("unroll") for (int m = 0; m < 4; ++m) _Pragma("unroll") for (int k = 0; k < 2; ++k) dst[m][k] = *(const LAS bf16x8*)(lds + PG_SA(b, h) + aoff + m * 2048 + k * 1024); } while (0)
#define PG_LDB(dst, b, h) do { _Pragma("unroll") for (int n = 0; n < 2; ++n) _Pragma("unroll") for (int k = 0; k < 2; ++k) dst[n][k] = *(const LAS bf16x8*)(lds + PG_SB(b, h) + boff + n * 2048 + k * 1024); } while (0)
#define PG_MMA(ai, bj, At, Bt) do { __builtin_amdgcn_s_setprio(1); _Pragma("unroll") for (int m = 0; m < 4; ++m) _Pragma("unroll") for (int n = 0; n < 2; ++n) _Pragma("unroll") for (int k = 0; k < 2; ++k) \
        acc[ai][bj][m][n] = __builtin_amdgcn_mfma_f32_16x16x32_bf16(Bt[n][k], At[m][k], acc[ai][bj][m][n], 0, 0, 0); __builtin_amdgcn_s_setprio(0); } while (0)
#define PG_WAIT_V(n) asm volatile("s_waitcnt vmcnt(" #n ")" ::: "memory")
#define PG_WAIT_L(n) asm volatile("s_waitcnt lgkmcnt(" #n ")" ::: "memory")
#define PG_BAR __builtin_amdgcn_s_barrier()
#define PG_SCHED __builtin_amdgcn_sched_barrier(0)
#define PG_SETA(v, u) do { _Pragma("unroll") for (int _h = 0; _h < 2; ++_h) _Pragma("unroll") for (int _i = 0; _i < 2; ++_i) { const int _r = _h * HALF + Rr[_i]; \
        const int _rr = _r < (u).nvalid ? _r : (u).nvalid - 1; const int _tok = g.list[(size_t)(u).e * T + (u).arow + _rr]; v[_h][_i] = (unsigned)(_tok * lda + Cc[_i]) * 2u; } } while (0)
#define PG_STA(bufoff, kb, h, NX) do { if constexpr (GATHER) { if (NX) PG_STAGE(bufoff, (const char*)g.A + (kb), vN[h]); else PG_STAGE(bufoff, (const char*)g.A + (kb), vA[h]); } \
        else PG_STAGE(bufoff, ((NX) ? nA : cA) + (kb) + (h) * hstepA, voffA); } while (0)
    Unit cur, nxt; int ui = 0;
    if (!S.next(0, cur)) return;
    f32x4 acc[2][2][4][2];
#pragma unroll
    for (int a = 0; a < 2; ++a)
#pragma unroll
        for (int b = 0; b < 2; ++b)
#pragma unroll
            for (int m = 0; m < 4; ++m)
#pragma unroll
                for (int n = 0; n < 2; ++n) acc[a][b][m][n] = (f32x4){0.f, 0.f, 0.f, 0.f};
    bf16x8 At[4][2], B0[2][2], B1[2][2];
    unsigned vA[2][2], vN[2][2], voffA[2];
    const size_t hstepA = (size_t)HALF * lda * 2;
#pragma unroll
    for (int i = 0; i < 2; ++i) voffA[i] = (unsigned)(Rr[i] * lda + Cc[i]) * 2u;
    if constexpr (GATHER) { PG_SETA(vA, cur); PG_WAIT_V(0); }
    const char* cA = (const char*)g.A + (GATHER ? (size_t)0 : (size_t)cur.arow * lda * 2); const char* nA = cA;
    const char* cB = (const char*)g.Bt + (size_t)cur.brow * K * 2;
    PG_STAGE(PG_SB(0, 0), cB, voffB); PG_STAGE(PG_SB(0, 1), cB + hstep, voffB); PG_STA(PG_SA(0, 0), 0, 0, false); PG_STA(PG_SA(0, 1), 0, 1, false);
    if (wr == 1) PG_BAR;
    PG_WAIT_V(2); PG_BAR;
    PG_STAGE(PG_SB(1, 0), cB + kstep, voffB); PG_STA(PG_SA(1, 0), kstep, 0, false); PG_STAGE(PG_SB(1, 1), cB + hstep + kstep, voffB);
    PG_WAIT_V(6); PG_BAR;
    for (;;) {
        const bool has_next = S.next(ui + 1, nxt);
        if constexpr (GATHER) {
            if (has_next) { PG_SETA(vN, nxt); PG_WAIT_V(0); }
            else {
#pragma unroll
                for (int h = 0; h < 2; ++h)
#pragma unroll
                    for (int i = 0; i < 2; ++i) vN[h][i] = vA[h][i]; }
        } else nA = has_next ? (const char*)g.A + (size_t)nxt.arow * lda * 2 : cA;
        const char* nB = has_next ? (const char*)g.Bt + (size_t)nxt.brow * K * 2 : cB;
#pragma unroll 1
        for (int t = 0; t < nt; t += 2) {
            const bool last = (t == nt - 2);
            const size_t k1 = (size_t)(t + 1) * kstep, k2 = last ? (size_t)0 : (size_t)(t + 2) * kstep, k3 = k2 + kstep;
            const char* b2 = last ? nB : cB + (size_t)(t + 2) * kstep; const char* b3 = b2 + kstep;
            PG_LDB(B0, 0, 0); PG_LDB(B1, 0, 1); PG_SCHED; PG_LDA(At, 0, 0); PG_STA(PG_SA(1, 1), k1, 1, false);
            PG_WAIT_V(8); PG_WAIT_L(0); PG_BAR; PG_MMA(0, 0, At, B0); PG_MMA(0, 1, At, B1); PG_BAR; PG_SCHED;
            PG_LDA(At, 0, 1); PG_STAGE(PG_SB(0, 0), b2, voffB); PG_STAGE(PG_SB(0, 1), b2 + hstep, voffB); PG_STA(PG_SA(0, 0), k2, 0, last);
            PG_WAIT_V(8); PG_WAIT_L(0); PG_BAR; PG_MMA(1, 0, At, B0); PG_MMA(1, 1, At, B1); PG_BAR; PG_SCHED;
            PG_LDB(B0, 1, 0); PG_LDB(B1, 1, 1); PG_SCHED; PG_LDA(At, 1, 0); PG_STA(PG_SA(0, 1), k2, 1, last);
            PG_WAIT_V(8); PG_WAIT_L(0); PG_BAR; PG_MMA(0, 0, At, B0); PG_MMA(0, 1, At, B1); PG_BAR; PG_SCHED;
            PG_LDA(At, 1, 1); PG_STAGE(PG_SB(1, 0), b3, voffB); PG_STAGE(PG_SB(1, 1), b3 + hstep, voffB); PG_STA(PG_SA(1, 0), k3, 0, last);
            PG_WAIT_V(8); PG_WAIT_L(0); PG_BAR; PG_MMA(1, 0, At, B0); PG_MMA(1, 1, At, B1); PG_BAR; PG_SCHED;
        }
        if constexpr (ALIGN_EPI) { if (wr == 0) PG_BAR; }
        E(acc, cur, wr, wc, fr, fq);
        if (!has_next) break;
#pragma unroll
        for (int a = 0; a < 2; ++a)
#pragma unroll
            for (int b = 0; b < 2; ++b)
#pragma unroll
                for (int m = 0; m < 4; ++m)
#pragma unroll
                    for (int n = 0; n < 2; ++n) acc[a][b][m][n] = (f32x4){0.f, 0.f, 0.f, 0.f};
        cur = nxt; cB = nB; cA = nA; ++ui;
        if constexpr (GATHER) {
#pragma unroll
            for (int h = 0; h < 2; ++h)
#pragma unroll
                for (int i = 0; i < 2; ++i) vA[h][i] = vN[h][i]; }
        if constexpr (ALIGN_EPI) { if (wr == 1) PG_BAR; }
    }
    PG_WAIT_V(0);
    if constexpr (!ALIGN_EPI) { if (wr == 0) PG_BAR; }
    PG_BAR;
#undef PG_SA
#undef PG_SB
#undef PG_STAGE
#undef PG_LDA
#undef PG_LDB
#undef PG_MMA
#undef PG_WAIT_V
#undef PG_WAIT_L
#undef PG_BAR
#undef PG_SCHED
#undef PG_SETA
#undef PG_STA
}
}

typedef f32x4 AccT[2][2][4][2];
__device__ __forceinline__ u32x4 pack8(f32x4 a, f32x4 b) { u32x4 w; w.x = cvtpk(a[0], a[1]); w.y = cvtpk(a[2], a[3]); w.z = cvtpk(b[0], b[1]); w.w = cvtpk(b[2], b[3]); return w; }

struct EpiProj {
    static constexpr bool PERM = true; bf16_t* O;
    __device__ __forceinline__ void operator()(const AccT& acc, const pg::Unit& u, int wr, int wc, int fr, int fq) const {
        const int row0 = u.pm * 256 + wr * 64 + fr, col0 = u.pn * 256 + wc * 32 + 8 * fq;
#pragma unroll
        for (int ai = 0; ai < 2; ++ai)
#pragma unroll
            for (int m = 0; m < 4; ++m) { bf16_t* rowp = O + (size_t)(row0 + ai * 128 + m * 16) * NPROJ + col0;
#pragma unroll
                for (int bj = 0; bj < 2; ++bj) *(u32x4*)(rowp + bj * 128) = pack8(acc[ai][bj][m][0], acc[ai][bj][m][1]); }
    }
};
struct EpiQ {
    static constexpr bool PERM = true; bf16_t* O; const float* rstd; const float* cs; float scale;
    __device__ __forceinline__ void operator()(const AccT& acc, const pg::Unit& u, int wr, int wc, int fr, int fq) const {
        const int row0 = u.pm * 256 + wr * 64 + fr;
#pragma unroll
        for (int ai = 0; ai < 2; ++ai)
#pragma unroll
            for (int m = 0; m < 4; ++m) { const int row = row0 + ai * 128 + m * 16; const float rs = rstd[row] * scale;
#pragma unroll
                for (int bj = 0; bj < 2; ++bj) { const int G = 8 * u.pn + 4 * bj + wc;
                    f32x4 v0 = acc[ai][bj][m][0] * rs, v1 = acc[ai][bj][m][1] * rs;
                    if ((G % 3) == 2) {
                        f32x4 p0, p1;
#pragma unroll
                        for (int j = 0; j < 4; ++j) { p0[j] = __shfl_xor(v0[j], 32); p1[j] = __shfl_xor(v1[j], 32); }
                        const float* cr = cs + (size_t)row * 32 + 8 * (fq & 1);
                        const f32x4 c0 = *(const f32x4*)cr, c1 = *(const f32x4*)(cr + 4), s0 = *(const f32x4*)(cr + 16), s1 = *(const f32x4*)(cr + 20);
                        if (fq < 2) { v0 = v0 * c0 - p0 * s0; v1 = v1 * c1 - p1 * s1; } else { v0 = v0 * c0 + p0 * s0; v1 = v1 * c1 + p1 * s1; }
                    }
                    *(u32x4*)(O + (size_t)row * 768 + 32 * G + 8 * fq) = pack8(v0, v1); }
                asm volatile("" ::: "memory"); }
    }
};
struct EpiKV {
    static constexpr bool PERM = true; bf16_t* Ko; bf16_t* Vo; const float* rstd;
    __device__ __forceinline__ void operator()(const AccT& acc, const pg::Unit& u, int wr, int wc, int fr, int fq) const {
        const int row0 = u.pm * 256 + wr * 64 + fr;
#pragma unroll
        for (int ai = 0; ai < 2; ++ai)
#pragma unroll
            for (int m = 0; m < 4; ++m) { const int row = row0 + ai * 128 + m * 16; const float rs = rstd[row];
#pragma unroll
                for (int bj = 0; bj < 2; ++bj) { const int G = 8 * u.pn + 4 * bj + wc, head = G >> 2, sub = G & 3;
                    bf16_t* dst = (sub < 2) ? Ko + (size_t)row * 768 + head * 96 + 32 * sub + 8 * fq : Vo + (size_t)row * 512 + head * 64 + 32 * (sub - 2) + 8 * fq;
                    *(u32x4*)dst = pack8(acc[ai][bj][m][0] * rs, acc[ai][bj][m][1] * rs); } }
    }
};
struct EpiX1 {
    static constexpr bool PERM = false; const float* x; const float* mod; float* O;
    __device__ __forceinline__ void operator()(const AccT& acc, const pg::Unit& u, int wr, int wc, int fr, int fq) const {
        const int row0 = u.pm * 256 + wr * 64 + fr, col0 = u.pn * 256 + wc * 32 + 4 * fq;
        const float* gt = mod + (size_t)(u.pm * 256 / SEQ) * 6144 + 2048 + col0;
        f32x4 gv[2][2];
#pragma unroll
        for (int bj = 0; bj < 2; ++bj)
#pragma unroll
            for (int n = 0; n < 2; ++n) gv[bj][n] = *(const f32x4*)(gt + bj * 128 + n * 16);
#pragma unroll
        for (int ai = 0; ai < 2; ++ai)
#pragma unroll
            for (int m = 0; m < 4; ++m) { const size_t off = (size_t)(row0 + ai * 128 + m * 16) * DM + col0;
#pragma unroll
                for (int bj = 0; bj < 2; ++bj)
#pragma unroll
                    for (int n = 0; n < 2; ++n) { const f32x4 xv = *(const f32x4*)(x + off + bj * 128 + n * 16); *(f32x4*)(O + off + bj * 128 + n * 16) = xv + gv[bj][n] * acc[ai][bj][m][n]; } }
    }
};
struct EpiGU {
    static constexpr bool PERM = true; bf16_t* O; const float* bias;
    __device__ __forceinline__ void operator()(const AccT& acc, const pg::Unit& u, int wr, int wc, int fr, int fq) const {
        const int row0 = u.pm * 256 + wr * 64 + fr, gcol = u.pn * 128 + wc * 32 + 8 * fq;
        const float* bp = bias + (size_t)u.e * 2048 + gcol;
        const f32x4 bg0 = *(const f32x4*)bp, bg1 = *(const f32x4*)(bp + 4), bu0 = *(const f32x4*)(bp + 1024), bu1 = *(const f32x4*)(bp + 1028);
#pragma unroll
        for (int ai = 0; ai < 2; ++ai)
#pragma unroll
            for (int m = 0; m < 4; ++m) {
                f32x4 r[2];
#pragma unroll
                for (int n = 0; n < 2; ++n) { const f32x4 g4 = acc[ai][0][m][n] + (n ? bg1 : bg0), u4 = acc[ai][1][m][n] + (n ? bu1 : bu0);
#pragma unroll
                    for (int j = 0; j < 4; ++j) { const float g = fminf(g4[j], 7.0f), up = fminf(fmaxf(u4[j], -7.0f), 7.0f);
                        r[n][j] = (up + 1.0f) * g * __builtin_amdgcn_rcpf(1.0f + __expf(-1.702f * g)); } }
                *(u32x4*)(O + (size_t)(row0 + ai * 128 + m * 16) * DE + gcol) = pack8(r[0], r[1]); }
    }
};
struct EpiDN {
    static constexpr bool PERM = true; bf16_t* O; const float* bias;
    __device__ __forceinline__ void operator()(const AccT& acc, const pg::Unit& u, int wr, int wc, int fr, int fq) const {
        const int row0 = u.pm * 256 + wr * 64 + fr, col0 = u.pn * 256 + wc * 32 + 8 * fq;
        const float* bp = bias + (size_t)u.e * DM + col0;
        f32x4 bv[2][2];
#pragma unroll
        for (int bj = 0; bj < 2; ++bj) { bv[bj][0] = *(const f32x4*)(bp + bj * 128); bv[bj][1] = *(const f32x4*)(bp + bj * 128 + 4); }
#pragma unroll
        for (int ai = 0; ai < 2; ++ai)
#pragma unroll
            for (int m = 0; m < 4; ++m) { bf16_t* rowp = O + (size_t)(row0 + ai * 128 + m * 16) * DM + col0;
#pragma unroll
                for (int bj = 0; bj < 2; ++bj) *(u32x4*)(rowp + bj * 128) = pack8(acc[ai][bj][m][0] + bv[bj][0], acc[ai][bj][m][1] + bv[bj][1]); }
    }
};

constexpr int NWAVES = 8;
enum { IN_X = 0, IN_C, IN_POS, IN_ADAW, IN_ADAB, IN_N1G, IN_WIN, IN_QNG, IN_WQB, IN_KVNG, IN_WKVB, IN_MLAOG, IN_CONVW, IN_ALOG, IN_DTB, IN_GDNG, IN_WOUT, IN_N2G, IN_RW, IN_RB, IN_WGU, IN_BGU, IN_WDN, IN_BDN, IN_FG, N_IN };
struct Frame {
    LAS unsigned char* lds; volatile LAS unsigned* MISC; unsigned* ctl; unsigned char* ws;
    int tid, lane, wave, G, vcu;
    const float* in[N_IN]; float* out;
};
#define WSP(T_, off) ((T_*)(F.ws + (off)))

__device__ __forceinline__ void p0_mod(Frame& F) {
    LAS float* cact = (LAS float*)F.lds;
    LAS float* red = (LAS float*)(F.lds + 32768);
    if ((int)blockIdx.x >= 96) return;
    const float* c = F.in[IN_C];
    for (int i = F.tid; i < BATCH * DM; i += NWAVES * 64) cact[i] = siluf(c[i]);
    __syncthreads();
    float* mod = WSP(float, WS_MOD);
    for (int it = blockIdx.x; it < 96; it += F.G) {
        const int j = it * 64 + F.lane; float a[8];
#pragma unroll
        for (int b = 0; b < 8; ++b) a[b] = 0.f;
        const float* w = F.in[IN_ADAW] + j;
#pragma unroll 4
        for (int k = F.wave * 128; k < F.wave * 128 + 128; ++k) { const float wv = w[(size_t)k * 6144];
#pragma unroll
            for (int b = 0; b < 8; ++b) a[b] += cact[b * DM + k] * wv; }
#pragma unroll
        for (int b = 0; b < 8; ++b) red[(F.wave * 8 + b) * 64 + F.lane] = a[b];
        __syncthreads();
        { const int b = F.tid >> 6, col = F.tid & 63; float s = 0.f;
#pragma unroll
          for (int w8 = 0; w8 < 8; ++w8) s += red[(w8 * 8 + b) * 64 + col];
          mod[b * 6144 + it * 64 + col] = s + F.in[IN_ADAB][it * 64 + col]; }
        __syncthreads();
    }
}
template <int MAP>
__device__ __forceinline__ void p0_tr_item(const float* W, int K, int N, int NP, bf16_t* WT, const float* ksc, LAS float* scr, int item, int lane) {
    const int nblk = NP / 32, kb = item / nblk, nb = item % nblk, k0 = 64 * kb, n0 = 32 * nb;
    const int nn = n0 + (lane & 31);
#pragma unroll 8
    for (int i = 0; i < 32; ++i) { const int kk = 2 * i + (lane >> 5); float v = (nn < N) ? W[(size_t)(k0 + kk) * N + nn] : 0.f; if (ksc) v *= ksc[k0 + kk]; scr[kk * 33 + (lane & 31)] = v; }
    LDS_WAIT(); asm volatile("" ::: "memory");
    const int c = lane & 7;
#pragma unroll
    for (int j = 0; j < 4; ++j) { const int n = (lane >> 3) + 8 * j; const LAS float* s = scr + (8 * c) * 33 + n;
        u32x4 o; o.x = cvtpk(s[0 * 33], s[1 * 33]); o.y = cvtpk(s[2 * 33], s[3 * 33]); o.z = cvtpk(s[4 * 33], s[5 * 33]); o.w = cvtpk(s[6 * 33], s[7 * 33]);
        int dn = n0 + n;
        if (MAP == 1) { const int half = dn >> 10, r = dn & 1023; dn = ((r >> 7) << 8) + (half << 7) + (r & 127); }
        *(GAS u32x4*)(WT + (size_t)dn * K + k0 + 8 * c) = o; }
    LDS_WAIT(); asm volatile("" ::: "memory");
}
__device__ __forceinline__ void p0_weights(Frame& F) {
    LAS float* scr = (LAS float*)(F.lds + 49152 + F.wave * 8704);
    const int gw = F.vcu * NWAVES + F.wave, NGW = F.G * NWAVES;
    constexpr int I_IN = (DM / 64) * (NPROJ / 32), I_Q = (QLORA / 64) * (768 / 32), I_KV = (KVLORA / 64) * (1024 / 32), I_O = (DM / 64) * (DM / 32);
    constexpr int I_GU = (DM / 64) * (2048 / 32), I_DN = (DE / 64) * (DM / 32);
    constexpr int NITEMS = I_IN + I_Q + I_KV + I_O + NE * I_GU + NE * I_DN;
    for (int it = gw; it < NITEMS; it += NGW) {
        int r = it;
        if (r < I_IN) { p0_tr_item<0>(F.in[IN_WIN], DM, IN_DIM, NPROJ, WSP(bf16_t, WS_WIN), nullptr, scr, r, F.lane); continue; } r -= I_IN;
        if (r < I_Q) { p0_tr_item<0>(F.in[IN_WQB], QLORA, 768, 768, WSP(bf16_t, WS_WQ), F.in[IN_QNG], scr, r, F.lane); continue; } r -= I_Q;
        if (r < I_KV) { p0_tr_item<0>(F.in[IN_WKVB], KVLORA, 1024, 1024, WSP(bf16_t, WS_WKV), F.in[IN_KVNG], scr, r, F.lane); continue; } r -= I_KV;
        if (r < I_O) { p0_tr_item<0>(F.in[IN_WOUT], DM, DM, DM, WSP(bf16_t, WS_WO), nullptr, scr, r, F.lane); continue; } r -= I_O;
        if (r < NE * I_GU) { const int e = r / I_GU; p0_tr_item<1>(F.in[IN_WGU] + (size_t)e * DM * 2048, DM, 2048, 2048, WSP(bf16_t, WS_WGU) + (size_t)e * 2048 * DM, nullptr, scr, r - e * I_GU, F.lane); continue; } r -= NE * I_GU;
        { const int e = r / I_DN; p0_tr_item<0>(F.in[IN_WDN] + (size_t)e * DE * DM, DE, DM, DM, WSP(bf16_t, WS_WDN) + (size_t)e * DM * DE, nullptr, scr, r - e * I_DN, F.lane); }
    }
    float* rwt = WSP(float, WS_RWT);
    for (int i = (int)blockIdx.x * NWAVES * 64 + F.tid; i < NE * DM; i += F.G * NWAVES * 64) { const int e = i >> 10, k = i & 1023; rwt[i] = F.in[IN_RW][k * NE + e]; }
}

__device__ __forceinline__ void norm_rows(Frame& F, const float* x, const float* gain, int SH, int SC, bf16_t* outp) {
    const int gw = F.vcu * NWAVES + F.wave, NGW = F.G * NWAVES;
    const float* mod = WSP(float, WS_MOD);
    for (int m = gw; m < T; m += NGW) {
        const f32x4* xr = (const f32x4*)(x + (size_t)m * DM) + F.lane; const float* mb = mod + (size_t)(m / SEQ) * 6144;
        f32x4 v[4]; float s = 0.f;
#pragma unroll
        for (int j = 0; j < 4; ++j) { v[j] = xr[64 * j]; s += (v[j][0] * v[j][0] + v[j][1] * v[j][1]) + (v[j][2] * v[j][2] + v[j][3] * v[j][3]); }
        const float rstd = __builtin_amdgcn_rsqf(wave_sum(s) * (1.f / DM) + EPS);
        u32x2* o8 = (u32x2*)(outp + (size_t)m * DM) + F.lane;
#pragma unroll
        for (int j = 0; j < 4; ++j) { const int col = 4 * (F.lane + 64 * j);
            const f32x4 g = *(const f32x4*)(gain + col), sc = *(const f32x4*)(mb + SC + col), sh = *(const f32x4*)(mb + SH + col);
            const f32x4 h = v[j] * rstd * g * (sc + 1.0f) + sh; u32x2 w; w.x = cvtpk(h[0], h[1]); w.y = cvtpk(h[2], h[3]); o8[64 * j] = w; }
    }
}

__device__ const float ROPE_INVF[16] = {1.0f, 0.5623413251903491f, 0.31622776601683794f, 0.1778279410038923f, 0.1f, 0.05623413251903491f, 0.03162277660168379f, 0.01778279410038923f,
    0.01f, 0.005623413251903491f, 0.003162277660168379f, 0.0017782794100389228f, 0.001f, 0.0005623413251903491f, 0.00031622776601683794f, 0.00017782794100389227f};
__device__ __forceinline__ float ssq8(u32x4 a) { float s = 0.f;
#pragma unroll
    for (int i = 0; i < 4; ++i) { const float lo = bflo(a[i]), hi = bfhi(a[i]); s += lo * lo + hi * hi; } return s; }
__device__ __forceinline__ void p3a_rows(Frame& F) {
    const int gw = F.vcu * NWAVES + F.wave, NGW = F.G * NWAVES, lane = F.lane;
    const bf16_t* proj = WSP(bf16_t, WS_PROJ); float* rsq = WSP(float, WS_RSQ); float* rskv = WSP(float, WS_RSKV); float* cs = WSP(float, WS_CS); bf16_t* Kb = WSP(bf16_t, WS_K);
    const int* pos = (const int*)F.in[IN_POS];
    for (int m = gw; m < T; m += NGW) {
        const u32x4* pr = (const u32x4*)(proj + (size_t)m * NPROJ);
        const u32x4 a = pr[lane]; u32x4 b = (u32x4){0u, 0u, 0u, 0u}; if (lane < 20) b = pr[64 + lane];
        const float sa = ssq8(a), sb = ssq8(b);
        const float sq = wave_sum(lane < 48 ? sa : 0.f), skv = wave_sum((lane >= 48 ? sa : 0.f) + (lane < 16 ? sb : 0.f));
        if (lane == 0) { rsq[m] = __builtin_amdgcn_rsqf(sq * (1.f / QLORA) + EPS); rskv[m] = __builtin_amdgcn_rsqf(skv * (1.f / KVLORA) + EPS); }
        const float ang = (float)pos[m] * ROPE_INVF[lane & 15];
        const double rev = (double)ang * 0.15915494309189535; const float fr = (float)(rev - __builtin_rint(rev));
        const float cv = __builtin_amdgcn_cosf(fr), sv = __builtin_amdgcn_sinf(fr);
        if (lane < 16) { cs[(size_t)m * 32 + lane] = cv; cs[(size_t)m * 32 + 16 + lane] = sv; }
        float xv[8], pv[8], cc[8], ss[8];
#pragma unroll
        for (int i = 0; i < 4; ++i) { xv[2 * i] = bflo(b[i]); xv[2 * i + 1] = bfhi(b[i]); }
        const int i0 = 8 * (lane & 1);
#pragma unroll
        for (int j = 0; j < 8; ++j) { pv[j] = __shfl_xor(xv[j], 2); cc[j] = __shfl(cv, i0 + j); ss[j] = __shfl(sv, i0 + j); }
        if (lane >= 16 && lane < 20) {
            float o[8];
#pragma unroll
            for (int j = 0; j < 8; ++j) o[j] = (lane < 18) ? xv[j] * cc[j] - pv[j] * ss[j] : xv[j] * cc[j] + pv[j] * ss[j];
            u32x4 w; w.x = cvtpk(o[0], o[1]); w.y = cvtpk(o[2], o[3]); w.z = cvtpk(o[4], o[5]); w.w = cvtpk(o[6], o[7]);
#pragma unroll
            for (int h = 0; h < NH; ++h) *(u32x4*)(Kb + (size_t)m * 768 + h * 96 + 64 + 8 * (lane - 16)) = w;
        }
    }
}

__device__ __forceinline__ int crow(int r, int hi) { return (r & 3) + 8 * (r >> 2) + 4 * hi; }
typedef short v4i16_t __attribute__((ext_vector_type(4)));
constexpr int AT_KROW = 208, AT_VROW = 144, AT_KBUF = 64 * AT_KROW, AT_VBUF = 64 * AT_VROW, AT_V0 = 2 * AT_KBUF, AT_WS = AT_V0 + 2 * AT_VBUF;
__device__ __forceinline__ void attn_unit(Frame& F, int b, int h, int qb) {
    const int tid = F.tid, lane = F.lane, wid = F.wave, r32 = lane & 31, hi = lane >> 5;
    const bf16_t* Qg = WSP(bf16_t, WS_Q); const bf16_t* Kg = WSP(bf16_t, WS_K); const bf16_t* Vg = WSP(bf16_t, WS_V); bf16_t* Og = WSP(bf16_t, WS_OA);
    LAS unsigned char* Kl = F.lds; LAS unsigned char* Vl = F.lds + AT_V0; LAS float* wsf = (LAS float*)(F.lds + AT_WS) + wid * 64;
    const size_t tb = (size_t)b * SEQ; const int q0 = qb * 256, NT = 4 * qb + 4;
    bf16x8 qr[6];
    { const bf16_t* Qp = Qg + (tb + q0 + wid * 32 + r32) * 768 + h * 96 + hi * 8;
#pragma unroll
      for (int d0 = 0; d0 < 6; ++d0) qr[d0] = *(const bf16x8*)(Qp + d0 * 16); }
    const int kr0 = tid / 12, kc0 = tid % 12, kr1 = (tid + 512) / 12, kc1 = (tid + 512) % 12, vr = tid >> 3, vc = tid & 7;
    const bf16_t* kp0 = Kg + (tb + kr0) * 768 + h * 96 + 8 * kc0; const bf16_t* kp1 = Kg + (tb + kr1) * 768 + h * 96 + 8 * kc1; const bf16_t* vp = Vg + (tb + vr) * 512 + h * 64 + 8 * vc;
    u32x4 kreg0, kreg1 = (u32x4){0u, 0u, 0u, 0u}, vreg;
#define AT_LOAD(t) do { kreg0 = *(const u32x4*)(kp0 + (size_t)(t) * 64 * 768); if (tid < 256) kreg1 = *(const u32x4*)(kp1 + (size_t)(t) * 64 * 768); vreg = *(const u32x4*)(vp + (size_t)(t) * 64 * 512); } while (0)
#define AT_STORE(bf) do { *(LAS u32x4*)(Kl + (bf) * AT_KBUF + kr0 * AT_KROW + kc0 * 16) = kreg0; if (tid < 256) *(LAS u32x4*)(Kl + (bf) * AT_KBUF + kr1 * AT_KROW + kc1 * 16) = kreg1; \
        *(LAS u32x4*)(Vl + (bf) * AT_VBUF + vr * AT_VROW + vc * 16) = vreg; } while (0)
    AT_LOAD(0); AT_STORE(0); __syncthreads();
    float m_run = -INFINITY, l_run = 0.f; f32x16 o[2];
#pragma unroll
    for (int r = 0; r < 16; ++r) { o[0][r] = 0.f; o[1][r] = 0.f; }
    const int qmax = q0 + wid * 32 + 31, qpos = q0 + wid * 32 + r32;
    for (int t = 0; t < NT; ++t) {
        const int bf = t & 1;
        if (t + 1 < NT) AT_LOAD(t + 1);
        if (64 * t <= qmax) {
            f32x16 p0, p1;
#pragma unroll
            for (int r = 0; r < 16; ++r) { p0[r] = 0.f; p1[r] = 0.f; }
            const LAS unsigned char* kb = Kl + bf * AT_KBUF + r32 * AT_KROW + hi * 16;
#pragma unroll
            for (int d0 = 0; d0 < 6; ++d0) { const bf16x8 k0 = *(const LAS bf16x8*)(kb + d0 * 32), k1 = *(const LAS bf16x8*)(kb + 32 * AT_KROW + d0 * 32);
                p0 = __builtin_amdgcn_mfma_f32_32x32x16_bf16(k0, qr[d0], p0, 0, 0, 0); p1 = __builtin_amdgcn_mfma_f32_32x32x16_bf16(k1, qr[d0], p1, 0, 0, 0); }
            if (t >= NT - 4) {
#pragma unroll
                for (int r = 0; r < 16; ++r) { const int kv = 64 * t + crow(r, hi); if (kv > qpos) p0[r] = -INFINITY; if (kv + 32 > qpos) p1[r] = -INFINITY; }
            }
            float mx = fmaxf(p0[0], p1[0]);
#pragma unroll
            for (int r = 1; r < 16; ++r) mx = fmaxf(mx, fmaxf(p0[r], p1[r]));
            mx = fmaxf(mx, __shfl_xor(mx, 32));
            const float m_new = fmaxf(m_run, mx);
            if (__any(m_new > m_run)) {
                const float f = __builtin_amdgcn_exp2f(m_run - m_new);
                l_run *= f; m_run = m_new;
                if (hi == 0) wsf[r32] = f;
                float fr_[16];
#pragma unroll
                for (int r = 0; r < 16; ++r) fr_[r] = wsf[crow(r, hi)];
#pragma unroll
                for (int r = 0; r < 16; ++r) { o[0][r] *= fr_[r]; o[1][r] *= fr_[r]; }
            }
            float rs = 0.f;
#pragma unroll
            for (int r = 0; r < 16; ++r) { p0[r] = __builtin_amdgcn_exp2f(p0[r] - m_run); p1[r] = __builtin_amdgcn_exp2f(p1[r] - m_run); rs += p0[r] + p1[r]; }
            l_run += rs;
            bf16x8 pa[4];
#pragma unroll
            for (int ks = 0; ks < 4; ++ks) { u32x4 w;
#pragma unroll
                for (int i = 0; i < 4; ++i) { const int r = (ks & 1) * 8 + 2 * i; w[i] = (ks < 2) ? cvtpk(p0[r], p0[r + 1]) : cvtpk(p1[r], p1[r + 1]); }
                pa[ks] = __builtin_bit_cast(bf16x8, w); }
            const LAS unsigned char* vb = Vl + bf * AT_VBUF + (4 * hi + ((lane & 15) >> 2)) * AT_VROW + (((lane >> 4) & 1) * 16 + (lane & 3) * 4) * 2;
#pragma unroll
            for (int d0 = 0; d0 < 2; ++d0)
#pragma unroll
                for (int ks = 0; ks < 4; ++ks) {
                    const v4i16_t lo = __builtin_amdgcn_ds_read_tr16_b64_v4i16((LAS v4i16_t*)(vb + ks * 16 * AT_VROW + d0 * 64));
                    const v4i16_t hv = __builtin_amdgcn_ds_read_tr16_b64_v4i16((LAS v4i16_t*)(vb + ks * 16 * AT_VROW + 8 * AT_VROW + d0 * 64));
                    const bf16x8 vf = (bf16x8){lo[0], lo[1], lo[2], lo[3], hv[0], hv[1], hv[2], hv[3]};
                    o[d0] = __builtin_amdgcn_mfma_f32_32x32x16_bf16(pa[ks], vf, o[d0], 0, 0, 0); }
        }
        if (t + 1 < NT) AT_STORE((t + 1) & 1);
        __syncthreads();
    }
    { float lt = l_run + __shfl_xor(l_run, 32);
      if (hi == 0) wsf[32 + r32] = lt;
      bf16_t* Ow = Og + (tb + q0 + wid * 32) * 512 + h * 64 + r32;
#pragma unroll
      for (int r = 0; r < 16; ++r) { const int qr_ = crow(r, hi); const float inv = 1.0f / wsf[32 + qr_];
          Ow[(size_t)qr_ * 512] = f2bf(o[0][r] * inv); Ow[(size_t)qr_ * 512 + 32] = f2bf(o[1][r] * inv); } }
#undef AT_LOAD
#undef AT_STORE
}

__device__ __forceinline__ void p4b_rows(Frame& F) {
    const int gw = F.vcu * NWAVES + F.wave, NGW = F.G * NWAVES, lane = F.lane;
    const bf16_t* oa = WSP(bf16_t, WS_OA); const bf16_t* og = WSP(bf16_t, WS_OG); const bf16_t* proj = WSP(bf16_t, WS_PROJ); bf16_t* mx = WSP(bf16_t, WS_H);
    const float* ga = F.in[IN_MLAOG] + 8 * lane; const float* gg = F.in[IN_GDNG] + 8 * (lane & 7);
    for (int m = gw; m < T; m += NGW) {
        const u32x4 a = *(const u32x4*)(oa + (size_t)m * 512 + 8 * lane), g = *(const u32x4*)(og + (size_t)m * 512 + 8 * lane), z = *(const u32x4*)(proj + (size_t)m * NPROJ + C_GZ + 8 * lane);
        const float ra = __builtin_amdgcn_rsqf(wave_sum(ssq8(a)) * (1.f / 512) + EPS);
        float sg = ssq8(g); sg += __shfl_xor(sg, 1); sg += __shfl_xor(sg, 2); sg += __shfl_xor(sg, 4);
        const float rg = __builtin_amdgcn_rsqf(sg * (1.f / 64) + EPS);
        float oa8[8], og8[8];
#pragma unroll
        for (int i = 0; i < 4; ++i) { oa8[2 * i] = bflo(a[i]) * ra * ga[2 * i]; oa8[2 * i + 1] = bfhi(a[i]) * ra * ga[2 * i + 1];
            og8[2 * i] = bflo(g[i]) * rg * gg[2 * i] * siluf(bflo(z[i])); og8[2 * i + 1] = bfhi(g[i]) * rg * gg[2 * i + 1] * siluf(bfhi(z[i])); }
        u32x4 wa, wg;
#pragma unroll
        for (int i = 0; i < 4; ++i) { wa[i] = cvtpk(oa8[2 * i], oa8[2 * i + 1]); wg[i] = cvtpk(og8[2 * i], og8[2 * i + 1]); }
        *(u32x4*)(mx + (size_t)m * DM + 8 * lane) = wa; *(u32x4*)(mx + (size_t)m * DM + 512 + 8 * lane) = wg;
    }
}

constexpr int G1_KRM = 0, G1_QRM = 4608, G1_AM = 9216, G1_QK = 13440, G1_UT = 16000, G1_WT = 21120, G1_KT = 26240, G1_GT = 31360, G1_SLOT = 32000, G1_CW = 4 * G1_SLOT;
static_assert(G1_CW + 3072 <= RING_BYTES, "G1 LDS");
__device__ __forceinline__ f32x4 mfma16(bf16x8 a, bf16x8 b, f32x4 c) { return __builtin_amdgcn_mfma_f32_16x16x32_bf16(a, b, c, 0, 0, 0); }

__device__ __forceinline__ void g1_unit(Frame& F, int unit) {
    const int tid = F.tid, lane = F.lane, wid = F.wave;
    const int bh = unit >> 5, c0 = (unit & 31) * 4, b = bh >> 3, h = bh & 7;
    const bf16_t* proj = WSP(bf16_t, WS_PROJ);
    LAS unsigned char* L = F.lds; LAS float* cw = (LAS float*)(L + G1_CW);
    const size_t tb = (size_t)b * SEQ;
    for (int i = tid; i < 768; i += NWAVES * 64) { const int x = i >> 8, w = (i >> 6) & 3, ch = i & 63; cw[i] = F.in[IN_CONVW][w * 1536 + x * 512 + h * 64 + ch]; }
    __syncthreads();
    { const int tk = tid >> 2, part = tid & 3, s = tk >> 5, i = tk & 31, isk = part >> 1, chb = (part & 1) * 32;
      const int sp = (c0 + s) * GC + i;
      const bf16_t* src = proj + (tb + sp) * NPROJ + (isk ? C_GK : C_GQ) + h * 64 + chb;
      float v[32];
#pragma unroll
      for (int c = 0; c < 32; ++c) v[c] = 0.f;
#pragma unroll
      for (int w = 0; w < 4; ++w) { if (sp - 3 + w >= 0) { const bf16_t* rp = src - (ptrdiff_t)(3 - w) * NPROJ;
#pragma unroll
          for (int q4 = 0; q4 < 4; ++q4) { const u32x4 d = *(const u32x4*)(rp + 8 * q4);
#pragma unroll
              for (int e = 0; e < 4; ++e) { const int ch = 8 * q4 + 2 * e; v[ch] += bflo(d[e]) * cw[(isk * 4 + w) * 64 + chb + ch]; v[ch + 1] += bfhi(d[e]) * cw[(isk * 4 + w) * 64 + chb + ch + 1]; } } } }
      float ss = 0.f;
#pragma unroll
      for (int c = 0; c < 32; ++c) { v[c] = siluf(v[c]); ss += v[c] * v[c]; }
      ss += __shfl_xor(ss, 1);
      const float rn = __builtin_amdgcn_rsqf(ss + EPS) * (isk ? 1.0f : 0.125f);
      LAS bf16_t* dst = (LAS bf16_t*)(L + s * G1_SLOT + (isk ? G1_KRM : G1_QRM)) + i * 72 + chb;
#pragma unroll
      for (int q4 = 0; q4 < 4; ++q4) { u32x4 w;
#pragma unroll
          for (int e = 0; e < 4; ++e) w[e] = cvtpk(v[8 * q4 + 2 * e] * rn, v[8 * q4 + 2 * e + 1] * rn);
          *(LAS u32x4*)(dst + 8 * q4) = w; }
      if (part == 0) { LAS float* gt = (LAS float*)(L + s * G1_SLOT + G1_GT);
          const float ain = bf2f(proj[(tb + sp) * NPROJ + C_GA + h]), bin = bf2f(proj[(tb + sp) * NPROJ + C_GB + h]);
          const float xs = ain + F.in[IN_DTB][h], sp_ = xs > 20.f ? xs : log1pf(__expf(xs));
          gt[i] = 1.0f / (1.0f + __expf(-bin));
          gt[32 + i] = -__expf(F.in[IN_ALOG][h]) * sp_; }
    }
    __syncthreads();
    if (tid < 4) { LAS float* gt = (LAS float*)(L + tid * G1_SLOT + G1_GT); float cum = 0.f;
        for (int i = 0; i < 32; ++i) { cum += gt[32 + i]; gt[64 + i] = cum; }
        for (int i = 0; i < 32; ++i) { gt[96 + i] = __expf(gt[64 + i]); gt[128 + i] = __expf(cum - gt[64 + i]); } }
    __syncthreads();
    const int s = wid >> 1, sub = wid & 1, l15 = lane & 15, kq = lane >> 4;
    LAS unsigned char* Ls = L + s * G1_SLOT; LAS float* gt = (LAS float*)(Ls + G1_GT);
    { const LAS bf16_t* X = (const LAS bf16_t*)(Ls + (sub ? G1_QRM : G1_KRM)); const LAS bf16_t* Kr = (const LAS bf16_t*)(Ls + G1_KRM);
#pragma unroll
      for (int it = 0; it < 2; ++it)
#pragma unroll
          for (int jt = 0; jt < 2; ++jt) { f32x4 acc = (f32x4){0.f, 0.f, 0.f, 0.f};
#pragma unroll
              for (int ks = 0; ks < 2; ++ks) acc = mfma16(*(const LAS bf16x8*)(X + (16 * it + l15) * 72 + 32 * ks + 8 * kq), *(const LAS bf16x8*)(Kr + (16 * jt + l15) * 72 + 32 * ks + 8 * kq), acc);
              const int j = 16 * jt + l15; const float gj = gt[64 + j];
#pragma unroll
              for (int r = 0; r < 4; ++r) { const int i = 16 * it + 4 * kq + r; const float gi = gt[64 + i];
                  if (sub == 0) { const float val = (i > j) ? acc[r] * gt[i] * __expf(gi - gj) : 0.f; ((LAS float*)(Ls + G1_AM))[i * 33 + j] = val; }
                  else { const float val = (i >= j) ? acc[r] * __expf(gi - gj) : 0.f; ((LAS bf16_t*)(Ls + G1_QK))[i * 40 + j] = f2bf(val); } } }
    }
    for (int idx = tid; idx < 4 * 64 * 32; idx += NWAVES * 64) { const int s2 = idx >> 11, d = (idx >> 5) & 63, c = idx & 31; LAS unsigned char* L2 = L + s2 * G1_SLOT;
        ((LAS bf16_t*)(L2 + G1_KT))[d * 40 + c] = f2bf(bf2f(((const LAS bf16_t*)(L2 + G1_KRM))[c * 72 + d]) * ((const LAS float*)(L2 + G1_GT))[128 + c]); }
    __syncthreads();
    { float sol[32];
      if (sub == 0) {
          const int sp0 = (c0 + s) * GC; const bf16_t* src = proj + (tb + sp0) * NPROJ + C_GV + h * 64 + lane;
          const float w0 = cw[(8 + 0) * 64 + lane], w1 = cw[(8 + 1) * 64 + lane], w2 = cw[(8 + 2) * 64 + lane], w3 = cw[(8 + 3) * 64 + lane];
          float x0 = (sp0 >= 3) ? bf2f(src[-3 * (ptrdiff_t)NPROJ]) : 0.f, x1 = (sp0 >= 2) ? bf2f(src[-2 * (ptrdiff_t)NPROJ]) : 0.f, x2 = (sp0 >= 1) ? bf2f(src[-1 * (ptrdiff_t)NPROJ]) : 0.f;
#pragma unroll
          for (int i = 0; i < 32; ++i) { const float x3 = bf2f(src[(size_t)i * NPROJ]); sol[i] = siluf(w0 * x0 + w1 * x1 + w2 * x2 + w3 * x3) * gt[i]; x0 = x1; x1 = x2; x2 = x3; }
      } else {
          const LAS bf16_t* Kr = (const LAS bf16_t*)(Ls + G1_KRM);
#pragma unroll
          for (int i = 0; i < 32; ++i) sol[i] = bf2f(Kr[i * 72 + lane]) * gt[i] * gt[96 + i];
      }
      const LAS float* Am = (const LAS float*)(Ls + G1_AM);
#pragma unroll
      for (int i = 1; i < 32; ++i) { const float arow = Am[i * 33 + (lane & 31)]; float a = sol[i];
#pragma unroll
          for (int j = 0; j < i; ++j) a -= __uint_as_float(__builtin_amdgcn_readlane(__float_as_uint(arow), j)) * sol[j];
          sol[i] = a; }
      LAS bf16_t* dst = (LAS bf16_t*)(Ls + (sub ? G1_WT : G1_UT)) + lane * 40;
#pragma unroll
      for (int q4 = 0; q4 < 4; ++q4) { u32x4 w;
#pragma unroll
          for (int e = 0; e < 4; ++e) w[e] = cvtpk(sol[8 * q4 + 2 * e], sol[8 * q4 + 2 * e + 1]);
          *(LAS u32x4*)(dst + 8 * q4) = w; }
    }
    __syncthreads();
    { unsigned char* gd = F.ws + WS_GD + (size_t)(bh * NCH + c0 + s) * 24576;
      const LAS bf16_t* uT = (const LAS bf16_t*)(Ls + G1_UT); const LAS bf16_t* wT = (const LAS bf16_t*)(Ls + G1_WT); const LAS bf16_t* kT = (const LAS bf16_t*)(Ls + G1_KT);
      const LAS bf16_t* qk = (const LAS bf16_t*)(Ls + G1_QK); const LAS bf16_t* qr = (const LAS bf16_t*)(Ls + G1_QRM);
      const f32x4 z4 = (f32x4){0.f, 0.f, 0.f, 0.f}; const float cd = gt[96 + 31];
      if (sub == 0) {
#pragma unroll
          for (int mt = 0; mt < 4; ++mt) { const bf16x8 af = *(const LAS bf16x8*)(wT + (16 * mt + l15) * 40 + 8 * kq);
#pragma unroll
              for (int nt = 0; nt < 4; ++nt) {
                  const f32x4 acc = mfma16(af, *(const LAS bf16x8*)(kT + (16 * nt + l15) * 40 + 8 * kq), z4); const int dout = 16 * nt + l15; u32x2 w; float o4[4];
#pragma unroll
                  for (int r = 0; r < 4; ++r) { const int din = 16 * mt + 4 * kq + r; o4[r] = ((din == dout) ? cd : 0.f) - acc[r]; }
                  w.x = cvtpk(o4[0], o4[1]); w.y = cvtpk(o4[2], o4[3]);
                  *(u32x2*)(gd + ((nt * 2 + (mt >> 1)) * 64 + kq * 16 + l15) * 16 + 8 * (mt & 1)) = w; }
#pragma unroll
              for (int ct = 0; ct < 2; ++ct) {
                  const f32x4 acc = mfma16(af, *(const LAS bf16x8*)(qk + (16 * ct + l15) * 40 + 8 * kq), z4); const int c = 16 * ct + l15; const float eg = gt[96 + c];
                  const u32x2 qv = *(const LAS u32x2*)(qr + c * 72 + 16 * mt + 4 * kq); u32x2 w;
                  w.x = cvtpk(bflo(qv.x) * eg - acc[0], bfhi(qv.x) * eg - acc[1]); w.y = cvtpk(bflo(qv.y) * eg - acc[2], bfhi(qv.y) * eg - acc[3]);
                  *(u32x2*)(gd + 8192 + ((ct * 2 + (mt >> 1)) * 64 + kq * 16 + l15) * 16 + 8 * (mt & 1)) = w; } }
      } else {
#pragma unroll
          for (int et = 0; et < 4; ++et) { const bf16x8 bfr = *(const LAS bf16x8*)(uT + (16 * et + l15) * 40 + 8 * kq);
#pragma unroll
              for (int dt = 0; dt < 4; ++dt) {
                  const f32x4 acc = mfma16(*(const LAS bf16x8*)(kT + (16 * dt + l15) * 40 + 8 * kq), bfr, z4); u32x2 w; w.x = cvtpk(acc[0], acc[1]); w.y = cvtpk(acc[2], acc[3]);
                  *(u32x2*)(gd + 12288 + ((dt * 4 + et) * 64 + lane) * 8) = w; }
#pragma unroll
              for (int ct = 0; ct < 2; ++ct) {
                  const f32x4 acc = mfma16(*(const LAS bf16x8*)(qk + (16 * ct + l15) * 40 + 8 * kq), bfr, z4); u32x2 w; w.x = cvtpk(acc[0], acc[1]); w.y = cvtpk(acc[2], acc[3]);
                  *(u32x2*)(gd + 20480 + ((ct * 4 + et) * 64 + lane) * 8) = w; } }
      }
    }
    __syncthreads();
}

__device__ __forceinline__ void g2_item(Frame& F, int item) {
    const int lane = F.lane, wid = F.wave, bh = item * 2 + (wid >> 2), es = wid & 3, b = bh >> 3, h = bh & 7, l15 = lane & 15, kq = lane >> 4;
    const unsigned char* gd = F.ws + WS_GD + (size_t)bh * NCH * 24576;
    bf16_t* og = WSP(bf16_t, WS_OG) + ((size_t)b * SEQ) * 512 + h * 64 + 16 * es + l15;
    f32x4 S[4];
#pragma unroll
    for (int m = 0; m < 4; ++m) S[m] = (f32x4){0.f, 0.f, 0.f, 0.f};
    bf16x8 Mf[4][2], Pf[2][2]; u32x2 Nv[4], Rv[2];
#define G2_LOAD(c) do { const unsigned char* p_ = gd + (size_t)(c) * 24576; \
        _Pragma("unroll") for (int m = 0; m < 4; ++m) _Pragma("unroll") for (int s2 = 0; s2 < 2; ++s2) Mf[m][s2] = *(const bf16x8*)(p_ + ((m * 2 + s2) * 64 + lane) * 16); \
        _Pragma("unroll") for (int ct = 0; ct < 2; ++ct) _Pragma("unroll") for (int s2 = 0; s2 < 2; ++s2) Pf[ct][s2] = *(const bf16x8*)(p_ + 8192 + ((ct * 2 + s2) * 64 + lane) * 16); \
        _Pragma("unroll") for (int m = 0; m < 4; ++m) Nv[m] = *(const u32x2*)(p_ + 12288 + ((m * 4 + es) * 64 + lane) * 8); \
        _Pragma("unroll") for (int ct = 0; ct < 2; ++ct) Rv[ct] = *(const u32x2*)(p_ + 20480 + ((ct * 4 + es) * 64 + lane) * 8); } while (0)
    G2_LOAD(0);
    for (int c = 0; c < NCH; ++c) {
        bf16x8 cM[4][2], cP[2][2]; u32x2 cN[4], cR[2];
#pragma unroll
        for (int m = 0; m < 4; ++m) { cM[m][0] = Mf[m][0]; cM[m][1] = Mf[m][1]; cN[m] = Nv[m]; }
#pragma unroll
        for (int ct = 0; ct < 2; ++ct) { cP[ct][0] = Pf[ct][0]; cP[ct][1] = Pf[ct][1]; cR[ct] = Rv[ct]; }
        if (c + 1 < NCH) G2_LOAD(c + 1);
        bf16x8 Bs[2];
#pragma unroll
        for (int s2 = 0; s2 < 2; ++s2) { u32x4 w; w.x = cvtpk(S[2 * s2][0], S[2 * s2][1]); w.y = cvtpk(S[2 * s2][2], S[2 * s2][3]); w.z = cvtpk(S[2 * s2 + 1][0], S[2 * s2 + 1][1]); w.w = cvtpk(S[2 * s2 + 1][2], S[2 * s2 + 1][3]);
            Bs[s2] = __builtin_bit_cast(bf16x8, w); }
#pragma unroll
        for (int ct = 0; ct < 2; ++ct) { f32x4 o = (f32x4){bflo(cR[ct].x), bfhi(cR[ct].x), bflo(cR[ct].y), bfhi(cR[ct].y)};
            o = mfma16(cP[ct][0], Bs[0], o); o = mfma16(cP[ct][1], Bs[1], o);
            bf16_t* op = og + (size_t)(c * GC + 16 * ct + 4 * kq) * 512;
#pragma unroll
            for (int r = 0; r < 4; ++r) op[(size_t)r * 512] = f2bf(o[r]); }
#pragma unroll
        for (int m = 0; m < 4; ++m) { f32x4 a = (f32x4){bflo(cN[m].x), bfhi(cN[m].x), bflo(cN[m].y), bfhi(cN[m].y)};
            a = mfma16(cM[m][0], Bs[0], a); S[m] = mfma16(cM[m][1], Bs[1], a); }
    }
#undef G2_LOAD
}

constexpr int P6_RW = 0, P6_TK = 131072;
__device__ __forceinline__ void p6_router(Frame& F) {
    const int lane = F.lane, wid = F.wave, tid = F.tid;
    LAS float* rw = (LAS float*)(F.lds + P6_RW);
    { const f32x4* src = (const f32x4*)WSP(float, WS_RWT);
      for (int i = tid; i < NE * DM / 4; i += NWAVES * 64) ((LAS f32x4*)rw)[i] = src[i]; }
    if (tid < 96) F.MISC[32 + tid] = 0u;
    __syncthreads();
    const float* x1 = WSP(float, WS_X1); const float* mod = WSP(float, WS_MOD); bf16_t* h2 = WSP(bf16_t, WS_H);
    int* tke = WSP(int, WS_TKE); float* tkw = WSP(float, WS_TKW); int* tkp = WSP(int, WS_TKP); int* lst = WSP(int, WS_LIST);
    const int tpw = T / F.G, t0 = (int)blockIdx.x * tpw;
    const float rb = F.in[IN_RB][lane >> 1];
    for (int tq = wid * 4; tq < tpw; tq += NWAVES * 4) {
        float acc[4][32];
#pragma unroll
        for (int q = 0; q < 4; ++q)
#pragma unroll
            for (int e = 0; e < 32; ++e) acc[q][e] = 0.f;
        float rstd[4];
#pragma unroll
        for (int q = 0; q < 4; ++q) { const f32x4* xr = (const f32x4*)(x1 + (size_t)(t0 + tq + q) * DM) + lane; float s = 0.f;
#pragma unroll
            for (int j = 0; j < 4; ++j) { const f32x4 v = xr[64 * j]; s += (v[0] * v[0] + v[1] * v[1]) + (v[2] * v[2] + v[3] * v[3]); }
            rstd[q] = __builtin_amdgcn_rsqf(wave_sum(s) * (1.f / DM) + EPS); }
        const float* mb = mod + (size_t)((t0 + tq) / SEQ) * 6144;
#pragma unroll 1
        for (int j = 0; j < 4; ++j) {
            const int col = 4 * (lane + 64 * j);
            const f32x4 g = *(const f32x4*)(F.in[IN_N2G] + col), sc = *(const f32x4*)(mb + 4096 + col), sh = *(const f32x4*)(mb + 3072 + col);
            f32x4 hv[4];
#pragma unroll
            for (int q = 0; q < 4; ++q) { const f32x4 v = *(const f32x4*)(x1 + (size_t)(t0 + tq + q) * DM + col); hv[q] = v * rstd[q] * g * (sc + 1.0f) + sh;
                u32x2 w; w.x = cvtpk(hv[q][0], hv[q][1]); w.y = cvtpk(hv[q][2], hv[q][3]); *(u32x2*)(h2 + (size_t)(t0 + tq + q) * DM + col) = w; }
#pragma unroll
            for (int e = 0; e < 32; ++e) { const f32x4 wv = *(const LAS f32x4*)(rw + e * DM + col);
#pragma unroll
                for (int q = 0; q < 4; ++q) acc[q][e] += (hv[q][0] * wv[0] + hv[q][1] * wv[1]) + (hv[q][2] * wv[2] + hv[q][3] * wv[3]); }
        }
#pragma unroll
        for (int q = 0; q < 4; ++q) {
            float v16[16], v8[8], v4[4], v2[2], v1;
            { const bool up = (lane & 32) != 0;
#pragma unroll
              for (int i = 0; i < 16; ++i) { const float keep = up ? acc[q][i + 16] : acc[q][i], give = up ? acc[q][i] : acc[q][i + 16]; v16[i] = keep + __shfl_xor(give, 32); } }
            { const bool up = (lane & 16) != 0;
#pragma unroll
              for (int i = 0; i < 8; ++i) { const float keep = up ? v16[i + 8] : v16[i], give = up ? v16[i] : v16[i + 8]; v8[i] = keep + __shfl_xor(give, 16); } }
            { const bool up = (lane & 8) != 0;
#pragma unroll
              for (int i = 0; i < 4; ++i) { const float keep = up ? v8[i + 4] : v8[i], give = up ? v8[i] : v8[i + 4]; v4[i] = keep + __shfl_xor(give, 8); } }
            { const bool up = (lane & 4) != 0;
#pragma unroll
              for (int i = 0; i < 2; ++i) { const float keep = up ? v4[i + 2] : v4[i], give = up ? v4[i] : v4[i + 2]; v2[i] = keep + __shfl_xor(give, 4); } }
            { const bool up = (lane & 2) != 0; const float keep = up ? v2[1] : v2[0], give = up ? v2[0] : v2[1]; v1 = keep + __shfl_xor(give, 2); }
            v1 += __shfl_xor(v1, 1);
            float logit = v1 + rb; const int me = lane >> 1;
            float tv[4]; int ti[4];
#pragma unroll
            for (int k = 0; k < 4; ++k) { float bv = logit; int bi = me;
#pragma unroll
                for (int o = 1; o < 64; o <<= 1) { const float ov = __shfl_xor(bv, o); const int oi = __shfl_xor(bi, o); if (ov > bv || (ov == bv && oi < bi)) { bv = ov; bi = oi; } }
                tv[k] = bv; ti[k] = bi; if (me == bi) logit = -INFINITY; }
            const float e1 = __expf(tv[1] - tv[0]), e2 = __expf(tv[2] - tv[0]), e3 = __expf(tv[3] - tv[0]), inv = 1.0f / (1.0f + e1 + e2 + e3);
            if (lane < 4) { const int t = t0 + tq + q; const int e = (lane == 0) ? ti[0] : (lane == 1) ? ti[1] : (lane == 2) ? ti[2] : ti[3];
                const float w = ((lane == 0) ? 1.0f : (lane == 1) ? e1 : (lane == 2) ? e2 : e3) * inv;
                const int lp = __hip_atomic_fetch_add((LAS int*)(F.lds + MISC_OFF) + 32 + e, 1, __ATOMIC_RELAXED, __HIP_MEMORY_SCOPE_WORKGROUP);
                tke[t * 4 + lane] = e; tkw[t * 4 + lane] = w; tkp[t * 4 + lane] = lp; }
        }
    }
    __syncthreads();
    if (tid < 32) { const int n = (int)F.MISC[32 + tid]; int base = 0; if (n > 0) base = (int)__hip_atomic_fetch_add(F.ctl + CW_CNT + 64 * tid, (unsigned)n, RLX_AGENT); F.MISC[64 + tid] = (unsigned)base; }
    VM_WAIT(); __syncthreads();
    for (int i = tid; i < tpw * 4; i += NWAVES * 64) { const int t = t0 + (i >> 2), e = tke[t * 4 + (i & 3)], p = tkp[t * 4 + (i & 3)] + (int)F.MISC[64 + e]; tkp[t * 4 + (i & 3)] = p; lst[(size_t)e * T + p] = t; }
}
__device__ __forceinline__ void moe_tables(Frame& F) {
    if (F.tid < 32) F.MISC[192 + F.tid] = __hip_atomic_load(F.ctl + CW_CNT + 64 * F.tid, RLX_AGENT);
    __syncthreads();
    if (F.tid == 0) { unsigned s = 0; for (int e = 0; e < 32; ++e) { F.MISC[128 + e] = s; s += (F.MISC[192 + e] + 255u) >> 8; } F.MISC[160] = s; }
    __syncthreads();
}
__device__ __forceinline__ void p10_combine(Frame& F) {
    const int gw = F.vcu * NWAVES + F.wave, NGW = F.G * NWAVES, lane = F.lane;
    const float* x1 = WSP(float, WS_X1); const float* mod = WSP(float, WS_MOD); const bf16_t* y = WSP(bf16_t, WS_Y);
    const int* tke = WSP(int, WS_TKE); const float* tkw = WSP(float, WS_TKW); const int* tkp = WSP(int, WS_TKP);
    for (int m = gw; m < T; m += NGW) {
        float a[16];
#pragma unroll
        for (int i = 0; i < 16; ++i) a[i] = 0.f;
#pragma unroll
        for (int k = 0; k < 4; ++k) { const int e = tke[m * 4 + k]; const float w = tkw[m * 4 + k]; const size_t row = (size_t)F.MISC[128 + e] * 256 + tkp[m * 4 + k];
            const u32x4 y0 = *(const u32x4*)(y + row * DM + 8 * lane), y1 = *(const u32x4*)(y + row * DM + 512 + 8 * lane);
#pragma unroll
            for (int i = 0; i < 4; ++i) { a[2 * i] += w * bflo(y0[i]); a[2 * i + 1] += w * bfhi(y0[i]); a[8 + 2 * i] += w * bflo(y1[i]); a[8 + 2 * i + 1] += w * bfhi(y1[i]); } }
        const float* mb = mod + (size_t)(m / SEQ) * 6144 + 5120; float ss = 0.f; f32x4 v[4];
#pragma unroll
        for (int q = 0; q < 4; ++q) { const int col = (q >> 1) * 512 + 8 * lane + 4 * (q & 1);
            const f32x4 xv = *(const f32x4*)(x1 + (size_t)m * DM + col), gt = *(const f32x4*)(mb + col);
#pragma unroll
            for (int i = 0; i < 4; ++i) { v[q][i] = xv[i] + gt[i] * a[(q >> 1) * 8 + 4 * (q & 1) + i]; ss += v[q][i] * v[q][i]; } }
        const float rstd = __builtin_amdgcn_rsqf(wave_sum(ss) * (1.f / DM) + EPS);
#pragma unroll
        for (int q = 0; q < 4; ++q) { const int col = (q >> 1) * 512 + 8 * lane + 4 * (q & 1); const f32x4 fg = *(const f32x4*)(F.in[IN_FG] + col);
            *(f32x4*)(F.out + (size_t)m * DM + col) = v[q] * rstd * fg; }
    }
}


__device__ __forceinline__ void dbg_final(Frame& F, const float* src) {
    const int gw = F.vcu * NWAVES + F.wave, NGW = F.G * NWAVES;
    for (int m = gw; m < T; m += NGW) {
        const f32x4* xr = (const f32x4*)(src + (size_t)m * DM) + F.lane; f32x4 v[4]; float s = 0.f;
#pragma unroll
        for (int j = 0; j < 4; ++j) { v[j] = xr[64 * j]; s += (v[j][0] * v[j][0] + v[j][1] * v[j][1]) + (v[j][2] * v[j][2] + v[j][3] * v[j][3]); }
        const float rstd = __builtin_amdgcn_rsqf(wave_sum(s) * (1.f / DM) + EPS);
#pragma unroll
        for (int j = 0; j < 4; ++j) { const int col = 4 * (F.lane + 64 * j); *(f32x4*)(F.out + (size_t)m * DM + col) = v[j] * rstd * *(const f32x4*)(F.in[IN_FG] + col); }
    }
}


__device__ __forceinline__ void dbg_dump_bf16(Frame& F, const bf16_t* src, int ld, int c0, int n) {
    for (size_t i = (size_t)blockIdx.x * NWAVES * 64 + F.tid; i < (size_t)T * n; i += (size_t)F.G * NWAVES * 64) { const size_t t = i / n; const int c = (int)(i % n); F.out[t * DM + c0 + c] = bf2f(src[t * ld + c]); }
}
#define DBG_DUMP(k, ...) do { if (DBG_STAGE == (k)) { xcd_barrier(bar); __VA_ARGS__; return; } } while (0)
#ifndef DBG_STAGE
#define DBG_STAGE (-1)
#endif

constexpr int N_PHASES = 13;
struct Args { const float* in[N_IN]; float* out; unsigned char* ws; int ph_lo, ph_hi; };
__global__ void __launch_bounds__(NWAVES * 64, 2) fwd_kernel(Args args) {
    extern __shared__ __attribute__((aligned(16))) unsigned char lds[];
    Frame F;
    F.lds = (LAS unsigned char*)lds; F.MISC = (volatile LAS unsigned*)(F.lds + MISC_OFF);
    F.tid = threadIdx.x; F.lane = F.tid & 63; F.wave = __builtin_amdgcn_readfirstlane(F.tid >> 6);
    F.G = gridDim.x; { const int bx = blockIdx.x; F.vcu = (F.G % 8 == 0) ? (bx % 8) * (F.G / 8) + bx / 8 : bx; }
    F.ws = args.ws; F.ctl = (unsigned*)(args.ws + WS_CTL); F.out = args.out;
#pragma unroll
    for (int i = 0; i < N_IN; ++i) F.in[i] = args.in[i];
    for (int u = F.tid; u < (LDS_BYTES - MISC_OFF) / 4; u += NWAVES * 64) ((LAS unsigned*)(F.lds + MISC_OFF))[u] = 0u;
    __syncthreads();
    XcdBarrier bar; bar.bar = F.ctl + CW_BAR; bar.x = 0; bar.st = nullptr;
    if (!N_LAUNCH_PER_PHASE) bar = xcd_barrier_post(F.ctl + CW_BAR, F.MISC + 8);
    const int lo = args.ph_lo, hi = args.ph_hi;
#ifndef PH_MASK
#define PH_MASK 0xFFFFu
#endif
#define IN(k) ((((PH_MASK) >> (k)) & 1u) && lo <= (k) && (k) < hi)
#define SEAM(k) do { if (IN(k) && IN((k) + 1)) xcd_barrier(bar); } while (0)

#if defined(DBG_BASE)
    dbg_final(F, F.in[IN_X]); return;
#endif
    if (IN(0)) { p0_mod(F); p0_weights(F); }
    SEAM(0);
    if (IN(1)) norm_rows(F, F.in[IN_X], F.in[IN_N1G], 0, 1024, WSP(bf16_t, WS_H));
    SEAM(1);
    if (IN(2)) {
        pg::Gemm g{WSP(bf16_t, WS_H), WSP(bf16_t, WS_WIN), DM, DM, nullptr}; pg::StaticOrder S; S.init(T, NPROJ, F.G, (int)blockIdx.x);
        EpiProj E{WSP(bf16_t, WS_PROJ)};
        pg::gemm_phase<EpiProj, pg::StaticOrder, false, true>(F.lds, g, S, E);
    }
    DBG_DUMP(2, dbg_dump_bf16(F, WSP(bf16_t, WS_PROJ), NPROJ, 0, 1024));
    SEAM(2);
    if (IN(3)) p3a_rows(F);
    SEAM(3);
    if (IN(4)) {
#ifndef NO_QG
        { pg::Gemm g{WSP(bf16_t, WS_PROJ) + C_QLAT, WSP(bf16_t, WS_WQ), NPROJ, QLORA, nullptr}; pg::StaticOrder S; S.init(T, 768, F.G, (int)blockIdx.x);
          EpiQ E{WSP(bf16_t, WS_Q), WSP(float, WS_RSQ), WSP(float, WS_CS), 0.10206207261596575f * 1.4426950408889634f};
          pg::gemm_phase<EpiQ, pg::StaticOrder, false, true>(F.lds, g, S, E); }
#endif
#ifndef NO_KVG
        { pg::Gemm g{WSP(bf16_t, WS_PROJ) + C_KVLAT, WSP(bf16_t, WS_WKV), NPROJ, KVLORA, nullptr}; pg::StaticOrder S; S.init(T, 1024, F.G, (int)(F.G - 1 - blockIdx.x));
          EpiKV E{WSP(bf16_t, WS_K), WSP(bf16_t, WS_V), WSP(float, WS_RSKV)};
          pg::gemm_phase<EpiKV, pg::StaticOrder, false, true>(F.lds, g, S, E); }
#endif
    }
    DBG_DUMP(4, dbg_dump_bf16(F, WSP(bf16_t, WS_Q), 768, 0, 768); dbg_dump_bf16(F, WSP(bf16_t, WS_K), 768, 768, 256));
    SEAM(4);
    if (IN(5)) { for (int u = blockIdx.x; u < BATCH * GH * NCH / 4; u += F.G) g1_unit(F, u); }
    SEAM(5);
    if (IN(6)) {
#ifndef NO_G2
        for (;;) {
            if (F.tid == 0) F.MISC[16] = __hip_atomic_fetch_add(F.ctl + CW_Q, 1u, RLX_AGENT);
            __syncthreads();
            const int item = (int)F.MISC[16];
            __syncthreads();
            if (item >= 32) break;
            g2_item(F, item);
        }
#endif
#ifndef NO_ATT
        for (;;) {
            if (F.tid == 0) F.MISC[16] = __hip_atomic_fetch_add(F.ctl + CW_Q + 64, 1u, RLX_AGENT);
            __syncthreads();
            const int item = (int)F.MISC[16];
            __syncthreads();
            if (item >= BATCH * NH * 16) break;
            const int qb = 15 - (item >> 6), bh = item & 63; attn_unit(F, bh >> 3, bh & 7, qb);
        }
#endif
    }
    DBG_DUMP(6, dbg_dump_bf16(F, WSP(bf16_t, DBG_SUB ? WS_OG : WS_OA), 512, 0, 512); dbg_dump_bf16(F, WSP(bf16_t, DBG_SUB ? WS_OG : WS_OA), 512, 512, 512));
    SEAM(6);
    if (IN(7)) p4b_rows(F);
    SEAM(7);
    if (IN(8)) {
        pg::Gemm g{WSP(bf16_t, WS_H), WSP(bf16_t, WS_WO), DM, DM, nullptr}; pg::StaticOrder S; S.init(T, DM, F.G, (int)blockIdx.x);
        EpiX1 E{F.in[IN_X], WSP(float, WS_MOD), WSP(float, WS_X1)};
        pg::gemm_phase<EpiX1, pg::StaticOrder, false, true>(F.lds, g, S, E);
    }
#if defined(DBG_STOP_X1)
    xcd_barrier(bar); dbg_final(F, WSP(float, WS_X1)); return;
#endif
    SEAM(8);
    if (IN(9)) p6_router(F);
    SEAM(9);
    if (IN(10)) {
        moe_tables(F);
        pg::Gemm g{WSP(bf16_t, WS_H), WSP(bf16_t, WS_WGU), DM, DM, WSP(int, WS_LIST)};
        pg::MoeOrder S{(const LAS int*)(F.lds + MISC_OFF) + 128, (const LAS int*)(F.lds + MISC_OFF) + 192, 8, 2048, F.G, (int)blockIdx.x, 0};
        EpiGU E{WSP(bf16_t, WS_ACT), F.in[IN_BGU]};
        pg::gemm_phase<EpiGU, pg::MoeOrder, true, true>(F.lds, g, S, E);
    }
    SEAM(10);
    if (IN(11)) {
        moe_tables(F);
        pg::Gemm g{WSP(bf16_t, WS_ACT), WSP(bf16_t, WS_WDN), DE, DE, nullptr};
        pg::MoeOrder S{(const LAS int*)(F.lds + MISC_OFF) + 128, (const LAS int*)(F.lds + MISC_OFF) + 192, 4, 1024, F.G, (int)blockIdx.x, 1};
        EpiDN E{WSP(bf16_t, WS_Y), F.in[IN_BDN]};
        pg::gemm_phase<EpiDN, pg::MoeOrder, false, true>(F.lds, g, S, E);
    }
    SEAM(11);
    if (IN(12)) { moe_tables(F); p10_combine(F); }
#undef IN
#undef SEAM
}

extern "C" void kernel_launch(void* const* d_in, const int* in_sizes, int n_in, void* d_out, int out_size, void* d_ws, size_t ws_size, hipStream_t stream) {
    static int grid = 0;
    if (grid == 0) {
        if (n_in != N_IN || out_size != T * DM || ws_size < WS_END) { fprintf(stderr, "kernel_launch: unexpected shapes (n_in %d, out %d, ws %zu)\n", n_in, out_size, ws_size); grid = -1; return; }
        int dev = 0, cus = 0;
        if (hipGetDevice(&dev) != hipSuccess || hipDeviceGetAttribute(&cus, hipDeviceAttributeMultiprocessorCount, dev) != hipSuccess) { grid = -1; return; }
        if (hipFuncSetAttribute((const void*)fwd_kernel, hipFuncAttributeMaxDynamicSharedMemorySize, LDS_BYTES) != hipSuccess) { grid = -1; return; }
        int per_cu = 0;
        if (hipOccupancyMaxActiveBlocksPerMultiprocessor(&per_cu, (const void*)fwd_kernel, NWAVES * 64, LDS_BYTES) != hipSuccess || per_cu < 1) fprintf(stderr, "kernel_launch: occupancy query says %d\n", per_cu);
        (void)hipGetLastError();
        grid = cus;
        while (grid > 8 && (T % grid) != 0) grid -= 8;
    }
    if (grid < 0) return;
    (void)hipMemsetAsync((char*)d_ws + WS_CTL, 0, CTL_BYTES, stream);
    Args a{};
    for (int i = 0; i < N_IN; ++i) a.in[i] = (const float*)d_in[i];
    a.out = (float*)d_out; a.ws = (unsigned char*)d_ws;
#if N_LAUNCH_PER_PHASE
    for (int p = 0; p < N_PHASES; ++p) { a.ph_lo = p; a.ph_hi = p + 1; hipLaunchKernelGGL(fwd_kernel, dim3(grid), dim3(NWAVES * 64), LDS_BYTES, stream, a); }
#else
    a.ph_lo = 0; a.ph_hi = N_PHASES;
    hipLaunchKernelGGL(fwd_kernel, dim3(grid), dim3(NWAVES * 64), LDS_BYTES, stream, a);
#endif
}
```

```cpp
#include <hip/hip_runtime.h>
#include <cstdio>
#include <cstdint>


#define DBG_SUB 0
#ifndef N_LAUNCH_PER_PHASE
#define N_LAUNCH_PER_PHASE 0
#endif

#define GAS __attribute__((address_space(1)))
#define LAS __attribute__((address_space(3)))
typedef unsigned short bf16_t;
typedef short bf16x8 __attribute__((ext_vector_type(8)));
typedef short s16x4 __attribute__((ext_vector_type(4)));
typedef float f32x4 __attribute__((ext_vector_type(4)));
typedef float f32x2 __attribute__((ext_vector_type(2)));
typedef float f32x16 __attribute__((ext_vector_type(16)));
typedef unsigned u32x4 __attribute__((ext_vector_type(4)));
typedef unsigned u32x2 __attribute__((ext_vector_type(2)));
typedef __bf16 bf16x2_t __attribute__((ext_vector_type(2)));

constexpr int BATCH = 8, SEQ = 4096, DM = 1024, T = BATCH * SEQ;
constexpr int NH = 8, QK = 96, NOPE = 64, ROPE = 32, VD = 64, QLORA = 384, KVLORA = 256;
constexpr int GH = 8, GDK = 64, GDV = 64;
constexpr int IN_DIM = 2736, NPROJ = 2816;
constexpr int C_QLAT = 0, C_KVLAT = 384, C_KPE = 640, C_GQ = 672, C_GK = 1184, C_GV = 1696, C_GZ = 2208, C_GA = 2720, C_GB = 2728;
constexpr int NE = 32, TOPK = 4, DE = 1024;
constexpr float EPS = 1e-6f;
constexpr float W8 = 32.0f;
constexpr int GC = 32, NCH = SEQ / GC;
constexpr int MAXROWS = T * TOPK + NE * 256;

constexpr size_t MiB = 1u << 20;
constexpr size_t WS_CTL = 0, CTL_BYTES = 1 * MiB;
constexpr size_t WS_MOD = 1 * MiB;
constexpr size_t WS_RSQ = 2 * MiB;
constexpr size_t WS_RSKV = WS_RSQ + 128 * 1024;
constexpr size_t WS_CS = 3 * MiB;
constexpr size_t WS_TKE = 7 * MiB;
constexpr size_t WS_TKW = WS_TKE + 512 * 1024;
constexpr size_t WS_TKP = WS_TKW + 512 * 1024;
constexpr size_t WS_LIST = 9 * MiB;
constexpr size_t WS_RWT = 13 * MiB;
constexpr size_t WS_WIN = 16 * MiB;
constexpr size_t WS_WQ = WS_WIN + (size_t)NPROJ * DM * 2;
constexpr size_t WS_WKV = WS_WQ + (size_t)768 * 384 * 2;
constexpr size_t WS_WO = WS_WKV + (size_t)1024 * 256 * 2;
constexpr size_t WS_WGU = 32 * MiB;
constexpr size_t WS_WDN = WS_WGU + (size_t)NE * 2048 * 1024 * 2;
constexpr size_t WS_H = 224 * MiB;
constexpr size_t WS_X1 = 288 * MiB;
constexpr size_t WS_PROJ = 416 * MiB;
constexpr size_t WS_Q = 592 * MiB;
constexpr size_t WS_K = 640 * MiB;
constexpr size_t WS_V = 688 * MiB;
constexpr size_t WS_OA = 720 * MiB;
constexpr size_t WS_OG = 752 * MiB;
constexpr size_t WS_GD = 784 * MiB;
constexpr size_t WS_ACT = 416 * MiB;
constexpr size_t WS_Y = 688 * MiB;
constexpr size_t WS_END = 976 * MiB;
static_assert(WS_WO + (size_t)1024 * 1024 * 2 <= WS_WGU && WS_WDN + (size_t)NE * 1024 * 1024 * 2 <= WS_H, "weights");
static_assert(WS_ACT + (size_t)MAXROWS * 1024 * 2 <= WS_Y && WS_Y + (size_t)MAXROWS * 1024 * 2 <= WS_END, "moe rows");
static_assert(WS_GD + (size_t)BATCH * GH * NCH * 24576 <= WS_END, "gdn");
constexpr int CW_BAR = 4096;
constexpr int CW_Q = 8192;
constexpr int CW_CNT = 12288;

constexpr int RING_BYTES = 131072;
constexpr int MISC_OFF = RING_BYTES;
constexpr int LDS_BYTES = 147456;

#define LDS_WAIT() asm volatile("s_waitcnt lgkmcnt(0)" ::: "memory")
#define VM_WAIT() asm volatile("s_waitcnt vmcnt(0)" ::: "memory")
#define RLX_AGENT __ATOMIC_RELAXED, __HIP_MEMORY_SCOPE_AGENT

__device__ __forceinline__ unsigned cvtpk(float lo, float hi) { f32x2 v = {lo, hi}; bf16x2_t b = __builtin_convertvector(v, bf16x2_t); return __builtin_bit_cast(unsigned, b); }
__device__ __forceinline__ bf16_t f2bf(float f) { return (bf16_t)(cvtpk(f, 0.f) & 0xffffu); }
__device__ __forceinline__ float bf2f(unsigned short h) { return __uint_as_float((unsigned)h << 16); }
__device__ __forceinline__ float bflo(unsigned w) { return __uint_as_float(w << 16); }
__device__ __forceinline__ float bfhi(unsigned w) { return __uint_as_float(w & 0xffff0000u); }
__device__ __forceinline__ float wave_sum(float v) {
#pragma unroll
    for (int o = 1; o < 64; o <<= 1) v += __shfl_xor(v, o);
    return v;
}
__device__ __forceinline__ unsigned pk4_fp8(float a, float b, float c, float d) { int w = 0; w = __builtin_amdgcn_cvt_pk_fp8_f32(a, b, w, false); w = __builtin_amdgcn_cvt_pk_fp8_f32(c, d, w, true); return (unsigned)w; }
__device__ __forceinline__ float siluf(float x) { return x / (1.f + __expf(-x)); }

#define XB_TMO      128
#define XB_XCNT(j)  (256  + 64 * (j))
#define XB_XSUB(j)  (1280 + 64 * (j))
#define XB_XGEN(j)  (2304 + 64 * (j))
#define XB_TOP      3328
#define XB_TOPGEN   3392
#define XCD_BAR_WORDS 3456
#define XB_SPIN_CAP (1u << 18)
__device__ __forceinline__ unsigned xb_ld(unsigned* p)              { return __hip_atomic_load(p, __ATOMIC_RELAXED, __HIP_MEMORY_SCOPE_AGENT); }
__device__ __forceinline__ unsigned xb_add(unsigned* p, unsigned v) { return __hip_atomic_fetch_add(p, v, __ATOMIC_RELAXED, __HIP_MEMORY_SCOPE_AGENT); }
__device__ __forceinline__ unsigned xb_xcc_id() { return (unsigned)__builtin_amdgcn_s_getreg((3 << 11) | 20) & 0xFu; }
#define XB_SPIN(cond, bar) do { unsigned _sp = 0; while (cond) { __builtin_amdgcn_s_sleep(1); \
    if ((++_sp & 255u) == 0u) { if (xb_ld(&(bar)[XB_TMO])) break; if (_sp > XB_SPIN_CAP) { atomicAdd(&(bar)[XB_TMO], 1u); break; } } } } while (0)
struct XcdBarrier { unsigned* bar; unsigned x; volatile LAS unsigned* st; };
__device__ __forceinline__ XcdBarrier xcd_barrier_post(unsigned* bar, volatile LAS unsigned* st) {
    XcdBarrier b; b.bar = bar; b.x = xb_xcc_id(); b.st = st;
    if (threadIdx.x == 0) (void)xb_add(&bar[XB_XCNT(b.x)], 1u);
    return b;
}
__device__ __forceinline__ void xcd_barrier_complete(unsigned* bar, unsigned x, unsigned& nloc, unsigned& nx) {
    const unsigned G = gridDim.x * gridDim.y * gridDim.z;
    unsigned sum, cnt, mine, sp = 0u;
    for (;;) {
        sum = 0u; cnt = 0u; mine = 0u;
#pragma unroll
        for (unsigned j = 0; j < 16; ++j) { const unsigned c = xb_ld(&bar[XB_XCNT(j)]); sum += c; cnt += (c > 0u) ? 1u : 0u; mine = (j == x) ? c : mine; }
        if (sum == G) break;
        __builtin_amdgcn_s_sleep(1);
        if ((++sp & 255u) == 0u) { if (xb_ld(&bar[XB_TMO])) break; if (sp > XB_SPIN_CAP) { atomicAdd(&bar[XB_TMO], 1u); break; } }
    }
    nloc = mine > 0u ? mine : 1u; nx = cnt > 0u ? cnt : 1u;
}
__device__ __forceinline__ void xcd_barrier(const XcdBarrier& b) {
    asm volatile("s_waitcnt vmcnt(0)" ::: "memory");
    __syncthreads();
    if (threadIdx.x == 0) {
        unsigned* bar = b.bar;
        __builtin_amdgcn_s_waitcnt(0);
        unsigned nloc = b.st[0], nx = b.st[1];
        if (nloc == 0u) { xcd_barrier_complete(bar, b.x, nloc, nx); b.st[0] = nloc; b.st[1] = nx; }
        const unsigned old = xb_add(&bar[XB_XSUB(b.x)], 1u);
        const unsigned gen = old / nloc;
        if (old + 1u == (gen + 1u) * nloc) {
            __builtin_amdgcn_fence(__ATOMIC_RELEASE, "agent");
            asm volatile("s_waitcnt vmcnt(0)" ::: "memory");
            const unsigned og = xb_add(&bar[XB_TOP], 1u);
            const unsigned tg = og / nx;
            if (og + 1u == (tg + 1u) * nx) xb_add(&bar[XB_TOPGEN], 1u);
            else XB_SPIN(xb_ld(&bar[XB_TOPGEN]) == tg, bar);
            __builtin_amdgcn_fence(__ATOMIC_ACQUIRE, "agent");
            xb_add(&bar[XB_XGEN(b.x)], 1u);
            asm volatile("s_waitcnt vmcnt(0)" ::: "memory");
        } else {
            XB_SPIN(xb_ld(&bar[XB_XGEN(b.x)]) == gen, bar);
            __builtin_amdgcn_fence(__ATOMIC_ACQUIRE, "agent");
            asm volatile("s_waitcnt vmcnt(0)" ::: "memory");
        }
    }
    __syncthreads();
}

namespace pg {
constexpr int BM = 256, BK = 64, HALF = 128, HTB = HALF * BK * 2, STAGE_BYTES = 8 * HTB, NXCD = 8, WGM = 8;
__host__ __device__ __forceinline__ int lds_byte(int r, int c) { const int st = (r >> 4) * 2 + (c >> 5), rr = r & 15, cc = c & 31, ob = rr * 64 + cc * 2; return st * 1024 + (ob ^ (((ob >> 9) & 1) << 5)); }
__host__ __device__ __forceinline__ void stage_rc(int b, int& R, int& C) { const int st = b / 1024, sb = b % 1024, swz = sb ^ (((sb >> 9) & 1) << 5); R = (st >> 1) * 16 + swz / 64; C = (st & 1) * 32 + (swz % 64) / 2; }
__host__ __device__ __forceinline__ int perm32(int rho) { const int n = rho >> 4, i = rho & 15; return 8 * (i >> 2) + 4 * n + (i & 3); }

struct Unit { int pm, pn, arow, brow, nvalid, e; };
struct Gemm { const void* A; const void* Bt; int lda, K; const int* list; };

struct StaticOrder {
    int nM, nN, nwg, G, c;
    __device__ __forceinline__ void init(int M, int N, int G_, int c_) { nM = M / BM; nN = N / BM; nwg = nM * nN; G = G_; c = c_; }
    __device__ __forceinline__ bool next(int i, Unit& u) const {
        const long L = (long)i * G + c; if (L >= nwg) return false;
        int wgid = (int)L; { const int q = nwg / NXCD, r = nwg % NXCD, xcd = wgid % NXCD, off = wgid / NXCD; wgid = (xcd < r ? xcd * (q + 1) : r * (q + 1) + (xcd - r) * q) + off; }
        const int nig = WGM * nN, gid = wgid / nig, fm = gid * WGM, gsz = (nM - fm) < WGM ? (nM - fm) : WGM;
        u.pm = fm + ((wgid % nig) % gsz); u.pn = (wgid % nig) / gsz; u.arow = u.pm * BM; u.brow = u.pn * BM; u.nvalid = BM; u.e = 0; return true;
    }
};
struct MoeOrder {
    const LAS int* pre;
    const LAS int* cnt;
    int NT, Nrows, G, c, contig;
    __device__ __forceinline__ bool next(int i, Unit& u) const {
        const int xcd = c & 7, j = c >> 3, q = i * (G >> 3) + j, mq = q / NT, nt = q - mq * NT, mt = mq * 8 + xcd;
        if (mt >= pre[32]) return false;
        int e = 0;
#pragma unroll 1
        while (pre[e + 1] <= mt) ++e;
        const int row0 = (mt - pre[e]) * BM;
        u.pm = mt; u.pn = nt; u.e = e; u.nvalid = cnt[e] - row0; u.arow = contig ? mt * BM : row0; u.brow = e * Nrows + nt * BM; return true;
    }
};

__device__ __forceinline__ void glds16s(const void* sbase, unsigned voff, unsigned ldsdst) { unsigned keep;
    asm volatile("s_mov_b32 %0, m0\n\ts_mov_b32 m0, %3\n\ts_nop 0\n\tglobal_load_lds_dwordx4 %1, %2\n\ts_mov_b32 m0, %0" : "=&s"(keep) : "v"(voff), "s"(sbase), "s"(ldsdst) : "memory"); }
typedef int i32x8 __attribute__((ext_vector_type(8)));
typedef int i32x4 __attribute__((ext_vector_type(4)));
template <class Epi, class Sched, bool GATHER, bool ALIGN_EPI, bool FP8 = false>
__device__ __forceinline__ void gemm_phase(LAS unsigned char* lds, const Gemm g, const Sched& S, const Epi& E) {
    const int tid = threadIdx.x, wid = __builtin_amdgcn_readfirstlane(tid >> 6), lane = tid & 63, wr = wid >> 2, wc = wid & 3, fr = lane & 15, fq = lane >> 4;
    const int K = g.K, nt = K / (BK * 2), lda = g.lda;
    unsigned voffB[2], voffA[2];
#pragma unroll
    for (int i = 0; i < 2; ++i) { int R, C; stage_rc(tid * 16 + i * 8192, R, C); const int Rb = Epi::PERM ? ((R & ~31) + perm32(R & 31)) : R; voffB[i] = (unsigned)(Rb * K + C * 2); voffA[i] = (unsigned)(R * lda + C * 2); }
    const size_t kstep = (size_t)(BK * 2);
    const size_t hstep = (size_t)HALF * K;
    const unsigned ldsw = (unsigned)wid * 1024u;
    const unsigned ldsa = (unsigned)__builtin_amdgcn_readfirstlane((int)((unsigned)(uintptr_t)lds + ldsw));
    const int aoff = lds_byte(wr * 64 + fr, fq * 8), boff = lds_byte(wc * 32 + fr, fq * 8);
#define PG_SA(b, h) (((b) * 2 + (h)) * HTB)
#define PG_SB(b, h) ((4 + (b) * 2 + (h)) * HTB)
#define PG_STAGE(bufoff, gbase, voff) do { _Pragma("unroll") for (int _i = 0; _i < 2; ++_i) \
        glds16s((const void*)(gbase), (voff)[_i], ldsa + (unsigned)(bufoff) + (unsigned)(_i * 8192)); } while (0)
#define PG_LDA(dst, b, h) do { _Pragma("unroll") for (int m = 0; m < 4; ++m) { if constexpr (FP8) { dst##8[m] = __builtin_shufflevector(*(const LAS i32x4*)(lds + PG_SA(b, h) + aoff + m * 2048), *(const LAS i32x4*)(lds + PG_SA(b, h) + aoff + m * 2048 + 1024), 0, 1, 2, 3, 4, 5, 6, 7); } \
        else { _Pragma("unroll") for (int k = 0; k < 2; ++k) dst[m][k] = *(const LAS bf16x8*)(lds + PG_SA(b, h) + aoff + m * 2048 + k * 1024); } } } while (0)
#define PG_LDB(dst, b, h) do { _Pragma("unroll") for (int n = 0; n < 2; ++n) { if constexpr (FP8) { dst##8[n] = __builtin_shufflevector(*(const LAS i32x4*)(lds + PG_SB(b, h) + boff + n * 2048), *(const LAS i32x4*)(lds + PG_SB(b, h) + boff + n * 2048 + 1024), 0, 1, 2, 3, 4, 5, 6, 7); } \
        else { _Pragma("unroll") for (int k = 0; k < 2; ++k) dst[n][k] = *(const LAS bf16x8*)(lds + PG_SB(b, h) + boff + n * 2048 + k * 1024); } } } while (0)
#define PG_MMA(ai, bj, At, Bt) do { __builtin_amdgcn_s_setprio(1); if constexpr (FP8) { _Pragma("unroll") for (int m = 0; m < 4; ++m) _Pragma("unroll") for (int n = 0; n < 2; ++n) \
        asm volatile("v_mfma_scale_f32_16x16x128_f8f6f4 %0, %1, %2, %0, %3, %3 op_sel_hi:[0,0,0]" : "+v"(acc[ai][bj][m][n]) : "v"(Bt##8[n]), "v"(At##8[m]), "v"(scl1)); } \
        else { _Pragma("unroll") for (int m = 0; m < 4; ++m) _Pragma("unroll") for (int n = 0; n < 2; ++n) _Pragma("unroll") for (int k = 0; k < 2; ++k) \
        acc[ai][bj][m][n] = __builtin_amdgcn_mfma_f32_16x16x32_bf16(Bt[n][k], At[m][k], acc[ai][bj][m][n], 0, 0, 0); } __builtin_amdgcn_s_setprio(0); } while (0)
#define PG_WAIT_V(n) asm volatile("s_waitcnt vmcnt(" #n ")" ::: "memory")
#define PG_WAIT_L(n) asm volatile("s_waitcnt lgkmcnt(" #n ")" ::: "memory")
#define PG_BAR __builtin_amdgcn_s_barrier()
#define PG_SCHED __builtin_amdgcn_sched_barrier(0)
#define PG_SETA(v, u) do { _Pragma("unroll") for (int _h = 0; _h < 2; ++_h) _Pragma("unroll") for (int _i = 0; _i < 2; ++_i) { int _R, _C; stage_rc(tid * 16 + _i * 8192, _R, _C); const int _r = _h * HALF + _R; \
        const int _rr = _r < (u).nvalid ? _r : (u).nvalid - 1; const int _tok = g.list[(size_t)(u).e * T + (u).arow + _rr]; v[_h][_i] = (unsigned)(_tok * lda + _C * 2); } } while (0)
#define PG_STA(bufoff, kb, h, NX) do { if constexpr (GATHER) { unsigned _vs[2]; _vs[0] = (NX) ? vN[h][0] : vA[h][0]; _vs[1] = (NX) ? vN[h][1] : vA[h][1]; PG_STAGE(bufoff, (const char*)g.A + (kb), _vs); } \
        else PG_STAGE(bufoff, ((NX) ? nA : cA) + (kb) + (h) * hstepA, voffA); } while (0)
    Unit cur, nxt; int ui = 0;
    if (!S.next(0, cur)) return;
    f32x4 acc[2][2][4][2];
#pragma unroll
    for (int a = 0; a < 2; ++a)
#pragma unroll
        for (int b = 0; b < 2; ++b)
#pragma unroll
            for (int m = 0; m < 4; ++m)
#pragma unroll
                for (int n = 0; n < 2; ++n) acc[a][b][m][n] = (f32x4){0.f, 0.f, 0.f, 0.f};
    const int scl1 = 0x7F7F7F7F;
    bf16x8 At[4][2], B0[2][2], B1[2][2]; i32x8 At8[4], B08[2], B18[2];
    unsigned vN[2][2] = {{0u, 0u}, {0u, 0u}};
    unsigned vA[2][2];
    LAS u32x4* const vnl = (LAS u32x4*)(lds + STAGE_BYTES + 1024) + tid;
    const size_t hstepA = (size_t)HALF * lda;
    if constexpr (GATHER) { PG_SETA(vA, cur); PG_WAIT_V(0); }
    const char* cA = (const char*)g.A + (GATHER ? (size_t)0 : (size_t)cur.arow * lda); const char* nA = cA;
    const char* cB = (const char*)g.Bt + (size_t)cur.brow * K;
    PG_STAGE(PG_SB(0, 0), cB, voffB); PG_STAGE(PG_SB(0, 1), cB + hstep, voffB); PG_STA(PG_SA(0, 0), 0, 0, false); PG_STA(PG_SA(0, 1), 0, 1, false);
    if (wr == 1) PG_BAR;
    PG_WAIT_V(2); PG_BAR;
    PG_STAGE(PG_SB(1, 0), cB + kstep, voffB); PG_STA(PG_SA(1, 0), kstep, 0, false); PG_STAGE(PG_SB(1, 1), cB + hstep + kstep, voffB);
    PG_WAIT_V(6); PG_BAR;
    for (;;) {
        const bool has_next = S.next(ui + 1, nxt);
        if constexpr (GATHER) {
            unsigned vT[2][2];
            if (has_next) { PG_SETA(vT, nxt); PG_WAIT_V(0); }
            else {
#pragma unroll
                for (int h = 0; h < 2; ++h)
#pragma unroll
                    for (int i = 0; i < 2; ++i) vT[h][i] = vA[h][i]; }
            *vnl = (u32x4){vT[0][0], vT[0][1], vT[1][0], vT[1][1]};
        } else nA = has_next ? (const char*)g.A + (size_t)nxt.arow * lda : cA;
        const char* nB = has_next ? (const char*)g.Bt + (size_t)nxt.brow * K : cB;
#pragma unroll 1
        for (int t = 0; t < nt; t += 2) {
            const bool last = (t == nt - 2);
            if constexpr (GATHER) { if (last) { const u32x4 q_ = *vnl; vN[0][0] = q_.x; vN[0][1] = q_.y; vN[1][0] = q_.z; vN[1][1] = q_.w; } else { vN[0][0] = vA[0][0]; vN[0][1] = vA[0][1]; vN[1][0] = vA[1][0]; vN[1][1] = vA[1][1]; } }
            const size_t k1 = (size_t)(t + 1) * kstep, k2 = last ? (size_t)0 : (size_t)(t + 2) * kstep, k3 = k2 + kstep;
            const char* b2 = last ? nB : cB + (size_t)(t + 2) * kstep; const char* b3 = b2 + kstep;
            PG_LDB(B0, 0, 0); PG_LDB(B1, 0, 1); PG_SCHED; PG_LDA(At, 0, 0); PG_STA(PG_SA(1, 1), k1, 1, false);
            PG_WAIT_V(8); PG_WAIT_L(0); PG_BAR; PG_MMA(0, 0, At, B0); PG_MMA(0, 1, At, B1); PG_BAR; PG_SCHED;
            PG_LDA(At, 0, 1); PG_STAGE(PG_SB(0, 0), b2, voffB); PG_STAGE(PG_SB(0, 1), b2 + hstep, voffB); PG_STA(PG_SA(0, 0), k2, 0, last);
            PG_WAIT_V(8); PG_WAIT_L(0); PG_BAR; PG_MMA(1, 0, At, B0); PG_MMA(1, 1, At, B1); PG_BAR; PG_SCHED;
            PG_LDB(B0, 1, 0); PG_LDB(B1, 1, 1); PG_SCHED; PG_LDA(At, 1, 0); PG_STA(PG_SA(0, 1), k2, 1, last);
            PG_WAIT_V(8); PG_WAIT_L(0); PG_BAR; PG_MMA(0, 0, At, B0); PG_MMA(0, 1, At, B1); PG_BAR; PG_SCHED;
            PG_LDA(At, 1, 1); PG_STAGE(PG_SB(1, 0), b3, voffB); PG_STAGE(PG_SB(1, 1), b3 + hstep, voffB); PG_STA(PG_SA(1, 0), k3, 0, last);
            PG_WAIT_V(8); PG_WAIT_L(0); PG_BAR; PG_MMA(1, 0, At, B0); PG_MMA(1, 1, At, B1); PG_BAR; PG_SCHED;
        }
        if constexpr (ALIGN_EPI) { if (wr == 0) PG_BAR; }
        if constexpr (FP8) asm volatile("s_nop 15\n\ts_nop 15" ::: "memory");
        E(acc, cur, wr, wc, fr, fq);
        if (!has_next) break;
#pragma unroll
        for (int a = 0; a < 2; ++a)
#pragma unroll
            for (int b = 0; b < 2; ++b)
#pragma unroll
                for (int m = 0; m < 4; ++m)
#pragma unroll
                    for (int n = 0; n < 2; ++n) acc[a][b][m][n] = (f32x4){0.f, 0.f, 0.f, 0.f};
        cur = nxt; cB = nB; cA = nA; ++ui;
        if constexpr (GATHER) { const u32x4 q_ = *vnl; vA[0][0] = q_.x; vA[0][1] = q_.y; vA[1][0] = q_.z; vA[1][1] = q_.w; }
        if constexpr (ALIGN_EPI) { if (wr == 1) PG_BAR; }
    }
    PG_WAIT_V(0);
    if constexpr (!ALIGN_EPI) { if (wr == 0) PG_BAR; }
    PG_BAR;
#undef PG_SA
#undef PG_SB
#undef PG_STAGE
#undef PG_LDA
#undef PG_LDB
#undef PG_MMA
#undef PG_WAIT_V
#undef PG_WAIT_L
#undef PG_BAR
#undef PG_SCHED
#undef PG_SETA
#undef PG_STA
}
}

typedef f32x4 AccT[2][2][4][2];
__device__ __forceinline__ u32x4 pack8(f32x4 a, f32x4 b) { u32x4 w; w.x = cvtpk(a[0], a[1]); w.y = cvtpk(a[2], a[3]); w.z = cvtpk(b[0], b[1]); w.w = cvtpk(b[2], b[3]); return w; }

struct EpiProj {
    static constexpr bool PERM = true; bf16_t* O;
    __device__ __forceinline__ void operator()(const AccT& acc, const pg::Unit& u, int wr, int wc, int fr, int fq) const {
        const int row0 = u.pm * 256 + wr * 64 + fr, col0 = u.pn * 256 + wc * 32 + 8 * fq;
#pragma unroll
        for (int ai = 0; ai < 2; ++ai)
#pragma unroll
            for (int m = 0; m < 4; ++m) { bf16_t* rowp = O + (size_t)(row0 + ai * 128 + m * 16) * NPROJ + col0;
#pragma unroll
                for (int bj = 0; bj < 2; ++bj) *(u32x4*)(rowp + bj * 128) = pack8(acc[ai][bj][m][0], acc[ai][bj][m][1]); }
    }
};
struct EpiQ {
    static constexpr bool PERM = true; bf16_t* O; const float* rstd; const float* cs; float scale;
    __device__ __forceinline__ void operator()(const AccT& acc, const pg::Unit& u, int wr, int wc, int fr, int fq) const {
        const int row0 = u.pm * 256 + wr * 64 + fr;
#pragma unroll
        for (int ai = 0; ai < 2; ++ai)
#pragma unroll
            for (int m = 0; m < 4; ++m) { const int row = row0 + ai * 128 + m * 16; const float rs = rstd[row] * scale;
#pragma unroll
                for (int bj = 0; bj < 2; ++bj) { const int G = 8 * u.pn + 4 * bj + wc;
                    f32x4 v0 = acc[ai][bj][m][0] * rs, v1 = acc[ai][bj][m][1] * rs;
                    if ((G % 3) == 2) {
                        f32x4 p0, p1;
#pragma unroll
                        for (int j = 0; j < 4; ++j) { p0[j] = __shfl_xor(v0[j], 32); p1[j] = __shfl_xor(v1[j], 32); }
                        const float* cr = cs + (size_t)row * 32 + 8 * (fq & 1);
                        const f32x4 c0 = *(const f32x4*)cr, c1 = *(const f32x4*)(cr + 4), s0 = *(const f32x4*)(cr + 16), s1 = *(const f32x4*)(cr + 20);
                        if (fq < 2) { v0 = v0 * c0 - p0 * s0; v1 = v1 * c1 - p1 * s1; } else { v0 = v0 * c0 + p0 * s0; v1 = v1 * c1 + p1 * s1; }
                    }
                    *(u32x4*)(O + (size_t)row * 768 + 32 * G + 8 * fq) = pack8(v0, v1); }
                asm volatile("" ::: "memory"); }
    }
};
struct EpiKV {
    static constexpr bool PERM = true; bf16_t* Ko; bf16_t* Vo; const float* rstd;
    __device__ __forceinline__ void operator()(const AccT& acc, const pg::Unit& u, int wr, int wc, int fr, int fq) const {
        const int row0 = u.pm * 256 + wr * 64 + fr;
#pragma unroll
        for (int ai = 0; ai < 2; ++ai)
#pragma unroll
            for (int m = 0; m < 4; ++m) { const int row = row0 + ai * 128 + m * 16; const float rs = rstd[row];
#pragma unroll
                for (int bj = 0; bj < 2; ++bj) { const int G = 8 * u.pn + 4 * bj + wc, head = G >> 2, sub = G & 3;
                    bf16_t* dst = (sub < 2) ? Ko + (size_t)row * 768 + head * 96 + 32 * sub + 8 * fq : Vo + (size_t)row * 512 + head * 64 + 32 * (sub - 2) + 8 * fq;
                    *(u32x4*)dst = pack8(acc[ai][bj][m][0] * rs, acc[ai][bj][m][1] * rs); } }
    }
};
struct EpiX1 {
    static constexpr bool PERM = false; const float* x; const float* mod; float* O;
    __device__ __forceinline__ void operator()(const AccT& acc, const pg::Unit& u, int wr, int wc, int fr, int fq) const {
        const int row0 = u.pm * 256 + wr * 64 + fr, col0 = u.pn * 256 + wc * 32 + 4 * fq;
        const float* gt = mod + (size_t)(u.pm * 256 / SEQ) * 6144 + 2048 + col0;
        f32x4 gv[2][2];
#pragma unroll
        for (int bj = 0; bj < 2; ++bj)
#pragma unroll
            for (int n = 0; n < 2; ++n) gv[bj][n] = *(const f32x4*)(gt + bj * 128 + n * 16);
#pragma unroll
        for (int ai = 0; ai < 2; ++ai)
#pragma unroll
            for (int m = 0; m < 4; ++m) { const size_t off = (size_t)(row0 + ai * 128 + m * 16) * DM + col0;
#pragma unroll
                for (int bj = 0; bj < 2; ++bj)
#pragma unroll
                    for (int n = 0; n < 2; ++n) { const f32x4 xv = *(const f32x4*)(x + off + bj * 128 + n * 16); *(f32x4*)(O + off + bj * 128 + n * 16) = xv + gv[bj][n] * acc[ai][bj][m][n]; } }
    }
};
struct EpiGU {
    static constexpr bool PERM = true; unsigned char* O; const float* bias;
    __device__ __forceinline__ void operator()(const AccT& acc, const pg::Unit& u, int wr, int wc, int fr, int fq) const {
        const int row0 = u.pm * 256 + wr * 64 + fr, gcol = u.pn * 128 + wc * 32 + 8 * fq;
        const float* bp = bias + (size_t)u.e * 2048 + gcol;
        const f32x4 bg0 = *(const f32x4*)bp, bg1 = *(const f32x4*)(bp + 4), bu0 = *(const f32x4*)(bp + 1024), bu1 = *(const f32x4*)(bp + 1028);
#pragma unroll
        for (int ai = 0; ai < 2; ++ai)
#pragma unroll
            for (int m = 0; m < 4; ++m) {
                f32x4 r[2];
#pragma unroll
                for (int n = 0; n < 2; ++n) { const f32x4 g4 = acc[ai][0][m][n] * (1.0f / W8) + (n ? bg1 : bg0), u4 = acc[ai][1][m][n] * (1.0f / W8) + (n ? bu1 : bu0);
#pragma unroll
                    for (int j = 0; j < 4; ++j) { const float g = fminf(g4[j], 7.0f), up = fminf(fmaxf(u4[j], -7.0f), 7.0f);
                        r[n][j] = (up + 1.0f) * g * __builtin_amdgcn_rcpf(1.0f + __expf(-1.702f * g)); } }
                u32x2 w; w.x = pk4_fp8(r[0][0], r[0][1], r[0][2], r[0][3]); w.y = pk4_fp8(r[1][0], r[1][1], r[1][2], r[1][3]); *(u32x2*)(O + (size_t)(row0 + ai * 128 + m * 16) * DE + gcol) = w; }
    }
};
struct EpiDN {
    static constexpr bool PERM = true; bf16_t* O; const float* bias;
    __device__ __forceinline__ void operator()(const AccT& acc, const pg::Unit& u, int wr, int wc, int fr, int fq) const {
        const int row0 = u.pm * 256 + wr * 64 + fr, col0 = u.pn * 256 + wc * 32 + 8 * fq;
        const float* bp = bias + (size_t)u.e * DM + col0;
        f32x4 bv[2][2];
#pragma unroll
        for (int bj = 0; bj < 2; ++bj) { bv[bj][0] = *(const f32x4*)(bp + bj * 128); bv[bj][1] = *(const f32x4*)(bp + bj * 128 + 4); }
#pragma unroll
        for (int ai = 0; ai < 2; ++ai)
#pragma unroll
            for (int m = 0; m < 4; ++m) { bf16_t* rowp = O + (size_t)(row0 + ai * 128 + m * 16) * DM + col0;
#pragma unroll
                for (int bj = 0; bj < 2; ++bj) *(u32x4*)(rowp + bj * 128) = pack8(acc[ai][bj][m][0] * (1.0f / W8) + bv[bj][0], acc[ai][bj][m][1] * (1.0f / W8) + bv[bj][1]); }
    }
};

constexpr int NWAVES = 8;
enum { IN_X = 0, IN_C, IN_POS, IN_ADAW, IN_ADAB, IN_N1G, IN_WIN, IN_QNG, IN_WQB, IN_KVNG, IN_WKVB, IN_MLAOG, IN_CONVW, IN_ALOG, IN_DTB, IN_GDNG, IN_WOUT, IN_N2G, IN_RW, IN_RB, IN_WGU, IN_BGU, IN_WDN, IN_BDN, IN_FG, N_IN };
struct Frame {
    LAS unsigned char* lds; volatile LAS unsigned* MISC; unsigned* ctl; unsigned char* ws;
    int tid, lane, wave, G, vcu;
    const float* in[N_IN]; float* out;
};
#define WSP(T_, off) ((T_*)(F.ws + (off)))

__device__ __forceinline__ void p0_mod(Frame& F) {
    LAS float* cact = (LAS float*)F.lds;
    LAS float* red = (LAS float*)(F.lds + 32768);
    if ((int)blockIdx.x >= 96) return;
    const float* c = F.in[IN_C];
    for (int i = F.tid; i < BATCH * DM; i += NWAVES * 64) cact[i] = siluf(c[i]);
    __syncthreads();
    float* mod = WSP(float, WS_MOD);
    for (int it = blockIdx.x; it < 96; it += F.G) {
        const int j = it * 64 + F.lane; float a[8];
#pragma unroll
        for (int b = 0; b < 8; ++b) a[b] = 0.f;
        const float* w = F.in[IN_ADAW] + j;
#pragma unroll 4
        for (int k = F.wave * 128; k < F.wave * 128 + 128; ++k) { const float wv = w[(size_t)k * 6144];
#pragma unroll
            for (int b = 0; b < 8; ++b) a[b] += cact[b * DM + k] * wv; }
#pragma unroll
        for (int b = 0; b < 8; ++b) red[(F.wave * 8 + b) * 64 + F.lane] = a[b];
        __syncthreads();
        { const int b = F.tid >> 6, col = F.tid & 63; float s = 0.f;
#pragma unroll
          for (int w8 = 0; w8 < 8; ++w8) s += red[(w8 * 8 + b) * 64 + col];
          mod[b * 6144 + it * 64 + col] = s + F.in[IN_ADAB][it * 64 + col]; }
        __syncthreads();
    }
}
template <int MAP, bool FP8 = false>
__device__ __forceinline__ void p0_tr_item(const float* W, int K, int N, int NP, void* WTv, const float* ksc, LAS float* scr, int item, int lane) {
    bf16_t* WT = (bf16_t*)WTv;
    const int nblk = NP / 32, kb = item / nblk, nb = item % nblk, k0 = 64 * kb, n0 = 32 * nb;
    const int nn = n0 + (lane & 31);
#pragma unroll 8
    for (int i = 0; i < 32; ++i) { const int kk = 2 * i + (lane >> 5); float v = (nn < N) ? W[(size_t)(k0 + kk) * N + nn] : 0.f; if (ksc) v *= ksc[k0 + kk]; scr[kk * 33 + (lane & 31)] = v; }
    LDS_WAIT(); asm volatile("" ::: "memory");
    const int c = lane & 7;
#pragma unroll
    for (int j = 0; j < 4; ++j) { const int n = (lane >> 3) + 8 * j; const LAS float* s = scr + (8 * c) * 33 + n;
        u32x4 o; o.x = cvtpk(s[0 * 33], s[1 * 33]); o.y = cvtpk(s[2 * 33], s[3 * 33]); o.z = cvtpk(s[4 * 33], s[5 * 33]); o.w = cvtpk(s[6 * 33], s[7 * 33]);
        int dn = n0 + n;
        if (MAP == 1) { const int half = dn >> 10, r = dn & 1023; dn = ((r >> 7) << 8) + (half << 7) + (r & 127); }
        if constexpr (FP8) { u32x2 o8; o8.x = pk4_fp8(s[0 * 33] * W8, s[1 * 33] * W8, s[2 * 33] * W8, s[3 * 33] * W8); o8.y = pk4_fp8(s[4 * 33] * W8, s[5 * 33] * W8, s[6 * 33] * W8, s[7 * 33] * W8);
            *(GAS u32x2*)((unsigned char*)WTv + (size_t)dn * K + k0 + 8 * c) = o8; }
        else *(GAS u32x4*)(WT + (size_t)dn * K + k0 + 8 * c) = o; }
    LDS_WAIT(); asm volatile("" ::: "memory");
}
__device__ __forceinline__ void p0_weights(Frame& F) {
    LAS float* scr = (LAS float*)(F.lds + 49152 + F.wave * 8704);
    const int gw = F.vcu * NWAVES + F.wave, NGW = F.G * NWAVES;
    constexpr int I_IN = (DM / 64) * (NPROJ / 32), I_Q = (QLORA / 64) * (768 / 32), I_KV = (KVLORA / 64) * (1024 / 32), I_O = (DM / 64) * (DM / 32);
    constexpr int I_GU = (DM / 64) * (2048 / 32), I_DN = (DE / 64) * (DM / 32);
    constexpr int NITEMS = I_IN + I_Q + I_KV + I_O + NE * I_GU + NE * I_DN;
    for (int it = gw; it < NITEMS; it += NGW) {
        int r = it;
        if (r < I_IN) { p0_tr_item<0>(F.in[IN_WIN], DM, IN_DIM, NPROJ, WSP(bf16_t, WS_WIN), nullptr, scr, r, F.lane); continue; } r -= I_IN;
        if (r < I_Q) { p0_tr_item<0>(F.in[IN_WQB], QLORA, 768, 768, WSP(bf16_t, WS_WQ), F.in[IN_QNG], scr, r, F.lane); continue; } r -= I_Q;
        if (r < I_KV) { p0_tr_item<0>(F.in[IN_WKVB], KVLORA, 1024, 1024, WSP(bf16_t, WS_WKV), F.in[IN_KVNG], scr, r, F.lane); continue; } r -= I_KV;
        if (r < I_O) { p0_tr_item<0>(F.in[IN_WOUT], DM, DM, DM, WSP(bf16_t, WS_WO), nullptr, scr, r, F.lane); continue; } r -= I_O;
        if (r < NE * I_GU) { const int e = r / I_GU; p0_tr_item<1, true>(F.in[IN_WGU] + (size_t)e * DM * 2048, DM, 2048, 2048, WSP(unsigned char, WS_WGU) + (size_t)e * 2048 * DM, nullptr, scr, r - e * I_GU, F.lane); continue; } r -= NE * I_GU;
        { const int e = r / I_DN; p0_tr_item<0, true>(F.in[IN_WDN] + (size_t)e * DE * DM, DE, DM, DM, WSP(unsigned char, WS_WDN) + (size_t)e * DM * DE, nullptr, scr, r - e * I_DN, F.lane); }
    }
    float* rwt = WSP(float, WS_RWT);
    for (int i = (int)blockIdx.x * NWAVES * 64 + F.tid; i < NE * DM; i += F.G * NWAVES * 64) { const int e = i >> 10, k = i & 1023; rwt[i] = F.in[IN_RW][k * NE + e]; }
}

__device__ __forceinline__ void norm_rows(Frame& F, const float* x, const float* gain, int SH, int SC, bf16_t* outp) {
    const int gw = F.vcu * NWAVES + F.wave, NGW = F.G * NWAVES;
    const float* mod = WSP(float, WS_MOD);
    for (int m = gw; m < T; m += NGW) {
        const f32x4* xr = (const f32x4*)(x + (size_t)m * DM) + F.lane; const float* mb = mod + (size_t)(m / SEQ) * 6144;
        f32x4 v[4]; float s = 0.f;
#pragma unroll
        for (int j = 0; j < 4; ++j) { v[j] = xr[64 * j]; s += (v[j][0] * v[j][0] + v[j][1] * v[j][1]) + (v[j][2] * v[j][2] + v[j][3] * v[j][3]); }
        const float rstd = __builtin_amdgcn_rsqf(wave_sum(s) * (1.f / DM) + EPS);
        u32x2* o8 = (u32x2*)(outp + (size_t)m * DM) + F.lane;
#pragma unroll
        for (int j = 0; j < 4; ++j) { const int col = 4 * (F.lane + 64 * j);
            const f32x4 g = *(const f32x4*)(gain + col), sc = *(const f32x4*)(mb + SC + col), sh = *(const f32x4*)(mb + SH + col);
            const f32x4 h = v[j] * rstd * g * (sc + 1.0f) + sh; u32x2 w; w.x = cvtpk(h[0], h[1]); w.y = cvtpk(h[2], h[3]); o8[64 * j] = w; }
    }
}

__device__ const float ROPE_INVF[16] = {1.0f, 0.5623413251903491f, 0.31622776601683794f, 0.1778279410038923f, 0.1f, 0.05623413251903491f, 0.03162277660168379f, 0.01778279410038923f,
    0.01f, 0.005623413251903491f, 0.003162277660168379f, 0.0017782794100389228f, 0.001f, 0.0005623413251903491f, 0.00031622776601683794f, 0.00017782794100389227f};
__device__ __forceinline__ float ssq8(u32x4 a) { float s = 0.f;
#pragma unroll
    for (int i = 0; i < 4; ++i) { const float lo = bflo(a[i]), hi = bfhi(a[i]); s += lo * lo + hi * hi; } return s; }
__device__ __forceinline__ void p3a_rows(Frame& F) {
    const int gw = F.vcu * NWAVES + F.wave, NGW = F.G * NWAVES, lane = F.lane;
    const bf16_t* proj = WSP(bf16_t, WS_PROJ); float* rsq = WSP(float, WS_RSQ); float* rskv = WSP(float, WS_RSKV); float* cs = WSP(float, WS_CS); bf16_t* Kb = WSP(bf16_t, WS_K);
    const int* pos = (const int*)F.in[IN_POS];
    for (int m = gw; m < T; m += NGW) {
        const u32x4* pr = (const u32x4*)(proj + (size_t)m * NPROJ);
        const u32x4 a = pr[lane]; u32x4 b = (u32x4){0u, 0u, 0u, 0u}; if (lane < 20) b = pr[64 + lane];
        const float sa = ssq8(a), sb = ssq8(b);
        const float sq = wave_sum(lane < 48 ? sa : 0.f), skv = wave_sum((lane >= 48 ? sa : 0.f) + (lane < 16 ? sb : 0.f));
        if (lane == 0) { rsq[m] = __builtin_amdgcn_rsqf(sq * (1.f / QLORA) + EPS); rskv[m] = __builtin_amdgcn_rsqf(skv * (1.f / KVLORA) + EPS); }
        const float ang = (float)pos[m] * ROPE_INVF[lane & 15];
        const double rev = (double)ang * 0.15915494309189535; const float fr = (float)(rev - __builtin_rint(rev));
        const float cv = __builtin_amdgcn_cosf(fr), sv = __builtin_amdgcn_sinf(fr);
        if (lane < 16) { cs[(size_t)m * 32 + lane] = cv; cs[(size_t)m * 32 + 16 + lane] = sv; }
        float xv[8], pv[8], cc[8], ss[8];
#pragma unroll
        for (int i = 0; i < 4; ++i) { xv[2 * i] = bflo(b[i]); xv[2 * i + 1] = bfhi(b[i]); }
        const int i0 = 8 * (lane & 1);
#pragma unroll
        for (int j = 0; j < 8; ++j) { pv[j] = __shfl_xor(xv[j], 2); cc[j] = __shfl(cv, i0 + j); ss[j] = __shfl(sv, i0 + j); }
        if (lane >= 16 && lane < 20) {
            float o[8];
#pragma unroll
            for (int j = 0; j < 8; ++j) o[j] = (lane < 18) ? xv[j] * cc[j] - pv[j] * ss[j] : xv[j] * cc[j] + pv[j] * ss[j];
            u32x4 w; w.x = cvtpk(o[0], o[1]); w.y = cvtpk(o[2], o[3]); w.z = cvtpk(o[4], o[5]); w.w = cvtpk(o[6], o[7]);
#pragma unroll
            for (int h = 0; h < NH; ++h) *(u32x4*)(Kb + (size_t)m * 768 + h * 96 + 64 + 8 * (lane - 16)) = w;
        }
    }
}

__device__ __forceinline__ int crow(int r, int hi) { return (r & 3) + 8 * (r >> 2) + 4 * hi; }
typedef short v4i16_t __attribute__((ext_vector_type(4)));
constexpr int AT_KROW = 208, AT_VROW = 144, AT_KBUF = 64 * AT_KROW, AT_VBUF = 64 * AT_VROW, AT_V0 = 2 * AT_KBUF, AT_WS = AT_V0 + 2 * AT_VBUF;
__device__ __forceinline__ void attn_unit(Frame& F, int b, int h, int qb) {
    const int tid = F.tid, lane = F.lane, wid = F.wave, r32 = lane & 31, hi = lane >> 5;
    const bf16_t* Qg = WSP(bf16_t, WS_Q); const bf16_t* Kg = WSP(bf16_t, WS_K); const bf16_t* Vg = WSP(bf16_t, WS_V); bf16_t* Og = WSP(bf16_t, WS_OA);
    LAS unsigned char* Kl = F.lds; LAS unsigned char* Vl = F.lds + AT_V0; LAS float* wsf = (LAS float*)(F.lds + AT_WS) + wid * 64;
    const size_t tb = (size_t)b * SEQ; const int q0 = qb * 256, NT = 4 * qb + 4;
    bf16x8 qr[6];
    { const bf16_t* Qp = Qg + (tb + q0 + wid * 32 + r32) * 768 + h * 96 + hi * 8;
#pragma unroll
      for (int d0 = 0; d0 < 6; ++d0) qr[d0] = *(const bf16x8*)(Qp + d0 * 16); }
    const int kr0 = tid / 12, kc0 = tid % 12, kr1 = (tid + 512) / 12, kc1 = (tid + 512) % 12, vr = tid >> 3, vc = tid & 7;
    const bf16_t* kp0 = Kg + (tb + kr0) * 768 + h * 96 + 8 * kc0; const bf16_t* kp1 = Kg + (tb + kr1) * 768 + h * 96 + 8 * kc1; const bf16_t* vp = Vg + (tb + vr) * 512 + h * 64 + 8 * vc;
    u32x4 kreg0, kreg1 = (u32x4){0u, 0u, 0u, 0u}, vreg;
#define AT_LOAD(t) do { kreg0 = *(const u32x4*)(kp0 + (size_t)(t) * 64 * 768); if (tid < 256) kreg1 = *(const u32x4*)(kp1 + (size_t)(t) * 64 * 768); vreg = *(const u32x4*)(vp + (size_t)(t) * 64 * 512); } while (0)
#define AT_STORE(bf) do { *(LAS u32x4*)(Kl + (bf) * AT_KBUF + kr0 * AT_KROW + kc0 * 16) = kreg0; if (tid < 256) *(LAS u32x4*)(Kl + (bf) * AT_KBUF + kr1 * AT_KROW + kc1 * 16) = kreg1; \
        *(LAS u32x4*)(Vl + (bf) * AT_VBUF + vr * AT_VROW + vc * 16) = vreg; } while (0)
    AT_LOAD(0); AT_STORE(0); __syncthreads();
    float m_run = -INFINITY, l_run = 0.f; f32x16 o[2];
#pragma unroll
    for (int r = 0; r < 16; ++r) { o[0][r] = 0.f; o[1][r] = 0.f; }
    const int qmax = q0 + wid * 32 + 31, qpos = q0 + wid * 32 + r32;
    for (int t = 0; t < NT; ++t) {
        const int bf = t & 1;
        if (t + 1 < NT) AT_LOAD(t + 1);
        if (64 * t <= qmax) {
            f32x16 p0, p1;
#pragma unroll
            for (int r = 0; r < 16; ++r) { p0[r] = 0.f; p1[r] = 0.f; }
            const LAS unsigned char* kb = Kl + bf * AT_KBUF + r32 * AT_KROW + hi * 16;
#pragma unroll
            for (int d0 = 0; d0 < 6; ++d0) { const bf16x8 k0 = *(const LAS bf16x8*)(kb + d0 * 32), k1 = *(const LAS bf16x8*)(kb + 32 * AT_KROW + d0 * 32);
                p0 = __builtin_amdgcn_mfma_f32_32x32x16_bf16(k0, qr[d0], p0, 0, 0, 0); p1 = __builtin_amdgcn_mfma_f32_32x32x16_bf16(k1, qr[d0], p1, 0, 0, 0); }
            if (t >= NT - 4) {
#pragma unroll
                for (int r = 0; r < 16; ++r) { const int kv = 64 * t + crow(r, hi); if (kv > qpos) p0[r] = -INFINITY; if (kv + 32 > qpos) p1[r] = -INFINITY; }
            }
            float mx = fmaxf(p0[0], p1[0]);
#pragma unroll
            for (int r = 1; r < 16; ++r) mx = fmaxf(mx, fmaxf(p0[r], p1[r]));
            mx = fmaxf(mx, __shfl_xor(mx, 32));
            const float m_new = fmaxf(m_run, mx);
            if (__any(m_new > m_run)) {
                const float f = __builtin_amdgcn_exp2f(m_run - m_new);
                l_run *= f; m_run = m_new;
                if (hi == 0) wsf[r32] = f;
                float fr_[16];
#pragma unroll
                for (int r = 0; r < 16; ++r) fr_[r] = wsf[crow(r, hi)];
#pragma unroll
                for (int r = 0; r < 16; ++r) { o[0][r] *= fr_[r]; o[1][r] *= fr_[r]; }
            }
            float rs = 0.f;
#pragma unroll
            for (int r = 0; r < 16; ++r) { p0[r] = __builtin_amdgcn_exp2f(p0[r] - m_run); p1[r] = __builtin_amdgcn_exp2f(p1[r] - m_run); rs += p0[r] + p1[r]; }
            l_run += rs;
            bf16x8 pa[4];
#pragma unroll
            for (int ks = 0; ks < 4; ++ks) { u32x4 w;
#pragma unroll
                for (int i = 0; i < 4; ++i) { const int r = (ks & 1) * 8 + 2 * i; w[i] = (ks < 2) ? cvtpk(p0[r], p0[r + 1]) : cvtpk(p1[r], p1[r + 1]); }
                pa[ks] = __builtin_bit_cast(bf16x8, w); }
            const LAS unsigned char* vb = Vl + bf * AT_VBUF + (4 * hi + ((lane & 15) >> 2)) * AT_VROW + (((lane >> 4) & 1) * 16 + (lane & 3) * 4) * 2;
#pragma unroll
            for (int d0 = 0; d0 < 2; ++d0)
#pragma unroll
                for (int ks = 0; ks < 4; ++ks) {
                    const v4i16_t lo = __builtin_amdgcn_ds_read_tr16_b64_v4i16((LAS v4i16_t*)(vb + ks * 16 * AT_VROW + d0 * 64));
                    const v4i16_t hv = __builtin_amdgcn_ds_read_tr16_b64_v4i16((LAS v4i16_t*)(vb + ks * 16 * AT_VROW + 8 * AT_VROW + d0 * 64));
                    const bf16x8 vf = (bf16x8){lo[0], lo[1], lo[2], lo[3], hv[0], hv[1], hv[2], hv[3]};
                    o[d0] = __builtin_amdgcn_mfma_f32_32x32x16_bf16(pa[ks], vf, o[d0], 0, 0, 0); }
        }
        if (t + 1 < NT) AT_STORE((t + 1) & 1);
        __syncthreads();
    }
    { float lt = l_run + __shfl_xor(l_run, 32);
      if (hi == 0) wsf[32 + r32] = lt;
      bf16_t* Ow = Og + (tb + q0 + wid * 32) * 512 + h * 64 + r32;
#pragma unroll
      for (int r = 0; r < 16; ++r) { const int qr_ = crow(r, hi); const float inv = 1.0f / wsf[32 + qr_];
          Ow[(size_t)qr_ * 512] = f2bf(o[0][r] * inv); Ow[(size_t)qr_ * 512 + 32] = f2bf(o[1][r] * inv); } }
#undef AT_LOAD
#undef AT_STORE
}

__device__ __forceinline__ void p4b_rows(Frame& F) {
    const int gw = F.vcu * NWAVES + F.wave, NGW = F.G * NWAVES, lane = F.lane;
    const bf16_t* oa = WSP(bf16_t, WS_OA); const bf16_t* og = WSP(bf16_t, WS_OG); const bf16_t* proj = WSP(bf16_t, WS_PROJ); bf16_t* mx = WSP(bf16_t, WS_H);
    const float* ga = F.in[IN_MLAOG] + 8 * lane; const float* gg = F.in[IN_GDNG] + 8 * (lane & 7);
    for (int m = gw; m < T; m += NGW) {
        const u32x4 a = *(const u32x4*)(oa + (size_t)m * 512 + 8 * lane), g = *(const u32x4*)(og + (size_t)m * 512 + 8 * lane), z = *(const u32x4*)(proj + (size_t)m * NPROJ + C_GZ + 8 * lane);
        const float ra = __builtin_amdgcn_rsqf(wave_sum(ssq8(a)) * (1.f / 512) + EPS);
        float sg = ssq8(g); sg += __shfl_xor(sg, 1); sg += __shfl_xor(sg, 2); sg += __shfl_xor(sg, 4);
        const float rg = __builtin_amdgcn_rsqf(sg * (1.f / 64) + EPS);
        float oa8[8], og8[8];
#pragma unroll
        for (int i = 0; i < 4; ++i) { oa8[2 * i] = bflo(a[i]) * ra * ga[2 * i]; oa8[2 * i + 1] = bfhi(a[i]) * ra * ga[2 * i + 1];
            og8[2 * i] = bflo(g[i]) * rg * gg[2 * i] * siluf(bflo(z[i])); og8[2 * i + 1] = bfhi(g[i]) * rg * gg[2 * i + 1] * siluf(bfhi(z[i])); }
        u32x4 wa, wg;
#pragma unroll
        for (int i = 0; i < 4; ++i) { wa[i] = cvtpk(oa8[2 * i], oa8[2 * i + 1]); wg[i] = cvtpk(og8[2 * i], og8[2 * i + 1]); }
        *(u32x4*)(mx + (size_t)m * DM + 8 * lane) = wa; *(u32x4*)(mx + (size_t)m * DM + 512 + 8 * lane) = wg;
    }
}

constexpr int G1_KRM = 0, G1_QRM = 4608, G1_AM = 9216, G1_QK = 13440, G1_UT = 16000, G1_WT = 21120, G1_KT = 26240, G1_GT = 31360, G1_SLOT = 32000, G1_CW = 4 * G1_SLOT;
static_assert(G1_CW + 3072 <= RING_BYTES, "G1 LDS");
__device__ __forceinline__ f32x4 mfma16(bf16x8 a, bf16x8 b, f32x4 c) { return __builtin_amdgcn_mfma_f32_16x16x32_bf16(a, b, c, 0, 0, 0); }

__device__ __forceinline__ void g1_unit(Frame& F, int unit) {
    const int tid = F.tid, lane = F.lane, wid = F.wave;
    const int bh = unit >> 5, c0 = (unit & 31) * 4, b = bh >> 3, h = bh & 7;
    const bf16_t* proj = WSP(bf16_t, WS_PROJ);
    LAS unsigned char* L = F.lds; LAS float* cw = (LAS float*)(L + G1_CW);
    const size_t tb = (size_t)b * SEQ;
    for (int i = tid; i < 768; i += NWAVES * 64) { const int x = i >> 8, w = (i >> 6) & 3, ch = i & 63; cw[i] = F.in[IN_CONVW][w * 1536 + x * 512 + h * 64 + ch]; }
    __syncthreads();
    { const int tk = tid >> 2, part = tid & 3, s = tk >> 5, i = tk & 31, isk = part >> 1, chb = (part & 1) * 32;
      const int sp = (c0 + s) * GC + i;
      const bf16_t* src = proj + (tb + sp) * NPROJ + (isk ? C_GK : C_GQ) + h * 64 + chb;
      float v[32];
#pragma unroll
      for (int c = 0; c < 32; ++c) v[c] = 0.f;
#pragma unroll
      for (int w = 0; w < 4; ++w) { if (sp - 3 + w >= 0) { const bf16_t* rp = src - (ptrdiff_t)(3 - w) * NPROJ;
#pragma unroll
          for (int q4 = 0; q4 < 4; ++q4) { const u32x4 d = *(const u32x4*)(rp + 8 * q4);
#pragma unroll
              for (int e = 0; e < 4; ++e) { const int ch = 8 * q4 + 2 * e; v[ch] += bflo(d[e]) * cw[(isk * 4 + w) * 64 + chb + ch]; v[ch + 1] += bfhi(d[e]) * cw[(isk * 4 + w) * 64 + chb + ch + 1]; } } } }
      float ss = 0.f;
#pragma unroll
      for (int c = 0; c < 32; ++c) { v[c] = siluf(v[c]); ss += v[c] * v[c]; }
      ss += __shfl_xor(ss, 1);
      const float rn = __builtin_amdgcn_rsqf(ss + EPS) * (isk ? 1.0f : 0.125f);
      LAS bf16_t* dst = (LAS bf16_t*)(L + s * G1_SLOT + (isk ? G1_KRM : G1_QRM)) + i * 72 + chb;
#pragma unroll
      for (int q4 = 0; q4 < 4; ++q4) { u32x4 w;
#pragma unroll
          for (int e = 0; e < 4; ++e) w[e] = cvtpk(v[8 * q4 + 2 * e] * rn, v[8 * q4 + 2 * e + 1] * rn);
          *(LAS u32x4*)(dst + 8 * q4) = w; }
      if (part == 0) { LAS float* gt = (LAS float*)(L + s * G1_SLOT + G1_GT);
          const float ain = bf2f(proj[(tb + sp) * NPROJ + C_GA + h]), bin = bf2f(proj[(tb + sp) * NPROJ + C_GB + h]);
          const float xs = ain + F.in[IN_DTB][h], sp_ = xs > 20.f ? xs : log1pf(__expf(xs));
          gt[i] = 1.0f / (1.0f + __expf(-bin));
          gt[32 + i] = -__expf(F.in[IN_ALOG][h]) * sp_; }
    }
    __syncthreads();
    if (tid < 4) { LAS float* gt = (LAS float*)(L + tid * G1_SLOT + G1_GT); float cum = 0.f;
        for (int i = 0; i < 32; ++i) { cum += gt[32 + i]; gt[64 + i] = cum; }
        for (int i = 0; i < 32; ++i) { gt[96 + i] = __expf(gt[64 + i]); gt[128 + i] = __expf(cum - gt[64 + i]); } }
    __syncthreads();
    const int s = wid >> 1, sub = wid & 1, l15 = lane & 15, kq = lane >> 4;
    LAS unsigned char* Ls = L + s * G1_SLOT; LAS float* gt = (LAS float*)(Ls + G1_GT);
    { const LAS bf16_t* X = (const LAS bf16_t*)(Ls + (sub ? G1_QRM : G1_KRM)); const LAS bf16_t* Kr = (const LAS bf16_t*)(Ls + G1_KRM);
#pragma unroll
      for (int it = 0; it < 2; ++it)
#pragma unroll
          for (int jt = 0; jt < 2; ++jt) { f32x4 acc = (f32x4){0.f, 0.f, 0.f, 0.f};
#pragma unroll
              for (int ks = 0; ks < 2; ++ks) acc = mfma16(*(const LAS bf16x8*)(X + (16 * it + l15) * 72 + 32 * ks + 8 * kq), *(const LAS bf16x8*)(Kr + (16 * jt + l15) * 72 + 32 * ks + 8 * kq), acc);
              const int j = 16 * jt + l15; const float gj = gt[64 + j];
#pragma unroll
              for (int r = 0; r < 4; ++r) { const int i = 16 * it + 4 * kq + r; const float gi = gt[64 + i];
                  if (sub == 0) { const float val = (i > j) ? acc[r] * gt[i] * __expf(gi - gj) : 0.f; ((LAS float*)(Ls + G1_AM))[i * 33 + j] = val; }
                  else { const float val = (i >= j) ? acc[r] * __expf(gi - gj) : 0.f; ((LAS bf16_t*)(Ls + G1_QK))[i * 40 + j] = f2bf(val); } } }
    }
    for (int idx = tid; idx < 4 * 64 * 32; idx += NWAVES * 64) { const int s2 = idx >> 11, d = (idx >> 5) & 63, c = idx & 31; LAS unsigned char* L2 = L + s2 * G1_SLOT;
        ((LAS bf16_t*)(L2 + G1_KT))[d * 40 + c] = f2bf(bf2f(((const LAS bf16_t*)(L2 + G1_KRM))[c * 72 + d]) * ((const LAS float*)(L2 + G1_GT))[128 + c]); }
    __syncthreads();
    { float sol[32];
      if (sub == 0) {
          const int sp0 = (c0 + s) * GC; const bf16_t* src = proj + (tb + sp0) * NPROJ + C_GV + h * 64 + lane;
          const float w0 = cw[(8 + 0) * 64 + lane], w1 = cw[(8 + 1) * 64 + lane], w2 = cw[(8 + 2) * 64 + lane], w3 = cw[(8 + 3) * 64 + lane];
          float x0 = (sp0 >= 3) ? bf2f(src[-3 * (ptrdiff_t)NPROJ]) : 0.f, x1 = (sp0 >= 2) ? bf2f(src[-2 * (ptrdiff_t)NPROJ]) : 0.f, x2 = (sp0 >= 1) ? bf2f(src[-1 * (ptrdiff_t)NPROJ]) : 0.f;
#pragma unroll
          for (int i = 0; i < 32; ++i) { const float x3 = bf2f(src[(size_t)i * NPROJ]); sol[i] = siluf(w0 * x0 + w1 * x1 + w2 * x2 + w3 * x3) * gt[i]; x0 = x1; x1 = x2; x2 = x3; }
      } else {
          const LAS bf16_t* Kr = (const LAS bf16_t*)(Ls + G1_KRM);
#pragma unroll
          for (int i = 0; i < 32; ++i) sol[i] = bf2f(Kr[i * 72 + lane]) * gt[i] * gt[96 + i];
      }
      const LAS float* Am = (const LAS float*)(Ls + G1_AM);
#pragma unroll
      for (int i = 1; i < 32; ++i) { const float arow = Am[i * 33 + (lane & 31)]; float a = sol[i];
#pragma unroll
          for (int j = 0; j < i; ++j) a -= __uint_as_float(__builtin_amdgcn_readlane(__float_as_uint(arow), j)) * sol[j];
          sol[i] = a; }
      LAS bf16_t* dst = (LAS bf16_t*)(Ls + (sub ? G1_WT : G1_UT)) + lane * 40;
#pragma unroll
      for (int q4 = 0; q4 < 4; ++q4) { u32x4 w;
#pragma unroll
          for (int e = 0; e < 4; ++e) w[e] = cvtpk(sol[8 * q4 + 2 * e], sol[8 * q4 + 2 * e + 1]);
          *(LAS u32x4*)(dst + 8 * q4) = w; }
    }
    __syncthreads();
    { unsigned char* gd = F.ws + WS_GD + (size_t)(bh * NCH + c0 + s) * 24576;
      const LAS bf16_t* uT = (const LAS bf16_t*)(Ls + G1_UT); const LAS bf16_t* wT = (const LAS bf16_t*)(Ls + G1_WT); const LAS bf16_t* kT = (const LAS bf16_t*)(Ls + G1_KT);
      const LAS bf16_t* qk = (const LAS bf16_t*)(Ls + G1_QK); const LAS bf16_t* qr = (const LAS bf16_t*)(Ls + G1_QRM);
      const f32x4 z4 = (f32x4){0.f, 0.f, 0.f, 0.f}; const float cd = gt[96 + 31];
      if (sub == 0) {
#pragma unroll
          for (int mt = 0; mt < 4; ++mt) { const bf16x8 af = *(const LAS bf16x8*)(wT + (16 * mt + l15) * 40 + 8 * kq);
#pragma unroll
              for (int nt = 0; nt < 4; ++nt) {
                  const f32x4 acc = mfma16(af, *(const LAS bf16x8*)(kT + (16 * nt + l15) * 40 + 8 * kq), z4); const int dout = 16 * nt + l15; u32x2 w; float o4[4];
#pragma unroll
                  for (int r = 0; r < 4; ++r) { const int din = 16 * mt + 4 * kq + r; o4[r] = ((din == dout) ? cd : 0.f) - acc[r]; }
                  w.x = cvtpk(o4[0], o4[1]); w.y = cvtpk(o4[2], o4[3]);
                  *(u32x2*)(gd + ((nt * 2 + (mt >> 1)) * 64 + kq * 16 + l15) * 16 + 8 * (mt & 1)) = w; }
#pragma unroll
              for (int ct = 0; ct < 2; ++ct) {
                  const f32x4 acc = mfma16(af, *(const LAS bf16x8*)(qk + (16 * ct + l15) * 40 + 8 * kq), z4); const int c = 16 * ct + l15; const float eg = gt[96 + c];
                  const u32x2 qv = *(const LAS u32x2*)(qr + c * 72 + 16 * mt + 4 * kq); u32x2 w;
                  w.x = cvtpk(bflo(qv.x) * eg - acc[0], bfhi(qv.x) * eg - acc[1]); w.y = cvtpk(bflo(qv.y) * eg - acc[2], bfhi(qv.y) * eg - acc[3]);
                  *(u32x2*)(gd + 8192 + ((ct * 2 + (mt >> 1)) * 64 + kq * 16 + l15) * 16 + 8 * (mt & 1)) = w; } }
      } else {
#pragma unroll
          for (int et = 0; et < 4; ++et) { const bf16x8 bfr = *(const LAS bf16x8*)(uT + (16 * et + l15) * 40 + 8 * kq);
#pragma unroll
              for (int dt = 0; dt < 4; ++dt) {
                  const f32x4 acc = mfma16(*(const LAS bf16x8*)(kT + (16 * dt + l15) * 40 + 8 * kq), bfr, z4); u32x2 w; w.x = cvtpk(acc[0], acc[1]); w.y = cvtpk(acc[2], acc[3]);
                  *(u32x2*)(gd + 12288 + ((dt * 4 + et) * 64 + lane) * 8) = w; }
#pragma unroll
              for (int ct = 0; ct < 2; ++ct) {
                  const f32x4 acc = mfma16(*(const LAS bf16x8*)(qk + (16 * ct + l15) * 40 + 8 * kq), bfr, z4); u32x2 w; w.x = cvtpk(acc[0], acc[1]); w.y = cvtpk(acc[2], acc[3]);
                  *(u32x2*)(gd + 20480 + ((ct * 4 + et) * 64 + lane) * 8) = w; } }
      }
    }
    __syncthreads();
}

__device__ __forceinline__ void g2_item(Frame& F, int item) {
    const int lane = F.lane, wid = F.wave, bh = item * 2 + (wid >> 2), es = wid & 3, b = bh >> 3, h = bh & 7, l15 = lane & 15, kq = lane >> 4;
    const unsigned char* gd = F.ws + WS_GD + (size_t)bh * NCH * 24576;
    bf16_t* og = WSP(bf16_t, WS_OG) + ((size_t)b * SEQ) * 512 + h * 64 + 16 * es + l15;
    f32x4 S[4];
#pragma unroll
    for (int m = 0; m < 4; ++m) S[m] = (f32x4){0.f, 0.f, 0.f, 0.f};
    bf16x8 Mf[4][2], Pf[2][2]; u32x2 Nv[4], Rv[2];
#define G2_LOAD(c) do { const unsigned char* p_ = gd + (size_t)(c) * 24576; \
        _Pragma("unroll") for (int m = 0; m < 4; ++m) _Pragma("unroll") for (int s2 = 0; s2 < 2; ++s2) Mf[m][s2] = *(const bf16x8*)(p_ + ((m * 2 + s2) * 64 + lane) * 16); \
        _Pragma("unroll") for (int ct = 0; ct < 2; ++ct) _Pragma("unroll") for (int s2 = 0; s2 < 2; ++s2) Pf[ct][s2] = *(const bf16x8*)(p_ + 8192 + ((ct * 2 + s2) * 64 + lane) * 16); \
        _Pragma("unroll") for (int m = 0; m < 4; ++m) Nv[m] = *(const u32x2*)(p_ + 12288 + ((m * 4 + es) * 64 + lane) * 8); \
        _Pragma("unroll") for (int ct = 0; ct < 2; ++ct) Rv[ct] = *(const u32x2*)(p_ + 20480 + ((ct * 4 + es) * 64 + lane) * 8); } while (0)
    G2_LOAD(0);
    for (int c = 0; c < NCH; ++c) {
        bf16x8 cM[4][2], cP[2][2]; u32x2 cN[4], cR[2];
#pragma unroll
        for (int m = 0; m < 4; ++m) { cM[m][0] = Mf[m][0]; cM[m][1] = Mf[m][1]; cN[m] = Nv[m]; }
#pragma unroll
        for (int ct = 0; ct < 2; ++ct) { cP[ct][0] = Pf[ct][0]; cP[ct][1] = Pf[ct][1]; cR[ct] = Rv[ct]; }
        if (c + 1 < NCH) G2_LOAD(c + 1);
        bf16x8 Bs[2];
#pragma unroll
        for (int s2 = 0; s2 < 2; ++s2) { u32x4 w; w.x = cvtpk(S[2 * s2][0], S[2 * s2][1]); w.y = cvtpk(S[2 * s2][2], S[2 * s2][3]); w.z = cvtpk(S[2 * s2 + 1][0], S[2 * s2 + 1][1]); w.w = cvtpk(S[2 * s2 + 1][2], S[2 * s2 + 1][3]);
            Bs[s2] = __builtin_bit_cast(bf16x8, w); }
#pragma unroll
        for (int ct = 0; ct < 2; ++ct) { f32x4 o = (f32x4){bflo(cR[ct].x), bfhi(cR[ct].x), bflo(cR[ct].y), bfhi(cR[ct].y)};
            o = mfma16(cP[ct][0], Bs[0], o); o = mfma16(cP[ct][1], Bs[1], o);
            bf16_t* op = og + (size_t)(c * GC + 16 * ct + 4 * kq) * 512;
#pragma unroll
            for (int r = 0; r < 4; ++r) op[(size_t)r * 512] = f2bf(o[r]); }
#pragma unroll
        for (int m = 0; m < 4; ++m) { f32x4 a = (f32x4){bflo(cN[m].x), bfhi(cN[m].x), bflo(cN[m].y), bfhi(cN[m].y)};
            a = mfma16(cM[m][0], Bs[0], a); S[m] = mfma16(cM[m][1], Bs[1], a); }
    }
#undef G2_LOAD
}

constexpr int P6_RW = 0, P6_TK = 131072;
__device__ __forceinline__ void p6_router(Frame& F, int rep) {
    const int lane = F.lane, wid = F.wave, tid = F.tid;
    LAS float* rw = (LAS float*)(F.lds + P6_RW);
    { const f32x4* src = (const f32x4*)WSP(float, WS_RWT);
      for (int i = tid; i < NE * DM / 4; i += NWAVES * 64) ((LAS f32x4*)rw)[i] = src[i]; }
    if (tid < 96) F.MISC[32 + tid] = 0u;
    __syncthreads();
    const float* x1 = WSP(float, WS_X1); const float* mod = WSP(float, WS_MOD); unsigned char* h2 = WSP(unsigned char, WS_H);
    const size_t ro = rep ? WS_END : 0;
    int* tke = WSP(int, ro + WS_TKE); float* tkw = WSP(float, ro + WS_TKW); int* tkp = WSP(int, ro + WS_TKP); int* lst = WSP(int, ro + WS_LIST);
    const int tpw = T / F.G, t0 = (int)blockIdx.x * tpw;
    const float rb = F.in[IN_RB][lane >> 1];
    for (int tq = wid * 4; tq < tpw; tq += NWAVES * 4) {
        float acc[4][32];
#pragma unroll
        for (int q = 0; q < 4; ++q)
#pragma unroll
            for (int e = 0; e < 32; ++e) acc[q][e] = 0.f;
        float rstd[4];
#pragma unroll
        for (int q = 0; q < 4; ++q) { const f32x4* xr = (const f32x4*)(x1 + (size_t)(t0 + tq + q) * DM) + lane; float s = 0.f;
#pragma unroll
            for (int j = 0; j < 4; ++j) { const f32x4 v = xr[64 * j]; s += (v[0] * v[0] + v[1] * v[1]) + (v[2] * v[2] + v[3] * v[3]); }
            rstd[q] = __builtin_amdgcn_rsqf(wave_sum(s) * (1.f / DM) + EPS); }
        const float* mb = mod + (size_t)((t0 + tq) / SEQ) * 6144;
#pragma unroll 1
        for (int j = 0; j < 4; ++j) {
            const int col = 4 * (lane + 64 * j);
            const f32x4 g = *(const f32x4*)(F.in[IN_N2G] + col), sc = *(const f32x4*)(mb + 4096 + col), sh = *(const f32x4*)(mb + 3072 + col);
            f32x4 hv[4];
#pragma unroll
            for (int q = 0; q < 4; ++q) { const f32x4 v = *(const f32x4*)(x1 + (size_t)(t0 + tq + q) * DM + col); hv[q] = v * rstd[q] * g * (sc + 1.0f) + sh;
                *(unsigned*)(h2 + (size_t)(t0 + tq + q) * DM + col) = pk4_fp8(hv[q][0], hv[q][1], hv[q][2], hv[q][3]); }
#pragma unroll
            for (int e = 0; e < 32; ++e) { const f32x4 wv = *(const LAS f32x4*)(rw + e * DM + col);
#pragma unroll
                for (int q = 0; q < 4; ++q) acc[q][e] += (hv[q][0] * wv[0] + hv[q][1] * wv[1]) + (hv[q][2] * wv[2] + hv[q][3] * wv[3]); }
        }
#pragma unroll
        for (int q = 0; q < 4; ++q) {
            float v16[16], v8[8], v4[4], v2[2], v1;
            { const bool up = (lane & 32) != 0;
#pragma unroll
              for (int i = 0; i < 16; ++i) { const float keep = up ? acc[q][i + 16] : acc[q][i], give = up ? acc[q][i] : acc[q][i + 16]; v16[i] = keep + __shfl_xor(give, 32); } }
            { const bool up = (lane & 16) != 0;
#pragma unroll
              for (int i = 0; i < 8; ++i) { const float keep = up ? v16[i + 8] : v16[i], give = up ? v16[i] : v16[i + 8]; v8[i] = keep + __shfl_xor(give, 16); } }
            { const bool up = (lane & 8) != 0;
#pragma unroll
              for (int i = 0; i < 4; ++i) { const float keep = up ? v8[i + 4] : v8[i], give = up ? v8[i] : v8[i + 4]; v4[i] = keep + __shfl_xor(give, 8); } }
            { const bool up = (lane & 4) != 0;
#pragma unroll
              for (int i = 0; i < 2; ++i) { const float keep = up ? v4[i + 2] : v4[i], give = up ? v4[i] : v4[i + 2]; v2[i] = keep + __shfl_xor(give, 4); } }
            { const bool up = (lane & 2) != 0; const float keep = up ? v2[1] : v2[0], give = up ? v2[0] : v2[1]; v1 = keep + __shfl_xor(give, 2); }
            v1 += __shfl_xor(v1, 1);
            float logit = v1 + rb; const int me = lane >> 1;
            float tv[4]; int ti[4];
#pragma unroll
            for (int k = 0; k < 4; ++k) { float bv = logit; int bi = me;
#pragma unroll
                for (int o = 1; o < 64; o <<= 1) { const float ov = __shfl_xor(bv, o); const int oi = __shfl_xor(bi, o); if (ov > bv || (ov == bv && oi < bi)) { bv = ov; bi = oi; } }
                tv[k] = bv; ti[k] = bi; if (me == bi) logit = -INFINITY; }
            const float e1 = __expf(tv[1] - tv[0]), e2 = __expf(tv[2] - tv[0]), e3 = __expf(tv[3] - tv[0]), inv = 1.0f / (1.0f + e1 + e2 + e3);
            if (lane < 4) { const int t = t0 + tq + q; const int e = (lane == 0) ? ti[0] : (lane == 1) ? ti[1] : (lane == 2) ? ti[2] : ti[3];
                const float w = ((lane == 0) ? 1.0f : (lane == 1) ? e1 : (lane == 2) ? e2 : e3) * inv;
                const int lp = __hip_atomic_fetch_add((LAS int*)(F.lds + MISC_OFF) + 32 + e, 1, __ATOMIC_RELAXED, __HIP_MEMORY_SCOPE_WORKGROUP);
                tke[t * 4 + lane] = e; tkw[t * 4 + lane] = w; tkp[t * 4 + lane] = lp; }
        }
    }
    __syncthreads();
    if (tid < 32) { const int n = (int)F.MISC[32 + tid]; int base = 0; if (n > 0) base = (int)__hip_atomic_fetch_add(F.ctl + CW_CNT + 4096 * rep + 64 * tid, (unsigned)n, RLX_AGENT); F.MISC[64 + tid] = (unsigned)base; }
    VM_WAIT(); __syncthreads();
    for (int i = tid; i < tpw * 4; i += NWAVES * 64) { const int t = t0 + (i >> 2), e = tke[t * 4 + (i & 3)], p = tkp[t * 4 + (i & 3)] + (int)F.MISC[64 + e]; tkp[t * 4 + (i & 3)] = p; lst[(size_t)e * T + p] = t; }
}
__device__ __forceinline__ void moe_tables(Frame& F) {
    if (F.tid < 32) F.MISC[192 + F.tid] = __hip_atomic_load(F.ctl + CW_CNT + 64 * F.tid, RLX_AGENT);
    __syncthreads();
    if (F.tid == 0) { unsigned s = 0; for (int e = 0; e < 32; ++e) { F.MISC[128 + e] = s; s += (F.MISC[192 + e] + 255u) >> 8; } F.MISC[160] = s; }
    __syncthreads();
}
__device__ __forceinline__ void p10_combine(Frame& F) {
    const int gw = F.vcu * NWAVES + F.wave, NGW = F.G * NWAVES, lane = F.lane;
    const float* x1 = WSP(float, WS_X1); const float* mod = WSP(float, WS_MOD); const bf16_t* y = WSP(bf16_t, WS_Y);
    const int* tke = WSP(int, WS_TKE); const float* tkw = WSP(float, WS_TKW); const int* tkp = WSP(int, WS_TKP);
    for (int m = gw; m < T; m += NGW) {
        float a[16];
#pragma unroll
        for (int i = 0; i < 16; ++i) a[i] = 0.f;
#pragma unroll
        for (int k = 0; k < 4; ++k) { const int e = tke[m * 4 + k]; const float w = tkw[m * 4 + k]; const size_t row = (size_t)F.MISC[128 + e] * 256 + tkp[m * 4 + k];
            const u32x4 y0 = *(const u32x4*)(y + row * DM + 8 * lane), y1 = *(const u32x4*)(y + row * DM + 512 + 8 * lane);
#pragma unroll
            for (int i = 0; i < 4; ++i) { a[2 * i] += w * bflo(y0[i]); a[2 * i + 1] += w * bfhi(y0[i]); a[8 + 2 * i] += w * bflo(y1[i]); a[8 + 2 * i + 1] += w * bfhi(y1[i]); } }
        const float* mb = mod + (size_t)(m / SEQ) * 6144 + 5120; float ss = 0.f; f32x4 v[4];
#pragma unroll
        for (int q = 0; q < 4; ++q) { const int col = (q >> 1) * 512 + 8 * lane + 4 * (q & 1);
            const f32x4 xv = *(const f32x4*)(x1 + (size_t)m * DM + col), gt = *(const f32x4*)(mb + col);
#pragma unroll
            for (int i = 0; i < 4; ++i) { v[q][i] = xv[i] + gt[i] * a[(q >> 1) * 8 + 4 * (q & 1) + i]; ss += v[q][i] * v[q][i]; } }
        const float rstd = __builtin_amdgcn_rsqf(wave_sum(ss) * (1.f / DM) + EPS);
#pragma unroll
        for (int q = 0; q < 4; ++q) { const int col = (q >> 1) * 512 + 8 * lane + 4 * (q & 1); const f32x4 fg = *(const f32x4*)(F.in[IN_FG] + col);
            *(f32x4*)(F.out + (size_t)m * DM + col) = v[q] * rstd * fg; }
    }
}


__device__ __forceinline__ void dbg_final(Frame& F, const float* src) {
    const int gw = F.vcu * NWAVES + F.wave, NGW = F.G * NWAVES;
    for (int m = gw; m < T; m += NGW) {
        const f32x4* xr = (const f32x4*)(src + (size_t)m * DM) + F.lane; f32x4 v[4]; float s = 0.f;
#pragma unroll
        for (int j = 0; j < 4; ++j) { v[j] = xr[64 * j]; s += (v[j][0] * v[j][0] + v[j][1] * v[j][1]) + (v[j][2] * v[j][2] + v[j][3] * v[j][3]); }
        const float rstd = __builtin_amdgcn_rsqf(wave_sum(s) * (1.f / DM) + EPS);
#pragma unroll
        for (int j = 0; j < 4; ++j) { const int col = 4 * (F.lane + 64 * j); *(f32x4*)(F.out + (size_t)m * DM + col) = v[j] * rstd * *(const f32x4*)(F.in[IN_FG] + col); }
    }
}


__device__ __forceinline__ void dbg_dump_bf16(Frame& F, const bf16_t* src, int ld, int c0, int n) {
    for (size_t i = (size_t)blockIdx.x * NWAVES * 64 + F.tid; i < (size_t)T * n; i += (size_t)F.G * NWAVES * 64) { const size_t t = i / n; const int c = (int)(i % n); F.out[t * DM + c0 + c] = bf2f(src[t * ld + c]); }
}
#define DBG_DUMP(k, ...) do { if (DBG_STAGE == (k)) { xcd_barrier(bar); __VA_ARGS__; return; } } while (0)
#ifndef DBG_STAGE
#define DBG_STAGE (-1)
#endif

constexpr int N_PHASES = 13;
struct Args { const float* in[N_IN]; float* out; unsigned char* ws; int ph_lo, ph_hi; };
__global__ void __launch_bounds__(NWAVES * 64, 2) fwd_kernel(Args args) {
    extern __shared__ __attribute__((aligned(16))) unsigned char lds[];
    Frame F;
    F.lds = (LAS unsigned char*)lds; F.MISC = (volatile LAS unsigned*)(F.lds + MISC_OFF);
    F.tid = threadIdx.x; F.lane = F.tid & 63; F.wave = __builtin_amdgcn_readfirstlane(F.tid >> 6);
    F.G = gridDim.x; { const int bx = blockIdx.x; F.vcu = (F.G % 8 == 0) ? (bx % 8) * (F.G / 8) + bx / 8 : bx; }
    F.ws = args.ws; F.ctl = (unsigned*)(args.ws + WS_CTL); F.out = args.out;
#pragma unroll
    for (int i = 0; i < N_IN; ++i) F.in[i] = args.in[i];
    for (int u = F.tid; u < (LDS_BYTES - MISC_OFF) / 4; u += NWAVES * 64) ((LAS unsigned*)(F.lds + MISC_OFF))[u] = 0u;
    __syncthreads();
    XcdBarrier bar; bar.bar = F.ctl + CW_BAR; bar.x = 0; bar.st = nullptr;
    if (!N_LAUNCH_PER_PHASE) bar = xcd_barrier_post(F.ctl + CW_BAR, F.MISC + 8);
    const int lo = args.ph_lo, hi = args.ph_hi;
#ifndef REP_PHASE
#define REP_PHASE (-1)
#endif
#define NREP(k) ((REP_PHASE == (k)) ? 2 : 1)
#define REPLOOP(k) _Pragma("unroll") for (int rep = 0; rep < NREP(k); ++rep)
#ifndef PH_MASK
#define PH_MASK 0xFFFFu
#endif
#define IN(k) ((((PH_MASK) >> (k)) & 1u) && lo <= (k) && (k) < hi)
#define SEAM(k) do { if (IN(k) && IN((k) + 1)) xcd_barrier(bar); } while (0)

#if defined(DBG_BASE)
    dbg_final(F, F.in[IN_X]); return;
#endif
    if (IN(0)) REPLOOP(0) { p0_mod(F); __syncthreads(); p0_weights(F); __syncthreads(); }
    SEAM(0);
    if (IN(1)) REPLOOP(1) norm_rows(F, F.in[IN_X], F.in[IN_N1G], 0, 1024, WSP(bf16_t, WS_H));
    SEAM(1);
    if (IN(2)) REPLOOP(2) {
        pg::Gemm g{WSP(bf16_t, WS_H), WSP(bf16_t, WS_WIN), DM * 2, DM * 2, nullptr}; pg::StaticOrder S; S.init(T, NPROJ, F.G, (int)blockIdx.x);
        EpiProj E{WSP(bf16_t, WS_PROJ)};
        pg::gemm_phase<EpiProj, pg::StaticOrder, false, true>(F.lds, g, S, E);
    }
    DBG_DUMP(2, dbg_dump_bf16(F, WSP(bf16_t, WS_PROJ), NPROJ, 0, 1024));
    SEAM(2);
    if (IN(3)) REPLOOP(3) p3a_rows(F);
    SEAM(3);
    if (IN(4)) REPLOOP(4) {
#ifndef NO_QG
        { pg::Gemm g{WSP(bf16_t, WS_PROJ) + C_QLAT, WSP(bf16_t, WS_WQ), NPROJ * 2, QLORA * 2, nullptr}; pg::StaticOrder S; S.init(T, 768, F.G, (int)blockIdx.x);
          EpiQ E{WSP(bf16_t, WS_Q), WSP(float, WS_RSQ), WSP(float, WS_CS), 0.10206207261596575f * 1.4426950408889634f};
          pg::gemm_phase<EpiQ, pg::StaticOrder, false, true>(F.lds, g, S, E); }
#endif
#ifndef NO_KVG
        { pg::Gemm g{WSP(bf16_t, WS_PROJ) + C_KVLAT, WSP(bf16_t, WS_WKV), NPROJ * 2, KVLORA * 2, nullptr}; pg::StaticOrder S; S.init(T, 1024, F.G, (int)(F.G - 1 - blockIdx.x));
          EpiKV E{WSP(bf16_t, WS_K), WSP(bf16_t, WS_V), WSP(float, WS_RSKV)};
          pg::gemm_phase<EpiKV, pg::StaticOrder, false, true>(F.lds, g, S, E); }
#endif
    }
    DBG_DUMP(4, dbg_dump_bf16(F, WSP(bf16_t, WS_Q), 768, 0, 768); dbg_dump_bf16(F, WSP(bf16_t, WS_K), 768, 768, 256));
    SEAM(4);
    if (IN(5)) REPLOOP(5) { for (int u = blockIdx.x; u < BATCH * GH * NCH / 4; u += F.G) g1_unit(F, u); }
    SEAM(5);
    if (IN(6)) REPLOOP(6) {
#ifndef NO_G2
        for (;;) {
            if (F.tid == 0) F.MISC[16] = __hip_atomic_fetch_add(F.ctl + CW_Q + 128 * rep, 1u, RLX_AGENT);
            __syncthreads();
            const int item = (int)F.MISC[16];
            __syncthreads();
            if (item >= 32) break;
            g2_item(F, item);
        }
#endif
#ifndef NO_ATT
        for (;;) {
            if (F.tid == 0) F.MISC[16] = __hip_atomic_fetch_add(F.ctl + CW_Q + 64 + 128 * rep, 1u, RLX_AGENT);
            __syncthreads();
            const int item = (int)F.MISC[16];
            __syncthreads();
            if (item >= BATCH * NH * 16) break;
            const int qb = 15 - (item >> 6), bh = item & 63; attn_unit(F, bh >> 3, bh & 7, qb);
        }
#endif
    }
    DBG_DUMP(6, dbg_dump_bf16(F, WSP(bf16_t, DBG_SUB ? WS_OG : WS_OA), 512, 0, 512); dbg_dump_bf16(F, WSP(bf16_t, DBG_SUB ? WS_OG : WS_OA), 512, 512, 512));
    SEAM(6);
    if (IN(7)) REPLOOP(7) p4b_rows(F);
    SEAM(7);
    if (IN(8)) REPLOOP(8) {
        pg::Gemm g{WSP(bf16_t, WS_H), WSP(bf16_t, WS_WO), DM * 2, DM * 2, nullptr}; pg::StaticOrder S; S.init(T, DM, F.G, (int)blockIdx.x);
        EpiX1 E{F.in[IN_X], WSP(float, WS_MOD), WSP(float, WS_X1)};
        pg::gemm_phase<EpiX1, pg::StaticOrder, false, true>(F.lds, g, S, E);
    }
#if defined(DBG_STOP_X1)
    xcd_barrier(bar); dbg_final(F, WSP(float, WS_X1)); return;
#endif
    SEAM(8);
    if (IN(9)) REPLOOP(9) { p6_router(F, rep); __syncthreads(); }
    SEAM(9);
    if (IN(10)) REPLOOP(10) {
        moe_tables(F);
        pg::Gemm g{WSP(unsigned char, WS_H), WSP(unsigned char, WS_WGU), DM, DM, WSP(int, WS_LIST)};
        pg::MoeOrder S{(const LAS int*)(F.lds + MISC_OFF) + 128, (const LAS int*)(F.lds + MISC_OFF) + 192, 8, 2048, F.G, (int)blockIdx.x, 0};
        EpiGU E{WSP(unsigned char, WS_ACT), F.in[IN_BGU]};
        pg::gemm_phase<EpiGU, pg::MoeOrder, true, true, true>(F.lds, g, S, E);
    }
    SEAM(10);
    if (IN(11)) REPLOOP(11) {
        moe_tables(F);
        pg::Gemm g{WSP(unsigned char, WS_ACT), WSP(unsigned char, WS_WDN), DE, DE, nullptr};
        pg::MoeOrder S{(const LAS int*)(F.lds + MISC_OFF) + 128, (const LAS int*)(F.lds + MISC_OFF) + 192, 4, 1024, F.G, (int)blockIdx.x, 1};
        EpiDN E{WSP(bf16_t, WS_Y), F.in[IN_BDN]};
        pg::gemm_phase<EpiDN, pg::MoeOrder, false, true, true>(F.lds, g, S, E);
    }
    SEAM(11);
    if (IN(12)) REPLOOP(12) { moe_tables(F); p10_combine(F); }
#undef IN
#undef SEAM
}

extern "C" void kernel_launch(void* const* d_in, const int* in_sizes, int n_in, void* d_out, int out_size, void* d_ws, size_t ws_size, hipStream_t stream) {
    static int grid = 0;
    if (grid == 0) {
        if (n_in != N_IN || out_size != T * DM || ws_size < WS_END) { fprintf(stderr, "kernel_launch: unexpected shapes (n_in %d, out %d, ws %zu)\n", n_in, out_size, ws_size); grid = -1; return; }
        int dev = 0, cus = 0;
        if (hipGetDevice(&dev) != hipSuccess || hipDeviceGetAttribute(&cus, hipDeviceAttributeMultiprocessorCount, dev) != hipSuccess) { grid = -1; return; }
        if (hipFuncSetAttribute((const void*)fwd_kernel, hipFuncAttributeMaxDynamicSharedMemorySize, LDS_BYTES) != hipSuccess) { grid = -1; return; }
        int per_cu = 0;
        if (hipOccupancyMaxActiveBlocksPerMultiprocessor(&per_cu, (const void*)fwd_kernel, NWAVES * 64, LDS_BYTES) != hipSuccess || per_cu < 1) fprintf(stderr, "kernel_launch: occupancy query says %d\n", per_cu);
        (void)hipGetLastError();
        grid = cus;
        while (grid > 8 && (T % grid) != 0) grid -= 8;
    }
    if (grid < 0) return;
    (void)hipMemsetAsync((char*)d_ws + WS_CTL, 0, CTL_BYTES, stream);
    Args a{};
    for (int i = 0; i < N_IN; ++i) a.in[i] = (const float*)d_in[i];
    a.out = (float*)d_out; a.ws = (unsigned char*)d_ws;
#if N_LAUNCH_PER_PHASE
    for (int p = 0; p < N_PHASES; ++p) { a.ph_lo = p; a.ph_hi = p + 1; hipLaunchKernelGGL(fwd_kernel, dim3(grid), dim3(NWAVES * 64), LDS_BYTES, stream, a); }
#else
    a.ph_lo = 0; a.ph_hi = N_PHASES;
    hipLaunchKernelGGL(fwd_kernel, dim3(grid), dim3(NWAVES * 64), LDS_BYTES, stream, a);
#endif
}
```

```cpp
#include <hip/hip_runtime.h>
#include <cstdio>
#include <cstdint>


#define DBG_SUB 0
#ifndef N_LAUNCH_PER_PHASE
#define N_LAUNCH_PER_PHASE 0
#endif

#define GAS __attribute__((address_space(1)))
#define LAS __attribute__((address_space(3)))
typedef unsigned short bf16_t;
typedef short bf16x8 __attribute__((ext_vector_type(8)));
typedef short s16x4 __attribute__((ext_vector_type(4)));
typedef float f32x4 __attribute__((ext_vector_type(4)));
typedef float f32x2 __attribute__((ext_vector_type(2)));
typedef float f32x16 __attribute__((ext_vector_type(16)));
typedef unsigned u32x4 __attribute__((ext_vector_type(4)));
typedef unsigned u32x2 __attribute__((ext_vector_type(2)));
typedef __bf16 bf16x2_t __attribute__((ext_vector_type(2)));
typedef int i32x4q __attribute__((ext_vector_type(4)));

constexpr int BATCH = 8, SEQ = 4096, DM = 1024, T = BATCH * SEQ;
constexpr int NH = 8, QK = 96, NOPE = 64, ROPE = 32, VD = 64, QLORA = 384, KVLORA = 256;
constexpr int GH = 8, GDK = 64, GDV = 64;
constexpr int IN_DIM = 2736, NPROJ = 2816;
constexpr int C_QLAT = 0, C_KVLAT = 384, C_KPE = 640, C_GQ = 672, C_GK = 1184, C_GV = 1696, C_GZ = 2208, C_GA = 2720, C_GB = 2728;
constexpr int NE = 32, TOPK = 4, DE = 1024;
constexpr float EPS = 1e-6f;
constexpr float W8 = 32.0f;
constexpr int GC = 32, NCH = SEQ / GC;
constexpr int MAXROWS = T * TOPK + NE * 256;

constexpr size_t MiB = 1u << 20;
constexpr size_t WS_CTL = 0, CTL_BYTES = 1 * MiB;
constexpr size_t WS_MOD = 1 * MiB;
constexpr size_t WS_RSQ = 2 * MiB;
constexpr size_t WS_RSKV = WS_RSQ + 128 * 1024;
constexpr size_t WS_CS = 3 * MiB;
constexpr size_t WS_TKE = 7 * MiB;
constexpr size_t WS_TKW = WS_TKE + 512 * 1024;
constexpr size_t WS_TKP = WS_TKW + 512 * 1024;
constexpr size_t WS_LIST = 9 * MiB;
constexpr size_t WS_RWT = 13 * MiB;
constexpr size_t WS_WIN = 16 * MiB;
constexpr size_t WS_WQ = WS_WIN + (size_t)NPROJ * DM * 2;
constexpr size_t WS_WKV = WS_WQ + (size_t)768 * 384 * 2;
constexpr size_t WS_WO = WS_WKV + (size_t)1024 * 256 * 2;
constexpr size_t WS_WGU = 32 * MiB;
constexpr size_t WS_WDN = WS_WGU + (size_t)NE * 2048 * 1024 * 2;
constexpr size_t WS_H = 224 * MiB;
constexpr size_t WS_X1 = 288 * MiB;
constexpr size_t WS_PROJ = 416 * MiB;
constexpr size_t WS_Q = 592 * MiB;
constexpr size_t WS_K = 640 * MiB;
constexpr size_t WS_V = 688 * MiB;
constexpr size_t WS_OA = 720 * MiB;
constexpr size_t WS_OG = 752 * MiB;
constexpr size_t WS_GD = 784 * MiB;
constexpr size_t WS_ACT = 416 * MiB;
constexpr size_t WS_Y = 688 * MiB;
constexpr size_t WS_END = 976 * MiB;
static_assert(WS_WO + (size_t)1024 * 1024 * 2 <= WS_WGU && WS_WDN + (size_t)NE * 1024 * 1024 * 2 <= WS_H, "weights");
static_assert(WS_ACT + (size_t)MAXROWS * 1024 * 2 <= WS_Y && WS_Y + (size_t)MAXROWS * 1024 * 2 <= WS_END, "moe rows");
static_assert(WS_GD + (size_t)BATCH * GH * NCH * 24576 <= WS_END, "gdn");
constexpr int CW_BAR = 4096;
constexpr int CW_Q = 8192;
constexpr int CW_CNT = 12288;

constexpr int RING_BYTES = 131072;
constexpr int MISC_OFF = RING_BYTES;
constexpr int LDS_BYTES = 147456;

#define LDS_WAIT() asm volatile("s_waitcnt lgkmcnt(0)" ::: "memory")
#define VM_WAIT() asm volatile("s_waitcnt vmcnt(0)" ::: "memory")
#define RLX_AGENT __ATOMIC_RELAXED, __HIP_MEMORY_SCOPE_AGENT

__device__ __forceinline__ unsigned cvtpk(float lo, float hi) { f32x2 v = {lo, hi}; bf16x2_t b = __builtin_convertvector(v, bf16x2_t); return __builtin_bit_cast(unsigned, b); }
__device__ __forceinline__ bf16_t f2bf(float f) { return (bf16_t)(cvtpk(f, 0.f) & 0xffffu); }
__device__ __forceinline__ float bf2f(unsigned short h) { return __uint_as_float((unsigned)h << 16); }
__device__ __forceinline__ float bflo(unsigned w) { return __uint_as_float(w << 16); }
__device__ __forceinline__ float bfhi(unsigned w) { return __uint_as_float(w & 0xffff0000u); }
__device__ __forceinline__ float wave_sum(float v) {
#pragma unroll
    for (int o = 1; o < 64; o <<= 1) v += __shfl_xor(v, o);
    return v;
}
__device__ __forceinline__ unsigned pk4_fp8(float a, float b, float c, float d) { int w = 0; w = __builtin_amdgcn_cvt_pk_fp8_f32(a, b, w, false); w = __builtin_amdgcn_cvt_pk_fp8_f32(c, d, w, true); return (unsigned)w; }
__device__ __forceinline__ float siluf(float x) { return x / (1.f + __expf(-x)); }

#define XB_TMO      128
#define XB_XCNT(j)  (256  + 64 * (j))
#define XB_XSUB(j)  (1280 + 64 * (j))
#define XB_XGEN(j)  (2304 + 64 * (j))
#define XB_TOP      3328
#define XB_TOPGEN   3392
#define XCD_BAR_WORDS 3456
#define XB_SPIN_CAP (1u << 18)
__device__ __forceinline__ unsigned xb_ld(unsigned* p)              { return __hip_atomic_load(p, __ATOMIC_RELAXED, __HIP_MEMORY_SCOPE_AGENT); }
__device__ __forceinline__ unsigned xb_add(unsigned* p, unsigned v) { return __hip_atomic_fetch_add(p, v, __ATOMIC_RELAXED, __HIP_MEMORY_SCOPE_AGENT); }
__device__ __forceinline__ unsigned xb_xcc_id() { return (unsigned)__builtin_amdgcn_s_getreg((3 << 11) | 20) & 0xFu; }
#define XB_SPIN(cond, bar) do { unsigned _sp = 0; while (cond) { __builtin_amdgcn_s_sleep(1); \
    if ((++_sp & 255u) == 0u) { if (xb_ld(&(bar)[XB_TMO])) break; if (_sp > XB_SPIN_CAP) { atomicAdd(&(bar)[XB_TMO], 1u); break; } } } } while (0)
struct XcdBarrier { unsigned* bar; unsigned x; volatile LAS unsigned* st; };
__device__ __forceinline__ XcdBarrier xcd_barrier_post(unsigned* bar, volatile LAS unsigned* st) {
    XcdBarrier b; b.bar = bar; b.x = xb_xcc_id(); b.st = st;
    if (threadIdx.x == 0) (void)xb_add(&bar[XB_XCNT(b.x)], 1u);
    return b;
}
__device__ __forceinline__ void xcd_barrier_complete(unsigned* bar, unsigned x, unsigned& nloc, unsigned& nx) {
    const unsigned G = gridDim.x * gridDim.y * gridDim.z;
    unsigned sum, cnt, mine, sp = 0u;
    for (;;) {
        sum = 0u; cnt = 0u; mine = 0u;
#pragma unroll
        for (unsigned j = 0; j < 16; ++j) { const unsigned c = xb_ld(&bar[XB_XCNT(j)]); sum += c; cnt += (c > 0u) ? 1u : 0u; mine = (j == x) ? c : mine; }
        if (sum == G) break;
        __builtin_amdgcn_s_sleep(1);
        if ((++sp & 255u) == 0u) { if (xb_ld(&bar[XB_TMO])) break; if (sp > XB_SPIN_CAP) { atomicAdd(&bar[XB_TMO], 1u); break; } }
    }
    nloc = mine > 0u ? mine : 1u; nx = cnt > 0u ? cnt : 1u;
}
__device__ __forceinline__ void xcd_barrier(const XcdBarrier& b) {
    asm volatile("s_waitcnt vmcnt(0)" ::: "memory");
    __syncthreads();
    if (threadIdx.x == 0) {
        unsigned* bar = b.bar;
        __builtin_amdgcn_s_waitcnt(0);
        unsigned nloc = b.st[0], nx = b.st[1];
        if (nloc == 0u) { xcd_barrier_complete(bar, b.x, nloc, nx); b.st[0] = nloc; b.st[1] = nx; }
        const unsigned old = xb_add(&bar[XB_XSUB(b.x)], 1u);
        const unsigned gen = old / nloc;
        if (old + 1u == (gen + 1u) * nloc) {
            __builtin_amdgcn_fence(__ATOMIC_RELEASE, "agent");
            asm volatile("s_waitcnt vmcnt(0)" ::: "memory");
            const unsigned og = xb_add(&bar[XB_TOP], 1u);
            const unsigned tg = og / nx;
            if (og + 1u == (tg + 1u) * nx) xb_add(&bar[XB_TOPGEN], 1u);
            else XB_SPIN(xb_ld(&bar[XB_TOPGEN]) == tg, bar);
            __builtin_amdgcn_fence(__ATOMIC_ACQUIRE, "agent");
            xb_add(&bar[XB_XGEN(b.x)], 1u);
            asm volatile("s_waitcnt vmcnt(0)" ::: "memory");
        } else {
            XB_SPIN(xb_ld(&bar[XB_XGEN(b.x)]) == gen, bar);
            __builtin_amdgcn_fence(__ATOMIC_ACQUIRE, "agent");
            asm volatile("s_waitcnt vmcnt(0)" ::: "memory");
        }
    }
    __syncthreads();
}

namespace pg {
constexpr int BM = 256, BK = 64, HALF = 128, HTB = HALF * BK * 2, STAGE_BYTES = 8 * HTB, NXCD = 8, WGM = 8;
__host__ __device__ __forceinline__ int lds_byte(int r, int c) { const int st = (r >> 4) * 2 + (c >> 5), rr = r & 15, cc = c & 31, ob = rr * 64 + cc * 2; return st * 1024 + (ob ^ (((ob >> 9) & 1) << 5)); }
__host__ __device__ __forceinline__ void stage_rc(int b, int& R, int& C) { const int st = b / 1024, sb = b % 1024, swz = sb ^ (((sb >> 9) & 1) << 5); R = (st >> 1) * 16 + swz / 64; C = (st & 1) * 32 + (swz % 64) / 2; }
__host__ __device__ __forceinline__ int perm32(int rho) { const int n = rho >> 4, i = rho & 15; return 8 * (i >> 2) + 4 * n + (i & 3); }

struct Unit { int pm, pn, arow, brow, nvalid, e; };
struct Gemm { const void* A; const void* Bt; int lda, K; const int* list; };

struct StaticOrder {
    int nM, nN, nwg, G, c;
    __device__ __forceinline__ void init(int M, int N, int G_, int c_) { nM = M / BM; nN = N / BM; nwg = nM * nN; G = G_; c = c_; }
    __device__ __forceinline__ bool next(int i, Unit& u) const {
        const long L = (long)i * G + c; if (L >= nwg) return false;
        int wgid = (int)L; { const int q = nwg / NXCD, r = nwg % NXCD, xcd = wgid % NXCD, off = wgid / NXCD; wgid = (xcd < r ? xcd * (q + 1) : r * (q + 1) + (xcd - r) * q) + off; }
        const int nig = WGM * nN, gid = wgid / nig, fm = gid * WGM, gsz = (nM - fm) < WGM ? (nM - fm) : WGM;
        u.pm = fm + ((wgid % nig) % gsz); u.pn = (wgid % nig) / gsz; u.arow = u.pm * BM; u.brow = u.pn * BM; u.nvalid = BM; u.e = 0; return true;
    }
};
struct MoeOrder {
    const LAS int* pre;
    const LAS int* cnt;
    int NT, Nrows, G, c, contig;
    __device__ __forceinline__ bool next(int i, Unit& u) const {
        const int xcd = c & 7, j = c >> 3, q = i * (G >> 3) + j, mq = q / NT, nt = q - mq * NT, mt = mq * 8 + xcd;
        if (mt >= pre[32]) return false;
        int e = 0;
#pragma unroll 1
        while (pre[e + 1] <= mt) ++e;
        const int row0 = (mt - pre[e]) * BM;
        u.pm = mt; u.pn = nt; u.e = e; u.nvalid = cnt[e] - row0; u.arow = contig ? mt * BM : row0; u.brow = e * Nrows + nt * BM; return true;
    }
};

__device__ __forceinline__ void glds16s(const void* sbase, unsigned voff, unsigned ldsdst) { unsigned keep;
    asm volatile("s_mov_b32 %0, m0\n\ts_mov_b32 m0, %3\n\ts_nop 0\n\tglobal_load_lds_dwordx4 %1, %2\n\ts_mov_b32 m0, %0" : "=&s"(keep) : "v"(voff), "s"(sbase), "s"(ldsdst) : "memory"); }
typedef int i32x8 __attribute__((ext_vector_type(8)));
typedef int i32x4 __attribute__((ext_vector_type(4)));
template <class Epi, class Sched, bool GATHER, bool ALIGN_EPI, bool FP8 = false>
__device__ __forceinline__ void gemm_phase(LAS unsigned char* lds, const Gemm g, const Sched& S, const Epi& E) {
    const int tid = threadIdx.x, wid = __builtin_amdgcn_readfirstlane(tid >> 6), lane = tid & 63, wr = wid >> 2, wc = wid & 3, fr = lane & 15, fq = lane >> 4;
    const int K = g.K, nt = K / (BK * 2), lda = g.lda;
    unsigned voffB[2], voffA[2];
#pragma unroll
    for (int i = 0; i < 2; ++i) { int R, C; stage_rc(tid * 16 + i * 8192, R, C); const int Rb = Epi::PERM ? ((R & ~31) + perm32(R & 31)) : R; voffB[i] = (unsigned)(Rb * K + C * 2); voffA[i] = (unsigned)(R * lda + C * 2); }
    const size_t kstep = (size_t)(BK * 2);
    const size_t hstep = (size_t)HALF * K;
    const unsigned ldsw = (unsigned)wid * 1024u;
    const unsigned ldsa = (unsigned)__builtin_amdgcn_readfirstlane((int)((unsigned)(uintptr_t)lds + ldsw));
    const int aoff = lds_byte(wr * 64 + fr, fq * 8), boff = lds_byte(wc * 32 + fr, fq * 8);
#define PG_SA(b, h) (((b) * 2 + (h)) * HTB)
#define PG_SB(b, h) ((4 + (b) * 2 + (h)) * HTB)
#define PG_STAGE(bufoff, gbase, voff) do { _Pragma("unroll") for (int _i = 0; _i < 2; ++_i) \
        glds16s((const void*)(gbase), (voff)[_i], ldsa + (unsigned)(bufoff) + (unsigned)(_i * 8192)); } while (0)
#define PG_LDA(dst, b, h) do { _Pragma("unroll") for (int m = 0; m < 4; ++m) { if constexpr (FP8) { dst##8[m] = __builtin_shufflevector(*(const LAS i32x4*)(lds + PG_SA(b, h) + aoff + m * 2048), *(const LAS i32x4*)(lds + PG_SA(b, h) + aoff + m * 2048 + 1024), 0, 1, 2, 3, 4, 5, 6, 7); } \
        else { _Pragma("unroll") for (int k = 0; k < 2; ++k) dst[m][k] = *(const LAS bf16x8*)(lds + PG_SA(b, h) + aoff + m * 2048 + k * 1024); } } } while (0)
#define PG_LDB(dst, b, h) do { _Pragma("unroll") for (int n = 0; n < 2; ++n) { if constexpr (FP8) { dst##8[n] = __builtin_shufflevector(*(const LAS i32x4*)(lds + PG_SB(b, h) + boff + n * 2048), *(const LAS i32x4*)(lds + PG_SB(b, h) + boff + n * 2048 + 1024), 0, 1, 2, 3, 4, 5, 6, 7); } \
        else { _Pragma("unroll") for (int k = 0; k < 2; ++k) dst[n][k] = *(const LAS bf16x8*)(lds + PG_SB(b, h) + boff + n * 2048 + k * 1024); } } } while (0)
#define PG_MMA(ai, bj, At, Bt) do { __builtin_amdgcn_s_setprio(1); if constexpr (FP8) { _Pragma("unroll") for (int m = 0; m < 4; ++m) _Pragma("unroll") for (int n = 0; n < 2; ++n) \
        asm volatile("v_mfma_scale_f32_16x16x128_f8f6f4 %0, %1, %2, %0, %3, %3 op_sel_hi:[0,0,0]" : "+v"(acc[ai][bj][m][n]) : "v"(Bt##8[n]), "v"(At##8[m]), "v"(scl1)); } \
        else { _Pragma("unroll") for (int m = 0; m < 4; ++m) _Pragma("unroll") for (int n = 0; n < 2; ++n) _Pragma("unroll") for (int k = 0; k < 2; ++k) \
        acc[ai][bj][m][n] = __builtin_amdgcn_mfma_f32_16x16x32_bf16(Bt[n][k], At[m][k], acc[ai][bj][m][n], 0, 0, 0); } __builtin_amdgcn_s_setprio(0); } while (0)
#define PG_WAIT_V(n) asm volatile("s_waitcnt vmcnt(" #n ")" ::: "memory")
#define PG_WAIT_L(n) asm volatile("s_waitcnt lgkmcnt(" #n ")" ::: "memory")
#define PG_BAR __builtin_amdgcn_s_barrier()
#define PG_SCHED __builtin_amdgcn_sched_barrier(0)
#define PG_SETA(v, u) do { _Pragma("unroll") for (int _h = 0; _h < 2; ++_h) _Pragma("unroll") for (int _i = 0; _i < 2; ++_i) { int _R, _C; stage_rc(tid * 16 + _i * 8192, _R, _C); const int _r = _h * HALF + _R; \
        const int _rr = _r < (u).nvalid ? _r : (u).nvalid - 1; const int _tok = g.list[(size_t)(u).e * T + (u).arow + _rr]; v[_h][_i] = (unsigned)(_tok * lda + _C * 2); } } while (0)
#define PG_STA(bufoff, kb, h, NX) do { if constexpr (GATHER) { unsigned _vs[2]; _vs[0] = (NX) ? vN[h][0] : vA[h][0]; _vs[1] = (NX) ? vN[h][1] : vA[h][1]; PG_STAGE(bufoff, (const char*)g.A + (kb), _vs); } \
        else PG_STAGE(bufoff, ((NX) ? nA : cA) + (kb) + (h) * hstepA, voffA); } while (0)
    Unit cur, nxt; int ui = 0;
    if (!S.next(0, cur)) return;
    f32x4 acc[2][2][4][2];
#pragma unroll
    for (int a = 0; a < 2; ++a)
#pragma unroll
        for (int b = 0; b < 2; ++b)
#pragma unroll
            for (int m = 0; m < 4; ++m)
#pragma unroll
                for (int n = 0; n < 2; ++n) acc[a][b][m][n] = (f32x4){0.f, 0.f, 0.f, 0.f};
    const int scl1 = 0x7F7F7F7F;
    bf16x8 At[4][2], B0[2][2], B1[2][2]; i32x8 At8[4], B08[2], B18[2];
    unsigned vN[2][2] = {{0u, 0u}, {0u, 0u}};
    unsigned vA[2][2];
    LAS u32x4* const vnl = (LAS u32x4*)(lds + STAGE_BYTES + 1024) + tid;
    const size_t hstepA = (size_t)HALF * lda;
    if constexpr (GATHER) { PG_SETA(vA, cur); PG_WAIT_V(0); }
    const char* cA = (const char*)g.A + (GATHER ? (size_t)0 : (size_t)cur.arow * lda); const char* nA = cA;
    const char* cB = (const char*)g.Bt + (size_t)cur.brow * K;
    PG_STAGE(PG_SB(0, 0), cB, voffB); PG_STAGE(PG_SB(0, 1), cB + hstep, voffB); PG_STA(PG_SA(0, 0), 0, 0, false); PG_STA(PG_SA(0, 1), 0, 1, false);
    if (wr == 1) PG_BAR;
    PG_WAIT_V(2); PG_BAR;
    PG_STAGE(PG_SB(1, 0), cB + kstep, voffB); PG_STA(PG_SA(1, 0), kstep, 0, false); PG_STAGE(PG_SB(1, 1), cB + hstep + kstep, voffB);
    PG_WAIT_V(6); PG_BAR;
    for (;;) {
        const bool has_next = S.next(ui + 1, nxt);
        if constexpr (GATHER) {
            unsigned vT[2][2];
            if (has_next) { PG_SETA(vT, nxt); PG_WAIT_V(0); }
            else {
#pragma unroll
                for (int h = 0; h < 2; ++h)
#pragma unroll
                    for (int i = 0; i < 2; ++i) vT[h][i] = vA[h][i]; }
            *vnl = (u32x4){vT[0][0], vT[0][1], vT[1][0], vT[1][1]};
        } else nA = has_next ? (const char*)g.A + (size_t)nxt.arow * lda : cA;
        const char* nB = has_next ? (const char*)g.Bt + (size_t)nxt.brow * K : cB;
#pragma unroll 1
        for (int t = 0; t < nt; t += 2) {
            const bool last = (t == nt - 2);
            if constexpr (GATHER) { if (last) { const u32x4 q_ = *vnl; vN[0][0] = q_.x; vN[0][1] = q_.y; vN[1][0] = q_.z; vN[1][1] = q_.w; } else { vN[0][0] = vA[0][0]; vN[0][1] = vA[0][1]; vN[1][0] = vA[1][0]; vN[1][1] = vA[1][1]; } }
            const size_t k1 = (size_t)(t + 1) * kstep, k2 = last ? (size_t)0 : (size_t)(t + 2) * kstep, k3 = k2 + kstep;
            const char* b2 = last ? nB : cB + (size_t)(t + 2) * kstep; const char* b3 = b2 + kstep;
            PG_LDB(B0, 0, 0); PG_LDB(B1, 0, 1); PG_SCHED; PG_LDA(At, 0, 0); PG_STA(PG_SA(1, 1), k1, 1, false);
            PG_WAIT_V(8); PG_WAIT_L(0); PG_BAR; PG_MMA(0, 0, At, B0); PG_MMA(0, 1, At, B1); PG_BAR; PG_SCHED;
            PG_LDA(At, 0, 1); PG_STAGE(PG_SB(0, 0), b2, voffB); PG_STAGE(PG_SB(0, 1), b2 + hstep, voffB); PG_STA(PG_SA(0, 0), k2, 0, last);
            PG_WAIT_V(8); PG_WAIT_L(0); PG_BAR; PG_MMA(1, 0, At, B0); PG_MMA(1, 1, At, B1); PG_BAR; PG_SCHED;
            PG_LDB(B0, 1, 0); PG_LDB(B1, 1, 1); PG_SCHED; PG_LDA(At, 1, 0); PG_STA(PG_SA(0, 1), k2, 1, last);
            PG_WAIT_V(8); PG_WAIT_L(0); PG_BAR; PG_MMA(0, 0, At, B0); PG_MMA(0, 1, At, B1); PG_BAR; PG_SCHED;
            PG_LDA(At, 1, 1); PG_STAGE(PG_SB(1, 0), b3, voffB); PG_STAGE(PG_SB(1, 1), b3 + hstep, voffB); PG_STA(PG_SA(1, 0), k3, 0, last);
            PG_WAIT_V(8); PG_WAIT_L(0); PG_BAR; PG_MMA(1, 0, At, B0); PG_MMA(1, 1, At, B1); PG_BAR; PG_SCHED;
        }
        if constexpr (ALIGN_EPI) { if (wr == 0) PG_BAR; }
        if constexpr (FP8) asm volatile("s_nop 15\n\ts_nop 15" ::: "memory");
        E(acc, cur, wr, wc, fr, fq);
        if (!has_next) break;
#pragma unroll
        for (int a = 0; a < 2; ++a)
#pragma unroll
            for (int b = 0; b < 2; ++b)
#pragma unroll
                for (int m = 0; m < 4; ++m)
#pragma unroll
                    for (int n = 0; n < 2; ++n) acc[a][b][m][n] = (f32x4){0.f, 0.f, 0.f, 0.f};
        cur = nxt; cB = nB; cA = nA; ++ui;
        if constexpr (GATHER) { const u32x4 q_ = *vnl; vA[0][0] = q_.x; vA[0][1] = q_.y; vA[1][0] = q_.z; vA[1][1] = q_.w; }
        if constexpr (ALIGN_EPI) { if (wr == 1) PG_BAR; }
    }
    PG_WAIT_V(0);
    if constexpr (!ALIGN_EPI) { if (wr == 0) PG_BAR; }
    PG_BAR;
#undef PG_SA
#undef PG_SB
#undef PG_STAGE
#undef PG_LDA
#undef PG_LDB
#undef PG_MMA
#undef PG_WAIT_V
#undef PG_WAIT_L
#undef PG_BAR
#undef PG_SCHED
#undef PG_SETA
#undef PG_STA
}
}

typedef f32x4 AccT[2][2][4][2];
__device__ __forceinline__ u32x4 pack8(f32x4 a, f32x4 b) { u32x4 w; w.x = cvtpk(a[0], a[1]); w.y = cvtpk(a[2], a[3]); w.z = cvtpk(b[0], b[1]); w.w = cvtpk(b[2], b[3]); return w; }

struct EpiProj {
    static constexpr bool PERM = true; bf16_t* O;
    __device__ __forceinline__ void operator()(const AccT& acc, const pg::Unit& u, int wr, int wc, int fr, int fq) const {
        const int row0 = u.pm * 256 + wr * 64 + fr, col0 = u.pn * 256 + wc * 32 + 8 * fq;
#pragma unroll
        for (int ai = 0; ai < 2; ++ai)
#pragma unroll
            for (int m = 0; m < 4; ++m) { bf16_t* rowp = O + (size_t)(row0 + ai * 128 + m * 16) * NPROJ + col0;
#pragma unroll
                for (int bj = 0; bj < 2; ++bj) *(u32x4*)(rowp + bj * 128) = pack8(acc[ai][bj][m][0], acc[ai][bj][m][1]); }
    }
};
struct EpiQ {
    static constexpr bool PERM = true; bf16_t* O; const float* rstd; const float* cs; float scale;
    __device__ __forceinline__ void operator()(const AccT& acc, const pg::Unit& u, int wr, int wc, int fr, int fq) const {
        const int row0 = u.pm * 256 + wr * 64 + fr;
#pragma unroll
        for (int ai = 0; ai < 2; ++ai)
#pragma unroll
            for (int m = 0; m < 4; ++m) { const int row = row0 + ai * 128 + m * 16; const float rs = rstd[row] * scale;
#pragma unroll
                for (int bj = 0; bj < 2; ++bj) { const int G = 8 * u.pn + 4 * bj + wc;
                    f32x4 v0 = acc[ai][bj][m][0] * rs, v1 = acc[ai][bj][m][1] * rs;
                    if ((G % 3) == 2) {
                        f32x4 p0, p1;
#pragma unroll
                        for (int j = 0; j < 4; ++j) { p0[j] = __shfl_xor(v0[j], 32); p1[j] = __shfl_xor(v1[j], 32); }
                        const float* cr = cs + (size_t)row * 32 + 8 * (fq & 1);
                        const f32x4 c0 = *(const f32x4*)cr, c1 = *(const f32x4*)(cr + 4), s0 = *(const f32x4*)(cr + 16), s1 = *(const f32x4*)(cr + 20);
                        if (fq < 2) { v0 = v0 * c0 - p0 * s0; v1 = v1 * c1 - p1 * s1; } else { v0 = v0 * c0 + p0 * s0; v1 = v1 * c1 + p1 * s1; }
                    }
                    *(u32x4*)(O + (size_t)row * 768 + 32 * G + 8 * fq) = pack8(v0, v1); }
                asm volatile("" ::: "memory"); }
    }
};
struct EpiKV {
    static constexpr bool PERM = true; bf16_t* Ko; bf16_t* Vo; const float* rstd;
    __device__ __forceinline__ void operator()(const AccT& acc, const pg::Unit& u, int wr, int wc, int fr, int fq) const {
        const int row0 = u.pm * 256 + wr * 64 + fr;
#pragma unroll
        for (int ai = 0; ai < 2; ++ai)
#pragma unroll
            for (int m = 0; m < 4; ++m) { const int row = row0 + ai * 128 + m * 16; const float rs = rstd[row];
#pragma unroll
                for (int bj = 0; bj < 2; ++bj) { const int G = 8 * u.pn + 4 * bj + wc, head = G >> 2, sub = G & 3;
                    bf16_t* dst = (sub < 2) ? Ko + (size_t)row * 768 + head * 96 + 32 * sub + 8 * fq : Vo + (size_t)row * 512 + head * 64 + 32 * (sub - 2) + 8 * fq;
                    *(u32x4*)dst = pack8(acc[ai][bj][m][0] * rs, acc[ai][bj][m][1] * rs); } }
    }
};
struct EpiX1 {
    static constexpr bool PERM = false; const float* x; const float* mod; float* O;
    __device__ __forceinline__ void operator()(const AccT& acc, const pg::Unit& u, int wr, int wc, int fr, int fq) const {
        const int row0 = u.pm * 256 + wr * 64 + fr, col0 = u.pn * 256 + wc * 32 + 4 * fq;
        const float* gt = mod + (size_t)(u.pm * 256 / SEQ) * 6144 + 2048 + col0;
        f32x4 gv[2][2];
#pragma unroll
        for (int bj = 0; bj < 2; ++bj)
#pragma unroll
            for (int n = 0; n < 2; ++n) gv[bj][n] = *(const f32x4*)(gt + bj * 128 + n * 16);
#pragma unroll
        for (int ai = 0; ai < 2; ++ai)
#pragma unroll
            for (int m = 0; m < 4; ++m) { const size_t off = (size_t)(row0 + ai * 128 + m * 16) * DM + col0;
#pragma unroll
                for (int bj = 0; bj < 2; ++bj)
#pragma unroll
                    for (int n = 0; n < 2; ++n) { const f32x4 xv = *(const f32x4*)(x + off + bj * 128 + n * 16); *(f32x4*)(O + off + bj * 128 + n * 16) = xv + gv[bj][n] * acc[ai][bj][m][n]; } }
    }
};
struct EpiGU {
    static constexpr bool PERM = true; unsigned char* O; const float* bias;
    __device__ __forceinline__ void operator()(const AccT& acc, const pg::Unit& u, int wr, int wc, int fr, int fq) const {
        const int row0 = u.pm * 256 + wr * 64 + fr, gcol = u.pn * 128 + wc * 32 + 8 * fq;
        const float* bp = bias + (size_t)u.e * 2048 + gcol;
        const f32x4 bg0 = *(const f32x4*)bp, bg1 = *(const f32x4*)(bp + 4), bu0 = *(const f32x4*)(bp + 1024), bu1 = *(const f32x4*)(bp + 1028);
#pragma unroll
        for (int ai = 0; ai < 2; ++ai)
#pragma unroll
            for (int m = 0; m < 4; ++m) {
                f32x4 r[2];
#pragma unroll
                for (int n = 0; n < 2; ++n) { const f32x4 g4 = acc[ai][0][m][n] * (1.0f / W8) + (n ? bg1 : bg0), u4 = acc[ai][1][m][n] * (1.0f / W8) + (n ? bu1 : bu0);
#pragma unroll
                    for (int j = 0; j < 4; ++j) { const float g = fminf(g4[j], 7.0f), up = fminf(fmaxf(u4[j], -7.0f), 7.0f);
                        r[n][j] = (up + 1.0f) * g * __builtin_amdgcn_rcpf(1.0f + __expf(-1.702f * g)); } }
                u32x2 w; w.x = pk4_fp8(r[0][0], r[0][1], r[0][2], r[0][3]); w.y = pk4_fp8(r[1][0], r[1][1], r[1][2], r[1][3]); *(u32x2*)(O + (size_t)(row0 + ai * 128 + m * 16) * DE + gcol) = w; }
    }
};
struct EpiDN {
    static constexpr bool PERM = true; bf16_t* O; const float* bias;
    __device__ __forceinline__ void operator()(const AccT& acc, const pg::Unit& u, int wr, int wc, int fr, int fq) const {
        const int row0 = u.pm * 256 + wr * 64 + fr, col0 = u.pn * 256 + wc * 32 + 8 * fq;
        const float* bp = bias + (size_t)u.e * DM + col0;
        f32x4 bv[2][2];
#pragma unroll
        for (int bj = 0; bj < 2; ++bj) { bv[bj][0] = *(const f32x4*)(bp + bj * 128); bv[bj][1] = *(const f32x4*)(bp + bj * 128 + 4); }
#pragma unroll
        for (int ai = 0; ai < 2; ++ai)
#pragma unroll
            for (int m = 0; m < 4; ++m) { bf16_t* rowp = O + (size_t)(row0 + ai * 128 + m * 16) * DM + col0;
#pragma unroll
                for (int bj = 0; bj < 2; ++bj) *(u32x4*)(rowp + bj * 128) = pack8(acc[ai][bj][m][0] * (1.0f / W8) + bv[bj][0], acc[ai][bj][m][1] * (1.0f / W8) + bv[bj][1]); }
    }
};

constexpr int NWAVES = 8;
enum { IN_X = 0, IN_C, IN_POS, IN_ADAW, IN_ADAB, IN_N1G, IN_WIN, IN_QNG, IN_WQB, IN_KVNG, IN_WKVB, IN_MLAOG, IN_CONVW, IN_ALOG, IN_DTB, IN_GDNG, IN_WOUT, IN_N2G, IN_RW, IN_RB, IN_WGU, IN_BGU, IN_WDN, IN_BDN, IN_FG, N_IN };
struct Frame {
    LAS unsigned char* lds; volatile LAS unsigned* MISC; unsigned* ctl; unsigned char* ws;
    int tid, lane, wave, G, vcu;
    const float* in[N_IN]; float* out;
};
#define WSP(T_, off) ((T_*)(F.ws + (off)))

__device__ __forceinline__ void p0_mod(Frame& F) {
    LAS float* cact = (LAS float*)F.lds;
    LAS float* red = (LAS float*)(F.lds + 32768);
    if ((int)blockIdx.x >= 96) return;
    const float* c = F.in[IN_C];
    for (int i = F.tid; i < BATCH * DM; i += NWAVES * 64) cact[i] = siluf(c[i]);
    __syncthreads();
    float* mod = WSP(float, WS_MOD);
    for (int it = blockIdx.x; it < 96; it += F.G) {
        const int j = it * 64 + F.lane; float a[8];
#pragma unroll
        for (int b = 0; b < 8; ++b) a[b] = 0.f;
        const float* w = F.in[IN_ADAW] + j;
#pragma unroll 4
        for (int k = F.wave * 128; k < F.wave * 128 + 128; ++k) { const float wv = w[(size_t)k * 6144];
#pragma unroll
            for (int b = 0; b < 8; ++b) a[b] += cact[b * DM + k] * wv; }
#pragma unroll
        for (int b = 0; b < 8; ++b) red[(F.wave * 8 + b) * 64 + F.lane] = a[b];
        __syncthreads();
        { const int b = F.tid >> 6, col = F.tid & 63; float s = 0.f;
#pragma unroll
          for (int w8 = 0; w8 < 8; ++w8) s += red[(w8 * 8 + b) * 64 + col];
          mod[b * 6144 + it * 64 + col] = s + F.in[IN_ADAB][it * 64 + col]; }
        __syncthreads();
    }
}
template <int MAP, bool FP8 = false>
__device__ __forceinline__ void p0_tr_item(const float* W, int K, int N, int NP, void* WTv, const float* ksc, LAS float* scr, int item, int lane) {
    bf16_t* WT = (bf16_t*)WTv;
    const int nblk = NP / 32, kb = item / nblk, nb = item % nblk, k0 = 64 * kb, n0 = 32 * nb;
    f32x4 ld[8];
#pragma unroll
    for (int j = 0; j < 8; ++j) { const int idx = j * 64 + lane, kk = idx >> 3, nn = n0 + 4 * (idx & 7); ld[j] = (nn < N) ? *(const f32x4*)(W + (size_t)(k0 + kk) * N + nn) : (f32x4){0.f, 0.f, 0.f, 0.f}; }
#pragma unroll
    for (int j = 0; j < 8; ++j) { const int idx = j * 64 + lane, kk = idx >> 3, c4 = idx & 7; f32x4 v = ld[j]; if (ksc) v = v * ksc[k0 + kk];
        LAS float* d = scr + kk * 33 + 4 * c4; d[0] = v[0]; d[1] = v[1]; d[2] = v[2]; d[3] = v[3]; }
    LDS_WAIT(); asm volatile("" ::: "memory");
    const int c = lane & 7;
#pragma unroll
    for (int j = 0; j < 4; ++j) { const int n = (lane >> 3) + 8 * j; const LAS float* s = scr + (8 * c) * 33 + n;
        u32x4 o; o.x = cvtpk(s[0 * 33], s[1 * 33]); o.y = cvtpk(s[2 * 33], s[3 * 33]); o.z = cvtpk(s[4 * 33], s[5 * 33]); o.w = cvtpk(s[6 * 33], s[7 * 33]);
        int dn = n0 + n;
        if (MAP == 1) { const int half = dn >> 10, r = dn & 1023; dn = ((r >> 7) << 8) + (half << 7) + (r & 127); }
        if constexpr (FP8) { u32x2 o8; o8.x = pk4_fp8(s[0 * 33] * W8, s[1 * 33] * W8, s[2 * 33] * W8, s[3 * 33] * W8); o8.y = pk4_fp8(s[4 * 33] * W8, s[5 * 33] * W8, s[6 * 33] * W8, s[7 * 33] * W8);
            *(GAS u32x2*)((unsigned char*)WTv + (size_t)dn * K + k0 + 8 * c) = o8; }
        else *(GAS u32x4*)(WT + (size_t)dn * K + k0 + 8 * c) = o; }
    LDS_WAIT(); asm volatile("" ::: "memory");
}
__device__ __forceinline__ void p0_weights(Frame& F) {
    LAS float* scr = (LAS float*)(F.lds + 49152 + F.wave * 8704);
    const int gw = F.vcu * NWAVES + F.wave, NGW = F.G * NWAVES;
    constexpr int I_IN = (DM / 64) * (NPROJ / 32), I_Q = (QLORA / 64) * (768 / 32), I_KV = (KVLORA / 64) * (1024 / 32), I_O = (DM / 64) * (DM / 32);
    constexpr int I_GU = (DM / 64) * (2048 / 32), I_DN = (DE / 64) * (DM / 32);
    constexpr int P_GU = I_GU / 2, P_DN = I_DN / 2;
    constexpr int NITEMS = I_IN + I_Q + I_KV + I_O;
    for (int it = gw; it < NITEMS; it += NGW) {
        int r = it;
        if (r < I_IN) { p0_tr_item<0>(F.in[IN_WIN], DM, IN_DIM, NPROJ, WSP(bf16_t, WS_WIN), nullptr, scr, r, F.lane); continue; } r -= I_IN;
        if (r < I_Q) { p0_tr_item<0>(F.in[IN_WQB], QLORA, 768, 768, WSP(bf16_t, WS_WQ), F.in[IN_QNG], scr, r, F.lane); continue; } r -= I_Q;
        if (r < I_KV) { p0_tr_item<0>(F.in[IN_WKVB], KVLORA, 1024, 1024, WSP(bf16_t, WS_WKV), F.in[IN_KVNG], scr, r, F.lane); continue; } r -= I_KV;
        if (r < I_O) { p0_tr_item<0>(F.in[IN_WOUT], DM, DM, DM, WSP(bf16_t, WS_WO), nullptr, scr, r, F.lane); continue; } r -= I_O;
        (void)scr;
    }
    float* rwt = WSP(float, WS_RWT);
    for (int i = (int)blockIdx.x * NWAVES * 64 + F.tid; i < NE * DM; i += F.G * NWAVES * 64) { const int e = i >> 10, k = i & 1023; rwt[i] = F.in[IN_RW][k * NE + e]; }
}

template <int MAP>
__device__ __forceinline__ void p0_tr_pair8(const float* W, int K, int N, unsigned char* WT8, LAS float* scr, int kp, int nb, int lane) {
    const int k0 = 128 * kp, n0 = 32 * nb;
    f32x4 ld[16];
#pragma unroll
    for (int j = 0; j < 16; ++j) { const int idx = j * 64 + lane, kk = idx >> 3, nn = n0 + 4 * (idx & 7); ld[j] = *(const f32x4*)(W + (size_t)(k0 + kk) * N + nn); }
#pragma unroll
    for (int hk = 0; hk < 2; ++hk) {
#pragma unroll
        for (int j = 0; j < 8; ++j) { const int idx = j * 64 + lane, kk = idx >> 3, c4 = idx & 7; const f32x4 v = ld[hk * 8 + j];
            LAS float* d = scr + kk * 33 + 4 * c4; d[0] = v[0]; d[1] = v[1]; d[2] = v[2]; d[3] = v[3]; }
        LDS_WAIT(); asm volatile("" ::: "memory");
        const int c = lane & 7;
#pragma unroll
        for (int j = 0; j < 4; ++j) { const int n = (lane >> 3) + 8 * j; const LAS float* s = scr + (8 * c) * 33 + n;
            int dn = n0 + n;
            if (MAP == 1) { const int half = dn >> 10, r = dn & 1023; dn = ((r >> 7) << 8) + (half << 7) + (r & 127); }
            u32x2 o8; o8.x = pk4_fp8(s[0 * 33] * W8, s[1 * 33] * W8, s[2 * 33] * W8, s[3 * 33] * W8); o8.y = pk4_fp8(s[4 * 33] * W8, s[5 * 33] * W8, s[6 * 33] * W8, s[7 * 33] * W8);
            *(GAS u32x2*)(WT8 + (size_t)dn * K + k0 + 64 * hk + 8 * c) = o8; }
        LDS_WAIT(); asm volatile("" ::: "memory");
    }
}
constexpr int MOE_CONV_ITEMS = (NE * (DM / 64) * (2048 / 32) / 2 + NE * (DE / 64) * (DM / 32) / 2) / 64;
__device__ __forceinline__ void moe_conv_item(Frame& F, int item) {
    LAS float* scr = (LAS float*)(F.lds + F.wave * 8704);
    constexpr int P_GU = (DM / 64) * (2048 / 32) / 2, P_DN = (DE / 64) * (DM / 32) / 2;
#pragma unroll 1
    for (int j = 0; j < 8; ++j) {
        int r = item * 64 + j * 8 + F.wave;
        if (r < NE * P_GU) { const int e = r / P_GU, p = r - e * P_GU, nb = p % 64, kp = p / 64;
            p0_tr_pair8<1>(F.in[IN_WGU] + (size_t)e * DM * 2048, DM, 2048, WSP(unsigned char, WS_WGU) + (size_t)e * 2048 * DM, scr, kp, nb, F.lane);
        } else { r -= NE * P_GU; const int e = r / P_DN, p = r - e * P_DN, nb = p % 32, kp = p / 32;
            p0_tr_pair8<0>(F.in[IN_WDN] + (size_t)e * DE * DM, DE, DM, WSP(unsigned char, WS_WDN) + (size_t)e * DM * DE, scr, kp, nb, F.lane); }
    }
}

__device__ __forceinline__ void norm_rows(Frame& F, const float* x, const float* gain, int SH, int SC, bf16_t* outp) {
    const int gw = F.vcu * NWAVES + F.wave, NGW = F.G * NWAVES;
    const float* mod = WSP(float, WS_MOD);
    constexpr int R = 4;
    for (int m0 = gw; m0 < T; m0 += R * NGW) {
        f32x4 v[R][4]; float s[R];
#pragma unroll
        for (int r = 0; r < R; ++r) { const int m = m0 + r * NGW; s[r] = 0.f; if (m < T) { const f32x4* xr = (const f32x4*)(x + (size_t)m * DM) + F.lane;
#pragma unroll
            for (int j = 0; j < 4; ++j) v[r][j] = xr[64 * j]; } else {
#pragma unroll
            for (int j = 0; j < 4; ++j) v[r][j] = (f32x4){0.f, 0.f, 0.f, 0.f}; } }
#pragma unroll
        for (int r = 0; r < R; ++r)
#pragma unroll
            for (int j = 0; j < 4; ++j) s[r] += (v[r][j][0] * v[r][j][0] + v[r][j][1] * v[r][j][1]) + (v[r][j][2] * v[r][j][2] + v[r][j][3] * v[r][j][3]);
#pragma unroll
        for (int o = 1; o < 64; o <<= 1)
#pragma unroll
            for (int r = 0; r < R; ++r) s[r] += __shfl_xor(s[r], o);
#pragma unroll
        for (int r = 0; r < R; ++r) { const int m = m0 + r * NGW; if (m >= T) continue;
            const float rstd = __builtin_amdgcn_rsqf(s[r] * (1.f / DM) + EPS); const float* mb = mod + (size_t)(m / SEQ) * 6144;
            u32x2* o8 = (u32x2*)(outp + (size_t)m * DM) + F.lane;
#pragma unroll
            for (int j = 0; j < 4; ++j) { const int col = 4 * (F.lane + 64 * j);
                const f32x4 g = *(const f32x4*)(gain + col), sc = *(const f32x4*)(mb + SC + col), sh = *(const f32x4*)(mb + SH + col);
                const f32x4 h = v[r][j] * rstd * g * (sc + 1.0f) + sh; u32x2 w; w.x = cvtpk(h[0], h[1]); w.y = cvtpk(h[2], h[3]); o8[64 * j] = w; } }
    }
}

__device__ const float ROPE_INVF[16] = {1.0f, 0.5623413251903491f, 0.31622776601683794f, 0.1778279410038923f, 0.1f, 0.05623413251903491f, 0.03162277660168379f, 0.01778279410038923f,
    0.01f, 0.005623413251903491f, 0.003162277660168379f, 0.0017782794100389228f, 0.001f, 0.0005623413251903491f, 0.00031622776601683794f, 0.00017782794100389227f};
__device__ __forceinline__ float ssq8(u32x4 a) { float s = 0.f;
#pragma unroll
    for (int i = 0; i < 4; ++i) { const float lo = bflo(a[i]), hi = bfhi(a[i]); s += lo * lo + hi * hi; } return s; }
__device__ __forceinline__ void p3a_rows(Frame& F) {
    const int gw = F.vcu * NWAVES + F.wave, NGW = F.G * NWAVES, lane = F.lane;
    const bf16_t* proj = WSP(bf16_t, WS_PROJ); float* rsq = WSP(float, WS_RSQ); float* rskv = WSP(float, WS_RSKV); float* cs = WSP(float, WS_CS); bf16_t* Kb = WSP(bf16_t, WS_K);
    const int* pos = (const int*)F.in[IN_POS];
    constexpr int R = 4;
    for (int m0 = gw; m0 < T; m0 += R * NGW) {
        u32x4 a[R], b[R]; int ps[R];
#pragma unroll
        for (int r = 0; r < R; ++r) { const int m = (m0 + r * NGW < T) ? m0 + r * NGW : m0; const u32x4* pr = (const u32x4*)(proj + (size_t)m * NPROJ);
            a[r] = pr[lane]; b[r] = (u32x4){0u, 0u, 0u, 0u}; if (lane < 20) b[r] = pr[64 + lane]; ps[r] = pos[m]; }
#pragma unroll
        for (int r = 0; r < R; ++r) { const int m = m0 + r * NGW; if (m >= T) continue;
            const float sa = ssq8(a[r]), sb = ssq8(b[r]);
            const float sq = wave_sum(lane < 48 ? sa : 0.f), skv = wave_sum((lane >= 48 ? sa : 0.f) + (lane < 16 ? sb : 0.f));
            if (lane == 0) { rsq[m] = __builtin_amdgcn_rsqf(sq * (1.f / QLORA) + EPS); rskv[m] = __builtin_amdgcn_rsqf(skv * (1.f / KVLORA) + EPS); }
            const float ang = (float)ps[r] * ROPE_INVF[lane & 15];
            const double rev = (double)ang * 0.15915494309189535; const float fr = (float)(rev - __builtin_rint(rev));
            const float cv = __builtin_amdgcn_cosf(fr), sv = __builtin_amdgcn_sinf(fr);
            if (lane < 16) { cs[(size_t)m * 32 + lane] = cv; cs[(size_t)m * 32 + 16 + lane] = sv; }
            float xv[8], pv[8], cc[8], ss[8];
#pragma unroll
            for (int i = 0; i < 4; ++i) { xv[2 * i] = bflo(b[r][i]); xv[2 * i + 1] = bfhi(b[r][i]); }
            const int i0 = 8 * (lane & 1);
#pragma unroll
            for (int j = 0; j < 8; ++j) { pv[j] = __shfl_xor(xv[j], 2); cc[j] = __shfl(cv, i0 + j); ss[j] = __shfl(sv, i0 + j); }
            if (lane >= 16 && lane < 20) {
                float o[8];
#pragma unroll
                for (int j = 0; j < 8; ++j) o[j] = (lane < 18) ? xv[j] * cc[j] - pv[j] * ss[j] : xv[j] * cc[j] + pv[j] * ss[j];
                u32x4 w; w.x = cvtpk(o[0], o[1]); w.y = cvtpk(o[2], o[3]); w.z = cvtpk(o[4], o[5]); w.w = cvtpk(o[6], o[7]);
#pragma unroll
                for (int h = 0; h < NH; ++h) *(u32x4*)(Kb + (size_t)m * 768 + h * 96 + 64 + 8 * (lane - 16)) = w;
            } }
    }
}

__device__ __forceinline__ int crow(int r, int hi) { return (r & 3) + 8 * (r >> 2) + 4 * hi; }
typedef short v4i16_t __attribute__((ext_vector_type(4)));
constexpr int AT_KROW = 208, AT_VROW = 144, AT_KBUF = 64 * AT_KROW, AT_VBUF = 64 * AT_VROW, AT_V0 = 2 * AT_KBUF, AT_WS = AT_V0 + 2 * AT_VBUF;
__device__ __forceinline__ void attn_unit(Frame& F, int b, int h, int qb) {
    const int tid = F.tid, lane = F.lane, wid = F.wave, r32 = lane & 31, hi = lane >> 5;
    const bf16_t* Qg = WSP(bf16_t, WS_Q); const bf16_t* Kg = WSP(bf16_t, WS_K); const bf16_t* Vg = WSP(bf16_t, WS_V); bf16_t* Og = WSP(bf16_t, WS_OA);
    LAS unsigned char* Kl = F.lds; LAS unsigned char* Vl = F.lds + AT_V0; LAS float* wsf = (LAS float*)(F.lds + AT_WS) + wid * 64;
    const size_t tb = (size_t)b * SEQ; const int q0 = qb * 256, NT = 4 * qb + 4;
    bf16x8 qr[6];
    { const bf16_t* Qp = Qg + (tb + q0 + wid * 32 + r32) * 768 + h * 96 + hi * 8;
#pragma unroll
      for (int d0 = 0; d0 < 6; ++d0) qr[d0] = *(const bf16x8*)(Qp + d0 * 16); }
    const int kr0 = tid / 12, kc0 = tid % 12, kr1 = (tid + 512) / 12, kc1 = (tid + 512) % 12, vr = tid >> 3, vc = tid & 7;
    const bf16_t* kp0 = Kg + (tb + kr0) * 768 + h * 96 + 8 * kc0; const bf16_t* kp1 = Kg + (tb + kr1) * 768 + h * 96 + 8 * kc1; const bf16_t* vp = Vg + (tb + vr) * 512 + h * 64 + 8 * vc;
    u32x4 kreg0, kreg1 = (u32x4){0u, 0u, 0u, 0u}, vreg;
#define AT_LOAD(t) do { kreg0 = *(const u32x4*)(kp0 + (size_t)(t) * 64 * 768); if (tid < 256) kreg1 = *(const u32x4*)(kp1 + (size_t)(t) * 64 * 768); vreg = *(const u32x4*)(vp + (size_t)(t) * 64 * 512); } while (0)
#define AT_STORE(bf) do { *(LAS u32x4*)(Kl + (bf) * AT_KBUF + kr0 * AT_KROW + kc0 * 16) = kreg0; if (tid < 256) *(LAS u32x4*)(Kl + (bf) * AT_KBUF + kr1 * AT_KROW + kc1 * 16) = kreg1; \
        *(LAS u32x4*)(Vl + (bf) * AT_VBUF + vr * AT_VROW + vc * 16) = vreg; } while (0)
    AT_LOAD(0); AT_STORE(0); __syncthreads();
    float m_run = -INFINITY, l_run = 0.f; f32x16 o[2];
#pragma unroll
    for (int r = 0; r < 16; ++r) { o[0][r] = 0.f; o[1][r] = 0.f; }
    const int qmax = q0 + wid * 32 + 31, qpos = q0 + wid * 32 + r32;
    for (int t = 0; t < NT; ++t) {
        const int bf = t & 1;
        if (t + 1 < NT) AT_LOAD(t + 1);
        if (64 * t <= qmax) {
            f32x16 p0, p1;
#pragma unroll
            for (int r = 0; r < 16; ++r) { p0[r] = 0.f; p1[r] = 0.f; }
            const LAS unsigned char* kb = Kl + bf * AT_KBUF + r32 * AT_KROW + hi * 16;
#pragma unroll
            for (int d0 = 0; d0 < 6; ++d0) { const bf16x8 k0 = *(const LAS bf16x8*)(kb + d0 * 32), k1 = *(const LAS bf16x8*)(kb + 32 * AT_KROW + d0 * 32);
                p0 = __builtin_amdgcn_mfma_f32_32x32x16_bf16(k0, qr[d0], p0, 0, 0, 0); p1 = __builtin_amdgcn_mfma_f32_32x32x16_bf16(k1, qr[d0], p1, 0, 0, 0); }
            if (t >= NT - 4) {
#pragma unroll
                for (int r = 0; r < 16; ++r) { const int kv = 64 * t + crow(r, hi); if (kv > qpos) p0[r] = -INFINITY; if (kv + 32 > qpos) p1[r] = -INFINITY; }
            }
            float mx = fmaxf(p0[0], p1[0]);
#pragma unroll
            for (int r = 1; r < 16; ++r) mx = fmaxf(mx, fmaxf(p0[r], p1[r]));
            mx = fmaxf(mx, __shfl_xor(mx, 32));
            const float m_new = fmaxf(m_run, mx);
            if (__any(m_new > m_run)) {
                const float f = __builtin_amdgcn_exp2f(m_run - m_new);
                l_run *= f; m_run = m_new;
                if (hi == 0) wsf[r32] = f;
                float fr_[16];
#pragma unroll
                for (int r = 0; r < 16; ++r) fr_[r] = wsf[crow(r, hi)];
#pragma unroll
                for (int r = 0; r < 16; ++r) { o[0][r] *= fr_[r]; o[1][r] *= fr_[r]; }
            }
            float rs = 0.f;
#pragma unroll
            for (int r = 0; r < 16; ++r) { p0[r] = __builtin_amdgcn_exp2f(p0[r] - m_run); p1[r] = __builtin_amdgcn_exp2f(p1[r] - m_run); rs += p0[r] + p1[r]; }
            l_run += rs;
            bf16x8 pa[4];
#pragma unroll
            for (int ks = 0; ks < 4; ++ks) { u32x4 w;
#pragma unroll
                for (int i = 0; i < 4; ++i) { const int r = (ks & 1) * 8 + 2 * i; w[i] = (ks < 2) ? cvtpk(p0[r], p0[r + 1]) : cvtpk(p1[r], p1[r + 1]); }
                pa[ks] = __builtin_bit_cast(bf16x8, w); }
            const LAS unsigned char* vb = Vl + bf * AT_VBUF + (4 * hi + ((lane & 15) >> 2)) * AT_VROW + (((lane >> 4) & 1) * 16 + (lane & 3) * 4) * 2;
#pragma unroll
            for (int d0 = 0; d0 < 2; ++d0)
#pragma unroll
                for (int ks = 0; ks < 4; ++ks) {
                    const v4i16_t lo = __builtin_amdgcn_ds_read_tr16_b64_v4i16((LAS v4i16_t*)(vb + ks * 16 * AT_VROW + d0 * 64));
                    const v4i16_t hv = __builtin_amdgcn_ds_read_tr16_b64_v4i16((LAS v4i16_t*)(vb + ks * 16 * AT_VROW + 8 * AT_VROW + d0 * 64));
                    const bf16x8 vf = (bf16x8){lo[0], lo[1], lo[2], lo[3], hv[0], hv[1], hv[2], hv[3]};
                    o[d0] = __builtin_amdgcn_mfma_f32_32x32x16_bf16(pa[ks], vf, o[d0], 0, 0, 0); }
        }
        if (t + 1 < NT) AT_STORE((t + 1) & 1);
        __syncthreads();
    }
    { float lt = l_run + __shfl_xor(l_run, 32);
      if (hi == 0) wsf[32 + r32] = lt;
      bf16_t* Ow = Og + (tb + q0 + wid * 32) * 512 + h * 64 + r32;
#pragma unroll
      for (int r = 0; r < 16; ++r) { const int qr_ = crow(r, hi); const float inv = 1.0f / wsf[32 + qr_];
          Ow[(size_t)qr_ * 512] = f2bf(o[0][r] * inv); Ow[(size_t)qr_ * 512 + 32] = f2bf(o[1][r] * inv); } }
#undef AT_LOAD
#undef AT_STORE
}

__device__ __forceinline__ void p4b_rows(Frame& F) {
    const int gw = F.vcu * NWAVES + F.wave, NGW = F.G * NWAVES, lane = F.lane;
    const bf16_t* oa = WSP(bf16_t, WS_OA); const bf16_t* og = WSP(bf16_t, WS_OG); const bf16_t* proj = WSP(bf16_t, WS_PROJ); bf16_t* mx = WSP(bf16_t, WS_H);
    const float* ga = F.in[IN_MLAOG] + 8 * lane; const float* gg = F.in[IN_GDNG] + 8 * (lane & 7);
    constexpr int R = 4;
    for (int m0 = gw; m0 < T; m0 += R * NGW) {
        u32x4 a[R], g[R], z[R];
#pragma unroll
        for (int r = 0; r < R; ++r) { const int m = (m0 + r * NGW < T) ? m0 + r * NGW : m0;
            a[r] = *(const u32x4*)(oa + (size_t)m * 512 + 8 * lane); g[r] = *(const u32x4*)(og + (size_t)m * 512 + 8 * lane); z[r] = *(const u32x4*)(proj + (size_t)m * NPROJ + C_GZ + 8 * lane); }
#pragma unroll
        for (int r = 0; r < R; ++r) { const int m = m0 + r * NGW; if (m >= T) continue;
            const float ra = __builtin_amdgcn_rsqf(wave_sum(ssq8(a[r])) * (1.f / 512) + EPS);
            float sg = ssq8(g[r]); sg += __shfl_xor(sg, 1); sg += __shfl_xor(sg, 2); sg += __shfl_xor(sg, 4);
            const float rg = __builtin_amdgcn_rsqf(sg * (1.f / 64) + EPS);
            float oa8[8], og8[8];
#pragma unroll
            for (int i = 0; i < 4; ++i) { oa8[2 * i] = bflo(a[r][i]) * ra * ga[2 * i]; oa8[2 * i + 1] = bfhi(a[r][i]) * ra * ga[2 * i + 1];
                og8[2 * i] = bflo(g[r][i]) * rg * gg[2 * i] * siluf(bflo(z[r][i])); og8[2 * i + 1] = bfhi(g[r][i]) * rg * gg[2 * i + 1] * siluf(bfhi(z[r][i])); }
            u32x4 wa, wg;
#pragma unroll
            for (int i = 0; i < 4; ++i) { wa[i] = cvtpk(oa8[2 * i], oa8[2 * i + 1]); wg[i] = cvtpk(og8[2 * i], og8[2 * i + 1]); }
            *(u32x4*)(mx + (size_t)m * DM + 8 * lane) = wa; *(u32x4*)(mx + (size_t)m * DM + 512 + 8 * lane) = wg; }
    }
}

constexpr int G1_KRM = 0, G1_QRM = 4608, G1_AM = 9216, G1_QK = 13440, G1_UT = 16000, G1_WT = 21120, G1_KT = 26240, G1_GT = 31360, G1_SLOT = 32000, G1_CW = 4 * G1_SLOT;
static_assert(G1_CW + 3072 <= RING_BYTES, "G1 LDS");
__device__ __forceinline__ f32x4 mfma16(bf16x8 a, bf16x8 b, f32x4 c) { return __builtin_amdgcn_mfma_f32_16x16x32_bf16(a, b, c, 0, 0, 0); }

#define LBAR() asm volatile("s_waitcnt lgkmcnt(0)\n\ts_barrier" ::: "memory")
__device__ __forceinline__ float silu_fast(float x) { return x * __builtin_amdgcn_rcpf(1.0f + __expf(-x)); }
#ifndef G1PROBE
#define G1PROBE (-1)
#endif
#define G1T(k) do { if (G1PROBE >= 0) { const unsigned long long n_ = __builtin_amdgcn_s_memrealtime(); if (G1PROBE == (k)) g1acc += n_ - g1t; g1t = n_; } } while (0)
__device__ __forceinline__ void g1_unit(Frame& F, int unit, unsigned long long& g1acc) {
    unsigned long long g1t = (G1PROBE >= 0) ? __builtin_amdgcn_s_memrealtime() : 0ull;
    const int tid = F.tid, lane = F.lane, wid = F.wave;
    const int bh = unit >> 5, c0 = (unit & 31) * 4, b = bh >> 3, h = bh & 7;
    const bf16_t* proj = WSP(bf16_t, WS_PROJ);
    LAS unsigned char* L = F.lds; LAS float* cw = (LAS float*)(L + G1_CW);
    const size_t tb = (size_t)b * SEQ;
    for (int i = tid; i < 768; i += NWAVES * 64) { const int x = i >> 8, w = (i >> 6) & 3, ch = i & 63; cw[i] = F.in[IN_CONVW][w * 1536 + x * 512 + h * 64 + ch]; }
    LBAR(); G1T(0);
    { const int tk = tid >> 2, part = tid & 3, s = tk >> 5, i = tk & 31, isk = part >> 1, chb = (part & 1) * 32;
      const int sp = (c0 + s) * GC + i;
      const bf16_t* src = proj + (tb + sp) * NPROJ + (isk ? C_GK : C_GQ) + h * 64 + chb;
      float ain = 0.f, bin = 0.f;
      if (part == 0) { ain = bf2f(proj[(tb + sp) * NPROJ + C_GA + h]); bin = bf2f(proj[(tb + sp) * NPROJ + C_GB + h]); }
      float v[32];
#pragma unroll
      for (int c = 0; c < 32; ++c) v[c] = 0.f;
#pragma unroll
      for (int w = 0; w < 4; ++w) { if (sp - 3 + w >= 0) { const bf16_t* rp = src - (ptrdiff_t)(3 - w) * NPROJ;
#pragma unroll
          for (int q4 = 0; q4 < 4; ++q4) { const u32x4 d = *(const u32x4*)(rp + 8 * q4); const LAS f32x4* wp = (const LAS f32x4*)(cw + (isk * 4 + w) * 64 + chb + 8 * q4); const f32x4 w0 = wp[0], w1 = wp[1];
              v[8 * q4 + 0] += bflo(d[0]) * w0[0]; v[8 * q4 + 1] += bfhi(d[0]) * w0[1]; v[8 * q4 + 2] += bflo(d[1]) * w0[2]; v[8 * q4 + 3] += bfhi(d[1]) * w0[3];
              v[8 * q4 + 4] += bflo(d[2]) * w1[0]; v[8 * q4 + 5] += bfhi(d[2]) * w1[1]; v[8 * q4 + 6] += bflo(d[3]) * w1[2]; v[8 * q4 + 7] += bfhi(d[3]) * w1[3]; } } }
      float ss = 0.f;
#pragma unroll
      for (int c = 0; c < 32; ++c) { v[c] = silu_fast(v[c]); ss += v[c] * v[c]; }
      ss += __shfl_xor(ss, 1);
      const float rn = __builtin_amdgcn_rsqf(ss + EPS) * (isk ? 1.0f : 0.125f);
      LAS bf16_t* dst = (LAS bf16_t*)(L + s * G1_SLOT + (isk ? G1_KRM : G1_QRM)) + i * 72 + chb;
#pragma unroll
      for (int q4 = 0; q4 < 4; ++q4) { u32x4 w;
#pragma unroll
          for (int e = 0; e < 4; ++e) w[e] = cvtpk(v[8 * q4 + 2 * e] * rn, v[8 * q4 + 2 * e + 1] * rn);
          *(LAS u32x4*)(dst + 8 * q4) = w; }
      if (part == 0) { LAS float* gt = (LAS float*)(L + s * G1_SLOT + G1_GT);
          const float xs = ain + F.in[IN_DTB][h], sp_ = xs > 20.f ? xs : __logf(1.0f + __expf(xs));
          gt[i] = 1.0f / (1.0f + __expf(-bin));
          gt[32 + i] = -__expf(F.in[IN_ALOG][h]) * sp_; }
    }
    LBAR(); G1T(1);
    if (wid < 2) { LAS float* gt = (LAS float*)(L + (2 * wid + (lane >> 5)) * G1_SLOT + G1_GT); const int i = lane & 31; float c = gt[32 + i];
#pragma unroll
        for (int o = 1; o < 32; o <<= 1) { const float t = __shfl_up(c, o, 32); if (i >= o) c += t; }
        const float last = __shfl(c, 31, 32);
        gt[64 + i] = c; gt[96 + i] = __expf(c); gt[128 + i] = __expf(last - c); }
    LBAR(); G1T(2);
    const int s = wid >> 1, sub = wid & 1, l15 = lane & 15, kq = lane >> 4;
    LAS unsigned char* Ls = L + s * G1_SLOT; LAS float* gt = (LAS float*)(Ls + G1_GT);
    { const LAS bf16_t* X = (const LAS bf16_t*)(Ls + (sub ? G1_QRM : G1_KRM)); const LAS bf16_t* Kr = (const LAS bf16_t*)(Ls + G1_KRM);
#pragma unroll
      for (int it = 0; it < 2; ++it)
#pragma unroll
          for (int jt = 0; jt < 2; ++jt) { f32x4 acc = (f32x4){0.f, 0.f, 0.f, 0.f};
#pragma unroll
              for (int ks = 0; ks < 2; ++ks) acc = mfma16(*(const LAS bf16x8*)(X + (16 * it + l15) * 72 + 32 * ks + 8 * kq), *(const LAS bf16x8*)(Kr + (16 * jt + l15) * 72 + 32 * ks + 8 * kq), acc);
              const int j = 16 * jt + l15; const float gj = gt[64 + j];
#pragma unroll
              for (int r = 0; r < 4; ++r) { const int i = 16 * it + 4 * kq + r; const float gi = gt[64 + i];
                  if (sub == 0) { const float val = (i > j) ? acc[r] * gt[i] * __expf(gi - gj) : 0.f; ((LAS float*)(Ls + G1_AM))[i * 33 + j] = val; }
                  else { const float val = (i >= j) ? acc[r] * __expf(gi - gj) : 0.f; ((LAS bf16_t*)(Ls + G1_QK))[i * 40 + j] = f2bf(val); } } }
    }
    for (int idx = tid; idx < 4 * 64 * 32; idx += NWAVES * 64) { const int s2 = idx >> 11, d = (idx >> 5) & 63, c = idx & 31; LAS unsigned char* L2 = L + s2 * G1_SLOT;
        ((LAS bf16_t*)(L2 + G1_KT))[d * 40 + c] = f2bf(bf2f(((const LAS bf16_t*)(L2 + G1_KRM))[c * 72 + d]) * ((const LAS float*)(L2 + G1_GT))[128 + c]); }
    LBAR(); G1T(3);
    { float sol[32];
      if (sub == 0) {
          const int sp0 = (c0 + s) * GC; const bf16_t* src = proj + (tb + sp0) * NPROJ + C_GV + h * 64 + lane;
          const float w0 = cw[(8 + 0) * 64 + lane], w1 = cw[(8 + 1) * 64 + lane], w2 = cw[(8 + 2) * 64 + lane], w3 = cw[(8 + 3) * 64 + lane];
          float x0 = (sp0 >= 3) ? bf2f(src[-3 * (ptrdiff_t)NPROJ]) : 0.f, x1 = (sp0 >= 2) ? bf2f(src[-2 * (ptrdiff_t)NPROJ]) : 0.f, x2 = (sp0 >= 1) ? bf2f(src[-1 * (ptrdiff_t)NPROJ]) : 0.f;
#pragma unroll
          for (int i = 0; i < 32; ++i) { const float x3 = bf2f(src[(size_t)i * NPROJ]); sol[i] = silu_fast(w0 * x0 + w1 * x1 + w2 * x2 + w3 * x3) * gt[i]; x0 = x1; x1 = x2; x2 = x3; }
      } else {
          const LAS bf16_t* Kr = (const LAS bf16_t*)(Ls + G1_KRM);
#pragma unroll
          for (int i = 0; i < 32; ++i) sol[i] = bf2f(Kr[i * 72 + lane]) * gt[i] * gt[96 + i];
      }
      const LAS float* Am = (const LAS float*)(Ls + G1_AM);
#pragma unroll
      for (int i = 1; i < 32; ++i) { const float arow = Am[i * 33 + (lane & 31)]; float a = sol[i];
#pragma unroll
          for (int j = 0; j < i; ++j) a -= __uint_as_float(__builtin_amdgcn_readlane(__float_as_uint(arow), j)) * sol[j];
          sol[i] = a; }
      LAS bf16_t* dst = (LAS bf16_t*)(Ls + (sub ? G1_WT : G1_UT)) + lane * 40;
#pragma unroll
      for (int q4 = 0; q4 < 4; ++q4) { u32x4 w;
#pragma unroll
          for (int e = 0; e < 4; ++e) w[e] = cvtpk(sol[8 * q4 + 2 * e], sol[8 * q4 + 2 * e + 1]);
          *(LAS u32x4*)(dst + 8 * q4) = w; }
    }
    LBAR(); G1T(4);
        { unsigned char* gd = F.ws + WS_GD + (size_t)(bh * NCH + c0 + s) * 24576;
          const LAS bf16_t* uT = (const LAS bf16_t*)(Ls + G1_UT); const LAS bf16_t* wT = (const LAS bf16_t*)(Ls + G1_WT); const LAS bf16_t* kT = (const LAS bf16_t*)(Ls + G1_KT);
          const LAS bf16_t* qk = (const LAS bf16_t*)(Ls + G1_QK); const LAS bf16_t* qr = (const LAS bf16_t*)(Ls + G1_QRM);
          const f32x4 z4 = (f32x4){0.f, 0.f, 0.f, 0.f}; const float cd = gt[96 + 31];
          if (sub == 0) {
#pragma unroll
              for (int mp = 0; mp < 2; ++mp) {
                  const bf16x8 af0 = *(const LAS bf16x8*)(wT + (32 * mp + l15) * 40 + 8 * kq), af1 = *(const LAS bf16x8*)(wT + (32 * mp + 16 + l15) * 40 + 8 * kq);
#pragma unroll
                  for (int nt = 0; nt < 4; ++nt) {
                      const bf16x8 bfr = *(const LAS bf16x8*)(kT + (16 * nt + l15) * 40 + 8 * kq);
                      const f32x4 a0 = mfma16(af0, bfr, z4), a1 = mfma16(af1, bfr, z4); const int dout = 16 * nt + l15; u32x4 w; float o8[8];
#pragma unroll
                      for (int r = 0; r < 4; ++r) { const int din = 32 * mp + 4 * kq + r; o8[r] = ((din == dout) ? cd : 0.f) - a0[r]; o8[4 + r] = ((din + 16 == dout) ? cd : 0.f) - a1[r]; }
                      w.x = cvtpk(o8[0], o8[1]); w.y = cvtpk(o8[2], o8[3]); w.z = cvtpk(o8[4], o8[5]); w.w = cvtpk(o8[6], o8[7]);
                      *(u32x4*)(gd + ((nt * 2 + mp) * 64 + kq * 16 + l15) * 16) = w; }
#pragma unroll
                  for (int ct = 0; ct < 2; ++ct) {
                      const bf16x8 bfr = *(const LAS bf16x8*)(qk + (16 * ct + l15) * 40 + 8 * kq);
                      const f32x4 a0 = mfma16(af0, bfr, z4), a1 = mfma16(af1, bfr, z4); const int c = 16 * ct + l15; const float eg = gt[96 + c];
                      const u32x2 q0 = *(const LAS u32x2*)(qr + c * 72 + 32 * mp + 4 * kq), q1 = *(const LAS u32x2*)(qr + c * 72 + 32 * mp + 16 + 4 * kq); u32x4 w;
                      w.x = cvtpk(bflo(q0.x) * eg - a0[0], bfhi(q0.x) * eg - a0[1]); w.y = cvtpk(bflo(q0.y) * eg - a0[2], bfhi(q0.y) * eg - a0[3]);
                      w.z = cvtpk(bflo(q1.x) * eg - a1[0], bfhi(q1.x) * eg - a1[1]); w.w = cvtpk(bflo(q1.y) * eg - a1[2], bfhi(q1.y) * eg - a1[3]);
                      *(u32x4*)(gd + 8192 + ((ct * 2 + mp) * 64 + kq * 16 + l15) * 16) = w; } }
          } else {
#pragma unroll
              for (int et = 0; et < 4; ++et) { const bf16x8 bfr = *(const LAS bf16x8*)(uT + (16 * et + l15) * 40 + 8 * kq);
#pragma unroll
                  for (int dt = 0; dt < 4; ++dt) {
                      const f32x4 acc = mfma16(*(const LAS bf16x8*)(kT + (16 * dt + l15) * 40 + 8 * kq), bfr, z4); u32x2 w; w.x = cvtpk(acc[0], acc[1]); w.y = cvtpk(acc[2], acc[3]);
                      *(u32x2*)(gd + 12288 + ((dt * 4 + et) * 64 + lane) * 8) = w; }
#pragma unroll
                  for (int ct = 0; ct < 2; ++ct) {
                      const f32x4 acc = mfma16(*(const LAS bf16x8*)(qk + (16 * ct + l15) * 40 + 8 * kq), bfr, z4); u32x2 w; w.x = cvtpk(acc[0], acc[1]); w.y = cvtpk(acc[2], acc[3]);
                      *(u32x2*)(gd + 20480 + ((ct * 4 + et) * 64 + lane) * 8) = w; } }
          }
        }
    LBAR(); G1T(5);
}

__device__ __forceinline__ void g2_item(Frame& F, int item) {
    const int lane = F.lane, wid = F.wave, bh = item * 2 + (wid >> 2), es = wid & 3, b = bh >> 3, h = bh & 7, l15 = lane & 15, kq = lane >> 4;
    const unsigned char* gd = F.ws + WS_GD + (size_t)bh * NCH * 24576;
    bf16_t* og = WSP(bf16_t, WS_OG) + ((size_t)b * SEQ) * 512 + h * 64 + 16 * es + l15;
    f32x4 S[4];
#pragma unroll
    for (int m = 0; m < 4; ++m) S[m] = (f32x4){0.f, 0.f, 0.f, 0.f};
    bf16x8 Mf[4][2], Pf[2][2]; u32x2 Nv[4], Rv[2];
#define G2_LOAD(c) do { const unsigned char* p_ = gd + (size_t)(c) * 24576; \
        _Pragma("unroll") for (int m = 0; m < 4; ++m) _Pragma("unroll") for (int s2 = 0; s2 < 2; ++s2) Mf[m][s2] = *(const bf16x8*)(p_ + ((m * 2 + s2) * 64 + lane) * 16); \
        _Pragma("unroll") for (int ct = 0; ct < 2; ++ct) _Pragma("unroll") for (int s2 = 0; s2 < 2; ++s2) Pf[ct][s2] = *(const bf16x8*)(p_ + 8192 + ((ct * 2 + s2) * 64 + lane) * 16); \
        _Pragma("unroll") for (int m = 0; m < 4; ++m) Nv[m] = *(const u32x2*)(p_ + 12288 + ((m * 4 + es) * 64 + lane) * 8); \
        _Pragma("unroll") for (int ct = 0; ct < 2; ++ct) Rv[ct] = *(const u32x2*)(p_ + 20480 + ((ct * 4 + es) * 64 + lane) * 8); } while (0)
    G2_LOAD(0);
    for (int c = 0; c < NCH; ++c) {
        bf16x8 cM[4][2], cP[2][2]; u32x2 cN[4], cR[2];
#pragma unroll
        for (int m = 0; m < 4; ++m) { cM[m][0] = Mf[m][0]; cM[m][1] = Mf[m][1]; cN[m] = Nv[m]; }
#pragma unroll
        for (int ct = 0; ct < 2; ++ct) { cP[ct][0] = Pf[ct][0]; cP[ct][1] = Pf[ct][1]; cR[ct] = Rv[ct]; }
        if (c + 1 < NCH) G2_LOAD(c + 1);
        bf16x8 Bs[2];
#pragma unroll
        for (int s2 = 0; s2 < 2; ++s2) { u32x4 w; w.x = cvtpk(S[2 * s2][0], S[2 * s2][1]); w.y = cvtpk(S[2 * s2][2], S[2 * s2][3]); w.z = cvtpk(S[2 * s2 + 1][0], S[2 * s2 + 1][1]); w.w = cvtpk(S[2 * s2 + 1][2], S[2 * s2 + 1][3]);
            Bs[s2] = __builtin_bit_cast(bf16x8, w); }
#pragma unroll
        for (int ct = 0; ct < 2; ++ct) { f32x4 o = (f32x4){bflo(cR[ct].x), bfhi(cR[ct].x), bflo(cR[ct].y), bfhi(cR[ct].y)};
            o = mfma16(cP[ct][0], Bs[0], o); o = mfma16(cP[ct][1], Bs[1], o);
            bf16_t* op = og + (size_t)(c * GC + 16 * ct + 4 * kq) * 512;
#pragma unroll
            for (int r = 0; r < 4; ++r) op[(size_t)r * 512] = f2bf(o[r]); }
#pragma unroll
        for (int m = 0; m < 4; ++m) { f32x4 a = (f32x4){bflo(cN[m].x), bfhi(cN[m].x), bflo(cN[m].y), bfhi(cN[m].y)};
            a = mfma16(cM[m][0], Bs[0], a); S[m] = mfma16(cM[m][1], Bs[1], a); }
    }
#undef G2_LOAD
}

constexpr int P6_RW = 0, P6_TK = 131072;
__device__ __forceinline__ void p6_router(Frame& F, int rep) {
    const int lane = F.lane, wid = F.wave, tid = F.tid;
    LAS float* rw = (LAS float*)(F.lds + P6_RW);
    { const f32x4* src = (const f32x4*)WSP(float, WS_RWT);
      for (int i = tid; i < NE * DM / 4; i += NWAVES * 64) ((LAS f32x4*)rw)[i] = src[i]; }
    if (tid < 96) F.MISC[32 + tid] = 0u;
    __syncthreads();
    const float* x1 = WSP(float, WS_X1); const float* mod = WSP(float, WS_MOD); unsigned char* h2 = WSP(unsigned char, WS_H);
    const size_t ro = rep ? WS_END : 0;
    int* tke = WSP(int, ro + WS_TKE); float* tkw = WSP(float, ro + WS_TKW); int* tkp = WSP(int, ro + WS_TKP); int* lst = WSP(int, ro + WS_LIST);
    const int tpw = T / F.G, t0 = (int)blockIdx.x * tpw;
    const float rb = F.in[IN_RB][lane >> 1];
    for (int tq = wid * 4; tq < tpw; tq += NWAVES * 4) {
        float acc[4][32];
#pragma unroll
        for (int q = 0; q < 4; ++q)
#pragma unroll
            for (int e = 0; e < 32; ++e) acc[q][e] = 0.f;
        float rstd[4];
#pragma unroll
        for (int q = 0; q < 4; ++q) { const f32x4* xr = (const f32x4*)(x1 + (size_t)(t0 + tq + q) * DM) + lane; float s = 0.f;
#pragma unroll
            for (int j = 0; j < 4; ++j) { const f32x4 v = xr[64 * j]; s += (v[0] * v[0] + v[1] * v[1]) + (v[2] * v[2] + v[3] * v[3]); }
            rstd[q] = __builtin_amdgcn_rsqf(wave_sum(s) * (1.f / DM) + EPS); }
        const float* mb = mod + (size_t)((t0 + tq) / SEQ) * 6144;
#pragma unroll 1
        for (int j = 0; j < 4; ++j) {
            const int col = 4 * (lane + 64 * j);
            const f32x4 g = *(const f32x4*)(F.in[IN_N2G] + col), sc = *(const f32x4*)(mb + 4096 + col), sh = *(const f32x4*)(mb + 3072 + col);
            f32x4 hv[4];
#pragma unroll
            for (int q = 0; q < 4; ++q) { const f32x4 v = *(const f32x4*)(x1 + (size_t)(t0 + tq + q) * DM + col); hv[q] = v * rstd[q] * g * (sc + 1.0f) + sh;
                *(unsigned*)(h2 + (size_t)(t0 + tq + q) * DM + col) = pk4_fp8(hv[q][0], hv[q][1], hv[q][2], hv[q][3]); }
#pragma unroll
            for (int e = 0; e < 32; ++e) { const f32x4 wv = *(const LAS f32x4*)(rw + e * DM + col);
#pragma unroll
                for (int q = 0; q < 4; ++q) acc[q][e] += (hv[q][0] * wv[0] + hv[q][1] * wv[1]) + (hv[q][2] * wv[2] + hv[q][3] * wv[3]); }
        }
#pragma unroll
        for (int q = 0; q < 4; ++q) {
            float v16[16], v8[8], v4[4], v2[2], v1;
            { const bool up = (lane & 32) != 0;
#pragma unroll
              for (int i = 0; i < 16; ++i) { const float keep = up ? acc[q][i + 16] : acc[q][i], give = up ? acc[q][i] : acc[q][i + 16]; v16[i] = keep + __shfl_xor(give, 32); } }
            { const bool up = (lane & 16) != 0;
#pragma unroll
              for (int i = 0; i < 8; ++i) { const float keep = up ? v16[i + 8] : v16[i], give = up ? v16[i] : v16[i + 8]; v8[i] = keep + __shfl_xor(give, 16); } }
            { const bool up = (lane & 8) != 0;
#pragma unroll
              for (int i = 0; i < 4; ++i) { const float keep = up ? v8[i + 4] : v8[i], give = up ? v8[i] : v8[i + 4]; v4[i] = keep + __shfl_xor(give, 8); } }
            { const bool up = (lane & 4) != 0;
#pragma unroll
              for (int i = 0; i < 2; ++i) { const float keep = up ? v4[i + 2] : v4[i], give = up ? v4[i] : v4[i + 2]; v2[i] = keep + __shfl_xor(give, 4); } }
            { const bool up = (lane & 2) != 0; const float keep = up ? v2[1] : v2[0], give = up ? v2[0] : v2[1]; v1 = keep + __shfl_xor(give, 2); }
            v1 += __shfl_xor(v1, 1);
            float logit = v1 + rb; const int me = lane >> 1;
            float tv[4]; int ti[4];
#pragma unroll
            for (int k = 0; k < 4; ++k) { float bv = logit; int bi = me;
#pragma unroll
                for (int o = 1; o < 64; o <<= 1) { const float ov = __shfl_xor(bv, o); const int oi = __shfl_xor(bi, o); if (ov > bv || (ov == bv && oi < bi)) { bv = ov; bi = oi; } }
                tv[k] = bv; ti[k] = bi; if (me == bi) logit = -INFINITY; }
            const float e1 = __expf(tv[1] - tv[0]), e2 = __expf(tv[2] - tv[0]), e3 = __expf(tv[3] - tv[0]), inv = 1.0f / (1.0f + e1 + e2 + e3);
            if (lane < 4) { const int t = t0 + tq + q; const int e = (lane == 0) ? ti[0] : (lane == 1) ? ti[1] : (lane == 2) ? ti[2] : ti[3];
                const float w = ((lane == 0) ? 1.0f : (lane == 1) ? e1 : (lane == 2) ? e2 : e3) * inv;
                const int lp = __hip_atomic_fetch_add((LAS int*)(F.lds + MISC_OFF) + 32 + e, 1, __ATOMIC_RELAXED, __HIP_MEMORY_SCOPE_WORKGROUP);
                tke[t * 4 + lane] = e; tkw[t * 4 + lane] = w; tkp[t * 4 + lane] = lp; }
        }
    }
    __syncthreads();
    if (tid < 32) { const int n = (int)F.MISC[32 + tid]; int base = 0; if (n > 0) base = (int)__hip_atomic_fetch_add(F.ctl + CW_CNT + 4096 * rep + 64 * tid, (unsigned)n, RLX_AGENT); F.MISC[64 + tid] = (unsigned)base; }
    VM_WAIT(); __syncthreads();
    for (int i = tid; i < tpw * 4; i += NWAVES * 64) { const int t = t0 + (i >> 2), e = tke[t * 4 + (i & 3)], p = tkp[t * 4 + (i & 3)] + (int)F.MISC[64 + e]; tkp[t * 4 + (i & 3)] = p; lst[(size_t)e * T + p] = t; }
}
__device__ __forceinline__ void moe_tables(Frame& F) {
    if (F.tid < 32) F.MISC[192 + F.tid] = __hip_atomic_load(F.ctl + CW_CNT + 64 * F.tid, RLX_AGENT);
    __syncthreads();
    if (F.tid == 0) { unsigned s = 0; for (int e = 0; e < 32; ++e) { F.MISC[128 + e] = s; s += (F.MISC[192 + e] + 255u) >> 8; } F.MISC[160] = s; }
    __syncthreads();
}
__device__ __forceinline__ void p10_combine(Frame& F) {
    const int gw = F.vcu * NWAVES + F.wave, NGW = F.G * NWAVES, lane = F.lane;
    const float* x1 = WSP(float, WS_X1); const float* mod = WSP(float, WS_MOD); const bf16_t* y = WSP(bf16_t, WS_Y);
    const int* tke = WSP(int, WS_TKE); const float* tkw = WSP(float, WS_TKW); const int* tkp = WSP(int, WS_TKP);
    constexpr int R = 2;
    for (int m0 = gw; m0 < T; m0 += R * NGW) {
        u32x4 y0[R][4], y1[R][4]; float w[R][4]; f32x4 xv[R][4];
#pragma unroll
        for (int r = 0; r < R; ++r) { const int m = (m0 + r * NGW < T) ? m0 + r * NGW : m0;
            const i32x4q e4 = *(const i32x4q*)(tke + m * 4), p4 = *(const i32x4q*)(tkp + m * 4); const f32x4 w4 = *(const f32x4*)(tkw + m * 4);
#pragma unroll
            for (int k = 0; k < 4; ++k) { const size_t row = (size_t)F.MISC[128 + e4[k]] * 256 + p4[k]; w[r][k] = w4[k];
                y0[r][k] = *(const u32x4*)(y + row * DM + 8 * lane); y1[r][k] = *(const u32x4*)(y + row * DM + 512 + 8 * lane); }
#pragma unroll
            for (int q = 0; q < 4; ++q) xv[r][q] = *(const f32x4*)(x1 + (size_t)m * DM + (q >> 1) * 512 + 8 * lane + 4 * (q & 1)); }
#pragma unroll
        for (int r = 0; r < R; ++r) { const int m = m0 + r * NGW; if (m >= T) continue;
            float a[16];
#pragma unroll
            for (int i = 0; i < 16; ++i) a[i] = 0.f;
#pragma unroll
            for (int k = 0; k < 4; ++k)
#pragma unroll
                for (int i = 0; i < 4; ++i) { a[2 * i] += w[r][k] * bflo(y0[r][k][i]); a[2 * i + 1] += w[r][k] * bfhi(y0[r][k][i]); a[8 + 2 * i] += w[r][k] * bflo(y1[r][k][i]); a[8 + 2 * i + 1] += w[r][k] * bfhi(y1[r][k][i]); }
            const float* mb = mod + (size_t)(m / SEQ) * 6144 + 5120; float ss = 0.f; f32x4 v[4];
#pragma unroll
            for (int q = 0; q < 4; ++q) { const int col = (q >> 1) * 512 + 8 * lane + 4 * (q & 1); const f32x4 gt = *(const f32x4*)(mb + col);
#pragma unroll
                for (int i = 0; i < 4; ++i) { v[q][i] = xv[r][q][i] + gt[i] * a[(q >> 1) * 8 + 4 * (q & 1) + i]; ss += v[q][i] * v[q][i]; } }
            const float rstd = __builtin_amdgcn_rsqf(wave_sum(ss) * (1.f / DM) + EPS);
#pragma unroll
            for (int q = 0; q < 4; ++q) { const int col = (q >> 1) * 512 + 8 * lane + 4 * (q & 1); const f32x4 fg = *(const f32x4*)(F.in[IN_FG] + col);
                *(f32x4*)(F.out + (size_t)m * DM + col) = v[q] * rstd * fg; } }
    }
}
__device__ __forceinline__ void dbg_final(Frame& F, const float* src) {
    const int gw = F.vcu * NWAVES + F.wave, NGW = F.G * NWAVES;
    for (int m = gw; m < T; m += NGW) {
        const f32x4* xr = (const f32x4*)(src + (size_t)m * DM) + F.lane; f32x4 v[4]; float s = 0.f;
#pragma unroll
        for (int j = 0; j < 4; ++j) { v[j] = xr[64 * j]; s += (v[j][0] * v[j][0] + v[j][1] * v[j][1]) + (v[j][2] * v[j][2] + v[j][3] * v[j][3]); }
        const float rstd = __builtin_amdgcn_rsqf(wave_sum(s) * (1.f / DM) + EPS);
#pragma unroll
        for (int j = 0; j < 4; ++j) { const int col = 4 * (F.lane + 64 * j); *(f32x4*)(F.out + (size_t)m * DM + col) = v[j] * rstd * *(const f32x4*)(F.in[IN_FG] + col); }
    }
}


__device__ __forceinline__ void dbg_dump_bf16(Frame& F, const bf16_t* src, int ld, int c0, int n) {
    for (size_t i = (size_t)blockIdx.x * NWAVES * 64 + F.tid; i < (size_t)T * n; i += (size_t)F.G * NWAVES * 64) { const size_t t = i / n; const int c = (int)(i % n); F.out[t * DM + c0 + c] = bf2f(src[t * ld + c]); }
}
#define DBG_DUMP(k, ...) do { if (DBG_STAGE == (k)) { xcd_barrier(bar); __VA_ARGS__; return; } } while (0)
#ifndef DBG_STAGE
#define DBG_STAGE (-1)
#endif

constexpr int N_PHASES = 13;
struct Args { const float* in[N_IN]; float* out; unsigned char* ws; int ph_lo, ph_hi; };
__global__ void __launch_bounds__(NWAVES * 64, 2) fwd_kernel(Args args) {
    extern __shared__ __attribute__((aligned(16))) unsigned char lds[];
    Frame F;
    F.lds = (LAS unsigned char*)lds; F.MISC = (volatile LAS unsigned*)(F.lds + MISC_OFF);
    F.tid = threadIdx.x; F.lane = F.tid & 63; F.wave = __builtin_amdgcn_readfirstlane(F.tid >> 6);
    F.G = gridDim.x; { const int bx = blockIdx.x; F.vcu = (F.G % 8 == 0) ? (bx % 8) * (F.G / 8) + bx / 8 : bx; }
    F.ws = args.ws; F.ctl = (unsigned*)(args.ws + WS_CTL); F.out = args.out;
#pragma unroll
    for (int i = 0; i < N_IN; ++i) F.in[i] = args.in[i];
    for (int u = F.tid; u < (LDS_BYTES - MISC_OFF) / 4; u += NWAVES * 64) ((LAS unsigned*)(F.lds + MISC_OFF))[u] = 0u;
    __syncthreads();
    XcdBarrier bar; bar.bar = F.ctl + CW_BAR; bar.x = 0; bar.st = nullptr;
    if (!N_LAUNCH_PER_PHASE) bar = xcd_barrier_post(F.ctl + CW_BAR, F.MISC + 8);
    const int lo = args.ph_lo, hi = args.ph_hi;
#ifndef REP_PHASE
#define REP_PHASE (-1)
#endif
#define NREP(k) ((REP_PHASE == (k)) ? 2 : 1)
#define REPLOOP(k) _Pragma("unroll") for (int rep = 0; rep < NREP(k); ++rep)
#ifndef PH_MASK
#define PH_MASK 0xFFFFu
#endif
#define IN(k) ((((PH_MASK) >> (k)) & 1u) && lo <= (k) && (k) < hi)
#ifndef TPROBE
#define TPROBE (-2)
#endif
    unsigned long long tp0 = (TPROBE == 0) ? __builtin_amdgcn_s_memrealtime() : 0ull, tpd = 0ull;
#define SEAM(k) do { if (IN(k) && IN((k) + 1)) xcd_barrier(bar); if (TPROBE == (k)) tpd = __builtin_amdgcn_s_memrealtime() - tp0; if (TPROBE == (k) + 1) tp0 = __builtin_amdgcn_s_memrealtime(); } while (0)

#if defined(DBG_BASE)
    dbg_final(F, F.in[IN_X]); return;
#endif
    if (IN(0)) REPLOOP(0) { p0_mod(F); __syncthreads(); p0_weights(F); __syncthreads(); }
    SEAM(0);
    if (IN(1)) REPLOOP(1) norm_rows(F, F.in[IN_X], F.in[IN_N1G], 0, 1024, WSP(bf16_t, WS_H));
    SEAM(1);
    if (IN(2)) REPLOOP(2) {
        pg::Gemm g{WSP(bf16_t, WS_H), WSP(bf16_t, WS_WIN), DM * 2, DM * 2, nullptr}; pg::StaticOrder S; S.init(T, NPROJ, F.G, (int)blockIdx.x);
        EpiProj E{WSP(bf16_t, WS_PROJ)};
        pg::gemm_phase<EpiProj, pg::StaticOrder, false, true>(F.lds, g, S, E);
    }
    DBG_DUMP(2, dbg_dump_bf16(F, WSP(bf16_t, WS_PROJ), NPROJ, 0, 1024));
    SEAM(2);
    if (IN(3)) REPLOOP(3) p3a_rows(F);
    SEAM(3);
    if (IN(4)) REPLOOP(4) {
#ifndef NO_QG
        { pg::Gemm g{WSP(bf16_t, WS_PROJ) + C_QLAT, WSP(bf16_t, WS_WQ), NPROJ * 2, QLORA * 2, nullptr}; pg::StaticOrder S; S.init(T, 768, F.G, (int)blockIdx.x);
          EpiQ E{WSP(bf16_t, WS_Q), WSP(float, WS_RSQ), WSP(float, WS_CS), 0.10206207261596575f * 1.4426950408889634f};
          pg::gemm_phase<EpiQ, pg::StaticOrder, false, true>(F.lds, g, S, E); }
#endif
#ifndef NO_KVG
        { pg::Gemm g{WSP(bf16_t, WS_PROJ) + C_KVLAT, WSP(bf16_t, WS_WKV), NPROJ * 2, KVLORA * 2, nullptr}; pg::StaticOrder S; S.init(T, 1024, F.G, (int)(F.G - 1 - blockIdx.x));
          EpiKV E{WSP(bf16_t, WS_K), WSP(bf16_t, WS_V), WSP(float, WS_RSKV)};
          pg::gemm_phase<EpiKV, pg::StaticOrder, false, true>(F.lds, g, S, E); }
#endif
    }
    DBG_DUMP(4, dbg_dump_bf16(F, WSP(bf16_t, WS_Q), 768, 0, 768); dbg_dump_bf16(F, WSP(bf16_t, WS_K), 768, 768, 256));
    SEAM(4);
    unsigned long long g1acc = 0ull;
    if (IN(5)) REPLOOP(5) { for (int u = blockIdx.x; u < BATCH * GH * NCH / 4; u += F.G) g1_unit(F, u, g1acc); }
    if (G1PROBE >= 0) tpd = g1acc;
    SEAM(5);
    if (IN(6)) REPLOOP(6) {
#ifndef NO_G2
        for (;;) {
            if (F.tid == 0) F.MISC[16] = __hip_atomic_fetch_add(F.ctl + CW_Q + 128 * rep, 1u, RLX_AGENT);
            __syncthreads();
            const int item = (int)F.MISC[16];
            __syncthreads();
            if (item >= 32) break;
            g2_item(F, item);
        }
#endif
        for (;;) {
            if (F.tid == 0) F.MISC[16] = __hip_atomic_fetch_add(F.ctl + CW_Q + 256, 1u, RLX_AGENT);
            __syncthreads();
            const int item = (int)F.MISC[16];
            __syncthreads();
            if (item >= MOE_CONV_ITEMS) break;
            moe_conv_item(F, item);
        }
#ifndef NO_ATT
        for (;;) {
            if (F.tid == 0) F.MISC[16] = __hip_atomic_fetch_add(F.ctl + CW_Q + 64 + 128 * rep, 1u, RLX_AGENT);
            __syncthreads();
            const int item = (int)F.MISC[16];
            __syncthreads();
            if (item >= BATCH * NH * 16) break;
            const int qb = 15 - (item >> 6), bh = item & 63; attn_unit(F, bh >> 3, bh & 7, qb);
        }
#endif
    }
    DBG_DUMP(6, dbg_dump_bf16(F, WSP(bf16_t, DBG_SUB ? WS_OG : WS_OA), 512, 0, 512); dbg_dump_bf16(F, WSP(bf16_t, DBG_SUB ? WS_OG : WS_OA), 512, 512, 512));
    SEAM(6);
    if (IN(7)) REPLOOP(7) p4b_rows(F);
    SEAM(7);
    if (IN(8)) REPLOOP(8) {
        pg::Gemm g{WSP(bf16_t, WS_H), WSP(bf16_t, WS_WO), DM * 2, DM * 2, nullptr}; pg::StaticOrder S; S.init(T, DM, F.G, (int)blockIdx.x);
        EpiX1 E{F.in[IN_X], WSP(float, WS_MOD), WSP(float, WS_X1)};
        pg::gemm_phase<EpiX1, pg::StaticOrder, false, true>(F.lds, g, S, E);
    }
#if defined(DBG_STOP_X1)
    xcd_barrier(bar); dbg_final(F, WSP(float, WS_X1)); return;
#endif
    SEAM(8);
    if (IN(9)) REPLOOP(9) { p6_router(F, rep); __syncthreads(); }
    SEAM(9);
    if (IN(10)) REPLOOP(10) {
        moe_tables(F);
        pg::Gemm g{WSP(unsigned char, WS_H), WSP(unsigned char, WS_WGU), DM, DM, WSP(int, WS_LIST)};
        pg::MoeOrder S{(const LAS int*)(F.lds + MISC_OFF) + 128, (const LAS int*)(F.lds + MISC_OFF) + 192, 8, 2048, F.G, (int)blockIdx.x, 0};
        EpiGU E{WSP(unsigned char, WS_ACT), F.in[IN_BGU]};
        pg::gemm_phase<EpiGU, pg::MoeOrder, true, true, true>(F.lds, g, S, E);
    }
    SEAM(10);
    if (IN(11)) REPLOOP(11) {
        moe_tables(F);
        pg::Gemm g{WSP(unsigned char, WS_ACT), WSP(unsigned char, WS_WDN), DE, DE, nullptr};
        pg::MoeOrder S{(const LAS int*)(F.lds + MISC_OFF) + 128, (const LAS int*)(F.lds + MISC_OFF) + 192, 4, 1024, F.G, (int)blockIdx.x, 1};
        EpiDN E{WSP(bf16_t, WS_Y), F.in[IN_BDN]};
        pg::gemm_phase<EpiDN, pg::MoeOrder, false, true, true>(F.lds, g, S, E);
    }
    SEAM(11);
    if (IN(12)) REPLOOP(12) { moe_tables(F); p10_combine(F); }
    if (TPROBE >= 0 || G1PROBE >= 0) { if (TPROBE == 12) { VM_WAIT(); tpd = __builtin_amdgcn_s_memrealtime() - tp0; }
        if (blockIdx.x == 0) { const unsigned long long t_ = __builtin_amdgcn_s_memrealtime(); while (__builtin_amdgcn_s_memrealtime() - t_ < 10ull * tpd) __builtin_amdgcn_s_sleep(8); } }
#undef IN
#undef SEAM
}

extern "C" void kernel_launch(void* const* d_in, const int* in_sizes, int n_in, void* d_out, int out_size, void* d_ws, size_t ws_size, hipStream_t stream) {
    static int grid = 0;
    if (grid == 0) {
        if (n_in != N_IN || out_size != T * DM || ws_size < WS_END) { fprintf(stderr, "kernel_launch: unexpected shapes (n_in %d, out %d, ws %zu)\n", n_in, out_size, ws_size); grid = -1; return; }
        int dev = 0, cus = 0;
        if (hipGetDevice(&dev) != hipSuccess || hipDeviceGetAttribute(&cus, hipDeviceAttributeMultiprocessorCount, dev) != hipSuccess) { grid = -1; return; }
        if (hipFuncSetAttribute((const void*)fwd_kernel, hipFuncAttributeMaxDynamicSharedMemorySize, LDS_BYTES) != hipSuccess) { grid = -1; return; }
        int per_cu = 0;
        if (hipOccupancyMaxActiveBlocksPerMultiprocessor(&per_cu, (const void*)fwd_kernel, NWAVES * 64, LDS_BYTES) != hipSuccess || per_cu < 1) fprintf(stderr, "kernel_launch: occupancy query says %d\n", per_cu);
        (void)hipGetLastError();
        grid = cus;
        while (grid > 8 && (T % grid) != 0) grid -= 8;
    }
    if (grid < 0) return;
    (void)hipMemsetAsync((char*)d_ws + WS_CTL, 0, CTL_BYTES, stream);
    Args a{};
    for (int i = 0; i < N_IN; ++i) a.in[i] = (const float*)d_in[i];
    a.out = (float*)d_out; a.ws = (unsigned char*)d_ws;
#if N_LAUNCH_PER_PHASE
    for (int p = 0; p < N_PHASES; ++p) { a.ph_lo = p; a.ph_hi = p + 1; hipLaunchKernelGGL(fwd_kernel, dim3(grid), dim3(NWAVES * 64), LDS_BYTES, stream, a); }
#else
    a.ph_lo = 0; a.ph_hi = N_PHASES;
    hipLaunchKernelGGL(fwd_kernel, dim3(grid), dim3(NWAVES * 64), LDS_BYTES, stream, a);
#endif
}
```

```cpp
#include <hip/hip_runtime.h>
#include <cstdio>
#include <cstdint>


#define DBG_SUB 0
#ifndef N_LAUNCH_PER_PHASE
#define N_LAUNCH_PER_PHASE 0
#endif

#define GAS __attribute__((address_space(1)))
#define LAS __attribute__((address_space(3)))
typedef unsigned short bf16_t;
typedef short bf16x8 __attribute__((ext_vector_type(8)));
typedef short s16x4 __attribute__((ext_vector_type(4)));
typedef float f32x4 __attribute__((ext_vector_type(4)));
typedef float f32x2 __attribute__((ext_vector_type(2)));
typedef float f32x16 __attribute__((ext_vector_type(16)));
typedef unsigned u32x4 __attribute__((ext_vector_type(4)));
typedef unsigned u32x2 __attribute__((ext_vector_type(2)));
typedef __bf16 bf16x2_t __attribute__((ext_vector_type(2)));
typedef int i32x4q __attribute__((ext_vector_type(4)));

constexpr int BATCH = 8, SEQ = 4096, DM = 1024, T = BATCH * SEQ;
constexpr int NH = 8, QK = 96, NOPE = 64, ROPE = 32, VD = 64, QLORA = 384, KVLORA = 256;
constexpr int GH = 8, GDK = 64, GDV = 64;
constexpr int IN_DIM = 2736, NPROJ = 2816;
constexpr int C_QLAT = 0, C_KVLAT = 384, C_KPE = 640, C_GQ = 672, C_GK = 1184, C_GV = 1696, C_GZ = 2208, C_GA = 2720, C_GB = 2728;
constexpr int NE = 32, TOPK = 4, DE = 1024;
constexpr float EPS = 1e-6f;
constexpr float W8 = 32.0f;
constexpr int GC = 32, NCH = SEQ / GC;
constexpr int MAXROWS = T * TOPK + NE * 256;

constexpr size_t MiB = 1u << 20;
constexpr size_t WS_CTL = 0, CTL_BYTES = 1 * MiB;
constexpr size_t WS_MOD = 1 * MiB;
constexpr size_t WS_RSQ = 2 * MiB;
constexpr size_t WS_RSKV = WS_RSQ + 128 * 1024;
constexpr size_t WS_CS = 3 * MiB;
constexpr size_t WS_TKE = 7 * MiB;
constexpr size_t WS_TKW = WS_TKE + 512 * 1024;
constexpr size_t WS_TKP = WS_TKW + 512 * 1024;
constexpr size_t WS_LIST = 9 * MiB;
constexpr size_t WS_RWT = 13 * MiB;
constexpr size_t WS_WIN = 16 * MiB;
constexpr size_t WS_WQ = WS_WIN + (size_t)NPROJ * DM * 2;
constexpr size_t WS_WKV = WS_WQ + (size_t)768 * 384 * 2;
constexpr size_t WS_WO = WS_WKV + (size_t)1024 * 256 * 2;
constexpr size_t WS_WGU = 32 * MiB;
constexpr size_t WS_WDN = WS_WGU + (size_t)NE * 2048 * 1024 * 2;
constexpr size_t WS_H = 224 * MiB;
constexpr size_t WS_X1 = 288 * MiB;
constexpr size_t WS_PROJ = 416 * MiB;
constexpr size_t WS_Q = 592 * MiB;
constexpr size_t WS_K = 640 * MiB;
constexpr size_t WS_V = 688 * MiB;
constexpr size_t WS_OA = 720 * MiB;
constexpr size_t WS_OG = 752 * MiB;
constexpr size_t WS_GD = 784 * MiB;
constexpr size_t WS_ACT = 416 * MiB;
constexpr size_t WS_Y = 688 * MiB;
constexpr size_t WS_END = 976 * MiB;
static_assert(WS_WO + (size_t)1024 * 1024 * 2 <= WS_WGU && WS_WDN + (size_t)NE * 1024 * 1024 * 2 <= WS_H, "weights");
static_assert(WS_ACT + (size_t)MAXROWS * 1024 * 2 <= WS_Y && WS_Y + (size_t)MAXROWS * 1024 * 2 <= WS_END, "moe rows");
static_assert(WS_GD + (size_t)BATCH * GH * NCH * 24576 <= WS_END, "gdn");
constexpr int CW_BAR = 4096;
constexpr int CW_Q = 8192;
constexpr int CW_CNT = 12288;

constexpr int RING_BYTES = 131072;
constexpr int MISC_OFF = RING_BYTES;
constexpr int LDS_BYTES = 147456;

#define LDS_WAIT() asm volatile("s_waitcnt lgkmcnt(0)" ::: "memory")
#define LBAR() asm volatile("s_waitcnt lgkmcnt(0)\n\ts_barrier" ::: "memory")
#define VM_WAIT() asm volatile("s_waitcnt vmcnt(0)" ::: "memory")
#define RLX_AGENT __ATOMIC_RELAXED, __HIP_MEMORY_SCOPE_AGENT

__device__ __forceinline__ unsigned cvtpk(float lo, float hi) { f32x2 v = {lo, hi}; bf16x2_t b = __builtin_convertvector(v, bf16x2_t); return __builtin_bit_cast(unsigned, b); }
__device__ __forceinline__ bf16_t f2bf(float f) { return (bf16_t)(cvtpk(f, 0.f) & 0xffffu); }
__device__ __forceinline__ float bf2f(unsigned short h) { return __uint_as_float((unsigned)h << 16); }
__device__ __forceinline__ float bflo(unsigned w) { return __uint_as_float(w << 16); }
__device__ __forceinline__ float bfhi(unsigned w) { return __uint_as_float(w & 0xffff0000u); }
__device__ __forceinline__ float wave_sum(float v) {
#pragma unroll
    for (int o = 1; o < 64; o <<= 1) v += __shfl_xor(v, o);
    return v;
}
__device__ __forceinline__ unsigned pk4_fp8(float a, float b, float c, float d) { int w = 0; w = __builtin_amdgcn_cvt_pk_fp8_f32(a, b, w, false); w = __builtin_amdgcn_cvt_pk_fp8_f32(c, d, w, true); return (unsigned)w; }
__device__ __forceinline__ float siluf(float x) { return x / (1.f + __expf(-x)); }

#define XB_TMO      128
#define XB_XCNT(j)  (256  + 64 * (j))
#define XB_XSUB(j)  (1280 + 64 * (j))
#define XB_XGEN(j)  (2304 + 64 * (j))
#define XB_TOP      3328
#define XB_TOPGEN   3392
#define XCD_BAR_WORDS 3456
#define XB_SPIN_CAP (1u << 18)
__device__ __forceinline__ unsigned xb_ld(unsigned* p)              { return __hip_atomic_load(p, __ATOMIC_RELAXED, __HIP_MEMORY_SCOPE_AGENT); }
__device__ __forceinline__ unsigned xb_add(unsigned* p, unsigned v) { return __hip_atomic_fetch_add(p, v, __ATOMIC_RELAXED, __HIP_MEMORY_SCOPE_AGENT); }
__device__ __forceinline__ unsigned xb_xcc_id() { return (unsigned)__builtin_amdgcn_s_getreg((3 << 11) | 20) & 0xFu; }
#define XB_SPIN(cond, bar) do { unsigned _sp = 0; while (cond) { __builtin_amdgcn_s_sleep(1); \
    if ((++_sp & 255u) == 0u) { if (xb_ld(&(bar)[XB_TMO])) break; if (_sp > XB_SPIN_CAP) { atomicAdd(&(bar)[XB_TMO], 1u); break; } } } } while (0)
struct XcdBarrier { unsigned* bar; unsigned x; volatile LAS unsigned* st; };
__device__ __forceinline__ XcdBarrier xcd_barrier_post(unsigned* bar, volatile LAS unsigned* st) {
    XcdBarrier b; b.bar = bar; b.x = xb_xcc_id(); b.st = st;
    if (threadIdx.x == 0) (void)xb_add(&bar[XB_XCNT(b.x)], 1u);
    return b;
}
__device__ __forceinline__ void xcd_barrier_complete(unsigned* bar, unsigned x, unsigned& nloc, unsigned& nx) {
    const unsigned G = gridDim.x * gridDim.y * gridDim.z;
    unsigned sum, cnt, mine, sp = 0u;
    for (;;) {
        sum = 0u; cnt = 0u; mine = 0u;
#pragma unroll
        for (unsigned j = 0; j < 16; ++j) { const unsigned c = xb_ld(&bar[XB_XCNT(j)]); sum += c; cnt += (c > 0u) ? 1u : 0u; mine = (j == x) ? c : mine; }
        if (sum == G) break;
        __builtin_amdgcn_s_sleep(1);
        if ((++sp & 255u) == 0u) { if (xb_ld(&bar[XB_TMO])) break; if (sp > XB_SPIN_CAP) { atomicAdd(&bar[XB_TMO], 1u); break; } }
    }
    nloc = mine > 0u ? mine : 1u; nx = cnt > 0u ? cnt : 1u;
}
__device__ __forceinline__ void xcd_barrier(const XcdBarrier& b) {
    asm volatile("s_waitcnt vmcnt(0)" ::: "memory");
    __syncthreads();
    if (threadIdx.x == 0) {
        unsigned* bar = b.bar;
        __builtin_amdgcn_s_waitcnt(0);
        unsigned nloc = b.st[0], nx = b.st[1];
        if (nloc == 0u) { xcd_barrier_complete(bar, b.x, nloc, nx); b.st[0] = nloc; b.st[1] = nx; }
        const unsigned old = xb_add(&bar[XB_XSUB(b.x)], 1u);
        const unsigned gen = old / nloc;
        if (old + 1u == (gen + 1u) * nloc) {
            __builtin_amdgcn_fence(__ATOMIC_RELEASE, "agent");
            asm volatile("s_waitcnt vmcnt(0)" ::: "memory");
            const unsigned og = xb_add(&bar[XB_TOP], 1u);
            const unsigned tg = og / nx;
            if (og + 1u == (tg + 1u) * nx) xb_add(&bar[XB_TOPGEN], 1u);
            else XB_SPIN(xb_ld(&bar[XB_TOPGEN]) == tg, bar);
            __builtin_amdgcn_fence(__ATOMIC_ACQUIRE, "agent");
            xb_add(&bar[XB_XGEN(b.x)], 1u);
            asm volatile("s_waitcnt vmcnt(0)" ::: "memory");
        } else {
            XB_SPIN(xb_ld(&bar[XB_XGEN(b.x)]) == gen, bar);
            __builtin_amdgcn_fence(__ATOMIC_ACQUIRE, "agent");
            asm volatile("s_waitcnt vmcnt(0)" ::: "memory");
        }
    }
    __syncthreads();
}

namespace pg {
constexpr int BM = 256, BK = 64, HALF = 128, HTB = HALF * BK * 2, STAGE_BYTES = 8 * HTB, NXCD = 8, WGM = 8;
__host__ __device__ __forceinline__ int lds_byte(int r, int c) { const int st = (r >> 4) * 2 + (c >> 5), rr = r & 15, cc = c & 31, ob = rr * 64 + cc * 2; return st * 1024 + (ob ^ (((ob >> 9) & 1) << 5)); }
__host__ __device__ __forceinline__ void stage_rc(int b, int& R, int& C) { const int st = b / 1024, sb = b % 1024, swz = sb ^ (((sb >> 9) & 1) << 5); R = (st >> 1) * 16 + swz / 64; C = (st & 1) * 32 + (swz % 64) / 2; }
__host__ __device__ __forceinline__ int perm32(int rho) { const int n = rho >> 4, i = rho & 15; return 8 * (i >> 2) + 4 * n + (i & 3); }

struct Unit { int pm, pn, arow, brow, nvalid, e; };
struct Gemm { const void* A; const void* Bt; int lda, K; const int* list; unsigned long long* tacc = nullptr; };

struct StaticOrder {
    int nM, nN, nwg, G, c;
    __device__ __forceinline__ void init(int M, int N, int G_, int c_) { nM = M / BM; nN = N / BM; nwg = nM * nN; G = G_; c = c_; }
    __device__ __forceinline__ bool next(int i, Unit& u) const {
        const long L = (long)i * G + c; if (L >= nwg) return false;
        int wgid = (int)L; { const int q = nwg / NXCD, r = nwg % NXCD, xcd = wgid % NXCD, off = wgid / NXCD; wgid = (xcd < r ? xcd * (q + 1) : r * (q + 1) + (xcd - r) * q) + off; }
        const int nig = WGM * nN, gid = wgid / nig, fm = gid * WGM, gsz = (nM - fm) < WGM ? (nM - fm) : WGM;
        u.pm = fm + ((wgid % nig) % gsz); u.pn = (wgid % nig) / gsz; u.arow = u.pm * BM; u.brow = u.pn * BM; u.nvalid = BM; u.e = 0; return true;
    }
};
struct MoeOrder {
    const LAS int* pre;
    const LAS int* cnt;
    int NT, Nrows, G, c, contig;
    __device__ __forceinline__ bool next(int i, Unit& u) const {
        const int xcd = c & 7, j = c >> 3, q = i * (G >> 3) + j, mq = q / NT, nt = q - mq * NT, mt = mq * 8 + xcd;
        if (mt >= pre[32]) return false;
        int e = 0;
#pragma unroll 1
        while (pre[e + 1] <= mt) ++e;
        const int row0 = (mt - pre[e]) * BM;
        u.pm = mt; u.pn = nt; u.e = e; u.nvalid = cnt[e] - row0; u.arow = contig ? mt * BM : row0; u.brow = e * Nrows + nt * BM; return true;
    }
};

__device__ __forceinline__ void glds16s(const void* sbase, unsigned voff, unsigned ldsdst) { unsigned keep;
    asm volatile("s_mov_b32 %0, m0\n\ts_mov_b32 m0, %3\n\ts_nop 0\n\tglobal_load_lds_dwordx4 %1, %2\n\ts_mov_b32 m0, %0" : "=&s"(keep) : "v"(voff), "s"(sbase), "s"(ldsdst) : "memory"); }
typedef int i32x8 __attribute__((ext_vector_type(8)));
typedef int i32x4 __attribute__((ext_vector_type(4)));
template <class Epi, class Sched, bool GATHER, bool ALIGN_EPI, bool FP8 = false>
__device__ __forceinline__ void gemm_phase(LAS unsigned char* lds, const Gemm g, const Sched& S, const Epi& E) {
    const int tid = threadIdx.x, wid = __builtin_amdgcn_readfirstlane(tid >> 6), lane = tid & 63, wr = wid >> 2, wc = wid & 3, fr = lane & 15, fq = lane >> 4;
    const int K = g.K, nt = K / (BK * 2), lda = g.lda;
    unsigned voffB[2], voffA[2];
#pragma unroll
    for (int i = 0; i < 2; ++i) { int R, C; stage_rc(tid * 16 + i * 8192, R, C); const int Rb = Epi::PERM ? ((R & ~31) + perm32(R & 31)) : R; voffB[i] = (unsigned)(Rb * K + C * 2); voffA[i] = (unsigned)(R * lda + C * 2); }
    const size_t kstep = (size_t)(BK * 2);
    const size_t hstep = (size_t)HALF * K;
    const unsigned ldsw = (unsigned)wid * 1024u;
    const unsigned ldsa = (unsigned)__builtin_amdgcn_readfirstlane((int)((unsigned)(uintptr_t)lds + ldsw));
    const int aoff = lds_byte(wr * 64 + fr, fq * 8), boff = lds_byte(wc * 32 + fr, fq * 8);
#define PG_SA(b, h) (((b) * 2 + (h)) * HTB)
#define PG_SB(b, h) ((4 + (b) * 2 + (h)) * HTB)
#define PG_STAGE(bufoff, gbase, voff) do { _Pragma("unroll") for (int _i = 0; _i < 2; ++_i) \
        glds16s((const void*)(gbase), (voff)[_i], ldsa + (unsigned)(bufoff) + (unsigned)(_i * 8192)); } while (0)
#define PG_LDA(dst, b, h) do { _Pragma("unroll") for (int m = 0; m < 4; ++m) { if constexpr (FP8) { dst##8[m] = __builtin_shufflevector(*(const LAS i32x4*)(lds + PG_SA(b, h) + aoff + m * 2048), *(const LAS i32x4*)(lds + PG_SA(b, h) + aoff + m * 2048 + 1024), 0, 1, 2, 3, 4, 5, 6, 7); } \
        else { _Pragma("unroll") for (int k = 0; k < 2; ++k) dst[m][k] = *(const LAS bf16x8*)(lds + PG_SA(b, h) + aoff + m * 2048 + k * 1024); } } } while (0)
#define PG_LDB(dst, b, h) do { _Pragma("unroll") for (int n = 0; n < 2; ++n) { if constexpr (FP8) { dst##8[n] = __builtin_shufflevector(*(const LAS i32x4*)(lds + PG_SB(b, h) + boff + n * 2048), *(const LAS i32x4*)(lds + PG_SB(b, h) + boff + n * 2048 + 1024), 0, 1, 2, 3, 4, 5, 6, 7); } \
        else { _Pragma("unroll") for (int k = 0; k < 2; ++k) dst[n][k] = *(const LAS bf16x8*)(lds + PG_SB(b, h) + boff + n * 2048 + k * 1024); } } } while (0)
#define PG_MMA(ai, bj, At, Bt) do { __builtin_amdgcn_s_setprio(1); if constexpr (FP8) { _Pragma("unroll") for (int m = 0; m < 4; ++m) _Pragma("unroll") for (int n = 0; n < 2; ++n) \
        asm volatile("v_mfma_scale_f32_16x16x128_f8f6f4 %0, %1, %2, %0, %3, %3 op_sel_hi:[0,0,0]" : "+v"(acc[ai][bj][m][n]) : "v"(Bt##8[n]), "v"(At##8[m]), "v"(scl1)); } \
        else { _Pragma("unroll") for (int m = 0; m < 4; ++m) _Pragma("unroll") for (int n = 0; n < 2; ++n) _Pragma("unroll") for (int k = 0; k < 2; ++k) \
        acc[ai][bj][m][n] = __builtin_amdgcn_mfma_f32_16x16x32_bf16(Bt[n][k], At[m][k], acc[ai][bj][m][n], 0, 0, 0); } __builtin_amdgcn_s_setprio(0); } while (0)
#define PG_WAIT_V(n) asm volatile("s_waitcnt vmcnt(" #n ")" ::: "memory")
#define PG_WAIT_L(n) asm volatile("s_waitcnt lgkmcnt(" #n ")" ::: "memory")
#define PG_BAR __builtin_amdgcn_s_barrier()
#define PG_SCHED __builtin_amdgcn_sched_barrier(0)
#define PG_SETA(v, u) do { _Pragma("unroll") for (int _h = 0; _h < 2; ++_h) _Pragma("unroll") for (int _i = 0; _i < 2; ++_i) { int _R, _C; stage_rc(tid * 16 + _i * 8192, _R, _C); const int _r = _h * HALF + _R; \
        const int _rr = _r < (u).nvalid ? _r : (u).nvalid - 1; const int _tok = g.list[(size_t)(u).e * T + (u).arow + _rr]; v[_h][_i] = (unsigned)(_tok * lda + _C * 2); } } while (0)
#define PG_STA(bufoff, kb, h, NX) do { if constexpr (GATHER) { unsigned _vs[2]; _vs[0] = (NX) ? vN[h][0] : vA[h][0]; _vs[1] = (NX) ? vN[h][1] : vA[h][1]; PG_STAGE(bufoff, (const char*)g.A + (kb), _vs); } \
        else PG_STAGE(bufoff, ((NX) ? nA : cA) + (kb) + (h) * hstepA, voffA); } while (0)
    Unit cur, nxt; int ui = 0;
    if (!S.next(0, cur)) return;
    f32x4 acc[2][2][4][2];
#pragma unroll
    for (int a = 0; a < 2; ++a)
#pragma unroll
        for (int b = 0; b < 2; ++b)
#pragma unroll
            for (int m = 0; m < 4; ++m)
#pragma unroll
                for (int n = 0; n < 2; ++n) acc[a][b][m][n] = (f32x4){0.f, 0.f, 0.f, 0.f};
    const int scl1 = 0x7F7F7F7F;
    bf16x8 At[4][2], B0[2][2], B1[2][2]; i32x8 At8[4], B08[2], B18[2];
    unsigned vN[2][2] = {{0u, 0u}, {0u, 0u}};
    unsigned vA[2][2];
    LAS u32x4* const vnl = (LAS u32x4*)(lds + STAGE_BYTES + 1024) + tid;
    const size_t hstepA = (size_t)HALF * lda;
    if constexpr (GATHER) { PG_SETA(vA, cur); PG_WAIT_V(0); }
    const char* cA = (const char*)g.A + (GATHER ? (size_t)0 : (size_t)cur.arow * lda); const char* nA = cA;
    const char* cB = (const char*)g.Bt + (size_t)cur.brow * K;
    PG_STAGE(PG_SB(0, 0), cB, voffB); PG_STAGE(PG_SB(0, 1), cB + hstep, voffB); PG_STA(PG_SA(0, 0), 0, 0, false); PG_STA(PG_SA(0, 1), 0, 1, false);
    if (wr == 1) PG_BAR;
    PG_WAIT_V(2); PG_BAR;
    PG_STAGE(PG_SB(1, 0), cB + kstep, voffB); PG_STA(PG_SA(1, 0), kstep, 0, false); PG_STAGE(PG_SB(1, 1), cB + hstep + kstep, voffB);
    PG_WAIT_V(6); PG_BAR;
    for (;;) {
        const bool has_next = S.next(ui + 1, nxt);
        if constexpr (GATHER) {
            unsigned vT[2][2];
            if (has_next) { PG_SETA(vT, nxt); PG_WAIT_V(0); }
            else {
#pragma unroll
                for (int h = 0; h < 2; ++h)
#pragma unroll
                    for (int i = 0; i < 2; ++i) vT[h][i] = vA[h][i]; }
            *vnl = (u32x4){vT[0][0], vT[0][1], vT[1][0], vT[1][1]};
        } else nA = has_next ? (const char*)g.A + (size_t)nxt.arow * lda : cA;
        const char* nB = has_next ? (const char*)g.Bt + (size_t)nxt.brow * K : cB;
#pragma unroll 1
        for (int t = 0; t < nt; t += 2) {
            const bool last = (t == nt - 2);
            if constexpr (GATHER) { if (last) { const u32x4 q_ = *vnl; vN[0][0] = q_.x; vN[0][1] = q_.y; vN[1][0] = q_.z; vN[1][1] = q_.w; } else { vN[0][0] = vA[0][0]; vN[0][1] = vA[0][1]; vN[1][0] = vA[1][0]; vN[1][1] = vA[1][1]; } }
            const size_t k1 = (size_t)(t + 1) * kstep, k2 = last ? (size_t)0 : (size_t)(t + 2) * kstep, k3 = k2 + kstep;
            const char* b2 = last ? nB : cB + (size_t)(t + 2) * kstep; const char* b3 = b2 + kstep;
            PG_LDB(B0, 0, 0); PG_LDB(B1, 0, 1); PG_SCHED; PG_LDA(At, 0, 0); PG_STA(PG_SA(1, 1), k1, 1, false);
            PG_WAIT_V(8); PG_WAIT_L(0); PG_BAR; PG_MMA(0, 0, At, B0); PG_MMA(0, 1, At, B1); PG_BAR; PG_SCHED;
            PG_LDA(At, 0, 1); PG_STAGE(PG_SB(0, 0), b2, voffB); PG_STAGE(PG_SB(0, 1), b2 + hstep, voffB); PG_STA(PG_SA(0, 0), k2, 0, last);
            PG_WAIT_V(8); PG_WAIT_L(0); PG_BAR; PG_MMA(1, 0, At, B0); PG_MMA(1, 1, At, B1); PG_BAR; PG_SCHED;
            PG_LDB(B0, 1, 0); PG_LDB(B1, 1, 1); PG_SCHED; PG_LDA(At, 1, 0); PG_STA(PG_SA(0, 1), k2, 1, last);
            PG_WAIT_V(8); PG_WAIT_L(0); PG_BAR; PG_MMA(0, 0, At, B0); PG_MMA(0, 1, At, B1); PG_BAR; PG_SCHED;
            PG_LDA(At, 1, 1); PG_STAGE(PG_SB(1, 0), b3, voffB); PG_STAGE(PG_SB(1, 1), b3 + hstep, voffB); PG_STA(PG_SA(1, 0), k3, 0, last);
            PG_WAIT_V(8); PG_WAIT_L(0); PG_BAR; PG_MMA(1, 0, At, B0); PG_MMA(1, 1, At, B1); PG_BAR; PG_SCHED;
        }
        if constexpr (ALIGN_EPI) { if (wr == 0) PG_BAR; }
        if constexpr (FP8) asm volatile("s_nop 15\n\ts_nop 15" ::: "memory");
#ifdef EPIPROBE
        const unsigned long long te0_ = __builtin_amdgcn_s_memrealtime();
#endif
        E(acc, cur, wr, wc, fr, fq);
#ifdef EPIPROBE
        if (g.tacc) { asm volatile("s_waitcnt vmcnt(0)" ::: "memory"); *g.tacc += __builtin_amdgcn_s_memrealtime() - te0_; }
#endif
        if (!has_next) break;
#pragma unroll
        for (int a = 0; a < 2; ++a)
#pragma unroll
            for (int b = 0; b < 2; ++b)
#pragma unroll
                for (int m = 0; m < 4; ++m)
#pragma unroll
                    for (int n = 0; n < 2; ++n) acc[a][b][m][n] = (f32x4){0.f, 0.f, 0.f, 0.f};
        cur = nxt; cB = nB; cA = nA; ++ui;
        if constexpr (GATHER) { const u32x4 q_ = *vnl; vA[0][0] = q_.x; vA[0][1] = q_.y; vA[1][0] = q_.z; vA[1][1] = q_.w; }
        if constexpr (ALIGN_EPI) { if (wr == 1) PG_BAR; }
    }
    PG_WAIT_V(0);
    if constexpr (!ALIGN_EPI) { if (wr == 0) PG_BAR; }
    PG_BAR;
#undef PG_SA
#undef PG_SB
#undef PG_STAGE
#undef PG_LDA
#undef PG_LDB
#undef PG_MMA
#undef PG_WAIT_V
#undef PG_WAIT_L
#undef PG_BAR
#undef PG_SCHED
#undef PG_SETA
#undef PG_STA
}
}

typedef f32x4 AccT[2][2][4][2];
__device__ __forceinline__ u32x4 pack8(f32x4 a, f32x4 b) { u32x4 w; w.x = cvtpk(a[0], a[1]); w.y = cvtpk(a[2], a[3]); w.z = cvtpk(b[0], b[1]); w.w = cvtpk(b[2], b[3]); return w; }

struct EpiProj {
    static constexpr bool PERM = true; bf16_t* O;
    __device__ __forceinline__ void operator()(const AccT& acc, const pg::Unit& u, int wr, int wc, int fr, int fq) const {
        const int row0 = u.pm * 256 + wr * 64 + fr, col0 = u.pn * 256 + wc * 32 + 8 * fq;
#pragma unroll
        for (int ai = 0; ai < 2; ++ai)
#pragma unroll
            for (int m = 0; m < 4; ++m) { bf16_t* rowp = O + (size_t)(row0 + ai * 128 + m * 16) * NPROJ + col0;
#pragma unroll
                for (int bj = 0; bj < 2; ++bj) *(u32x4*)(rowp + bj * 128) = pack8(acc[ai][bj][m][0], acc[ai][bj][m][1]); }
    }
};
struct EpiQ {
    static constexpr bool PERM = true; bf16_t* O; const float* rstd; const float* cs; float scale;
    __device__ __forceinline__ void operator()(const AccT& acc, const pg::Unit& u, int wr, int wc, int fr, int fq) const {
        const int row0 = u.pm * 256 + wr * 64 + fr;
#pragma unroll
        for (int ai = 0; ai < 2; ++ai)
#pragma unroll
            for (int m = 0; m < 4; ++m) { const int row = row0 + ai * 128 + m * 16; const float rs = rstd[row] * scale;
#pragma unroll
                for (int bj = 0; bj < 2; ++bj) { const int G = 8 * u.pn + 4 * bj + wc;
                    f32x4 v0 = acc[ai][bj][m][0] * rs, v1 = acc[ai][bj][m][1] * rs;
                    if ((G % 3) == 2) {
                        f32x4 p0, p1;
#pragma unroll
                        for (int j = 0; j < 4; ++j) { p0[j] = __shfl_xor(v0[j], 32); p1[j] = __shfl_xor(v1[j], 32); }
                        const float* cr = cs + (size_t)row * 32 + 8 * (fq & 1);
                        const f32x4 c0 = *(const f32x4*)cr, c1 = *(const f32x4*)(cr + 4), s0 = *(const f32x4*)(cr + 16), s1 = *(const f32x4*)(cr + 20);
                        if (fq < 2) { v0 = v0 * c0 - p0 * s0; v1 = v1 * c1 - p1 * s1; } else { v0 = v0 * c0 + p0 * s0; v1 = v1 * c1 + p1 * s1; }
                    }
                    *(u32x4*)(O + (size_t)row * 768 + 32 * G + 8 * fq) = pack8(v0, v1); }
                asm volatile("" ::: "memory"); }
    }
};
struct EpiKV {
    static constexpr bool PERM = true; bf16_t* Ko; bf16_t* Vo; const float* rstd;
    __device__ __forceinline__ void operator()(const AccT& acc, const pg::Unit& u, int wr, int wc, int fr, int fq) const {
        const int row0 = u.pm * 256 + wr * 64 + fr;
#pragma unroll
        for (int ai = 0; ai < 2; ++ai)
#pragma unroll
            for (int m = 0; m < 4; ++m) { const int row = row0 + ai * 128 + m * 16; const float rs = rstd[row];
#pragma unroll
                for (int bj = 0; bj < 2; ++bj) { const int G = 8 * u.pn + 4 * bj + wc, head = G >> 2, sub = G & 3;
                    bf16_t* dst = (sub < 2) ? Ko + (size_t)row * 768 + head * 96 + 32 * sub + 8 * fq : Vo + (size_t)row * 512 + head * 64 + 32 * (sub - 2) + 8 * fq;
                    *(u32x4*)dst = pack8(acc[ai][bj][m][0] * rs, acc[ai][bj][m][1] * rs); } }
    }
};
struct EpiX1 {
    static constexpr bool PERM = false; const float* x; const float* mod; float* O;
    __device__ __forceinline__ void operator()(const AccT& acc, const pg::Unit& u, int wr, int wc, int fr, int fq) const {
        const int row0 = u.pm * 256 + wr * 64 + fr, col0 = u.pn * 256 + wc * 32 + 4 * fq;
        const float* gt = mod + (size_t)(u.pm * 256 / SEQ) * 6144 + 2048 + col0;
        f32x4 gv[2][2];
#pragma unroll
        for (int bj = 0; bj < 2; ++bj)
#pragma unroll
            for (int n = 0; n < 2; ++n) gv[bj][n] = *(const f32x4*)(gt + bj * 128 + n * 16);
#pragma unroll
        for (int ai = 0; ai < 2; ++ai)
#pragma unroll
            for (int m = 0; m < 4; ++m) { const size_t off = (size_t)(row0 + ai * 128 + m * 16) * DM + col0;
#pragma unroll
                for (int bj = 0; bj < 2; ++bj)
#pragma unroll
                    for (int n = 0; n < 2; ++n) { const f32x4 xv = *(const f32x4*)(x + off + bj * 128 + n * 16); *(f32x4*)(O + off + bj * 128 + n * 16) = xv + gv[bj][n] * acc[ai][bj][m][n]; } }
    }
};
struct EpiGU {
    static constexpr bool PERM = true; unsigned char* O; const float* bias;
    __device__ __forceinline__ void operator()(const AccT& acc, const pg::Unit& u, int wr, int wc, int fr, int fq) const {
        const int row0 = u.pm * 256 + wr * 64 + fr, gcol = u.pn * 128 + wc * 32 + 8 * fq;
        const float* bp = bias + (size_t)u.e * 2048 + gcol;
        const f32x4 bg0 = *(const f32x4*)bp, bg1 = *(const f32x4*)(bp + 4), bu0 = *(const f32x4*)(bp + 1024), bu1 = *(const f32x4*)(bp + 1028);
#pragma unroll
        for (int ai = 0; ai < 2; ++ai)
#pragma unroll
            for (int m = 0; m < 4; ++m) {
                f32x4 r[2];
#pragma unroll
                for (int n = 0; n < 2; ++n) { const f32x4 g4 = acc[ai][0][m][n] * (1.0f / W8) + (n ? bg1 : bg0), u4 = acc[ai][1][m][n] * (1.0f / W8) + (n ? bu1 : bu0);
#pragma unroll
                    for (int j = 0; j < 4; ++j) { const float g = fminf(g4[j], 7.0f), up = fminf(fmaxf(u4[j], -7.0f), 7.0f);
                        r[n][j] = (up + 1.0f) * g * __builtin_amdgcn_rcpf(1.0f + __expf(-1.702f * g)); } }
                u32x2 w; w.x = pk4_fp8(r[0][0], r[0][1], r[0][2], r[0][3]); w.y = pk4_fp8(r[1][0], r[1][1], r[1][2], r[1][3]); *(u32x2*)(O + (size_t)(row0 + ai * 128 + m * 16) * DE + gcol) = w; }
    }
};
struct EpiDN {
    static constexpr bool PERM = true; unsigned char* O; const float* bias;
    __device__ __forceinline__ void operator()(const AccT& acc, const pg::Unit& u, int wr, int wc, int fr, int fq) const {
        const int row0 = u.pm * 256 + wr * 64 + fr, col0 = u.pn * 256 + wc * 32 + 8 * fq;
        const float* bp = bias + (size_t)u.e * DM + col0;
        f32x4 bv[2][2];
#pragma unroll
        for (int bj = 0; bj < 2; ++bj) { bv[bj][0] = *(const f32x4*)(bp + bj * 128); bv[bj][1] = *(const f32x4*)(bp + bj * 128 + 4); }
#pragma unroll
        for (int ai = 0; ai < 2; ++ai)
#pragma unroll
            for (int m = 0; m < 4; ++m) { unsigned char* rowp = O + (size_t)(row0 + ai * 128 + m * 16) * DM + col0;
#pragma unroll
                for (int bj = 0; bj < 2; ++bj) { const f32x4 v0 = acc[ai][bj][m][0] * (1.0f / W8) + bv[bj][0], v1 = acc[ai][bj][m][1] * (1.0f / W8) + bv[bj][1];
                    u32x2 w; w.x = pk4_fp8(v0[0], v0[1], v0[2], v0[3]); w.y = pk4_fp8(v1[0], v1[1], v1[2], v1[3]); *(u32x2*)(rowp + bj * 128) = w; } }
    }
};

constexpr int NWAVES = 8;
enum { IN_X = 0, IN_C, IN_POS, IN_ADAW, IN_ADAB, IN_N1G, IN_WIN, IN_QNG, IN_WQB, IN_KVNG, IN_WKVB, IN_MLAOG, IN_CONVW, IN_ALOG, IN_DTB, IN_GDNG, IN_WOUT, IN_N2G, IN_RW, IN_RB, IN_WGU, IN_BGU, IN_WDN, IN_BDN, IN_FG, N_IN };
struct Frame {
    LAS unsigned char* lds; volatile LAS unsigned* MISC; unsigned* ctl; unsigned char* ws;
    int tid, lane, wave, G, vcu;
    const float* in[N_IN]; float* out;
};
#define WSP(T_, off) ((T_*)(F.ws + (off)))

__device__ __forceinline__ void p0_mod(Frame& F) {
    LAS float* cact = (LAS float*)F.lds;
    LAS float* red = (LAS float*)(F.lds + 32768);
    if ((int)blockIdx.x >= 96) return;
    const float* c = F.in[IN_C];
    for (int i = F.tid; i < BATCH * DM; i += NWAVES * 64) cact[i] = siluf(c[i]);
    __syncthreads();
    float* mod = WSP(float, WS_MOD);
    for (int it = blockIdx.x; it < 96; it += F.G) {
        const int j = it * 64 + F.lane; float a[8];
#pragma unroll
        for (int b = 0; b < 8; ++b) a[b] = 0.f;
        const float* w = F.in[IN_ADAW] + j;
#pragma unroll 4
        for (int k = F.wave * 128; k < F.wave * 128 + 128; ++k) { const float wv = w[(size_t)k * 6144];
#pragma unroll
            for (int b = 0; b < 8; ++b) a[b] += cact[b * DM + k] * wv; }
#pragma unroll
        for (int b = 0; b < 8; ++b) red[(F.wave * 8 + b) * 64 + F.lane] = a[b];
        __syncthreads();
        { const int b = F.tid >> 6, col = F.tid & 63; float s = 0.f;
#pragma unroll
          for (int w8 = 0; w8 < 8; ++w8) s += red[(w8 * 8 + b) * 64 + col];
          mod[b * 6144 + it * 64 + col] = s + F.in[IN_ADAB][it * 64 + col]; }
        __syncthreads();
    }
}
template <int MAP, bool FP8 = false>
__device__ __forceinline__ void p0_tr_item(const float* W, int K, int N, int NP, void* WTv, const float* ksc, LAS float* scr, int item, int lane) {
    bf16_t* WT = (bf16_t*)WTv;
    const int nblk = NP / 32, kb = item / nblk, nb = item % nblk, k0 = 64 * kb, n0 = 32 * nb;
    f32x4 ld[8];
#pragma unroll
    for (int j = 0; j < 8; ++j) { const int idx = j * 64 + lane, kk = idx >> 3, nn = n0 + 4 * (idx & 7); ld[j] = (nn < N) ? *(const f32x4*)(W + (size_t)(k0 + kk) * N + nn) : (f32x4){0.f, 0.f, 0.f, 0.f}; }
#pragma unroll
    for (int j = 0; j < 8; ++j) { const int idx = j * 64 + lane, kk = idx >> 3, c4 = idx & 7; f32x4 v = ld[j]; if (ksc) v = v * ksc[k0 + kk];
        LAS float* d = scr + kk * 33 + 4 * c4; d[0] = v[0]; d[1] = v[1]; d[2] = v[2]; d[3] = v[3]; }
    LDS_WAIT(); asm volatile("" ::: "memory");
    const int c = lane & 7;
#pragma unroll
    for (int j = 0; j < 4; ++j) { const int n = (lane >> 3) + 8 * j; const LAS float* s = scr + (8 * c) * 33 + n;
        u32x4 o; o.x = cvtpk(s[0 * 33], s[1 * 33]); o.y = cvtpk(s[2 * 33], s[3 * 33]); o.z = cvtpk(s[4 * 33], s[5 * 33]); o.w = cvtpk(s[6 * 33], s[7 * 33]);
        int dn = n0 + n;
        if (MAP == 1) { const int half = dn >> 10, r = dn & 1023; dn = ((r >> 7) << 8) + (half << 7) + (r & 127); }
        if constexpr (FP8) { u32x2 o8; o8.x = pk4_fp8(s[0 * 33] * W8, s[1 * 33] * W8, s[2 * 33] * W8, s[3 * 33] * W8); o8.y = pk4_fp8(s[4 * 33] * W8, s[5 * 33] * W8, s[6 * 33] * W8, s[7 * 33] * W8);
            *(GAS u32x2*)((unsigned char*)WTv + (size_t)dn * K + k0 + 8 * c) = o8; }
        else *(GAS u32x4*)(WT + (size_t)dn * K + k0 + 8 * c) = o; }
    LDS_WAIT(); asm volatile("" ::: "memory");
}
__device__ __forceinline__ void p0_weights(Frame& F) {
    LAS float* scr = (LAS float*)(F.lds + 49152 + F.wave * 8704);
    const int gw = F.vcu * NWAVES + F.wave, NGW = F.G * NWAVES;
    constexpr int I_IN = (DM / 64) * (NPROJ / 32), I_Q = (QLORA / 64) * (768 / 32), I_KV = (KVLORA / 64) * (1024 / 32), I_O = (DM / 64) * (DM / 32);
    constexpr int I_GU = (DM / 64) * (2048 / 32), I_DN = (DE / 64) * (DM / 32);
    constexpr int P_GU = I_GU / 2, P_DN = I_DN / 2;
    constexpr int NITEMS = I_IN + I_Q + I_KV + I_O;
    for (int it = gw; it < NITEMS; it += NGW) {
        int r = it;
        if (r < I_IN) { p0_tr_item<0>(F.in[IN_WIN], DM, IN_DIM, NPROJ, WSP(bf16_t, WS_WIN), nullptr, scr, r, F.lane); continue; } r -= I_IN;
        if (r < I_Q) { p0_tr_item<0>(F.in[IN_WQB], QLORA, 768, 768, WSP(bf16_t, WS_WQ), F.in[IN_QNG], scr, r, F.lane); continue; } r -= I_Q;
        if (r < I_KV) { p0_tr_item<0>(F.in[IN_WKVB], KVLORA, 1024, 1024, WSP(bf16_t, WS_WKV), F.in[IN_KVNG], scr, r, F.lane); continue; } r -= I_KV;
        if (r < I_O) { p0_tr_item<0>(F.in[IN_WOUT], DM, DM, DM, WSP(bf16_t, WS_WO), nullptr, scr, r, F.lane); continue; } r -= I_O;
        (void)scr;
    }
    float* rwt = WSP(float, WS_RWT);
    for (int i = (int)blockIdx.x * NWAVES * 64 + F.tid; i < NE * DM; i += F.G * NWAVES * 64) { const int e = i >> 10, k = i & 1023; rwt[i] = F.in[IN_RW][k * NE + e]; }
}

template <int MAP>
__device__ __forceinline__ void p0_tr_pair8(const float* W, int K, int N, unsigned char* WT8, LAS float* scr, int kp, int nb, int lane) {
    const int k0 = 128 * kp, n0 = 32 * nb;
    f32x4 ld[16];
#pragma unroll
    for (int j = 0; j < 16; ++j) { const int idx = j * 64 + lane, kk = idx >> 3, nn = n0 + 4 * (idx & 7); ld[j] = *(const f32x4*)(W + (size_t)(k0 + kk) * N + nn); }
#pragma unroll
    for (int hk = 0; hk < 2; ++hk) {
#pragma unroll
        for (int j = 0; j < 8; ++j) { const int idx = j * 64 + lane, kk = idx >> 3, c4 = idx & 7; const f32x4 v = ld[hk * 8 + j];
            LAS float* d = scr + kk * 33 + 4 * c4; d[0] = v[0]; d[1] = v[1]; d[2] = v[2]; d[3] = v[3]; }
        LDS_WAIT(); asm volatile("" ::: "memory");
        const int c = lane & 7;
#pragma unroll
        for (int j = 0; j < 4; ++j) { const int n = (lane >> 3) + 8 * j; const LAS float* s = scr + (8 * c) * 33 + n;
            int dn = n0 + n;
            if (MAP == 1) { const int half = dn >> 10, r = dn & 1023; dn = ((r >> 7) << 8) + (half << 7) + (r & 127); }
            u32x2 o8; o8.x = pk4_fp8(s[0 * 33] * W8, s[1 * 33] * W8, s[2 * 33] * W8, s[3 * 33] * W8); o8.y = pk4_fp8(s[4 * 33] * W8, s[5 * 33] * W8, s[6 * 33] * W8, s[7 * 33] * W8);
            *(GAS u32x2*)(WT8 + (size_t)dn * K + k0 + 64 * hk + 8 * c) = o8; }
        LDS_WAIT(); asm volatile("" ::: "memory");
    }
}
constexpr int MOE_CONV_ITEMS = (NE * (DM / 64) * (2048 / 32) / 2 + NE * (DE / 64) * (DM / 32) / 2) / 64;
__device__ __forceinline__ void moe_conv_item(Frame& F, int item) {
    LAS float* scr = (LAS float*)(F.lds + F.wave * 8704);
    constexpr int P_GU = (DM / 64) * (2048 / 32) / 2, P_DN = (DE / 64) * (DM / 32) / 2;
#pragma unroll 1
    for (int j = 0; j < 8; ++j) {
        int r = item * 64 + j * 8 + F.wave;
        if (r < NE * P_GU) { const int e = r / P_GU, p = r - e * P_GU, nb = p % 64, kp = p / 64;
            p0_tr_pair8<1>(F.in[IN_WGU] + (size_t)e * DM * 2048, DM, 2048, WSP(unsigned char, WS_WGU) + (size_t)e * 2048 * DM, scr, kp, nb, F.lane);
        } else { r -= NE * P_GU; const int e = r / P_DN, p = r - e * P_DN, nb = p % 32, kp = p / 32;
            p0_tr_pair8<0>(F.in[IN_WDN] + (size_t)e * DE * DM, DE, DM, WSP(unsigned char, WS_WDN) + (size_t)e * DM * DE, scr, kp, nb, F.lane); }
    }
}

__device__ __forceinline__ void norm_rows(Frame& F, const float* x, const float* gain, int SH, int SC, bf16_t* outp) {
    const int gw = F.vcu * NWAVES + F.wave, NGW = F.G * NWAVES;
    const float* mod = WSP(float, WS_MOD);
    constexpr int R = 4;
    for (int m0 = gw; m0 < T; m0 += R * NGW) {
        f32x4 v[R][4]; float s[R];
#pragma unroll
        for (int r = 0; r < R; ++r) { const int m = m0 + r * NGW; s[r] = 0.f; if (m < T) { const f32x4* xr = (const f32x4*)(x + (size_t)m * DM) + F.lane;
#pragma unroll
            for (int j = 0; j < 4; ++j) v[r][j] = xr[64 * j]; } else {
#pragma unroll
            for (int j = 0; j < 4; ++j) v[r][j] = (f32x4){0.f, 0.f, 0.f, 0.f}; } }
#pragma unroll
        for (int r = 0; r < R; ++r)
#pragma unroll
            for (int j = 0; j < 4; ++j) s[r] += (v[r][j][0] * v[r][j][0] + v[r][j][1] * v[r][j][1]) + (v[r][j][2] * v[r][j][2] + v[r][j][3] * v[r][j][3]);
#pragma unroll
        for (int o = 1; o < 64; o <<= 1)
#pragma unroll
            for (int r = 0; r < R; ++r) s[r] += __shfl_xor(s[r], o);
#pragma unroll
        for (int r = 0; r < R; ++r) { const int m = m0 + r * NGW; if (m >= T) continue;
            const float rstd = __builtin_amdgcn_rsqf(s[r] * (1.f / DM) + EPS); const float* mb = mod + (size_t)(m / SEQ) * 6144;
            u32x2* o8 = (u32x2*)(outp + (size_t)m * DM) + F.lane;
#pragma unroll
            for (int j = 0; j < 4; ++j) { const int col = 4 * (F.lane + 64 * j);
                const f32x4 g = *(const f32x4*)(gain + col), sc = *(const f32x4*)(mb + SC + col), sh = *(const f32x4*)(mb + SH + col);
                const f32x4 h = v[r][j] * rstd * g * (sc + 1.0f) + sh; u32x2 w; w.x = cvtpk(h[0], h[1]); w.y = cvtpk(h[2], h[3]); o8[64 * j] = w; } }
    }
}

__device__ const float ROPE_INVF[16] = {1.0f, 0.5623413251903491f, 0.31622776601683794f, 0.1778279410038923f, 0.1f, 0.05623413251903491f, 0.03162277660168379f, 0.01778279410038923f,
    0.01f, 0.005623413251903491f, 0.003162277660168379f, 0.0017782794100389228f, 0.001f, 0.0005623413251903491f, 0.00031622776601683794f, 0.00017782794100389227f};
__device__ __forceinline__ float ssq8(u32x4 a) { float s = 0.f;
#pragma unroll
    for (int i = 0; i < 4; ++i) { const float lo = bflo(a[i]), hi = bfhi(a[i]); s += lo * lo + hi * hi; } return s; }
__device__ __forceinline__ void p3a_rows(Frame& F) {
    const int gw = F.vcu * NWAVES + F.wave, NGW = F.G * NWAVES, lane = F.lane;
    const bf16_t* proj = WSP(bf16_t, WS_PROJ); float* rsq = WSP(float, WS_RSQ); float* rskv = WSP(float, WS_RSKV); float* cs = WSP(float, WS_CS); bf16_t* Kb = WSP(bf16_t, WS_K);
    const int* pos = (const int*)F.in[IN_POS];
    constexpr int R = 4;
    for (int m0 = gw; m0 < T; m0 += R * NGW) {
        u32x4 a[R], b[R]; int ps[R];
#pragma unroll
        for (int r = 0; r < R; ++r) { const int m = (m0 + r * NGW < T) ? m0 + r * NGW : m0; const u32x4* pr = (const u32x4*)(proj + (size_t)m * NPROJ);
            a[r] = pr[lane]; b[r] = (u32x4){0u, 0u, 0u, 0u}; if (lane < 20) b[r] = pr[64 + lane]; ps[r] = pos[m]; }
#pragma unroll
        for (int r = 0; r < R; ++r) { const int m = m0 + r * NGW; if (m >= T) continue;
            const float sa = ssq8(a[r]), sb = ssq8(b[r]);
            const float sq = wave_sum(lane < 48 ? sa : 0.f), skv = wave_sum((lane >= 48 ? sa : 0.f) + (lane < 16 ? sb : 0.f));
            if (lane == 0) { rsq[m] = __builtin_amdgcn_rsqf(sq * (1.f / QLORA) + EPS); rskv[m] = __builtin_amdgcn_rsqf(skv * (1.f / KVLORA) + EPS); }
            const float ang = (float)ps[r] * ROPE_INVF[lane & 15];
            const double rev = (double)ang * 0.15915494309189535; const float fr = (float)(rev - __builtin_rint(rev));
            const float cv = __builtin_amdgcn_cosf(fr), sv = __builtin_amdgcn_sinf(fr);
            if (lane < 16) { cs[(size_t)m * 32 + lane] = cv; cs[(size_t)m * 32 + 16 + lane] = sv; }
            float xv[8], pv[8], cc[8], ss[8];
#pragma unroll
            for (int i = 0; i < 4; ++i) { xv[2 * i] = bflo(b[r][i]); xv[2 * i + 1] = bfhi(b[r][i]); }
            const int i0 = 8 * (lane & 1);
#pragma unroll
            for (int j = 0; j < 8; ++j) { pv[j] = __shfl_xor(xv[j], 2); cc[j] = __shfl(cv, i0 + j); ss[j] = __shfl(sv, i0 + j); }
            if (lane >= 16 && lane < 20) {
                float o[8];
#pragma unroll
                for (int j = 0; j < 8; ++j) o[j] = (lane < 18) ? xv[j] * cc[j] - pv[j] * ss[j] : xv[j] * cc[j] + pv[j] * ss[j];
                u32x4 w; w.x = cvtpk(o[0], o[1]); w.y = cvtpk(o[2], o[3]); w.z = cvtpk(o[4], o[5]); w.w = cvtpk(o[6], o[7]);
#pragma unroll
                for (int h = 0; h < NH; ++h) *(u32x4*)(Kb + (size_t)m * 768 + h * 96 + 64 + 8 * (lane - 16)) = w;
            } }
    }
}

__device__ __forceinline__ int crow(int r, int hi) { return (r & 3) + 8 * (r >> 2) + 4 * hi; }
typedef short v4i16_t __attribute__((ext_vector_type(4)));
constexpr int AT_KROW = 208, AT_VROW = 144, AT_KBUF = 64 * AT_KROW, AT_VBUF = 64 * AT_VROW, AT_V0 = 2 * AT_KBUF, AT_WS = AT_V0 + 2 * AT_VBUF;
__device__ __forceinline__ void attn_unit(Frame& F, int b, int h, int qb) {
    const int tid = F.tid, lane = F.lane, wid = F.wave, r32 = lane & 31, hi = lane >> 5;
    const bf16_t* Qg = WSP(bf16_t, WS_Q); const bf16_t* Kg = WSP(bf16_t, WS_K); const bf16_t* Vg = WSP(bf16_t, WS_V); bf16_t* Og = WSP(bf16_t, WS_OA);
    LAS unsigned char* Kl = F.lds; LAS unsigned char* Vl = F.lds + AT_V0; LAS float* wsf = (LAS float*)(F.lds + AT_WS) + wid * 64;
    const size_t tb = (size_t)b * SEQ; const int q0 = qb * 256, NT = 4 * qb + 4;
    bf16x8 qr[6];
    { const bf16_t* Qp = Qg + (tb + q0 + wid * 32 + r32) * 768 + h * 96 + hi * 8;
#pragma unroll
      for (int d0 = 0; d0 < 6; ++d0) qr[d0] = *(const bf16x8*)(Qp + d0 * 16); }
    unsigned kvo[2], vvo[2];
#pragma unroll
    for (int i = 0; i < 2; ++i) { const int ok = (wid + 8 * i) * 1024 + 16 * lane, kr = ok / AT_KROW, kc = (ok % AT_KROW) >> 4; kvo[i] = (unsigned)((kr < 64 ? kr : 63) * 1536 + (kc < 12 ? kc : 0) * 16);
        const int ov = (wid + 8 * i) * 1024 + 16 * lane, vr = ov / AT_VROW, vc = (ov % AT_VROW) >> 4; vvo[i] = (unsigned)((vr < 64 ? vr : 63) * 1024 + (vc < 8 ? vc : 0) * 16); }
    const unsigned kl0 = (unsigned)__builtin_amdgcn_readfirstlane((int)((unsigned)(uintptr_t)Kl + (unsigned)wid * 1024u)), vl0 = (unsigned)__builtin_amdgcn_readfirstlane((int)((unsigned)(uintptr_t)Vl + (unsigned)wid * 1024u));
    const char* kg0 = (const char*)(Kg + tb * 768 + h * 96); const char* vg0 = (const char*)(Vg + tb * 512 + h * 64);
#define AT_DMAK(t, bf) do { pg::glds16s(kg0 + (size_t)(t) * 64 * 1536, kvo[0], kl0 + (unsigned)((bf) * AT_KBUF)); if (wid < 5) pg::glds16s(kg0 + (size_t)(t) * 64 * 1536, kvo[1], kl0 + (unsigned)((bf) * AT_KBUF + 8192)); } while (0)
#define AT_DMAV(t, bf) do { pg::glds16s(vg0 + (size_t)(t) * 64 * 1024, vvo[0], vl0 + (unsigned)((bf) * AT_VBUF)); if (wid == 0) pg::glds16s(vg0 + (size_t)(t) * 64 * 1024, vvo[1], vl0 + (unsigned)((bf) * AT_VBUF + 8192)); } while (0)
#define AT_QK(P0, P1, bf) do { _Pragma("unroll") for (int r = 0; r < 16; ++r) { P0[r] = 0.f; P1[r] = 0.f; } \
        const LAS unsigned char* kb_ = Kl + (bf) * AT_KBUF + r32 * AT_KROW + hi * 16; \
        _Pragma("unroll") for (int d0 = 0; d0 < 6; ++d0) { const bf16x8 k0 = *(const LAS bf16x8*)(kb_ + d0 * 32), k1 = *(const LAS bf16x8*)(kb_ + 32 * AT_KROW + d0 * 32); \
            P0 = __builtin_amdgcn_mfma_f32_32x32x16_bf16(k0, qr[d0], P0, 0, 0, 0); P1 = __builtin_amdgcn_mfma_f32_32x32x16_bf16(k1, qr[d0], P1, 0, 0, 0); } } while (0)
#define AT_SPV(P0, P1, t, bf) do { \
        if ((t) >= NT - 4) { _Pragma("unroll") for (int r = 0; r < 16; ++r) { const int kv = 64 * (t) + crow(r, hi); if (kv > qpos) P0[r] = -INFINITY; if (kv + 32 > qpos) P1[r] = -INFINITY; } } \
        float mx = fmaxf(P0[0], P1[0]); \
        _Pragma("unroll") for (int r = 1; r < 16; ++r) mx = fmaxf(mx, fmaxf(P0[r], P1[r])); \
        mx = fmaxf(mx, __shfl_xor(mx, 32)); \
        const float m_new = fmaxf(m_run, mx); \
        if (__any(m_new > m_run)) { const float f = __builtin_amdgcn_exp2f(m_run - m_new); l_run *= f; m_run = m_new; \
            if (hi == 0) wsf[r32] = f; float fr_[16]; \
            _Pragma("unroll") for (int r = 0; r < 16; ++r) fr_[r] = wsf[crow(r, hi)]; \
            _Pragma("unroll") for (int r = 0; r < 16; ++r) { o[0][r] *= fr_[r]; o[1][r] *= fr_[r]; } } \
        float rs = 0.f; \
        _Pragma("unroll") for (int r = 0; r < 16; ++r) { P0[r] = __builtin_amdgcn_exp2f(P0[r] - m_run); P1[r] = __builtin_amdgcn_exp2f(P1[r] - m_run); rs += P0[r] + P1[r]; } \
        l_run += rs; bf16x8 pa[4]; \
        _Pragma("unroll") for (int ks = 0; ks < 4; ++ks) { u32x4 w_; \
            _Pragma("unroll") for (int i = 0; i < 4; ++i) { const int r = (ks & 1) * 8 + 2 * i; w_[i] = (ks < 2) ? cvtpk(P0[r], P0[r + 1]) : cvtpk(P1[r], P1[r + 1]); } \
            pa[ks] = __builtin_bit_cast(bf16x8, w_); } \
        const LAS unsigned char* vb_ = Vl + (bf) * AT_VBUF + (4 * hi + ((lane & 15) >> 2)) * AT_VROW + (((lane >> 4) & 1) * 16 + (lane & 3) * 4) * 2; \
        _Pragma("unroll") for (int d0 = 0; d0 < 2; ++d0) _Pragma("unroll") for (int ks = 0; ks < 4; ++ks) { \
            const v4i16_t lo = __builtin_amdgcn_ds_read_tr16_b64_v4i16((LAS v4i16_t*)(vb_ + ks * 16 * AT_VROW + d0 * 64)); \
            const v4i16_t hv = __builtin_amdgcn_ds_read_tr16_b64_v4i16((LAS v4i16_t*)(vb_ + ks * 16 * AT_VROW + 8 * AT_VROW + d0 * 64)); \
            const bf16x8 vf = (bf16x8){lo[0], lo[1], lo[2], lo[3], hv[0], hv[1], hv[2], hv[3]}; \
            o[d0] = __builtin_amdgcn_mfma_f32_32x32x16_bf16(pa[ks], vf, o[d0], 0, 0, 0); } } while (0)
#define AT_STEP(C0, C1, N0, N1, t) do { \
        if ((t) + 2 < NT) AT_DMAK((t) + 2, (t) & 1); if ((t) + 1 < NT) AT_DMAV((t) + 1, ((t) + 1) & 1); \
        if ((t) + 1 < NT && 64 * ((t) + 1) <= qmax) AT_QK(N0, N1, ((t) + 1) & 1); \
        if (64 * (t) <= qmax) AT_SPV(C0, C1, t, (t) & 1); \
        VM_WAIT(); __syncthreads(); } while (0)
    AT_DMAK(0, 0); AT_DMAV(0, 0); AT_DMAK(1, 1); VM_WAIT(); __syncthreads();
    float m_run = -INFINITY, l_run = 0.f; f32x16 o[2];
#pragma unroll
    for (int r = 0; r < 16; ++r) { o[0][r] = 0.f; o[1][r] = 0.f; }
    const int qmax = q0 + wid * 32 + 31, qpos = q0 + wid * 32 + r32;
    f32x16 sA0, sA1, sB0, sB1;
    AT_QK(sA0, sA1, 0);
    LBAR();
    for (int t = 0; t < NT; t += 2) {
        AT_STEP(sA0, sA1, sB0, sB1, t);
        AT_STEP(sB0, sB1, sA0, sA1, t + 1);
    }
    { float lt = l_run + __shfl_xor(l_run, 32);
      if (hi == 0) wsf[32 + r32] = lt;
      bf16_t* Ow = Og + (tb + q0 + wid * 32) * 512 + h * 64 + r32;
#pragma unroll
      for (int r = 0; r < 16; ++r) { const int qr_ = crow(r, hi); const float inv = 1.0f / wsf[32 + qr_];
          Ow[(size_t)qr_ * 512] = f2bf(o[0][r] * inv); Ow[(size_t)qr_ * 512 + 32] = f2bf(o[1][r] * inv); } }
#undef AT_DMAK
#undef AT_DMAV
#undef AT_QK
#undef AT_SPV
#undef AT_STEP
}

__device__ __forceinline__ void p4b_rows(Frame& F) {
    const int gw = F.vcu * NWAVES + F.wave, NGW = F.G * NWAVES, lane = F.lane;
    const bf16_t* oa = WSP(bf16_t, WS_OA); const bf16_t* og = WSP(bf16_t, WS_OG); const bf16_t* proj = WSP(bf16_t, WS_PROJ); bf16_t* mx = WSP(bf16_t, WS_H);
    const float* ga = F.in[IN_MLAOG] + 8 * lane; const float* gg = F.in[IN_GDNG] + 8 * (lane & 7);
    constexpr int R = 4;
    for (int m0 = gw; m0 < T; m0 += R * NGW) {
        u32x4 a[R], g[R], z[R];
#pragma unroll
        for (int r = 0; r < R; ++r) { const int m = (m0 + r * NGW < T) ? m0 + r * NGW : m0;
            a[r] = *(const u32x4*)(oa + (size_t)m * 512 + 8 * lane); g[r] = *(const u32x4*)(og + (size_t)m * 512 + 8 * lane); z[r] = *(const u32x4*)(proj + (size_t)m * NPROJ + C_GZ + 8 * lane); }
#pragma unroll
        for (int r = 0; r < R; ++r) { const int m = m0 + r * NGW; if (m >= T) continue;
            const float ra = __builtin_amdgcn_rsqf(wave_sum(ssq8(a[r])) * (1.f / 512) + EPS);
            float sg = ssq8(g[r]); sg += __shfl_xor(sg, 1); sg += __shfl_xor(sg, 2); sg += __shfl_xor(sg, 4);
            const float rg = __builtin_amdgcn_rsqf(sg * (1.f / 64) + EPS);
            float oa8[8], og8[8];
#pragma unroll
            for (int i = 0; i < 4; ++i) { oa8[2 * i] = bflo(a[r][i]) * ra * ga[2 * i]; oa8[2 * i + 1] = bfhi(a[r][i]) * ra * ga[2 * i + 1];
                og8[2 * i] = bflo(g[r][i]) * rg * gg[2 * i] * siluf(bflo(z[r][i])); og8[2 * i + 1] = bfhi(g[r][i]) * rg * gg[2 * i + 1] * siluf(bfhi(z[r][i])); }
            u32x4 wa, wg;
#pragma unroll
            for (int i = 0; i < 4; ++i) { wa[i] = cvtpk(oa8[2 * i], oa8[2 * i + 1]); wg[i] = cvtpk(og8[2 * i], og8[2 * i + 1]); }
            *(u32x4*)(mx + (size_t)m * DM + 8 * lane) = wa; *(u32x4*)(mx + (size_t)m * DM + 512 + 8 * lane) = wg; }
    }
}

constexpr int G1_KRM = 0, G1_QRM = 4608, G1_AM = 9216, G1_QK = 13440, G1_UT = 16000, G1_WT = 21120, G1_KT = 26240, G1_GT = 31360, G1_SLOT = 32000, G1_CW = 4 * G1_SLOT;
static_assert(G1_CW + 3072 <= RING_BYTES, "G1 LDS");
__device__ __forceinline__ f32x4 mfma16(bf16x8 a, bf16x8 b, f32x4 c) { return __builtin_amdgcn_mfma_f32_16x16x32_bf16(a, b, c, 0, 0, 0); }

__device__ __forceinline__ float silu_fast(float x) { return x * __builtin_amdgcn_rcpf(1.0f + __expf(-x)); }
#ifndef G1PROBE
#define G1PROBE (-1)
#endif
#define G1T(k) do { if (G1PROBE >= 0) { const unsigned long long n_ = __builtin_amdgcn_s_memrealtime(); if (G1PROBE == (k)) g1acc += n_ - g1t; g1t = n_; } } while (0)
__device__ __forceinline__ void g1_unit(Frame& F, int unit, unsigned long long& g1acc) {
    unsigned long long g1t = (G1PROBE >= 0) ? __builtin_amdgcn_s_memrealtime() : 0ull;
    const int tid = F.tid, lane = F.lane, wid = F.wave;
    const int bh = unit >> 5, c0 = (unit & 31) * 4, b = bh >> 3, h = bh & 7;
    const bf16_t* proj = WSP(bf16_t, WS_PROJ);
    LAS unsigned char* L = F.lds; LAS float* cw = (LAS float*)(L + G1_CW);
    const size_t tb = (size_t)b * SEQ;
    for (int i = tid; i < 768; i += NWAVES * 64) { const int x = i >> 8, w = (i >> 6) & 3, ch = i & 63; cw[i] = F.in[IN_CONVW][w * 1536 + x * 512 + h * 64 + ch]; }
    LBAR(); G1T(0);
    { const int tk = tid >> 2, part = tid & 3, s = tk >> 5, i = tk & 31, isk = part >> 1, chb = (part & 1) * 32;
      const int sp = (c0 + s) * GC + i;
      const bf16_t* src = proj + (tb + sp) * NPROJ + (isk ? C_GK : C_GQ) + h * 64 + chb;
      float ain = 0.f, bin = 0.f;
      if (part == 0) { ain = bf2f(proj[(tb + sp) * NPROJ + C_GA + h]); bin = bf2f(proj[(tb + sp) * NPROJ + C_GB + h]); }
      float v[32];
#pragma unroll
      for (int c = 0; c < 32; ++c) v[c] = 0.f;
#pragma unroll
      for (int w = 0; w < 4; ++w) { if (sp - 3 + w >= 0) { const bf16_t* rp = src - (ptrdiff_t)(3 - w) * NPROJ;
#pragma unroll
          for (int q4 = 0; q4 < 4; ++q4) { const u32x4 d = *(const u32x4*)(rp + 8 * q4); const LAS f32x4* wp = (const LAS f32x4*)(cw + (isk * 4 + w) * 64 + chb + 8 * q4); const f32x4 w0 = wp[0], w1 = wp[1];
              v[8 * q4 + 0] += bflo(d[0]) * w0[0]; v[8 * q4 + 1] += bfhi(d[0]) * w0[1]; v[8 * q4 + 2] += bflo(d[1]) * w0[2]; v[8 * q4 + 3] += bfhi(d[1]) * w0[3];
              v[8 * q4 + 4] += bflo(d[2]) * w1[0]; v[8 * q4 + 5] += bfhi(d[2]) * w1[1]; v[8 * q4 + 6] += bflo(d[3]) * w1[2]; v[8 * q4 + 7] += bfhi(d[3]) * w1[3]; } } }
      float ss = 0.f;
#pragma unroll
      for (int c = 0; c < 32; ++c) { v[c] = silu_fast(v[c]); ss += v[c] * v[c]; }
      ss += __shfl_xor(ss, 1);
      const float rn = __builtin_amdgcn_rsqf(ss + EPS) * (isk ? 1.0f : 0.125f);
      LAS bf16_t* dst = (LAS bf16_t*)(L + s * G1_SLOT + (isk ? G1_KRM : G1_QRM)) + i * 72 + chb;
#pragma unroll
      for (int q4 = 0; q4 < 4; ++q4) { u32x4 w;
#pragma unroll
          for (int e = 0; e < 4; ++e) w[e] = cvtpk(v[8 * q4 + 2 * e] * rn, v[8 * q4 + 2 * e + 1] * rn);
          *(LAS u32x4*)(dst + 8 * q4) = w; }
      if (part == 0) { LAS float* gt = (LAS float*)(L + s * G1_SLOT + G1_GT);
          const float xs = ain + F.in[IN_DTB][h], sp_ = xs > 20.f ? xs : __logf(1.0f + __expf(xs));
          gt[i] = 1.0f / (1.0f + __expf(-bin));
          gt[32 + i] = -__expf(F.in[IN_ALOG][h]) * sp_; }
    }
    LBAR(); G1T(1);
    if (wid < 2) { LAS float* gt = (LAS float*)(L + (2 * wid + (lane >> 5)) * G1_SLOT + G1_GT); const int i = lane & 31; float c = gt[32 + i];
#pragma unroll
        for (int o = 1; o < 32; o <<= 1) { const float t = __shfl_up(c, o, 32); if (i >= o) c += t; }
        const float last = __shfl(c, 31, 32);
        gt[64 + i] = c; gt[96 + i] = __expf(c); gt[128 + i] = __expf(last - c); }
    LBAR(); G1T(2);
    const int s = wid >> 1, sub = wid & 1, l15 = lane & 15, kq = lane >> 4;
    LAS unsigned char* Ls = L + s * G1_SLOT; LAS float* gt = (LAS float*)(Ls + G1_GT);
    { const LAS bf16_t* X = (const LAS bf16_t*)(Ls + (sub ? G1_QRM : G1_KRM)); const LAS bf16_t* Kr = (const LAS bf16_t*)(Ls + G1_KRM);
#pragma unroll
      for (int it = 0; it < 2; ++it)
#pragma unroll
          for (int jt = 0; jt < 2; ++jt) { f32x4 acc = (f32x4){0.f, 0.f, 0.f, 0.f};
#pragma unroll
              for (int ks = 0; ks < 2; ++ks) acc = mfma16(*(const LAS bf16x8*)(X + (16 * it + l15) * 72 + 32 * ks + 8 * kq), *(const LAS bf16x8*)(Kr + (16 * jt + l15) * 72 + 32 * ks + 8 * kq), acc);
              const int j = 16 * jt + l15; const float gj = gt[64 + j];
#pragma unroll
              for (int r = 0; r < 4; ++r) { const int i = 16 * it + 4 * kq + r; const float gi = gt[64 + i];
                  if (sub == 0) { const float val = (i > j) ? acc[r] * gt[i] * __expf(gi - gj) : 0.f; ((LAS float*)(Ls + G1_AM))[i * 33 + j] = val; }
                  else { const float val = (i >= j) ? acc[r] * __expf(gi - gj) : 0.f; ((LAS bf16_t*)(Ls + G1_QK))[i * 40 + j] = f2bf(val); } } }
    }
    for (int idx = tid; idx < 4 * 64 * 32; idx += NWAVES * 64) { const int s2 = idx >> 11, d = (idx >> 5) & 63, c = idx & 31; LAS unsigned char* L2 = L + s2 * G1_SLOT;
        ((LAS bf16_t*)(L2 + G1_KT))[d * 40 + c] = f2bf(bf2f(((const LAS bf16_t*)(L2 + G1_KRM))[c * 72 + d]) * ((const LAS float*)(L2 + G1_GT))[128 + c]); }
    LBAR(); G1T(3);
    { float sol[32];
      if (sub == 0) {
          const int sp0 = (c0 + s) * GC; const bf16_t* src = proj + (tb + sp0) * NPROJ + C_GV + h * 64 + lane;
          const float w0 = cw[(8 + 0) * 64 + lane], w1 = cw[(8 + 1) * 64 + lane], w2 = cw[(8 + 2) * 64 + lane], w3 = cw[(8 + 3) * 64 + lane];
          float x0 = (sp0 >= 3) ? bf2f(src[-3 * (ptrdiff_t)NPROJ]) : 0.f, x1 = (sp0 >= 2) ? bf2f(src[-2 * (ptrdiff_t)NPROJ]) : 0.f, x2 = (sp0 >= 1) ? bf2f(src[-1 * (ptrdiff_t)NPROJ]) : 0.f;
#pragma unroll
          for (int i = 0; i < 32; ++i) { const float x3 = bf2f(src[(size_t)i * NPROJ]); sol[i] = silu_fast(w0 * x0 + w1 * x1 + w2 * x2 + w3 * x3) * gt[i]; x0 = x1; x1 = x2; x2 = x3; }
      } else {
          const LAS bf16_t* Kr = (const LAS bf16_t*)(Ls + G1_KRM);
#pragma unroll
          for (int i = 0; i < 32; ++i) sol[i] = bf2f(Kr[i * 72 + lane]) * gt[i] * gt[96 + i];
      }
      const LAS float* Am = (const LAS float*)(Ls + G1_AM);
#pragma unroll
      for (int i = 1; i < 32; ++i) { const float arow = Am[i * 33 + (lane & 31)]; float a = sol[i];
#pragma unroll
          for (int j = 0; j < i; ++j) a -= __uint_as_float(__builtin_amdgcn_readlane(__float_as_uint(arow), j)) * sol[j];
          sol[i] = a; }
      LAS bf16_t* dst = (LAS bf16_t*)(Ls + (sub ? G1_WT : G1_UT)) + lane * 40;
#pragma unroll
      for (int q4 = 0; q4 < 4; ++q4) { u32x4 w;
#pragma unroll
          for (int e = 0; e < 4; ++e) w[e] = cvtpk(sol[8 * q4 + 2 * e], sol[8 * q4 + 2 * e + 1]);
          *(LAS u32x4*)(dst + 8 * q4) = w; }
    }
    LBAR(); G1T(4);
        { unsigned char* gd = F.ws + WS_GD + (size_t)(bh * NCH + c0 + s) * 24576;
          const LAS bf16_t* uT = (const LAS bf16_t*)(Ls + G1_UT); const LAS bf16_t* wT = (const LAS bf16_t*)(Ls + G1_WT); const LAS bf16_t* kT = (const LAS bf16_t*)(Ls + G1_KT);
          const LAS bf16_t* qk = (const LAS bf16_t*)(Ls + G1_QK); const LAS bf16_t* qr = (const LAS bf16_t*)(Ls + G1_QRM);
          const f32x4 z4 = (f32x4){0.f, 0.f, 0.f, 0.f}; const float cd = gt[96 + 31];
          if (sub == 0) {
#pragma unroll
              for (int mp = 0; mp < 2; ++mp) {
                  const bf16x8 af0 = *(const LAS bf16x8*)(wT + (32 * mp + l15) * 40 + 8 * kq), af1 = *(const LAS bf16x8*)(wT + (32 * mp + 16 + l15) * 40 + 8 * kq);
#pragma unroll
                  for (int nt = 0; nt < 4; ++nt) {
                      const bf16x8 bfr = *(const LAS bf16x8*)(kT + (16 * nt + l15) * 40 + 8 * kq);
                      const f32x4 a0 = mfma16(af0, bfr, z4), a1 = mfma16(af1, bfr, z4); const int dout = 16 * nt + l15; u32x4 w; float o8[8];
#pragma unroll
                      for (int r = 0; r < 4; ++r) { const int din = 32 * mp + 4 * kq + r; o8[r] = ((din == dout) ? cd : 0.f) - a0[r]; o8[4 + r] = ((din + 16 == dout) ? cd : 0.f) - a1[r]; }
                      w.x = cvtpk(o8[0], o8[1]); w.y = cvtpk(o8[2], o8[3]); w.z = cvtpk(o8[4], o8[5]); w.w = cvtpk(o8[6], o8[7]);
                      *(u32x4*)(gd + ((nt * 2 + mp) * 64 + kq * 16 + l15) * 16) = w; }
#pragma unroll
                  for (int ct = 0; ct < 2; ++ct) {
                      const bf16x8 bfr = *(const LAS bf16x8*)(qk + (16 * ct + l15) * 40 + 8 * kq);
                      const f32x4 a0 = mfma16(af0, bfr, z4), a1 = mfma16(af1, bfr, z4); const int c = 16 * ct + l15; const float eg = gt[96 + c];
                      const u32x2 q0 = *(const LAS u32x2*)(qr + c * 72 + 32 * mp + 4 * kq), q1 = *(const LAS u32x2*)(qr + c * 72 + 32 * mp + 16 + 4 * kq); u32x4 w;
                      w.x = cvtpk(bflo(q0.x) * eg - a0[0], bfhi(q0.x) * eg - a0[1]); w.y = cvtpk(bflo(q0.y) * eg - a0[2], bfhi(q0.y) * eg - a0[3]);
                      w.z = cvtpk(bflo(q1.x) * eg - a1[0], bfhi(q1.x) * eg - a1[1]); w.w = cvtpk(bflo(q1.y) * eg - a1[2], bfhi(q1.y) * eg - a1[3]);
                      *(u32x4*)(gd + 8192 + ((ct * 2 + mp) * 64 + kq * 16 + l15) * 16) = w; } }
          } else {
#pragma unroll
              for (int et = 0; et < 4; ++et) { const bf16x8 bfr = *(const LAS bf16x8*)(uT + (16 * et + l15) * 40 + 8 * kq);
#pragma unroll
                  for (int dt = 0; dt < 4; ++dt) {
                      const f32x4 acc = mfma16(*(const LAS bf16x8*)(kT + (16 * dt + l15) * 40 + 8 * kq), bfr, z4); u32x2 w; w.x = cvtpk(acc[0], acc[1]); w.y = cvtpk(acc[2], acc[3]);
                      *(u32x2*)(gd + 12288 + ((dt * 4 + et) * 64 + lane) * 8) = w; }
#pragma unroll
                  for (int ct = 0; ct < 2; ++ct) {
                      const f32x4 acc = mfma16(*(const LAS bf16x8*)(qk + (16 * ct + l15) * 40 + 8 * kq), bfr, z4); u32x2 w; w.x = cvtpk(acc[0], acc[1]); w.y = cvtpk(acc[2], acc[3]);
                      *(u32x2*)(gd + 20480 + ((ct * 4 + et) * 64 + lane) * 8) = w; } }
          }
        }
    LBAR(); G1T(5);
}

__device__ __forceinline__ void g2_item(Frame& F, int item) {
    const int lane = F.lane, wid = F.wave, bh = item * 2 + (wid >> 2), es = wid & 3, b = bh >> 3, h = bh & 7, l15 = lane & 15, kq = lane >> 4;
    const unsigned char* gd = F.ws + WS_GD + (size_t)bh * NCH * 24576;
    bf16_t* og = WSP(bf16_t, WS_OG) + ((size_t)b * SEQ) * 512 + h * 64 + 16 * es + l15;
    f32x4 S[4];
#pragma unroll
    for (int m = 0; m < 4; ++m) S[m] = (f32x4){0.f, 0.f, 0.f, 0.f};
    bf16x8 Mf[4][2], Pf[2][2]; u32x2 Nv[4], Rv[2];
#define G2_LOAD(c) do { const unsigned char* p_ = gd + (size_t)(c) * 24576; \
        _Pragma("unroll") for (int m = 0; m < 4; ++m) _Pragma("unroll") for (int s2 = 0; s2 < 2; ++s2) Mf[m][s2] = *(const bf16x8*)(p_ + ((m * 2 + s2) * 64 + lane) * 16); \
        _Pragma("unroll") for (int ct = 0; ct < 2; ++ct) _Pragma("unroll") for (int s2 = 0; s2 < 2; ++s2) Pf[ct][s2] = *(const bf16x8*)(p_ + 8192 + ((ct * 2 + s2) * 64 + lane) * 16); \
        _Pragma("unroll") for (int m = 0; m < 4; ++m) Nv[m] = *(const u32x2*)(p_ + 12288 + ((m * 4 + es) * 64 + lane) * 8); \
        _Pragma("unroll") for (int ct = 0; ct < 2; ++ct) Rv[ct] = *(const u32x2*)(p_ + 20480 + ((ct * 4 + es) * 64 + lane) * 8); } while (0)
    G2_LOAD(0);
    for (int c = 0; c < NCH; ++c) {
        bf16x8 cM[4][2], cP[2][2]; u32x2 cN[4], cR[2];
#pragma unroll
        for (int m = 0; m < 4; ++m) { cM[m][0] = Mf[m][0]; cM[m][1] = Mf[m][1]; cN[m] = Nv[m]; }
#pragma unroll
        for (int ct = 0; ct < 2; ++ct) { cP[ct][0] = Pf[ct][0]; cP[ct][1] = Pf[ct][1]; cR[ct] = Rv[ct]; }
        if (c + 1 < NCH) G2_LOAD(c + 1);
        bf16x8 Bs[2];
#pragma unroll
        for (int s2 = 0; s2 < 2; ++s2) { u32x4 w; w.x = cvtpk(S[2 * s2][0], S[2 * s2][1]); w.y = cvtpk(S[2 * s2][2], S[2 * s2][3]); w.z = cvtpk(S[2 * s2 + 1][0], S[2 * s2 + 1][1]); w.w = cvtpk(S[2 * s2 + 1][2], S[2 * s2 + 1][3]);
            Bs[s2] = __builtin_bit_cast(bf16x8, w); }
#pragma unroll
        for (int ct = 0; ct < 2; ++ct) { f32x4 o = (f32x4){bflo(cR[ct].x), bfhi(cR[ct].x), bflo(cR[ct].y), bfhi(cR[ct].y)};
            o = mfma16(cP[ct][0], Bs[0], o); o = mfma16(cP[ct][1], Bs[1], o);
            bf16_t* op = og + (size_t)(c * GC + 16 * ct + 4 * kq) * 512;
#pragma unroll
            for (int r = 0; r < 4; ++r) op[(size_t)r * 512] = f2bf(o[r]); }
#pragma unroll
        for (int m = 0; m < 4; ++m) { f32x4 a = (f32x4){bflo(cN[m].x), bfhi(cN[m].x), bflo(cN[m].y), bfhi(cN[m].y)};
            a = mfma16(cM[m][0], Bs[0], a); S[m] = mfma16(cM[m][1], Bs[1], a); }
    }
#undef G2_LOAD
}

constexpr int P6_RW = 0, P6_TK = 131072;
__device__ __forceinline__ void p6_router(Frame& F, int rep) {
    const int lane = F.lane, wid = F.wave, tid = F.tid;
    LAS float* rw = (LAS float*)(F.lds + P6_RW);
    { const f32x4* src = (const f32x4*)WSP(float, WS_RWT);
      for (int i = tid; i < NE * DM / 4; i += NWAVES * 64) ((LAS f32x4*)rw)[i] = src[i]; }
    if (tid < 96) F.MISC[32 + tid] = 0u;
    __syncthreads();
    const float* x1 = WSP(float, WS_X1); const float* mod = WSP(float, WS_MOD); unsigned char* h2 = WSP(unsigned char, WS_H);
    const size_t ro = rep ? WS_END : 0;
    int* tke = WSP(int, ro + WS_TKE); float* tkw = WSP(float, ro + WS_TKW); int* tkp = WSP(int, ro + WS_TKP); int* lst = WSP(int, ro + WS_LIST);
    const int tpw = T / F.G, t0 = (int)blockIdx.x * tpw;
    const float rb = F.in[IN_RB][lane >> 1];
    for (int tq = wid * 4; tq < tpw; tq += NWAVES * 4) {
        float acc[4][32];
#pragma unroll
        for (int q = 0; q < 4; ++q)
#pragma unroll
            for (int e = 0; e < 32; ++e) acc[q][e] = 0.f;
        float rstd[4];
#pragma unroll
        for (int q = 0; q < 4; ++q) { const f32x4* xr = (const f32x4*)(x1 + (size_t)(t0 + tq + q) * DM) + lane; float s = 0.f;
#pragma unroll
            for (int j = 0; j < 4; ++j) { const f32x4 v = xr[64 * j]; s += (v[0] * v[0] + v[1] * v[1]) + (v[2] * v[2] + v[3] * v[3]); }
            rstd[q] = __builtin_amdgcn_rsqf(wave_sum(s) * (1.f / DM) + EPS); }
        const float* mb = mod + (size_t)((t0 + tq) / SEQ) * 6144;
#pragma unroll 1
        for (int j = 0; j < 4; ++j) {
            const int col = 4 * (lane + 64 * j);
            const f32x4 g = *(const f32x4*)(F.in[IN_N2G] + col), sc = *(const f32x4*)(mb + 4096 + col), sh = *(const f32x4*)(mb + 3072 + col);
            f32x4 hv[4];
#pragma unroll
            for (int q = 0; q < 4; ++q) { const f32x4 v = *(const f32x4*)(x1 + (size_t)(t0 + tq + q) * DM + col); hv[q] = v * rstd[q] * g * (sc + 1.0f) + sh;
                *(unsigned*)(h2 + (size_t)(t0 + tq + q) * DM + col) = pk4_fp8(hv[q][0], hv[q][1], hv[q][2], hv[q][3]); }
#pragma unroll
            for (int e = 0; e < 32; ++e) { const f32x4 wv = *(const LAS f32x4*)(rw + e * DM + col);
#pragma unroll
                for (int q = 0; q < 4; ++q) acc[q][e] += (hv[q][0] * wv[0] + hv[q][1] * wv[1]) + (hv[q][2] * wv[2] + hv[q][3] * wv[3]); }
        }
#pragma unroll
        for (int q = 0; q < 4; ++q) {
            float v16[16], v8[8], v4[4], v2[2], v1;
            { const bool up = (lane & 32) != 0;
#pragma unroll
              for (int i = 0; i < 16; ++i) { const float keep = up ? acc[q][i + 16] : acc[q][i], give = up ? acc[q][i] : acc[q][i + 16]; v16[i] = keep + __shfl_xor(give, 32); } }
            { const bool up = (lane & 16) != 0;
#pragma unroll
              for (int i = 0; i < 8; ++i) { const float keep = up ? v16[i + 8] : v16[i], give = up ? v16[i] : v16[i + 8]; v8[i] = keep + __shfl_xor(give, 16); } }
            { const bool up = (lane & 8) != 0;
#pragma unroll
              for (int i = 0; i < 4; ++i) { const float keep = up ? v8[i + 4] : v8[i], give = up ? v8[i] : v8[i + 4]; v4[i] = keep + __shfl_xor(give, 8); } }
            { const bool up = (lane & 4) != 0;
#pragma unroll
              for (int i = 0; i < 2; ++i) { const float keep = up ? v4[i + 2] : v4[i], give = up ? v4[i] : v4[i + 2]; v2[i] = keep + __shfl_xor(give, 4); } }
            { const bool up = (lane & 2) != 0; const float keep = up ? v2[1] : v2[0], give = up ? v2[0] : v2[1]; v1 = keep + __shfl_xor(give, 2); }
            v1 += __shfl_xor(v1, 1);
            float logit = v1 + rb; const int me = lane >> 1;
            float tv[4]; int ti[4];
#pragma unroll
            for (int k = 0; k < 4; ++k) { float bv = logit; int bi = me;
#pragma unroll
                for (int o = 1; o < 64; o <<= 1) { const float ov = __shfl_xor(bv, o); const int oi = __shfl_xor(bi, o); if (ov > bv || (ov == bv && oi < bi)) { bv = ov; bi = oi; } }
                tv[k] = bv; ti[k] = bi; if (me == bi) logit = -INFINITY; }
            const float e1 = __expf(tv[1] - tv[0]), e2 = __expf(tv[2] - tv[0]), e3 = __expf(tv[3] - tv[0]), inv = 1.0f / (1.0f + e1 + e2 + e3);
            if (lane < 4) { const int t = t0 + tq + q; const int e = (lane == 0) ? ti[0] : (lane == 1) ? ti[1] : (lane == 2) ? ti[2] : ti[3];
                const float w = ((lane == 0) ? 1.0f : (lane == 1) ? e1 : (lane == 2) ? e2 : e3) * inv;
                const int lp = __hip_atomic_fetch_add((LAS int*)(F.lds + MISC_OFF) + 32 + e, 1, __ATOMIC_RELAXED, __HIP_MEMORY_SCOPE_WORKGROUP);
                tke[t * 4 + lane] = e; tkw[t * 4 + lane] = w; tkp[t * 4 + lane] = lp; }
        }
    }
    __syncthreads();
    if (tid < 32) { const int n = (int)F.MISC[32 + tid]; int base = 0; if (n > 0) base = (int)__hip_atomic_fetch_add(F.ctl + CW_CNT + 4096 * rep + 64 * tid, (unsigned)n, RLX_AGENT); F.MISC[64 + tid] = (unsigned)base; }
    VM_WAIT(); __syncthreads();
    for (int i = tid; i < tpw * 4; i += NWAVES * 64) { const int t = t0 + (i >> 2), e = tke[t * 4 + (i & 3)], p = tkp[t * 4 + (i & 3)] + (int)F.MISC[64 + e]; tkp[t * 4 + (i & 3)] = p; lst[(size_t)e * T + p] = t; }
}
__device__ __forceinline__ void moe_tables(Frame& F) {
    if (F.tid < 32) F.MISC[192 + F.tid] = __hip_atomic_load(F.ctl + CW_CNT + 64 * F.tid, RLX_AGENT);
    __syncthreads();
    if (F.tid == 0) { unsigned s = 0; for (int e = 0; e < 32; ++e) { F.MISC[128 + e] = s; s += (F.MISC[192 + e] + 255u) >> 8; } F.MISC[160] = s; }
    __syncthreads();
}
__device__ __forceinline__ void p10_combine(Frame& F) {
    const int gw = F.vcu * NWAVES + F.wave, NGW = F.G * NWAVES, lane = F.lane;
    const float* x1 = WSP(float, WS_X1); const float* mod = WSP(float, WS_MOD); const unsigned char* y = WSP(unsigned char, WS_Y);
    const int* tke = WSP(int, WS_TKE); const float* tkw = WSP(float, WS_TKW); const int* tkp = WSP(int, WS_TKP);
    constexpr int R = 2;
    for (int m0 = gw; m0 < T; m0 += R * NGW) {
        u32x2 y0[R][4], y1[R][4]; float w[R][4]; f32x4 xv[R][4];
#pragma unroll
        for (int r = 0; r < R; ++r) { const int m = (m0 + r * NGW < T) ? m0 + r * NGW : m0;
            const i32x4q e4 = *(const i32x4q*)(tke + m * 4), p4 = *(const i32x4q*)(tkp + m * 4); const f32x4 w4 = *(const f32x4*)(tkw + m * 4);
#pragma unroll
            for (int k = 0; k < 4; ++k) { const size_t row = (size_t)F.MISC[128 + e4[k]] * 256 + p4[k]; w[r][k] = w4[k];
                y0[r][k] = *(const u32x2*)(y + row * DM + 8 * lane); y1[r][k] = *(const u32x2*)(y + row * DM + 512 + 8 * lane); }
#pragma unroll
            for (int q = 0; q < 4; ++q) xv[r][q] = *(const f32x4*)(x1 + (size_t)m * DM + (q >> 1) * 512 + 8 * lane + 4 * (q & 1)); }
#pragma unroll
        for (int r = 0; r < R; ++r) { const int m = m0 + r * NGW; if (m >= T) continue;
            float a[16];
#pragma unroll
            for (int i = 0; i < 16; ++i) a[i] = 0.f;
#pragma unroll
            for (int k = 0; k < 4; ++k)
#pragma unroll
                for (int i = 0; i < 2; ++i) { const f32x2 l0 = __builtin_amdgcn_cvt_pk_f32_fp8((int)y0[r][k][i], false), h0 = __builtin_amdgcn_cvt_pk_f32_fp8((int)y0[r][k][i], true);
                    const f32x2 l1 = __builtin_amdgcn_cvt_pk_f32_fp8((int)y1[r][k][i], false), h1 = __builtin_amdgcn_cvt_pk_f32_fp8((int)y1[r][k][i], true);
                    a[4 * i] += w[r][k] * l0[0]; a[4 * i + 1] += w[r][k] * l0[1]; a[4 * i + 2] += w[r][k] * h0[0]; a[4 * i + 3] += w[r][k] * h0[1];
                    a[8 + 4 * i] += w[r][k] * l1[0]; a[8 + 4 * i + 1] += w[r][k] * l1[1]; a[8 + 4 * i + 2] += w[r][k] * h1[0]; a[8 + 4 * i + 3] += w[r][k] * h1[1]; }
            const float* mb = mod + (size_t)(m / SEQ) * 6144 + 5120; float ss = 0.f; f32x4 v[4];
#pragma unroll
            for (int q = 0; q < 4; ++q) { const int col = (q >> 1) * 512 + 8 * lane + 4 * (q & 1); const f32x4 gt = *(const f32x4*)(mb + col);
#pragma unroll
                for (int i = 0; i < 4; ++i) { v[q][i] = xv[r][q][i] + gt[i] * a[(q >> 1) * 8 + 4 * (q & 1) + i]; ss += v[q][i] * v[q][i]; } }
            const float rstd = __builtin_amdgcn_rsqf(wave_sum(ss) * (1.f / DM) + EPS);
#pragma unroll
            for (int q = 0; q < 4; ++q) { const int col = (q >> 1) * 512 + 8 * lane + 4 * (q & 1); const f32x4 fg = *(const f32x4*)(F.in[IN_FG] + col);
                *(f32x4*)(F.out + (size_t)m * DM + col) = v[q] * rstd * fg; } }
    }
}
__device__ __forceinline__ void dbg_final(Frame& F, const float* src) {
    const int gw = F.vcu * NWAVES + F.wave, NGW = F.G * NWAVES;
    for (int m = gw; m < T; m += NGW) {
        const f32x4* xr = (const f32x4*)(src + (size_t)m * DM) + F.lane; f32x4 v[4]; float s = 0.f;
#pragma unroll
        for (int j = 0; j < 4; ++j) { v[j] = xr[64 * j]; s += (v[j][0] * v[j][0] + v[j][1] * v[j][1]) + (v[j][2] * v[j][2] + v[j][3] * v[j][3]); }
        const float rstd = __builtin_amdgcn_rsqf(wave_sum(s) * (1.f / DM) + EPS);
#pragma unroll
        for (int j = 0; j < 4; ++j) { const int col = 4 * (F.lane + 64 * j); *(f32x4*)(F.out + (size_t)m * DM + col) = v[j] * rstd * *(const f32x4*)(F.in[IN_FG] + col); }
    }
}


__device__ __forceinline__ void dbg_dump_bf16(Frame& F, const bf16_t* src, int ld, int c0, int n) {
    for (size_t i = (size_t)blockIdx.x * NWAVES * 64 + F.tid; i < (size_t)T * n; i += (size_t)F.G * NWAVES * 64) { const size_t t = i / n; const int c = (int)(i % n); F.out[t * DM + c0 + c] = bf2f(src[t * ld + c]); }
}
#define DBG_DUMP(k, ...) do { if (DBG_STAGE == (k)) { xcd_barrier(bar); __VA_ARGS__; return; } } while (0)
#ifndef DBG_STAGE
#define DBG_STAGE (-1)
#endif

constexpr int N_PHASES = 13;
struct Args { const float* in[N_IN]; float* out; unsigned char* ws; int ph_lo, ph_hi; };
__global__ void __launch_bounds__(NWAVES * 64, 2) fwd_kernel(Args args) {
    extern __shared__ __attribute__((aligned(16))) unsigned char lds[];
    Frame F;
    F.lds = (LAS unsigned char*)lds; F.MISC = (volatile LAS unsigned*)(F.lds + MISC_OFF);
    F.tid = threadIdx.x; F.lane = F.tid & 63; F.wave = __builtin_amdgcn_readfirstlane(F.tid >> 6);
    F.G = gridDim.x; { const int bx = blockIdx.x; F.vcu = (F.G % 8 == 0) ? (bx % 8) * (F.G / 8) + bx / 8 : bx; }
    F.ws = args.ws; F.ctl = (unsigned*)(args.ws + WS_CTL); F.out = args.out;
#pragma unroll
    for (int i = 0; i < N_IN; ++i) F.in[i] = args.in[i];
    for (int u = F.tid; u < (LDS_BYTES - MISC_OFF) / 4; u += NWAVES * 64) ((LAS unsigned*)(F.lds + MISC_OFF))[u] = 0u;
    __syncthreads();
    XcdBarrier bar; bar.bar = F.ctl + CW_BAR; bar.x = 0; bar.st = nullptr;
    if (!N_LAUNCH_PER_PHASE) bar = xcd_barrier_post(F.ctl + CW_BAR, F.MISC + 8);
    const int lo = args.ph_lo, hi = args.ph_hi;
#ifndef REP_PHASE
#define REP_PHASE (-1)
#endif
#define NREP(k) ((REP_PHASE == (k)) ? 2 : 1)
#define REPLOOP(k) _Pragma("unroll") for (int rep = 0; rep < NREP(k); ++rep)
#ifndef PH_MASK
#define PH_MASK 0xFFFFu
#endif
#define IN(k) ((((PH_MASK) >> (k)) & 1u) && lo <= (k) && (k) < hi)
#ifndef TPROBE
#define TPROBE (-2)
#endif
    unsigned long long tp0 = (TPROBE == 0) ? __builtin_amdgcn_s_memrealtime() : 0ull, tpd = 0ull;
#define SEAM(k) do { if (IN(k) && IN((k) + 1)) xcd_barrier(bar); if (TPROBE == (k)) tpd = __builtin_amdgcn_s_memrealtime() - tp0; if (TPROBE == (k) + 1) tp0 = __builtin_amdgcn_s_memrealtime(); } while (0)

#if defined(DBG_BASE)
    dbg_final(F, F.in[IN_X]); return;
#endif
    if (IN(0)) REPLOOP(0) { p0_mod(F); __syncthreads(); p0_weights(F); __syncthreads(); }
    SEAM(0);
    if (IN(1)) REPLOOP(1) norm_rows(F, F.in[IN_X], F.in[IN_N1G], 0, 1024, WSP(bf16_t, WS_H));
    SEAM(1);
    if (IN(2)) REPLOOP(2) {
        pg::Gemm g{WSP(bf16_t, WS_H), WSP(bf16_t, WS_WIN), DM * 2, DM * 2, nullptr}; pg::StaticOrder S; S.init(T, NPROJ, F.G, (int)blockIdx.x);
        EpiProj E{WSP(bf16_t, WS_PROJ)};
        pg::gemm_phase<EpiProj, pg::StaticOrder, false, true>(F.lds, g, S, E);
    }
    DBG_DUMP(2, dbg_dump_bf16(F, WSP(bf16_t, WS_PROJ), NPROJ, 0, 1024));
    SEAM(2);
    if (IN(3)) REPLOOP(3) p3a_rows(F);
    SEAM(3);
    if (IN(4)) REPLOOP(4) {
#ifndef NO_QG
        { pg::Gemm g{WSP(bf16_t, WS_PROJ) + C_QLAT, WSP(bf16_t, WS_WQ), NPROJ * 2, QLORA * 2, nullptr}; pg::StaticOrder S; S.init(T, 768, F.G, (int)blockIdx.x);
          EpiQ E{WSP(bf16_t, WS_Q), WSP(float, WS_RSQ), WSP(float, WS_CS), 0.10206207261596575f * 1.4426950408889634f};
          pg::gemm_phase<EpiQ, pg::StaticOrder, false, true>(F.lds, g, S, E); }
#endif
#ifndef NO_KVG
        { pg::Gemm g{WSP(bf16_t, WS_PROJ) + C_KVLAT, WSP(bf16_t, WS_WKV), NPROJ * 2, KVLORA * 2, nullptr}; pg::StaticOrder S; S.init(T, 1024, F.G, (int)(F.G - 1 - blockIdx.x));
          EpiKV E{WSP(bf16_t, WS_K), WSP(bf16_t, WS_V), WSP(float, WS_RSKV)};
          pg::gemm_phase<EpiKV, pg::StaticOrder, false, true>(F.lds, g, S, E); }
#endif
    }
    DBG_DUMP(4, dbg_dump_bf16(F, WSP(bf16_t, WS_Q), 768, 0, 768); dbg_dump_bf16(F, WSP(bf16_t, WS_K), 768, 768, 256));
    SEAM(4);
    unsigned long long g1acc = 0ull;
    if (IN(5)) REPLOOP(5) { for (int u = blockIdx.x; u < BATCH * GH * NCH / 4; u += F.G) g1_unit(F, u, g1acc); }
    if (G1PROBE >= 0) tpd = g1acc;
    SEAM(5);
#ifndef NCONV
#define NCONV 40
#endif
    if (IN(6)) {
        if (F.tid == 0) F.MISC[17] = __hip_atomic_fetch_add(F.ctl + CW_Q + 320, 1u, RLX_AGENT);
        for (;;) {
            if (F.tid == 0) F.MISC[16] = __hip_atomic_fetch_add(F.ctl + CW_Q, 1u, RLX_AGENT);
            __syncthreads();
            const int item = (int)F.MISC[16];
            __syncthreads();
            if (item >= 32) break;
            g2_item(F, item);
        }
        const int ticket = (int)F.MISC[17];
#define CONV_LOOP() for (;;) { if (F.tid == 0) F.MISC[16] = __hip_atomic_fetch_add(F.ctl + CW_Q + 256, 1u, RLX_AGENT); __syncthreads(); const int item = (int)F.MISC[16]; __syncthreads(); \
            if (item >= MOE_CONV_ITEMS) break; moe_conv_item(F, item); }
        if (ticket >= 32 && ticket < 32 + NCONV) CONV_LOOP();
        for (;;) {
            if (F.tid == 0) F.MISC[16] = __hip_atomic_fetch_add(F.ctl + CW_Q + 64, 1u, RLX_AGENT);
            __syncthreads();
            const int item = (int)F.MISC[16];
            __syncthreads();
            if (item >= BATCH * NH * 16) break;
            const int qb = 15 - (item >> 6), bh = item & 63; attn_unit(F, bh >> 3, bh & 7, qb);
        }
        CONV_LOOP();
#undef CONV_LOOP
    }
    DBG_DUMP(6, dbg_dump_bf16(F, WSP(bf16_t, DBG_SUB ? WS_OG : WS_OA), 512, 0, 512); dbg_dump_bf16(F, WSP(bf16_t, DBG_SUB ? WS_OG : WS_OA), 512, 512, 512));
    SEAM(6);
    if (IN(7)) REPLOOP(7) p4b_rows(F);
    SEAM(7);
    if (IN(8)) REPLOOP(8) {
        pg::Gemm g{WSP(bf16_t, WS_H), WSP(bf16_t, WS_WO), DM * 2, DM * 2, nullptr}; pg::StaticOrder S; S.init(T, DM, F.G, (int)blockIdx.x);
        EpiX1 E{F.in[IN_X], WSP(float, WS_MOD), WSP(float, WS_X1)};
        pg::gemm_phase<EpiX1, pg::StaticOrder, false, true>(F.lds, g, S, E);
    }
#if defined(DBG_STOP_X1)
    xcd_barrier(bar); dbg_final(F, WSP(float, WS_X1)); return;
#endif
    SEAM(8);
    if (IN(9)) REPLOOP(9) { p6_router(F, rep); __syncthreads(); }
    SEAM(9);
    if (IN(10)) REPLOOP(10) {
        moe_tables(F);
        pg::Gemm g{WSP(unsigned char, WS_H), WSP(unsigned char, WS_WGU), DM, DM, WSP(int, WS_LIST)};
#if defined(EPIPROBE) && EPIPROBE == 10
        g.tacc = &tpd;
#endif
        pg::MoeOrder S{(const LAS int*)(F.lds + MISC_OFF) + 128, (const LAS int*)(F.lds + MISC_OFF) + 192, 8, 2048, F.G, (int)blockIdx.x, 0};
        EpiGU E{WSP(unsigned char, WS_ACT), F.in[IN_BGU]};
        pg::gemm_phase<EpiGU, pg::MoeOrder, true, true, true>(F.lds, g, S, E);
    }
    SEAM(10);
    if (IN(11)) REPLOOP(11) {
        moe_tables(F);
        pg::Gemm g{WSP(unsigned char, WS_ACT), WSP(unsigned char, WS_WDN), DE, DE, nullptr};
#if defined(EPIPROBE) && EPIPROBE == 11
        g.tacc = &tpd;
#endif
        pg::MoeOrder S{(const LAS int*)(F.lds + MISC_OFF) + 128, (const LAS int*)(F.lds + MISC_OFF) + 192, 4, 1024, F.G, (int)blockIdx.x, 1};
        EpiDN E{WSP(unsigned char, WS_Y), F.in[IN_BDN]};
        pg::gemm_phase<EpiDN, pg::MoeOrder, false, true, true>(F.lds, g, S, E);
    }
    SEAM(11);
    if (IN(12)) REPLOOP(12) { moe_tables(F); p10_combine(F); }
#ifdef EPIPROBE
    const bool epiprobe_ = true;
#else
    const bool epiprobe_ = false;
#endif
    if (TPROBE >= 0 || G1PROBE >= 0 || epiprobe_) { if (TPROBE == 12) { VM_WAIT(); tpd = __builtin_amdgcn_s_memrealtime() - tp0; }
        if (blockIdx.x == 0) { const unsigned long long t_ = __builtin_amdgcn_s_memrealtime(); while (__builtin_amdgcn_s_memrealtime() - t_ < 10ull * tpd) __builtin_amdgcn_s_sleep(8); } }
#undef IN
#undef SEAM
}

extern "C" void kernel_launch(void* const* d_in, const int* in_sizes, int n_in, void* d_out, int out_size, void* d_ws, size_t ws_size, hipStream_t stream) {
    static int grid = 0;
    if (grid == 0) {
        if (n_in != N_IN || out_size != T * DM || ws_size < WS_END) { fprintf(stderr, "kernel_launch: unexpected shapes (n_in %d, out %d, ws %zu)\n", n_in, out_size, ws_size); grid = -1; return; }
        int dev = 0, cus = 0;
        if (hipGetDevice(&dev) != hipSuccess || hipDeviceGetAttribute(&cus, hipDeviceAttributeMultiprocessorCount, dev) != hipSuccess) { grid = -1; return; }
        if (hipFuncSetAttribute((const void*)fwd_kernel, hipFuncAttributeMaxDynamicSharedMemorySize, LDS_BYTES) != hipSuccess) { grid = -1; return; }
        int per_cu = 0;
        if (hipOccupancyMaxActiveBlocksPerMultiprocessor(&per_cu, (const void*)fwd_kernel, NWAVES * 64, LDS_BYTES) != hipSuccess || per_cu < 1) fprintf(stderr, "kernel_launch: occupancy query says %d\n", per_cu);
        (void)hipGetLastError();
        grid = cus;
        while (grid > 8 && (T % grid) != 0) grid -= 8;
    }
    if (grid < 0) return;
    (void)hipMemsetAsync((char*)d_ws + WS_CTL, 0, CTL_BYTES, stream);
    Args a{};
    for (int i = 0; i < N_IN; ++i) a.in[i] = (const float*)d_in[i];
    a.out = (float*)d_out; a.ws = (unsigned char*)d_ws;
#if N_LAUNCH_PER_PHASE
    for (int p = 0; p < N_PHASES; ++p) { a.ph_lo = p; a.ph_hi = p + 1; hipLaunchKernelGGL(fwd_kernel, dim3(grid), dim3(NWAVES * 64), LDS_BYTES, stream, a); }
#else
    a.ph_lo = 0; a.ph_hi = N_PHASES;
    hipLaunchKernelGGL(fwd_kernel, dim3(grid), dim3(NWAVES * 64), LDS_BYTES, stream, a);
#endif
}
```

```cpp
#include <hip/hip_runtime.h>
#include <cstdio>
#include <cstdint>


#define DBG_SUB 0
#ifndef N_LAUNCH_PER_PHASE
#define N_LAUNCH_PER_PHASE 0
#endif

#define GAS __attribute__((address_space(1)))
#define LAS __attribute__((address_space(3)))
typedef unsigned short bf16_t;
typedef short bf16x8 __attribute__((ext_vector_type(8)));
typedef short s16x4 __attribute__((ext_vector_type(4)));
typedef float f32x4 __attribute__((ext_vector_type(4)));
typedef float f32x2 __attribute__((ext_vector_type(2)));
typedef float f32x16 __attribute__((ext_vector_type(16)));
typedef unsigned u32x4 __attribute__((ext_vector_type(4)));
typedef unsigned u32x2 __attribute__((ext_vector_type(2)));
typedef __bf16 bf16x2_t __attribute__((ext_vector_type(2)));
typedef int i32x4q __attribute__((ext_vector_type(4)));

constexpr int BATCH = 8, SEQ = 4096, DM = 1024, T = BATCH * SEQ;
constexpr int NH = 8, QK = 96, NOPE = 64, ROPE = 32, VD = 64, QLORA = 384, KVLORA = 256;
constexpr int GH = 8, GDK = 64, GDV = 64;
constexpr int IN_DIM = 2736, NPROJ = 2816;
constexpr int C_QLAT = 0, C_KVLAT = 384, C_KPE = 640, C_GQ = 672, C_GK = 1184, C_GV = 1696, C_GZ = 2208, C_GA = 2720, C_GB = 2728;
constexpr int NE = 32, TOPK = 4, DE = 1024;
constexpr float EPS = 1e-6f;
constexpr float W8 = 32.0f;
constexpr int GC = 32, NCH = SEQ / GC;
constexpr int MAXROWS = T * TOPK + NE * 256;

constexpr size_t MiB = 1u << 20;
constexpr size_t WS_CTL = 0, CTL_BYTES = 1 * MiB;
constexpr size_t WS_MOD = 1 * MiB;
constexpr size_t WS_RSQ = 2 * MiB;
constexpr size_t WS_RSKV = WS_RSQ + 128 * 1024;
constexpr size_t WS_CS = 3 * MiB;
constexpr size_t WS_TKE = 7 * MiB;
constexpr size_t WS_TKW = WS_TKE + 512 * 1024;
constexpr size_t WS_TKP = WS_TKW + 512 * 1024;
constexpr size_t WS_LIST = 9 * MiB;
constexpr size_t WS_RWT = 13 * MiB;
constexpr size_t WS_PART = 13 * MiB + 256 * 1024;
constexpr size_t WS_WIN = 16 * MiB;
constexpr size_t WS_WQ = WS_WIN + (size_t)NPROJ * DM * 2;
constexpr size_t WS_WKV = WS_WQ + (size_t)768 * 384 * 2;
constexpr size_t WS_WO = WS_WKV + (size_t)1024 * 256 * 2;
constexpr size_t WS_WGU = 32 * MiB;
constexpr size_t WS_WDN = WS_WGU + (size_t)NE * 2048 * 1024 * 2;
constexpr size_t WS_H = 224 * MiB;
constexpr size_t WS_X1 = 288 * MiB;
constexpr size_t WS_PROJ = 416 * MiB;
constexpr size_t WS_Q = 592 * MiB;
constexpr size_t WS_K = 640 * MiB;
constexpr size_t WS_V = 688 * MiB;
constexpr size_t WS_OA = 720 * MiB;
constexpr size_t WS_OG = 752 * MiB;
constexpr size_t WS_GD = 784 * MiB;
constexpr size_t WS_ACT = 416 * MiB;
constexpr size_t WS_Y = 688 * MiB;
constexpr size_t WS_END = 976 * MiB;
static_assert(WS_WO + (size_t)1024 * 1024 * 2 <= WS_WGU && WS_WDN + (size_t)NE * 1024 * 1024 * 2 <= WS_H, "weights");
static_assert(WS_ACT + (size_t)MAXROWS * 1024 * 2 <= WS_Y && WS_Y + (size_t)MAXROWS * 1024 * 2 <= WS_END, "moe rows");
static_assert(WS_GD + (size_t)BATCH * GH * NCH * 24576 <= WS_END, "gdn");
constexpr int CW_BAR = 4096;
constexpr int CW_Q = 8192;
constexpr int CW_CNT = 12288;

constexpr int RING_BYTES = 131072;
constexpr int MISC_OFF = RING_BYTES;
constexpr int LDS_BYTES = 147456;

#define LDS_WAIT() asm volatile("s_waitcnt lgkmcnt(0)" ::: "memory")
#define LBAR() asm volatile("s_waitcnt lgkmcnt(0)\n\ts_barrier" ::: "memory")
#define VM_WAIT() asm volatile("s_waitcnt vmcnt(0)" ::: "memory")
#define RLX_AGENT __ATOMIC_RELAXED, __HIP_MEMORY_SCOPE_AGENT

__device__ __forceinline__ unsigned cvtpk(float lo, float hi) { f32x2 v = {lo, hi}; bf16x2_t b = __builtin_convertvector(v, bf16x2_t); return __builtin_bit_cast(unsigned, b); }
__device__ __forceinline__ bf16_t f2bf(float f) { return (bf16_t)(cvtpk(f, 0.f) & 0xffffu); }
__device__ __forceinline__ float bf2f(unsigned short h) { return __uint_as_float((unsigned)h << 16); }
__device__ __forceinline__ float bflo(unsigned w) { return __uint_as_float(w << 16); }
__device__ __forceinline__ float bfhi(unsigned w) { return __uint_as_float(w & 0xffff0000u); }
__device__ __forceinline__ float wave_sum(float v) {
#pragma unroll
    for (int o = 1; o < 64; o <<= 1) v += __shfl_xor(v, o);
    return v;
}
__device__ __forceinline__ unsigned pk4_fp8(float a, float b, float c, float d) { int w = 0; w = __builtin_amdgcn_cvt_pk_fp8_f32(a, b, w, false); w = __builtin_amdgcn_cvt_pk_fp8_f32(c, d, w, true); return (unsigned)w; }
__device__ __forceinline__ float siluf(float x) { return x / (1.f + __expf(-x)); }

#define XB_TMO      128
#define XB_XCNT(j)  (256  + 64 * (j))
#define XB_XSUB(j)  (1280 + 64 * (j))
#define XB_XGEN(j)  (2304 + 64 * (j))
#define XB_TOP      3328
#define XB_TOPGEN   3392
#define XCD_BAR_WORDS 3456
#define XB_SPIN_CAP (1u << 18)
__device__ __forceinline__ unsigned xb_ld(unsigned* p)              { return __hip_atomic_load(p, __ATOMIC_RELAXED, __HIP_MEMORY_SCOPE_AGENT); }
__device__ __forceinline__ unsigned xb_add(unsigned* p, unsigned v) { return __hip_atomic_fetch_add(p, v, __ATOMIC_RELAXED, __HIP_MEMORY_SCOPE_AGENT); }
__device__ __forceinline__ unsigned xb_xcc_id() { return (unsigned)__builtin_amdgcn_s_getreg((3 << 11) | 20) & 0xFu; }
#define XB_SPIN(cond, bar) do { unsigned _sp = 0; while (cond) { __builtin_amdgcn_s_sleep(1); \
    if ((++_sp & 255u) == 0u) { if (xb_ld(&(bar)[XB_TMO])) break; if (_sp > XB_SPIN_CAP) { atomicAdd(&(bar)[XB_TMO], 1u); break; } } } } while (0)
struct XcdBarrier { unsigned* bar; unsigned x; volatile LAS unsigned* st; };
__device__ __forceinline__ XcdBarrier xcd_barrier_post(unsigned* bar, volatile LAS unsigned* st) {
    XcdBarrier b; b.bar = bar; b.x = xb_xcc_id(); b.st = st;
    if (threadIdx.x == 0) (void)xb_add(&bar[XB_XCNT(b.x)], 1u);
    return b;
}
__device__ __forceinline__ void xcd_barrier_complete(unsigned* bar, unsigned x, unsigned& nloc, unsigned& nx) {
    const unsigned G = gridDim.x * gridDim.y * gridDim.z;
    unsigned sum, cnt, mine, sp = 0u;
    for (;;) {
        sum = 0u; cnt = 0u; mine = 0u;
#pragma unroll
        for (unsigned j = 0; j < 16; ++j) { const unsigned c = xb_ld(&bar[XB_XCNT(j)]); sum += c; cnt += (c > 0u) ? 1u : 0u; mine = (j == x) ? c : mine; }
        if (sum == G) break;
        __builtin_amdgcn_s_sleep(1);
        if ((++sp & 255u) == 0u) { if (xb_ld(&bar[XB_TMO])) break; if (sp > XB_SPIN_CAP) { atomicAdd(&bar[XB_TMO], 1u); break; } }
    }
    nloc = mine > 0u ? mine : 1u; nx = cnt > 0u ? cnt : 1u;
}
__device__ __forceinline__ void xcd_barrier(const XcdBarrier& b) {
    asm volatile("s_waitcnt vmcnt(0)" ::: "memory");
    __syncthreads();
    if (threadIdx.x == 0) {
        unsigned* bar = b.bar;
        __builtin_amdgcn_s_waitcnt(0);
        unsigned nloc = b.st[0], nx = b.st[1];
        if (nloc == 0u) { xcd_barrier_complete(bar, b.x, nloc, nx); b.st[0] = nloc; b.st[1] = nx; }
        const unsigned old = xb_add(&bar[XB_XSUB(b.x)], 1u);
        const unsigned gen = old / nloc;
        if (old + 1u == (gen + 1u) * nloc) {
            __builtin_amdgcn_fence(__ATOMIC_RELEASE, "agent");
            asm volatile("s_waitcnt vmcnt(0)" ::: "memory");
            const unsigned og = xb_add(&bar[XB_TOP], 1u);
            const unsigned tg = og / nx;
            if (og + 1u == (tg + 1u) * nx) xb_add(&bar[XB_TOPGEN], 1u);
            else XB_SPIN(xb_ld(&bar[XB_TOPGEN]) == tg, bar);
            __builtin_amdgcn_fence(__ATOMIC_ACQUIRE, "agent");
            xb_add(&bar[XB_XGEN(b.x)], 1u);
            asm volatile("s_waitcnt vmcnt(0)" ::: "memory");
        } else {
            XB_SPIN(xb_ld(&bar[XB_XGEN(b.x)]) == gen, bar);
            __builtin_amdgcn_fence(__ATOMIC_ACQUIRE, "agent");
            asm volatile("s_waitcnt vmcnt(0)" ::: "memory");
        }
    }
    __syncthreads();
}

namespace pg {
constexpr int BM = 256, BK = 64, HALF = 128, HTB = HALF * BK * 2, STAGE_BYTES = 8 * HTB, NXCD = 8, WGM = 8;
__host__ __device__ __forceinline__ int lds_byte(int r, int c) { const int st = (r >> 4) * 2 + (c >> 5), rr = r & 15, cc = c & 31, ob = rr * 64 + cc * 2; return st * 1024 + (ob ^ (((ob >> 9) & 1) << 5)); }
__host__ __device__ __forceinline__ void stage_rc(int b, int& R, int& C) { const int st = b / 1024, sb = b % 1024, swz = sb ^ (((sb >> 9) & 1) << 5); R = (st >> 1) * 16 + swz / 64; C = (st & 1) * 32 + (swz % 64) / 2; }
__host__ __device__ __forceinline__ int perm32(int rho) { const int n = rho >> 4, i = rho & 15; return 8 * (i >> 2) + 4 * n + (i & 3); }

struct Unit { int pm, pn, arow, brow, nvalid, e; };
struct Gemm { const void* A; const void* Bt; int lda, K; const int* list; unsigned long long* tacc = nullptr; };

struct StaticOrder {
    int nM, nN, nwg, G, c;
    __device__ __forceinline__ void init(int M, int N, int G_, int c_) { nM = M / BM; nN = N / BM; nwg = nM * nN; G = G_; c = c_; }
    __device__ __forceinline__ bool next(int i, Unit& u) const {
        const long L = (long)i * G + c; if (L >= nwg) return false;
        int wgid = (int)L; { const int q = nwg / NXCD, r = nwg % NXCD, xcd = wgid % NXCD, off = wgid / NXCD; wgid = (xcd < r ? xcd * (q + 1) : r * (q + 1) + (xcd - r) * q) + off; }
        const int nig = WGM * nN, gid = wgid / nig, fm = gid * WGM, gsz = (nM - fm) < WGM ? (nM - fm) : WGM;
        u.pm = fm + ((wgid % nig) % gsz); u.pn = (wgid % nig) / gsz; u.arow = u.pm * BM; u.brow = u.pn * BM; u.nvalid = BM; u.e = 0; return true;
    }
};
struct MoeOrder {
    const LAS int* pre;
    const LAS int* cnt;
    int NT, Nrows, G, c, contig;
    __device__ __forceinline__ bool next(int i, Unit& u) const {
        const int xcd = c & 7, j = c >> 3, q = i * (G >> 3) + j, mq = q / NT, nt = q - mq * NT, mt = mq * 8 + xcd;
        if (mt >= pre[32]) return false;
        const int e = pre[2176 + mt];
        const int row0 = (mt - pre[e]) * BM;
        u.pm = mt; u.pn = nt; u.e = e; u.nvalid = cnt[e] - row0; u.arow = contig ? mt * BM : row0; u.brow = e * Nrows + nt * BM; return true;
    }
};

__device__ __forceinline__ void glds16s(const void* sbase, unsigned voff, unsigned ldsdst) { unsigned keep;
    asm volatile("s_mov_b32 %0, m0\n\ts_mov_b32 m0, %3\n\ts_nop 0\n\tglobal_load_lds_dwordx4 %1, %2\n\ts_mov_b32 m0, %0" : "=&s"(keep) : "v"(voff), "s"(sbase), "s"(ldsdst) : "memory"); }
typedef int i32x8 __attribute__((ext_vector_type(8)));
typedef int i32x4 __attribute__((ext_vector_type(4)));
template <class Epi, class Sched, bool GATHER, bool ALIGN_EPI, bool FP8 = false>
__device__ __forceinline__ void gemm_phase(LAS unsigned char* lds, const Gemm g, const Sched& S, const Epi& E) {
    const int tid = threadIdx.x, wid = __builtin_amdgcn_readfirstlane(tid >> 6), lane = tid & 63, wr = wid >> 2, wc = wid & 3, fr = lane & 15, fq = lane >> 4;
    const int K = g.K, nt = K / (BK * 2), lda = g.lda;
    unsigned voffB[2], voffA[2];
#pragma unroll
    for (int i = 0; i < 2; ++i) { int R, C; stage_rc(tid * 16 + i * 8192, R, C); const int Rb = Epi::PERM ? ((R & ~31) + perm32(R & 31)) : R; voffB[i] = (unsigned)(Rb * K + C * 2); voffA[i] = (unsigned)(R * lda + C * 2); }
    const size_t kstep = (size_t)(BK * 2);
    const size_t hstep = (size_t)HALF * K;
    const unsigned ldsw = (unsigned)wid * 1024u;
    const unsigned ldsa = (unsigned)__builtin_amdgcn_readfirstlane((int)((unsigned)(uintptr_t)lds + ldsw));
    const int aoff = lds_byte(wr * 64 + fr, fq * 8), boff = lds_byte(wc * 32 + fr, fq * 8);
#define PG_SA(b, h) (((b) * 2 + (h)) * HTB)
#define PG_SB(b, h) ((4 + (b) * 2 + (h)) * HTB)
#define PG_STAGE(bufoff, gbase, voff) do { _Pragma("unroll") for (int _i = 0; _i < 2; ++_i) \
        glds16s((const void*)(gbase), (voff)[_i], ldsa + (unsigned)(bufoff) + (unsigned)(_i * 8192)); } while (0)
#define PG_LDA(dst, b, h) do { _Pragma("unroll") for (int m = 0; m < 4; ++m) { if constexpr (FP8) { dst##8[m] = __builtin_shufflevector(*(const LAS i32x4*)(lds + PG_SA(b, h) + aoff + m * 2048), *(const LAS i32x4*)(lds + PG_SA(b, h) + aoff + m * 2048 + 1024), 0, 1, 2, 3, 4, 5, 6, 7); } \
        else { _Pragma("unroll") for (int k = 0; k < 2; ++k) dst[m][k] = *(const LAS bf16x8*)(lds + PG_SA(b, h) + aoff + m * 2048 + k * 1024); } } } while (0)
#define PG_LDB(dst, b, h) do { _Pragma("unroll") for (int n = 0; n < 2; ++n) { if constexpr (FP8) { dst##8[n] = __builtin_shufflevector(*(const LAS i32x4*)(lds + PG_SB(b, h) + boff + n * 2048), *(const LAS i32x4*)(lds + PG_SB(b, h) + boff + n * 2048 + 1024), 0, 1, 2, 3, 4, 5, 6, 7); } \
        else { _Pragma("unroll") for (int k = 0; k < 2; ++k) dst[n][k] = *(const LAS bf16x8*)(lds + PG_SB(b, h) + boff + n * 2048 + k * 1024); } } } while (0)
#define PG_MMA(ai, bj, At, Bt) do { __builtin_amdgcn_s_setprio(1); if constexpr (FP8) { _Pragma("unroll") for (int m = 0; m < 4; ++m) _Pragma("unroll") for (int n = 0; n < 2; ++n) \
        asm volatile("v_mfma_scale_f32_16x16x128_f8f6f4 %0, %1, %2, %0, %3, %3 op_sel_hi:[0,0,0]" : "+v"(acc[ai][bj][m][n]) : "v"(Bt##8[n]), "v"(At##8[m]), "v"(scl1)); } \
        else { _Pragma("unroll") for (int m = 0; m < 4; ++m) _Pragma("unroll") for (int n = 0; n < 2; ++n) _Pragma("unroll") for (int k = 0; k < 2; ++k) \
        acc[ai][bj][m][n] = __builtin_amdgcn_mfma_f32_16x16x32_bf16(Bt[n][k], At[m][k], acc[ai][bj][m][n], 0, 0, 0); } __builtin_amdgcn_s_setprio(0); } while (0)
#define PG_WAIT_V(n) asm volatile("s_waitcnt vmcnt(" #n ")" ::: "memory")
#define PG_WAIT_L(n) asm volatile("s_waitcnt lgkmcnt(" #n ")" ::: "memory")
#define PG_BAR __builtin_amdgcn_s_barrier()
#define PG_SCHED __builtin_amdgcn_sched_barrier(0)
#define PG_SETA(v, u) do { _Pragma("unroll") for (int _h = 0; _h < 2; ++_h) _Pragma("unroll") for (int _i = 0; _i < 2; ++_i) { int _R, _C; stage_rc(tid * 16 + _i * 8192, _R, _C); const int _r = _h * HALF + _R; \
        const int _rr = _r < (u).nvalid ? _r : (u).nvalid - 1; const int _tok = g.list[(size_t)(u).e * T + (u).arow + _rr]; v[_h][_i] = (unsigned)(_tok * lda + _C * 2); } } while (0)
#define PG_STA(bufoff, kb, h, NX) do { if constexpr (GATHER) { unsigned _vs[2]; _vs[0] = (NX) ? vN[h][0] : vA[h][0]; _vs[1] = (NX) ? vN[h][1] : vA[h][1]; PG_STAGE(bufoff, (const char*)g.A + (kb), _vs); } \
        else PG_STAGE(bufoff, ((NX) ? nA : cA) + (kb) + (h) * hstepA, voffA); } while (0)
    Unit cur, nxt; int ui = 0;
    if (!S.next(0, cur)) return;
    f32x4 acc[2][2][4][2];
#pragma unroll
    for (int a = 0; a < 2; ++a)
#pragma unroll
        for (int b = 0; b < 2; ++b)
#pragma unroll
            for (int m = 0; m < 4; ++m)
#pragma unroll
                for (int n = 0; n < 2; ++n) acc[a][b][m][n] = (f32x4){0.f, 0.f, 0.f, 0.f};
    const int scl1 = 0x7F7F7F7F;
    bf16x8 At[4][2], B0[2][2], B1[2][2]; i32x8 At8[4], B08[2], B18[2];
    unsigned vN[2][2] = {{0u, 0u}, {0u, 0u}};
    unsigned vA[2][2];
    LAS u32x4* const vnl = (LAS u32x4*)(lds + STAGE_BYTES + 1024) + tid;
    const size_t hstepA = (size_t)HALF * lda;
    if constexpr (GATHER) { PG_SETA(vA, cur); PG_WAIT_V(0); }
    const char* cA = (const char*)g.A + (GATHER ? (size_t)0 : (size_t)cur.arow * lda); const char* nA = cA;
    const char* cB = (const char*)g.Bt + (size_t)cur.brow * K;
    PG_STAGE(PG_SB(0, 0), cB, voffB); PG_STAGE(PG_SB(0, 1), cB + hstep, voffB); PG_STA(PG_SA(0, 0), 0, 0, false); PG_STA(PG_SA(0, 1), 0, 1, false);
    if (wr == 1) PG_BAR;
    PG_WAIT_V(2); PG_BAR;
    PG_STAGE(PG_SB(1, 0), cB + kstep, voffB); PG_STA(PG_SA(1, 0), kstep, 0, false); PG_STAGE(PG_SB(1, 1), cB + hstep + kstep, voffB);
    PG_WAIT_V(6); PG_BAR;
    for (;;) {
        const bool has_next = S.next(ui + 1, nxt);
        if constexpr (GATHER) {
            unsigned vT[2][2];
            if (has_next) { PG_SETA(vT, nxt); PG_WAIT_V(0); }
            else {
#pragma unroll
                for (int h = 0; h < 2; ++h)
#pragma unroll
                    for (int i = 0; i < 2; ++i) vT[h][i] = vA[h][i]; }
            *vnl = (u32x4){vT[0][0], vT[0][1], vT[1][0], vT[1][1]};
        } else nA = has_next ? (const char*)g.A + (size_t)nxt.arow * lda : cA;
        const char* nB = has_next ? (const char*)g.Bt + (size_t)nxt.brow * K : cB;
#pragma unroll 1
        for (int t = 0; t < nt; t += 2) {
            const bool last = (t == nt - 2);
            if constexpr (GATHER) { if (last) { const u32x4 q_ = *vnl; vN[0][0] = q_.x; vN[0][1] = q_.y; vN[1][0] = q_.z; vN[1][1] = q_.w; } else { vN[0][0] = vA[0][0]; vN[0][1] = vA[0][1]; vN[1][0] = vA[1][0]; vN[1][1] = vA[1][1]; } }
            const size_t k1 = (size_t)(t + 1) * kstep, k2 = last ? (size_t)0 : (size_t)(t + 2) * kstep, k3 = k2 + kstep;
            const char* b2 = last ? nB : cB + (size_t)(t + 2) * kstep; const char* b3 = b2 + kstep;
            PG_LDB(B0, 0, 0); PG_LDB(B1, 0, 1); PG_SCHED; PG_LDA(At, 0, 0); PG_STA(PG_SA(1, 1), k1, 1, false);
            PG_WAIT_V(8); PG_WAIT_L(0); PG_BAR; PG_MMA(0, 0, At, B0); PG_MMA(0, 1, At, B1); PG_BAR; PG_SCHED;
            PG_LDA(At, 0, 1); PG_STAGE(PG_SB(0, 0), b2, voffB); PG_STAGE(PG_SB(0, 1), b2 + hstep, voffB); PG_STA(PG_SA(0, 0), k2, 0, last);
            PG_WAIT_V(8); PG_WAIT_L(0); PG_BAR; PG_MMA(1, 0, At, B0); PG_MMA(1, 1, At, B1); PG_BAR; PG_SCHED;
            PG_LDB(B0, 1, 0); PG_LDB(B1, 1, 1); PG_SCHED; PG_LDA(At, 1, 0); PG_STA(PG_SA(0, 1), k2, 1, last);
            PG_WAIT_V(8); PG_WAIT_L(0); PG_BAR; PG_MMA(0, 0, At, B0); PG_MMA(0, 1, At, B1); PG_BAR; PG_SCHED;
            PG_LDA(At, 1, 1); PG_STAGE(PG_SB(1, 0), b3, voffB); PG_STAGE(PG_SB(1, 1), b3 + hstep, voffB); PG_STA(PG_SA(1, 0), k3, 0, last);
            PG_WAIT_V(8); PG_WAIT_L(0); PG_BAR; PG_MMA(1, 0, At, B0); PG_MMA(1, 1, At, B1); PG_BAR; PG_SCHED;
        }
        if constexpr (ALIGN_EPI) { if (wr == 0) PG_BAR; }
        if constexpr (FP8) asm volatile("s_nop 15\n\ts_nop 15" ::: "memory");
#ifdef EPIPROBE
        const unsigned long long te0_ = __builtin_amdgcn_s_memrealtime();
#endif
        E(acc, cur, wr, wc, fr, fq);
#ifdef EPIPROBE
        if (g.tacc) { asm volatile("s_waitcnt vmcnt(0)" ::: "memory"); *g.tacc += __builtin_amdgcn_s_memrealtime() - te0_; }
#endif
        if (!has_next) break;
#pragma unroll
        for (int a = 0; a < 2; ++a)
#pragma unroll
            for (int b = 0; b < 2; ++b)
#pragma unroll
                for (int m = 0; m < 4; ++m)
#pragma unroll
                    for (int n = 0; n < 2; ++n) acc[a][b][m][n] = (f32x4){0.f, 0.f, 0.f, 0.f};
        cur = nxt; cB = nB; cA = nA; ++ui;
        if constexpr (GATHER) { const u32x4 q_ = *vnl; vA[0][0] = q_.x; vA[0][1] = q_.y; vA[1][0] = q_.z; vA[1][1] = q_.w; }
        if constexpr (ALIGN_EPI) { if (wr == 1) PG_BAR; }
    }
    PG_WAIT_V(0);
    if constexpr (!ALIGN_EPI) { if (wr == 0) PG_BAR; }
    PG_BAR;
#undef PG_SA
#undef PG_SB
#undef PG_STAGE
#undef PG_LDA
#undef PG_LDB
#undef PG_MMA
#undef PG_WAIT_V
#undef PG_WAIT_L
#undef PG_BAR
#undef PG_SCHED
#undef PG_SETA
#undef PG_STA
}
}

typedef f32x4 AccT[2][2][4][2];
__device__ __forceinline__ float ssq8(u32x4 a) { float s = 0.f;
#pragma unroll
    for (int i = 0; i < 4; ++i) { const float lo = bflo(a[i]), hi = bfhi(a[i]); s += lo * lo + hi * hi; } return s; }

__device__ __forceinline__ u32x4 pack8(f32x4 a, f32x4 b) { u32x4 w; w.x = cvtpk(a[0], a[1]); w.y = cvtpk(a[2], a[3]); w.z = cvtpk(b[0], b[1]); w.w = cvtpk(b[2], b[3]); return w; }

struct EpiProj {
    static constexpr bool PERM = true; bf16_t* O; float* part;
    __device__ __forceinline__ void operator()(const AccT& acc, const pg::Unit& u, int wr, int wc, int fr, int fq) const {
        const int row0 = u.pm * 256 + wr * 64 + fr, col0 = u.pn * 256 + wc * 32 + 8 * fq;
#pragma unroll
        for (int ai = 0; ai < 2; ++ai)
#pragma unroll
            for (int m = 0; m < 4; ++m) { const int row = row0 + ai * 128 + m * 16; bf16_t* rowp = O + (size_t)row * NPROJ + col0;
#pragma unroll
                for (int bj = 0; bj < 2; ++bj) { const u32x4 w = pack8(acc[ai][bj][m][0], acc[ai][bj][m][1]); *(u32x4*)(rowp + bj * 128) = w;
                    const int grp = 8 * u.pn + 4 * bj + wc;
                    if (grp < 20) {
                        float sq = ssq8(w); sq += __shfl_xor(sq, 16); sq += __shfl_xor(sq, 32);
                        if (fq == 0) part[(size_t)row * 20 + grp] = sq; } } }
    }
};
struct EpiQ {
    static constexpr bool PERM = true; bf16_t* O; const float* part; const float* cs; float scale;
    __device__ __forceinline__ void operator()(const AccT& acc, const pg::Unit& u, int wr, int wc, int fr, int fq) const {
        const int row0 = u.pm * 256 + wr * 64 + fr;
#pragma unroll
        for (int ai = 0; ai < 2; ++ai)
#pragma unroll
            for (int m = 0; m < 4; ++m) { const int row = row0 + ai * 128 + m * 16; const f32x4* pp = (const f32x4*)(part + (size_t)row * 20); const f32x4 s0 = pp[0], s1 = pp[1], s2 = pp[2];
                const float rs = __builtin_amdgcn_rsqf((((s0[0] + s0[1]) + (s0[2] + s0[3])) + ((s1[0] + s1[1]) + (s1[2] + s1[3])) + ((s2[0] + s2[1]) + (s2[2] + s2[3]))) * (1.f / QLORA) + EPS) * scale;
#pragma unroll
                for (int bj = 0; bj < 2; ++bj) { const int G = 8 * u.pn + 4 * bj + wc;
                    f32x4 v0 = acc[ai][bj][m][0] * rs, v1 = acc[ai][bj][m][1] * rs;
                    if ((G % 3) == 2) {
                        f32x4 p0, p1;
#pragma unroll
                        for (int j = 0; j < 4; ++j) { p0[j] = __shfl_xor(v0[j], 32); p1[j] = __shfl_xor(v1[j], 32); }
                        const float* cr = cs + (size_t)row * 32 + 8 * (fq & 1);
                        const f32x4 c0 = *(const f32x4*)cr, c1 = *(const f32x4*)(cr + 4), s0 = *(const f32x4*)(cr + 16), s1 = *(const f32x4*)(cr + 20);
                        if (fq < 2) { v0 = v0 * c0 - p0 * s0; v1 = v1 * c1 - p1 * s1; } else { v0 = v0 * c0 + p0 * s0; v1 = v1 * c1 + p1 * s1; }
                    }
                    *(u32x4*)(O + (size_t)row * 768 + 32 * G + 8 * fq) = pack8(v0, v1); }
                asm volatile("" ::: "memory"); }
    }
};
struct EpiKV {
    static constexpr bool PERM = true; bf16_t* Ko; bf16_t* Vo; const float* part; const bf16_t* proj; const float* cs;
    __device__ __forceinline__ void operator()(const AccT& acc, const pg::Unit& u, int wr, int wc, int fr, int fq) const {
        const int row0 = u.pm * 256 + wr * 64 + fr;
#pragma unroll
        for (int ai = 0; ai < 2; ++ai)
#pragma unroll
            for (int m = 0; m < 4; ++m) { const int row = row0 + ai * 128 + m * 16; const f32x4* pp = (const f32x4*)(part + (size_t)row * 20 + 12); const f32x4 s0 = pp[0], s1 = pp[1];
                const float rs = __builtin_amdgcn_rsqf((((s0[0] + s0[1]) + (s0[2] + s0[3])) + ((s1[0] + s1[1]) + (s1[2] + s1[3]))) * (1.f / KVLORA) + EPS);
#pragma unroll
                for (int bj = 0; bj < 2; ++bj) { const int G = 8 * u.pn + 4 * bj + wc, head = G >> 2, sub = G & 3;
                    bf16_t* dst = (sub < 2) ? Ko + (size_t)row * 768 + head * 96 + 32 * sub + 8 * fq : Vo + (size_t)row * 512 + head * 64 + 32 * (sub - 2) + 8 * fq;
                    *(u32x4*)dst = pack8(acc[ai][bj][m][0] * rs, acc[ai][bj][m][1] * rs); } }
        if (u.pn == 0) {
            const int lane = fq * 16 + fr, tid = (wr * 4 + wc) * 64 + lane, row = u.pm * 256 + (tid >> 1), half = tid & 1;
            const u32x4* src = (const u32x4*)(proj + (size_t)row * NPROJ + C_KPE + 16 * half); const u32x4 a = src[0], b = src[1];
            const f32x4* cp = (const f32x4*)(cs + (size_t)row * 32);
            float xv[16], pv[16], cc[16], ss[16];
#pragma unroll
            for (int i = 0; i < 4; ++i) { xv[2 * i] = bflo(a[i]); xv[2 * i + 1] = bfhi(a[i]); xv[8 + 2 * i] = bflo(b[i]); xv[8 + 2 * i + 1] = bfhi(b[i]);
                const f32x4 c4 = cp[i], s4 = cp[4 + i]; cc[4 * i] = c4[0]; cc[4 * i + 1] = c4[1]; cc[4 * i + 2] = c4[2]; cc[4 * i + 3] = c4[3]; ss[4 * i] = s4[0]; ss[4 * i + 1] = s4[1]; ss[4 * i + 2] = s4[2]; ss[4 * i + 3] = s4[3]; }
#pragma unroll
            for (int j = 0; j < 16; ++j) pv[j] = __shfl_xor(xv[j], 1);
            float o[16];
#pragma unroll
            for (int j = 0; j < 16; ++j) o[j] = (half == 0) ? xv[j] * cc[j] - pv[j] * ss[j] : xv[j] * cc[j] + pv[j] * ss[j];
            u32x4 w0, w1;
#pragma unroll
            for (int i = 0; i < 4; ++i) { w0[i] = cvtpk(o[2 * i], o[2 * i + 1]); w1[i] = cvtpk(o[8 + 2 * i], o[8 + 2 * i + 1]); }
#pragma unroll
            for (int h = 0; h < NH; ++h) { bf16_t* d = Ko + (size_t)row * 768 + h * 96 + 64 + 16 * half; *(u32x4*)d = w0; *(u32x4*)(d + 8) = w1; }
        }
    }
};
struct EpiX1 {
    static constexpr bool PERM = false; const float* x; const float* mod; float* O;
    __device__ __forceinline__ void operator()(const AccT& acc, const pg::Unit& u, int wr, int wc, int fr, int fq) const {
        const int row0 = u.pm * 256 + wr * 64 + fr, col0 = u.pn * 256 + wc * 32 + 4 * fq;
        const float* gt = mod + (size_t)(u.pm * 256 / SEQ) * 6144 + 2048 + col0;
        f32x4 gv[2][2];
#pragma unroll
        for (int bj = 0; bj < 2; ++bj)
#pragma unroll
            for (int n = 0; n < 2; ++n) gv[bj][n] = *(const f32x4*)(gt + bj * 128 + n * 16);
#pragma unroll
        for (int ai = 0; ai < 2; ++ai)
#pragma unroll
            for (int m = 0; m < 4; ++m) { const size_t off = (size_t)(row0 + ai * 128 + m * 16) * DM + col0;
#pragma unroll
                for (int bj = 0; bj < 2; ++bj)
#pragma unroll
                    for (int n = 0; n < 2; ++n) { const f32x4 xv = *(const f32x4*)(x + off + bj * 128 + n * 16); *(f32x4*)(O + off + bj * 128 + n * 16) = xv + gv[bj][n] * acc[ai][bj][m][n]; } }
    }
};
struct EpiGU {
    static constexpr bool PERM = true; unsigned char* O; const float* bias;
    __device__ __forceinline__ void operator()(const AccT& acc, const pg::Unit& u, int wr, int wc, int fr, int fq) const {
        const int row0 = u.pm * 256 + wr * 64 + fr, gcol = u.pn * 128 + wc * 32 + 8 * fq;
        const float* bp = bias + (size_t)u.e * 2048 + gcol;
        const f32x4 bg0 = *(const f32x4*)bp, bg1 = *(const f32x4*)(bp + 4), bu0 = *(const f32x4*)(bp + 1024), bu1 = *(const f32x4*)(bp + 1028);
#pragma unroll
        for (int ai = 0; ai < 2; ++ai)
#pragma unroll
            for (int m = 0; m < 4; ++m) {
                f32x4 r[2];
#pragma unroll
                for (int n = 0; n < 2; ++n) { const f32x4 g4 = acc[ai][0][m][n] * (1.0f / W8) + (n ? bg1 : bg0), u4 = acc[ai][1][m][n] * (1.0f / W8) + (n ? bu1 : bu0);
#pragma unroll
                    for (int j = 0; j < 4; ++j) { const float g = fminf(g4[j], 7.0f), up = fminf(fmaxf(u4[j], -7.0f), 7.0f);
                        r[n][j] = (up + 1.0f) * g * __builtin_amdgcn_rcpf(1.0f + __expf(-1.702f * g)); } }
                u32x2 w; w.x = pk4_fp8(r[0][0], r[0][1], r[0][2], r[0][3]); w.y = pk4_fp8(r[1][0], r[1][1], r[1][2], r[1][3]); *(u32x2*)(O + (size_t)(row0 + ai * 128 + m * 16) * DE + gcol) = w; }
    }
};
struct EpiDN {
    static constexpr bool PERM = true; unsigned char* O; const float* bias;
    __device__ __forceinline__ void operator()(const AccT& acc, const pg::Unit& u, int wr, int wc, int fr, int fq) const {
        const int row0 = u.pm * 256 + wr * 64 + fr, col0 = u.pn * 256 + wc * 32 + 8 * fq;
        const float* bp = bias + (size_t)u.e * DM + col0;
        f32x4 bv[2][2];
#pragma unroll
        for (int bj = 0; bj < 2; ++bj) { bv[bj][0] = *(const f32x4*)(bp + bj * 128); bv[bj][1] = *(const f32x4*)(bp + bj * 128 + 4); }
#pragma unroll
        for (int ai = 0; ai < 2; ++ai)
#pragma unroll
            for (int m = 0; m < 4; ++m) { unsigned char* rowp = O + (size_t)(row0 + ai * 128 + m * 16) * DM + col0;
#pragma unroll
                for (int bj = 0; bj < 2; ++bj) { const f32x4 v0 = acc[ai][bj][m][0] * (1.0f / W8) + bv[bj][0], v1 = acc[ai][bj][m][1] * (1.0f / W8) + bv[bj][1];
                    u32x2 w; w.x = pk4_fp8(v0[0], v0[1], v0[2], v0[3]); w.y = pk4_fp8(v1[0], v1[1], v1[2], v1[3]); *(u32x2*)(rowp + bj * 128) = w; } }
    }
};

constexpr int NWAVES = 8;
enum { IN_X = 0, IN_C, IN_POS, IN_ADAW, IN_ADAB, IN_N1G, IN_WIN, IN_QNG, IN_WQB, IN_KVNG, IN_WKVB, IN_MLAOG, IN_CONVW, IN_ALOG, IN_DTB, IN_GDNG, IN_WOUT, IN_N2G, IN_RW, IN_RB, IN_WGU, IN_BGU, IN_WDN, IN_BDN, IN_FG, N_IN };
struct Frame {
    LAS unsigned char* lds; volatile LAS unsigned* MISC; unsigned* ctl; unsigned char* ws;
    int tid, lane, wave, G, vcu;
    const float* in[N_IN]; float* out;
};
#define WSP(T_, off) ((T_*)(F.ws + (off)))

__device__ __forceinline__ void p0_mod(Frame& F) {
    LAS float* cact = (LAS float*)F.lds;
    LAS float* red = (LAS float*)(F.lds + 32768);
    if ((int)blockIdx.x >= 96) return;
    const float* c = F.in[IN_C];
    for (int i = F.tid; i < BATCH * DM; i += NWAVES * 64) cact[i] = siluf(c[i]);
    __syncthreads();
    float* mod = WSP(float, WS_MOD);
    for (int it = blockIdx.x; it < 96; it += F.G) {
        const int j = it * 64 + F.lane; float a[8];
#pragma unroll
        for (int b = 0; b < 8; ++b) a[b] = 0.f;
        const float* w = F.in[IN_ADAW] + j;
#pragma unroll 4
        for (int k = F.wave * 128; k < F.wave * 128 + 128; ++k) { const float wv = w[(size_t)k * 6144];
#pragma unroll
            for (int b = 0; b < 8; ++b) a[b] += cact[b * DM + k] * wv; }
#pragma unroll
        for (int b = 0; b < 8; ++b) red[(F.wave * 8 + b) * 64 + F.lane] = a[b];
        __syncthreads();
        { const int b = F.tid >> 6, col = F.tid & 63; float s = 0.f;
#pragma unroll
          for (int w8 = 0; w8 < 8; ++w8) s += red[(w8 * 8 + b) * 64 + col];
          mod[b * 6144 + it * 64 + col] = s + F.in[IN_ADAB][it * 64 + col]; }
        __syncthreads();
    }
}
template <int MAP, bool FP8 = false>
__device__ __forceinline__ void p0_tr_item(const float* W, int K, int N, int NP, void* WTv, const float* ksc, LAS float* scr, int item, int lane) {
    bf16_t* WT = (bf16_t*)WTv;
    const int nblk = NP / 32, kb = item / nblk, nb = item % nblk, k0 = 64 * kb, n0 = 32 * nb;
    f32x4 ld[8];
#pragma unroll
    for (int j = 0; j < 8; ++j) { const int idx = j * 64 + lane, kk = idx >> 3, nn = n0 + 4 * (idx & 7); ld[j] = (nn < N) ? *(const f32x4*)(W + (size_t)(k0 + kk) * N + nn) : (f32x4){0.f, 0.f, 0.f, 0.f}; }
#pragma unroll
    for (int j = 0; j < 8; ++j) { const int idx = j * 64 + lane, kk = idx >> 3, c4 = idx & 7; f32x4 v = ld[j]; if (ksc) v = v * ksc[k0 + kk];
        LAS float* d = scr + kk * 33 + 4 * c4; d[0] = v[0]; d[1] = v[1]; d[2] = v[2]; d[3] = v[3]; }
    LDS_WAIT(); asm volatile("" ::: "memory");
    const int c = lane & 7;
#pragma unroll
    for (int j = 0; j < 4; ++j) { const int n = (lane >> 3) + 8 * j; const LAS float* s = scr + (8 * c) * 33 + n;
        u32x4 o; o.x = cvtpk(s[0 * 33], s[1 * 33]); o.y = cvtpk(s[2 * 33], s[3 * 33]); o.z = cvtpk(s[4 * 33], s[5 * 33]); o.w = cvtpk(s[6 * 33], s[7 * 33]);
        int dn = n0 + n;
        if (MAP == 1) { const int half = dn >> 10, r = dn & 1023; dn = ((r >> 7) << 8) + (half << 7) + (r & 127); }
        if constexpr (FP8) { u32x2 o8; o8.x = pk4_fp8(s[0 * 33] * W8, s[1 * 33] * W8, s[2 * 33] * W8, s[3 * 33] * W8); o8.y = pk4_fp8(s[4 * 33] * W8, s[5 * 33] * W8, s[6 * 33] * W8, s[7 * 33] * W8);
            *(GAS u32x2*)((unsigned char*)WTv + (size_t)dn * K + k0 + 8 * c) = o8; }
        else *(GAS u32x4*)(WT + (size_t)dn * K + k0 + 8 * c) = o; }
    LDS_WAIT(); asm volatile("" ::: "memory");
}
__device__ __forceinline__ void p0_weights(Frame& F) {
    LAS float* scr = (LAS float*)(F.lds + 49152 + F.wave * 8704);
    const int gw = F.vcu * NWAVES + F.wave, NGW = F.G * NWAVES;
    constexpr int I_IN = (DM / 64) * (NPROJ / 32), I_Q = (QLORA / 64) * (768 / 32), I_KV = (KVLORA / 64) * (1024 / 32), I_O = (DM / 64) * (DM / 32);
    constexpr int I_GU = (DM / 64) * (2048 / 32), I_DN = (DE / 64) * (DM / 32);
    constexpr int P_GU = I_GU / 2, P_DN = I_DN / 2;
    constexpr int NITEMS = I_IN + I_Q + I_KV + I_O;
    for (int it = gw; it < NITEMS; it += NGW) {
        int r = it;
        if (r < I_IN) { p0_tr_item<0>(F.in[IN_WIN], DM, IN_DIM, NPROJ, WSP(bf16_t, WS_WIN), nullptr, scr, r, F.lane); continue; } r -= I_IN;
        if (r < I_Q) { p0_tr_item<0>(F.in[IN_WQB], QLORA, 768, 768, WSP(bf16_t, WS_WQ), F.in[IN_QNG], scr, r, F.lane); continue; } r -= I_Q;
        if (r < I_KV) { p0_tr_item<0>(F.in[IN_WKVB], KVLORA, 1024, 1024, WSP(bf16_t, WS_WKV), F.in[IN_KVNG], scr, r, F.lane); continue; } r -= I_KV;
        if (r < I_O) { p0_tr_item<0>(F.in[IN_WOUT], DM, DM, DM, WSP(bf16_t, WS_WO), nullptr, scr, r, F.lane); continue; } r -= I_O;
        (void)scr;
    }
    float* rwt = WSP(float, WS_RWT);
    for (int i = (int)blockIdx.x * NWAVES * 64 + F.tid; i < NE * DM; i += F.G * NWAVES * 64) { const int e = i >> 10, k = i & 1023; rwt[i] = F.in[IN_RW][k * NE + e]; }
}

template <int MAP>
__device__ __forceinline__ void p0_tr_pair8(const float* W, int K, int N, unsigned char* WT8, LAS float* scr, int kp, int nb, int lane) {
    const int k0 = 128 * kp, n0 = 32 * nb;
    f32x4 ld[16];
#pragma unroll
    for (int j = 0; j < 16; ++j) { const int idx = j * 64 + lane, kk = idx >> 3, nn = n0 + 4 * (idx & 7); ld[j] = *(const f32x4*)(W + (size_t)(k0 + kk) * N + nn); }
#pragma unroll
    for (int hk = 0; hk < 2; ++hk) {
#pragma unroll
        for (int j = 0; j < 8; ++j) { const int idx = j * 64 + lane, kk = idx >> 3, c4 = idx & 7; const f32x4 v = ld[hk * 8 + j];
            LAS float* d = scr + kk * 33 + 4 * c4; d[0] = v[0]; d[1] = v[1]; d[2] = v[2]; d[3] = v[3]; }
        LDS_WAIT(); asm volatile("" ::: "memory");
        const int c = lane & 7;
#pragma unroll
        for (int j = 0; j < 4; ++j) { const int n = (lane >> 3) + 8 * j; const LAS float* s = scr + (8 * c) * 33 + n;
            int dn = n0 + n;
            if (MAP == 1) { const int half = dn >> 10, r = dn & 1023; dn = ((r >> 7) << 8) + (half << 7) + (r & 127); }
            u32x2 o8; o8.x = pk4_fp8(s[0 * 33] * W8, s[1 * 33] * W8, s[2 * 33] * W8, s[3 * 33] * W8); o8.y = pk4_fp8(s[4 * 33] * W8, s[5 * 33] * W8, s[6 * 33] * W8, s[7 * 33] * W8);
            *(GAS u32x2*)(WT8 + (size_t)dn * K + k0 + 64 * hk + 8 * c) = o8; }
        LDS_WAIT(); asm volatile("" ::: "memory");
    }
}
constexpr int MOE_CONV_ITEMS = (NE * (DM / 64) * (2048 / 32) / 2 + NE * (DE / 64) * (DM / 32) / 2) / 64;
__device__ __forceinline__ void moe_conv_item(Frame& F, int item) {
    LAS float* scr = (LAS float*)(F.lds + F.wave * 8704);
    constexpr int P_GU = (DM / 64) * (2048 / 32) / 2, P_DN = (DE / 64) * (DM / 32) / 2;
#pragma unroll 1
    for (int j = 0; j < 8; ++j) {
        int r = item * 64 + j * 8 + F.wave;
        if (r < NE * P_GU) { const int e = r / P_GU, p = r - e * P_GU, nb = p % 64, kp = p / 64;
            p0_tr_pair8<1>(F.in[IN_WGU] + (size_t)e * DM * 2048, DM, 2048, WSP(unsigned char, WS_WGU) + (size_t)e * 2048 * DM, scr, kp, nb, F.lane);
        } else { r -= NE * P_GU; const int e = r / P_DN, p = r - e * P_DN, nb = p % 32, kp = p / 32;
            p0_tr_pair8<0>(F.in[IN_WDN] + (size_t)e * DE * DM, DE, DM, WSP(unsigned char, WS_WDN) + (size_t)e * DM * DE, scr, kp, nb, F.lane); }
    }
}

__device__ const float ROPE_INVF[16] = {1.0f, 0.5623413251903491f, 0.31622776601683794f, 0.1778279410038923f, 0.1f, 0.05623413251903491f, 0.03162277660168379f, 0.01778279410038923f,
    0.01f, 0.005623413251903491f, 0.003162277660168379f, 0.0017782794100389228f, 0.001f, 0.0005623413251903491f, 0.00031622776601683794f, 0.00017782794100389227f};
__device__ __forceinline__ void norm_rows(Frame& F, const float* x, const float* gain, int SH, int SC, bf16_t* outp) {
    const int gw = F.vcu * NWAVES + F.wave, NGW = F.G * NWAVES;
    const float* mod = WSP(float, WS_MOD);
    constexpr int R = 4;
    for (int m0 = gw; m0 < T; m0 += R * NGW) {
        f32x4 v[R][4]; float s[R];
#pragma unroll
        for (int r = 0; r < R; ++r) { const int m = m0 + r * NGW; s[r] = 0.f; if (m < T) { const f32x4* xr = (const f32x4*)(x + (size_t)m * DM) + F.lane;
#pragma unroll
            for (int j = 0; j < 4; ++j) v[r][j] = xr[64 * j]; } else {
#pragma unroll
            for (int j = 0; j < 4; ++j) v[r][j] = (f32x4){0.f, 0.f, 0.f, 0.f}; } }
#pragma unroll
        for (int r = 0; r < R; ++r)
#pragma unroll
            for (int j = 0; j < 4; ++j) s[r] += (v[r][j][0] * v[r][j][0] + v[r][j][1] * v[r][j][1]) + (v[r][j][2] * v[r][j][2] + v[r][j][3] * v[r][j][3]);
#pragma unroll
        for (int o = 1; o < 64; o <<= 1)
#pragma unroll
            for (int r = 0; r < R; ++r) s[r] += __shfl_xor(s[r], o);
#pragma unroll
        for (int r = 0; r < R; ++r) { const int m = m0 + r * NGW; if (m >= T) continue;
            {
              const float ang = (float)((const int*)F.in[IN_POS])[m] * ROPE_INVF[F.lane & 15];
              const double rev = (double)ang * 0.15915494309189535; const float fr_ = (float)(rev - __builtin_rint(rev));
              if (F.lane < 16) { float* cs = WSP(float, WS_CS) + (size_t)m * 32; cs[F.lane] = __builtin_amdgcn_cosf(fr_); cs[16 + F.lane] = __builtin_amdgcn_sinf(fr_); } }
            const float rstd = __builtin_amdgcn_rsqf(s[r] * (1.f / DM) + EPS); const float* mb = mod + (size_t)(m / SEQ) * 6144;
            u32x2* o8 = (u32x2*)(outp + (size_t)m * DM) + F.lane;
#pragma unroll
            for (int j = 0; j < 4; ++j) { const int col = 4 * (F.lane + 64 * j);
                const f32x4 g = *(const f32x4*)(gain + col), sc = *(const f32x4*)(mb + SC + col), sh = *(const f32x4*)(mb + SH + col);
                const f32x4 h = v[r][j] * rstd * g * (sc + 1.0f) + sh; u32x2 w; w.x = cvtpk(h[0], h[1]); w.y = cvtpk(h[2], h[3]); o8[64 * j] = w; } }
    }
}

__device__ __forceinline__ void p3a_rows(Frame& F) {
    const int gw = F.vcu * NWAVES + F.wave, NGW = F.G * NWAVES, lane = F.lane;
    const bf16_t* proj = WSP(bf16_t, WS_PROJ); float* rsq = WSP(float, WS_RSQ); float* rskv = WSP(float, WS_RSKV); float* cs = WSP(float, WS_CS); bf16_t* Kb = WSP(bf16_t, WS_K);
    const int* pos = (const int*)F.in[IN_POS];
    constexpr int R = 4;
    for (int m0 = gw; m0 < T; m0 += R * NGW) {
        u32x4 a[R], b[R]; int ps[R];
#pragma unroll
        for (int r = 0; r < R; ++r) { const int m = (m0 + r * NGW < T) ? m0 + r * NGW : m0; const u32x4* pr = (const u32x4*)(proj + (size_t)m * NPROJ);
            a[r] = pr[lane]; b[r] = (u32x4){0u, 0u, 0u, 0u}; if (lane < 20) b[r] = pr[64 + lane]; ps[r] = pos[m]; }
#pragma unroll
        for (int r = 0; r < R; ++r) { const int m = m0 + r * NGW; if (m >= T) continue;
            const float sa = ssq8(a[r]), sb = ssq8(b[r]);
            const float sq = wave_sum(lane < 48 ? sa : 0.f), skv = wave_sum((lane >= 48 ? sa : 0.f) + (lane < 16 ? sb : 0.f));
            if (lane == 0) { rsq[m] = __builtin_amdgcn_rsqf(sq * (1.f / QLORA) + EPS); rskv[m] = __builtin_amdgcn_rsqf(skv * (1.f / KVLORA) + EPS); }
            const float ang = (float)ps[r] * ROPE_INVF[lane & 15];
            const double rev = (double)ang * 0.15915494309189535; const float fr = (float)(rev - __builtin_rint(rev));
            const float cv = __builtin_amdgcn_cosf(fr), sv = __builtin_amdgcn_sinf(fr);
            if (lane < 16) { cs[(size_t)m * 32 + lane] = cv; cs[(size_t)m * 32 + 16 + lane] = sv; }
            float xv[8], pv[8], cc[8], ss[8];
#pragma unroll
            for (int i = 0; i < 4; ++i) { xv[2 * i] = bflo(b[r][i]); xv[2 * i + 1] = bfhi(b[r][i]); }
            const int i0 = 8 * (lane & 1);
#pragma unroll
            for (int j = 0; j < 8; ++j) { pv[j] = __shfl_xor(xv[j], 2); cc[j] = __shfl(cv, i0 + j); ss[j] = __shfl(sv, i0 + j); }
            if (lane >= 16 && lane < 20) {
                float o[8];
#pragma unroll
                for (int j = 0; j < 8; ++j) o[j] = (lane < 18) ? xv[j] * cc[j] - pv[j] * ss[j] : xv[j] * cc[j] + pv[j] * ss[j];
                u32x4 w; w.x = cvtpk(o[0], o[1]); w.y = cvtpk(o[2], o[3]); w.z = cvtpk(o[4], o[5]); w.w = cvtpk(o[6], o[7]);
#pragma unroll
                for (int h = 0; h < NH; ++h) *(u32x4*)(Kb + (size_t)m * 768 + h * 96 + 64 + 8 * (lane - 16)) = w;
            } }
    }
}

__device__ __forceinline__ int crow(int r, int hi) { return (r & 3) + 8 * (r >> 2) + 4 * hi; }
typedef short v4i16_t __attribute__((ext_vector_type(4)));
constexpr int AT_KROW = 208, AT_VROW = 144, AT_KBUF = 64 * AT_KROW, AT_VBUF = 64 * AT_VROW, AT_V0 = 2 * AT_KBUF, AT_WS = AT_V0 + 2 * AT_VBUF;
__device__ __forceinline__ void attn_unit(Frame& F, int b, int h, int qb) {
    const int tid = F.tid, lane = F.lane, wid = F.wave, r32 = lane & 31, hi = lane >> 5;
    const bf16_t* Qg = WSP(bf16_t, WS_Q); const bf16_t* Kg = WSP(bf16_t, WS_K); const bf16_t* Vg = WSP(bf16_t, WS_V); bf16_t* Og = WSP(bf16_t, WS_OA);
    LAS unsigned char* Kl = F.lds; LAS unsigned char* Vl = F.lds + AT_V0; LAS float* wsf = (LAS float*)(F.lds + AT_WS) + wid * 64;
    const size_t tb = (size_t)b * SEQ; const int q0 = qb * 256, NT = 4 * qb + 4;
    bf16x8 qr[6];
    { const bf16_t* Qp = Qg + (tb + q0 + wid * 32 + r32) * 768 + h * 96 + hi * 8;
#pragma unroll
      for (int d0 = 0; d0 < 6; ++d0) qr[d0] = *(const bf16x8*)(Qp + d0 * 16); }
    unsigned kvo[2], vvo[2];
#pragma unroll
    for (int i = 0; i < 2; ++i) { const int ok = (wid + 8 * i) * 1024 + 16 * lane, kr = ok / AT_KROW, kc = (ok % AT_KROW) >> 4; kvo[i] = (unsigned)((kr < 64 ? kr : 63) * 1536 + (kc < 12 ? kc : 0) * 16);
        const int ov = (wid + 8 * i) * 1024 + 16 * lane, vr = ov / AT_VROW, vc = (ov % AT_VROW) >> 4; vvo[i] = (unsigned)((vr < 64 ? vr : 63) * 1024 + (vc < 8 ? vc : 0) * 16); }
    const unsigned kl0 = (unsigned)__builtin_amdgcn_readfirstlane((int)((unsigned)(uintptr_t)Kl + (unsigned)wid * 1024u)), vl0 = (unsigned)__builtin_amdgcn_readfirstlane((int)((unsigned)(uintptr_t)Vl + (unsigned)wid * 1024u));
    const char* kg0 = (const char*)(Kg + tb * 768 + h * 96); const char* vg0 = (const char*)(Vg + tb * 512 + h * 64);
#define AT_DMAK(t, bf) do { pg::glds16s(kg0 + (size_t)(t) * 64 * 1536, kvo[0], kl0 + (unsigned)((bf) * AT_KBUF)); if (wid < 5) pg::glds16s(kg0 + (size_t)(t) * 64 * 1536, kvo[1], kl0 + (unsigned)((bf) * AT_KBUF + 8192)); } while (0)
#define AT_DMAV(t, bf) do { pg::glds16s(vg0 + (size_t)(t) * 64 * 1024, vvo[0], vl0 + (unsigned)((bf) * AT_VBUF)); if (wid == 0) pg::glds16s(vg0 + (size_t)(t) * 64 * 1024, vvo[1], vl0 + (unsigned)((bf) * AT_VBUF + 8192)); } while (0)
#define AT_QK(P0, P1, bf) do { _Pragma("unroll") for (int r = 0; r < 16; ++r) { P0[r] = 0.f; P1[r] = 0.f; } \
        const LAS unsigned char* kb_ = Kl + (bf) * AT_KBUF + r32 * AT_KROW + hi * 16; \
        _Pragma("unroll") for (int d0 = 0; d0 < 6; ++d0) { const bf16x8 k0 = *(const LAS bf16x8*)(kb_ + d0 * 32), k1 = *(const LAS bf16x8*)(kb_ + 32 * AT_KROW + d0 * 32); \
            P0 = __builtin_amdgcn_mfma_f32_32x32x16_bf16(k0, qr[d0], P0, 0, 0, 0); P1 = __builtin_amdgcn_mfma_f32_32x32x16_bf16(k1, qr[d0], P1, 0, 0, 0); } } while (0)
#define AT_SPV(P0, P1, t, bf) do { \
        if ((t) >= NT - 4) { _Pragma("unroll") for (int r = 0; r < 16; ++r) { const int kv = 64 * (t) + crow(r, hi); if (kv > qpos) P0[r] = -INFINITY; if (kv + 32 > qpos) P1[r] = -INFINITY; } } \
        float mx = fmaxf(P0[0], P1[0]); \
        _Pragma("unroll") for (int r = 1; r < 16; ++r) mx = fmaxf(mx, fmaxf(P0[r], P1[r])); \
        mx = fmaxf(mx, __shfl_xor(mx, 32)); \
        const float m_new = fmaxf(m_run, mx); \
        if (__any(m_new > m_run)) { const float f = __builtin_amdgcn_exp2f(m_run - m_new); l_run *= f; m_run = m_new; \
            if (hi == 0) wsf[r32] = f; float fr_[16]; \
            _Pragma("unroll") for (int r = 0; r < 16; ++r) fr_[r] = wsf[crow(r, hi)]; \
            _Pragma("unroll") for (int r = 0; r < 16; ++r) { o[0][r] *= fr_[r]; o[1][r] *= fr_[r]; } } \
        float rs = 0.f; \
        _Pragma("unroll") for (int r = 0; r < 16; ++r) { P0[r] = __builtin_amdgcn_exp2f(P0[r] - m_run); P1[r] = __builtin_amdgcn_exp2f(P1[r] - m_run); rs += P0[r] + P1[r]; } \
        l_run += rs; bf16x8 pa[4]; \
        _Pragma("unroll") for (int ks = 0; ks < 4; ++ks) { u32x4 w_; \
            _Pragma("unroll") for (int i = 0; i < 4; ++i) { const int r = (ks & 1) * 8 + 2 * i; w_[i] = (ks < 2) ? cvtpk(P0[r], P0[r + 1]) : cvtpk(P1[r], P1[r + 1]); } \
            pa[ks] = __builtin_bit_cast(bf16x8, w_); } \
        const LAS unsigned char* vb_ = Vl + (bf) * AT_VBUF + (4 * hi + ((lane & 15) >> 2)) * AT_VROW + (((lane >> 4) & 1) * 16 + (lane & 3) * 4) * 2; \
        _Pragma("unroll") for (int d0 = 0; d0 < 2; ++d0) _Pragma("unroll") for (int ks = 0; ks < 4; ++ks) { \
            const v4i16_t lo = __builtin_amdgcn_ds_read_tr16_b64_v4i16((LAS v4i16_t*)(vb_ + ks * 16 * AT_VROW + d0 * 64)); \
            const v4i16_t hv = __builtin_amdgcn_ds_read_tr16_b64_v4i16((LAS v4i16_t*)(vb_ + ks * 16 * AT_VROW + 8 * AT_VROW + d0 * 64)); \
            const bf16x8 vf = (bf16x8){lo[0], lo[1], lo[2], lo[3], hv[0], hv[1], hv[2], hv[3]}; \
            o[d0] = __builtin_amdgcn_mfma_f32_32x32x16_bf16(pa[ks], vf, o[d0], 0, 0, 0); } } while (0)
#define AT_STEP(C0, C1, N0, N1, t) do { \
        if ((t) + 2 < NT) AT_DMAK((t) + 2, (t) & 1); if ((t) + 1 < NT) AT_DMAV((t) + 1, ((t) + 1) & 1); \
        if ((t) + 1 < NT && 64 * ((t) + 1) <= qmax) AT_QK(N0, N1, ((t) + 1) & 1); \
        if (64 * (t) <= qmax) AT_SPV(C0, C1, t, (t) & 1); \
        VM_WAIT(); __syncthreads(); } while (0)
    AT_DMAK(0, 0); AT_DMAV(0, 0); AT_DMAK(1, 1); VM_WAIT(); __syncthreads();
    float m_run = -INFINITY, l_run = 0.f; f32x16 o[2];
#pragma unroll
    for (int r = 0; r < 16; ++r) { o[0][r] = 0.f; o[1][r] = 0.f; }
    const int qmax = q0 + wid * 32 + 31, qpos = q0 + wid * 32 + r32;
    f32x16 sA0, sA1, sB0, sB1;
    AT_QK(sA0, sA1, 0);
    LBAR();
    for (int t = 0; t < NT; t += 2) {
        AT_STEP(sA0, sA1, sB0, sB1, t);
        AT_STEP(sB0, sB1, sA0, sA1, t + 1);
    }
    { float lt = l_run + __shfl_xor(l_run, 32);
      if (hi == 0) wsf[32 + r32] = lt;
      bf16_t* Ow = Og + (tb + q0 + wid * 32) * 512 + h * 64 + r32;
#pragma unroll
      for (int r = 0; r < 16; ++r) { const int qr_ = crow(r, hi); const float inv = 1.0f / wsf[32 + qr_];
          Ow[(size_t)qr_ * 512] = f2bf(o[0][r] * inv); Ow[(size_t)qr_ * 512 + 32] = f2bf(o[1][r] * inv); } }
#undef AT_DMAK
#undef AT_DMAV
#undef AT_QK
#undef AT_SPV
#undef AT_STEP
}

__device__ __forceinline__ void p4b_rows(Frame& F) {
    const int gw = F.vcu * NWAVES + F.wave, NGW = F.G * NWAVES, lane = F.lane;
    const bf16_t* oa = WSP(bf16_t, WS_OA); const bf16_t* og = WSP(bf16_t, WS_OG); const bf16_t* proj = WSP(bf16_t, WS_PROJ); bf16_t* mx = WSP(bf16_t, WS_H);
    const float* ga = F.in[IN_MLAOG] + 8 * lane; const float* gg = F.in[IN_GDNG] + 8 * (lane & 7);
    constexpr int R = 4;
    for (int m0 = gw; m0 < T; m0 += R * NGW) {
        u32x4 a[R], g[R], z[R];
#pragma unroll
        for (int r = 0; r < R; ++r) { const int m = (m0 + r * NGW < T) ? m0 + r * NGW : m0;
            a[r] = *(const u32x4*)(oa + (size_t)m * 512 + 8 * lane); g[r] = *(const u32x4*)(og + (size_t)m * 512 + 8 * lane); z[r] = *(const u32x4*)(proj + (size_t)m * NPROJ + C_GZ + 8 * lane); }
#pragma unroll
        for (int r = 0; r < R; ++r) { const int m = m0 + r * NGW; if (m >= T) continue;
            const float ra = __builtin_amdgcn_rsqf(wave_sum(ssq8(a[r])) * (1.f / 512) + EPS);
            float sg = ssq8(g[r]); sg += __shfl_xor(sg, 1); sg += __shfl_xor(sg, 2); sg += __shfl_xor(sg, 4);
            const float rg = __builtin_amdgcn_rsqf(sg * (1.f / 64) + EPS);
            float oa8[8], og8[8];
#pragma unroll
            for (int i = 0; i < 4; ++i) { oa8[2 * i] = bflo(a[r][i]) * ra * ga[2 * i]; oa8[2 * i + 1] = bfhi(a[r][i]) * ra * ga[2 * i + 1];
                og8[2 * i] = bflo(g[r][i]) * rg * gg[2 * i] * siluf(bflo(z[r][i])); og8[2 * i + 1] = bfhi(g[r][i]) * rg * gg[2 * i + 1] * siluf(bfhi(z[r][i])); }
            u32x4 wa, wg;
#pragma unroll
            for (int i = 0; i < 4; ++i) { wa[i] = cvtpk(oa8[2 * i], oa8[2 * i + 1]); wg[i] = cvtpk(og8[2 * i], og8[2 * i + 1]); }
            *(u32x4*)(mx + (size_t)m * DM + 8 * lane) = wa; *(u32x4*)(mx + (size_t)m * DM + 512 + 8 * lane) = wg; }
    }
}

constexpr int G1_KRM = 0, G1_QRM = 4608, G1_AM = 9216, G1_QK = 13440, G1_UT = 16000, G1_WT = 21120, G1_KT = 26240, G1_GT = 31360, G1_SLOT = 32000, G1_CW = 4 * G1_SLOT;
static_assert(G1_CW + 3072 <= RING_BYTES, "G1 LDS");
__device__ __forceinline__ f32x4 mfma16(bf16x8 a, bf16x8 b, f32x4 c) { return __builtin_amdgcn_mfma_f32_16x16x32_bf16(a, b, c, 0, 0, 0); }

__device__ __forceinline__ float silu_fast(float x) { return x * __builtin_amdgcn_rcpf(1.0f + __expf(-x)); }
#ifndef G1PROBE
#define G1PROBE (-1)
#endif
#define G1T(k) do { if (G1PROBE >= 0) { const unsigned long long n_ = __builtin_amdgcn_s_memrealtime(); if (G1PROBE == (k)) g1acc += n_ - g1t; g1t = n_; } } while (0)
__device__ __forceinline__ void g1_unit(Frame& F, int unit, unsigned long long& g1acc) {
    unsigned long long g1t = (G1PROBE >= 0) ? __builtin_amdgcn_s_memrealtime() : 0ull;
    const int tid = F.tid, lane = F.lane, wid = F.wave;
    const int bh = unit >> 5, c0 = (unit & 31) * 4, b = bh >> 3, h = bh & 7;
    const bf16_t* proj = WSP(bf16_t, WS_PROJ);
    LAS unsigned char* L = F.lds; LAS float* cw = (LAS float*)(L + G1_CW);
    const size_t tb = (size_t)b * SEQ;
    for (int i = tid; i < 768; i += NWAVES * 64) { const int x = i >> 8, w = (i >> 6) & 3, ch = i & 63; cw[i] = F.in[IN_CONVW][w * 1536 + x * 512 + h * 64 + ch]; }
    LBAR(); G1T(0);
    { const int tk = tid >> 2, part = tid & 3, s = tk >> 5, i = tk & 31, isk = part >> 1, chb = (part & 1) * 32;
      const int sp = (c0 + s) * GC + i;
      const bf16_t* src = proj + (tb + sp) * NPROJ + (isk ? C_GK : C_GQ) + h * 64 + chb;
      float ain = 0.f, bin = 0.f;
      if (part == 0) { ain = bf2f(proj[(tb + sp) * NPROJ + C_GA + h]); bin = bf2f(proj[(tb + sp) * NPROJ + C_GB + h]); }
      float v[32];
#pragma unroll
      for (int c = 0; c < 32; ++c) v[c] = 0.f;
#pragma unroll
      for (int w = 0; w < 4; ++w) { if (sp - 3 + w >= 0) { const bf16_t* rp = src - (ptrdiff_t)(3 - w) * NPROJ;
#pragma unroll
          for (int q4 = 0; q4 < 4; ++q4) { const u32x4 d = *(const u32x4*)(rp + 8 * q4); const LAS f32x4* wp = (const LAS f32x4*)(cw + (isk * 4 + w) * 64 + chb + 8 * q4); const f32x4 w0 = wp[0], w1 = wp[1];
              v[8 * q4 + 0] += bflo(d[0]) * w0[0]; v[8 * q4 + 1] += bfhi(d[0]) * w0[1]; v[8 * q4 + 2] += bflo(d[1]) * w0[2]; v[8 * q4 + 3] += bfhi(d[1]) * w0[3];
              v[8 * q4 + 4] += bflo(d[2]) * w1[0]; v[8 * q4 + 5] += bfhi(d[2]) * w1[1]; v[8 * q4 + 6] += bflo(d[3]) * w1[2]; v[8 * q4 + 7] += bfhi(d[3]) * w1[3]; } } }
      float ss = 0.f;
#pragma unroll
      for (int c = 0; c < 32; ++c) { v[c] = silu_fast(v[c]); ss += v[c] * v[c]; }
      ss += __shfl_xor(ss, 1);
      const float rn = __builtin_amdgcn_rsqf(ss + EPS) * (isk ? 1.0f : 0.125f);
      LAS bf16_t* dst = (LAS bf16_t*)(L + s * G1_SLOT + (isk ? G1_KRM : G1_QRM)) + i * 72 + chb;
#pragma unroll
      for (int q4 = 0; q4 < 4; ++q4) { u32x4 w;
#pragma unroll
          for (int e = 0; e < 4; ++e) w[e] = cvtpk(v[8 * q4 + 2 * e] * rn, v[8 * q4 + 2 * e + 1] * rn);
          *(LAS u32x4*)(dst + 8 * q4) = w; }
      if (part == 0) { LAS float* gt = (LAS float*)(L + s * G1_SLOT + G1_GT);
          const float xs = ain + F.in[IN_DTB][h], sp_ = xs > 20.f ? xs : __logf(1.0f + __expf(xs));
          gt[i] = 1.0f / (1.0f + __expf(-bin));
          gt[32 + i] = -__expf(F.in[IN_ALOG][h]) * sp_; }
    }
    LBAR(); G1T(1);
    if (wid < 2) { LAS float* gt = (LAS float*)(L + (2 * wid + (lane >> 5)) * G1_SLOT + G1_GT); const int i = lane & 31; float c = gt[32 + i];
#pragma unroll
        for (int o = 1; o < 32; o <<= 1) { const float t = __shfl_up(c, o, 32); if (i >= o) c += t; }
        const float last = __shfl(c, 31, 32);
        gt[64 + i] = c; gt[96 + i] = __expf(c); gt[128 + i] = __expf(last - c); }
    LBAR(); G1T(2);
    const int s = wid >> 1, sub = wid & 1, l15 = lane & 15, kq = lane >> 4;
    LAS unsigned char* Ls = L + s * G1_SLOT; LAS float* gt = (LAS float*)(Ls + G1_GT);
    { const LAS bf16_t* X = (const LAS bf16_t*)(Ls + (sub ? G1_QRM : G1_KRM)); const LAS bf16_t* Kr = (const LAS bf16_t*)(Ls + G1_KRM);
#pragma unroll
      for (int it = 0; it < 2; ++it)
#pragma unroll
          for (int jt = 0; jt < 2; ++jt) { f32x4 acc = (f32x4){0.f, 0.f, 0.f, 0.f};
#pragma unroll
              for (int ks = 0; ks < 2; ++ks) acc = mfma16(*(const LAS bf16x8*)(X + (16 * it + l15) * 72 + 32 * ks + 8 * kq), *(const LAS bf16x8*)(Kr + (16 * jt + l15) * 72 + 32 * ks + 8 * kq), acc);
              const int j = 16 * jt + l15; const float gj = gt[64 + j];
#pragma unroll
              for (int r = 0; r < 4; ++r) { const int i = 16 * it + 4 * kq + r; const float gi = gt[64 + i];
                  if (sub == 0) { const float val = (i > j) ? acc[r] * gt[i] * __expf(gi - gj) : 0.f; ((LAS float*)(Ls + G1_AM))[i * 33 + j] = val; }
                  else { const float val = (i >= j) ? acc[r] * __expf(gi - gj) : 0.f; ((LAS bf16_t*)(Ls + G1_QK))[i * 40 + j] = f2bf(val); } } }
    }
    for (int idx = tid; idx < 4 * 64 * 32; idx += NWAVES * 64) { const int s2 = idx >> 11, d = (idx >> 5) & 63, c = idx & 31; LAS unsigned char* L2 = L + s2 * G1_SLOT;
        ((LAS bf16_t*)(L2 + G1_KT))[d * 40 + c] = f2bf(bf2f(((const LAS bf16_t*)(L2 + G1_KRM))[c * 72 + d]) * ((const LAS float*)(L2 + G1_GT))[128 + c]); }
    LBAR(); G1T(3);
    { float sol[32];
      if (sub == 0) {
          const int sp0 = (c0 + s) * GC; const bf16_t* src = proj + (tb + sp0) * NPROJ + C_GV + h * 64 + lane;
          const float w0 = cw[(8 + 0) * 64 + lane], w1 = cw[(8 + 1) * 64 + lane], w2 = cw[(8 + 2) * 64 + lane], w3 = cw[(8 + 3) * 64 + lane];
          float x0 = (sp0 >= 3) ? bf2f(src[-3 * (ptrdiff_t)NPROJ]) : 0.f, x1 = (sp0 >= 2) ? bf2f(src[-2 * (ptrdiff_t)NPROJ]) : 0.f, x2 = (sp0 >= 1) ? bf2f(src[-1 * (ptrdiff_t)NPROJ]) : 0.f;
#pragma unroll
          for (int i = 0; i < 32; ++i) { const float x3 = bf2f(src[(size_t)i * NPROJ]); sol[i] = silu_fast(w0 * x0 + w1 * x1 + w2 * x2 + w3 * x3) * gt[i]; x0 = x1; x1 = x2; x2 = x3; }
      } else {
          const LAS bf16_t* Kr = (const LAS bf16_t*)(Ls + G1_KRM);
#pragma unroll
          for (int i = 0; i < 32; ++i) sol[i] = bf2f(Kr[i * 72 + lane]) * gt[i] * gt[96 + i];
      }
      const LAS float* Am = (const LAS float*)(Ls + G1_AM);
#pragma unroll
      for (int i = 1; i < 32; ++i) { const float arow = Am[i * 33 + (lane & 31)]; float a = sol[i];
#pragma unroll
          for (int j = 0; j < i; ++j) a -= __uint_as_float(__builtin_amdgcn_readlane(__float_as_uint(arow), j)) * sol[j];
          sol[i] = a; }
      LAS bf16_t* dst = (LAS bf16_t*)(Ls + (sub ? G1_WT : G1_UT)) + lane * 40;
#pragma unroll
      for (int q4 = 0; q4 < 4; ++q4) { u32x4 w;
#pragma unroll
          for (int e = 0; e < 4; ++e) w[e] = cvtpk(sol[8 * q4 + 2 * e], sol[8 * q4 + 2 * e + 1]);
          *(LAS u32x4*)(dst + 8 * q4) = w; }
    }
    LBAR(); G1T(4);
        { unsigned char* gd = F.ws + WS_GD + (size_t)(bh * NCH + c0 + s) * 24576;
          const LAS bf16_t* uT = (const LAS bf16_t*)(Ls + G1_UT); const LAS bf16_t* wT = (const LAS bf16_t*)(Ls + G1_WT); const LAS bf16_t* kT = (const LAS bf16_t*)(Ls + G1_KT);
          const LAS bf16_t* qk = (const LAS bf16_t*)(Ls + G1_QK); const LAS bf16_t* qr = (const LAS bf16_t*)(Ls + G1_QRM);
          const f32x4 z4 = (f32x4){0.f, 0.f, 0.f, 0.f}; const float cd = gt[96 + 31];
          if (sub == 0) {
#pragma unroll
              for (int mp = 0; mp < 2; ++mp) {
                  const bf16x8 af0 = *(const LAS bf16x8*)(wT + (32 * mp + l15) * 40 + 8 * kq), af1 = *(const LAS bf16x8*)(wT + (32 * mp + 16 + l15) * 40 + 8 * kq);
#pragma unroll
                  for (int nt = 0; nt < 4; ++nt) {
                      const bf16x8 bfr = *(const LAS bf16x8*)(kT + (16 * nt + l15) * 40 + 8 * kq);
                      const f32x4 a0 = mfma16(af0, bfr, z4), a1 = mfma16(af1, bfr, z4); const int dout = 16 * nt + l15; u32x4 w; float o8[8];
#pragma unroll
                      for (int r = 0; r < 4; ++r) { const int din = 32 * mp + 4 * kq + r; o8[r] = ((din == dout) ? cd : 0.f) - a0[r]; o8[4 + r] = ((din + 16 == dout) ? cd : 0.f) - a1[r]; }
                      w.x = cvtpk(o8[0], o8[1]); w.y = cvtpk(o8[2], o8[3]); w.z = cvtpk(o8[4], o8[5]); w.w = cvtpk(o8[6], o8[7]);
                      *(u32x4*)(gd + ((nt * 2 + mp) * 64 + kq * 16 + l15) * 16) = w; }
#pragma unroll
                  for (int ct = 0; ct < 2; ++ct) {
                      const bf16x8 bfr = *(const LAS bf16x8*)(qk + (16 * ct + l15) * 40 + 8 * kq);
                      const f32x4 a0 = mfma16(af0, bfr, z4), a1 = mfma16(af1, bfr, z4); const int c = 16 * ct + l15; const float eg = gt[96 + c];
                      const u32x2 q0 = *(const LAS u32x2*)(qr + c * 72 + 32 * mp + 4 * kq), q1 = *(const LAS u32x2*)(qr + c * 72 + 32 * mp + 16 + 4 * kq); u32x4 w;
                      w.x = cvtpk(bflo(q0.x) * eg - a0[0], bfhi(q0.x) * eg - a0[1]); w.y = cvtpk(bflo(q0.y) * eg - a0[2], bfhi(q0.y) * eg - a0[3]);
                      w.z = cvtpk(bflo(q1.x) * eg - a1[0], bfhi(q1.x) * eg - a1[1]); w.w = cvtpk(bflo(q1.y) * eg - a1[2], bfhi(q1.y) * eg - a1[3]);
                      *(u32x4*)(gd + 8192 + ((ct * 2 + mp) * 64 + kq * 16 + l15) * 16) = w; } }
          } else {
#pragma unroll
              for (int et = 0; et < 4; ++et) { const bf16x8 bfr = *(const LAS bf16x8*)(uT + (16 * et + l15) * 40 + 8 * kq);
#pragma unroll
                  for (int dt = 0; dt < 4; ++dt) {
                      const f32x4 acc = mfma16(*(const LAS bf16x8*)(kT + (16 * dt + l15) * 40 + 8 * kq), bfr, z4); u32x2 w; w.x = cvtpk(acc[0], acc[1]); w.y = cvtpk(acc[2], acc[3]);
                      *(u32x2*)(gd + 12288 + ((dt * 4 + et) * 64 + lane) * 8) = w; }
#pragma unroll
                  for (int ct = 0; ct < 2; ++ct) {
                      const f32x4 acc = mfma16(*(const LAS bf16x8*)(qk + (16 * ct + l15) * 40 + 8 * kq), bfr, z4); u32x2 w; w.x = cvtpk(acc[0], acc[1]); w.y = cvtpk(acc[2], acc[3]);
                      *(u32x2*)(gd + 20480 + ((ct * 4 + et) * 64 + lane) * 8) = w; } }
          }
        }
    LBAR(); G1T(5);
}

__device__ __forceinline__ void g2_item(Frame& F, int item) {
    const int lane = F.lane, wid = F.wave, bh = item * 2 + (wid >> 2), es = wid & 3, b = bh >> 3, h = bh & 7, l15 = lane & 15, kq = lane >> 4;
    const unsigned char* gd = F.ws + WS_GD + (size_t)bh * NCH * 24576;
    bf16_t* og = WSP(bf16_t, WS_OG) + ((size_t)b * SEQ) * 512 + h * 64 + 16 * es + l15;
    f32x4 S[4];
#pragma unroll
    for (int m = 0; m < 4; ++m) S[m] = (f32x4){0.f, 0.f, 0.f, 0.f};
    bf16x8 Mf[4][2], Pf[2][2]; u32x2 Nv[4], Rv[2];
#define G2_LOAD(c) do { const unsigned char* p_ = gd + (size_t)(c) * 24576; \
        _Pragma("unroll") for (int m = 0; m < 4; ++m) _Pragma("unroll") for (int s2 = 0; s2 < 2; ++s2) Mf[m][s2] = *(const bf16x8*)(p_ + ((m * 2 + s2) * 64 + lane) * 16); \
        _Pragma("unroll") for (int ct = 0; ct < 2; ++ct) _Pragma("unroll") for (int s2 = 0; s2 < 2; ++s2) Pf[ct][s2] = *(const bf16x8*)(p_ + 8192 + ((ct * 2 + s2) * 64 + lane) * 16); \
        _Pragma("unroll") for (int m = 0; m < 4; ++m) Nv[m] = *(const u32x2*)(p_ + 12288 + ((m * 4 + es) * 64 + lane) * 8); \
        _Pragma("unroll") for (int ct = 0; ct < 2; ++ct) Rv[ct] = *(const u32x2*)(p_ + 20480 + ((ct * 4 + es) * 64 + lane) * 8); } while (0)
    G2_LOAD(0);
    for (int c = 0; c < NCH; ++c) {
        bf16x8 cM[4][2], cP[2][2]; u32x2 cN[4], cR[2];
#pragma unroll
        for (int m = 0; m < 4; ++m) { cM[m][0] = Mf[m][0]; cM[m][1] = Mf[m][1]; cN[m] = Nv[m]; }
#pragma unroll
        for (int ct = 0; ct < 2; ++ct) { cP[ct][0] = Pf[ct][0]; cP[ct][1] = Pf[ct][1]; cR[ct] = Rv[ct]; }
        if (c + 1 < NCH) G2_LOAD(c + 1);
        bf16x8 Bs[2];
#pragma unroll
        for (int s2 = 0; s2 < 2; ++s2) { u32x4 w; w.x = cvtpk(S[2 * s2][0], S[2 * s2][1]); w.y = cvtpk(S[2 * s2][2], S[2 * s2][3]); w.z = cvtpk(S[2 * s2 + 1][0], S[2 * s2 + 1][1]); w.w = cvtpk(S[2 * s2 + 1][2], S[2 * s2 + 1][3]);
            Bs[s2] = __builtin_bit_cast(bf16x8, w); }
#pragma unroll
        for (int ct = 0; ct < 2; ++ct) { f32x4 o = (f32x4){bflo(cR[ct].x), bfhi(cR[ct].x), bflo(cR[ct].y), bfhi(cR[ct].y)};
            o = mfma16(cP[ct][0], Bs[0], o); o = mfma16(cP[ct][1], Bs[1], o);
            bf16_t* op = og + (size_t)(c * GC + 16 * ct + 4 * kq) * 512;
#pragma unroll
            for (int r = 0; r < 4; ++r) op[(size_t)r * 512] = f2bf(o[r]); }
#pragma unroll
        for (int m = 0; m < 4; ++m) { f32x4 a = (f32x4){bflo(cN[m].x), bfhi(cN[m].x), bflo(cN[m].y), bfhi(cN[m].y)};
            a = mfma16(cM[m][0], Bs[0], a); S[m] = mfma16(cM[m][1], Bs[1], a); }
    }
#undef G2_LOAD
}

constexpr int P6_RW = 0, P6_TK = 131072;
__device__ __forceinline__ void p6_router(Frame& F, int rep) {
    const int lane = F.lane, wid = F.wave, tid = F.tid, l15 = lane & 15, kq = lane >> 4;
    LAS unsigned char* rwl = F.lds;
    LAS float* gml = (LAS float*)(F.lds + MISC_OFF + 1024);
    const float* x1 = WSP(float, WS_X1); const float* mod = WSP(float, WS_MOD); unsigned char* h2 = WSP(unsigned char, WS_H);
    const size_t ro = rep ? WS_END : 0;
    int* tke = WSP(int, ro + WS_TKE); float* tkw = WSP(float, ro + WS_TKW); int* tkp = WSP(int, ro + WS_TKP); int* lst = WSP(int, ro + WS_LIST);
    const int tpw = T / F.G, t0 = (int)blockIdx.x * tpw;
    { const float* rwt = WSP(float, WS_RWT);
      for (int idx = tid; idx < NE * 128; idx += NWAVES * 64) { const int e = idx >> 7, c = idx & 127; const f32x4 a = *(const f32x4*)(rwt + e * DM + 8 * c), bq = *(const f32x4*)(rwt + e * DM + 8 * c + 4);
          u32x4 hi4, lo4; float v[8] = {a[0], a[1], a[2], a[3], bq[0], bq[1], bq[2], bq[3]};
#pragma unroll
          for (int i = 0; i < 4; ++i) { const unsigned hw = cvtpk(v[2 * i], v[2 * i + 1]); hi4[i] = hw; lo4[i] = cvtpk(v[2 * i] - bflo(hw), v[2 * i + 1] - bfhi(hw)); }
          const int off = e * 2048 + ((c ^ (e & 15)) << 4);
          *(LAS u32x4*)(rwl + off) = hi4; *(LAS u32x4*)(rwl + 65536 + off) = lo4; }
      const float* mb = mod + (size_t)(t0 / SEQ) * 6144;
      for (int i = tid; i < DM; i += NWAVES * 64) { gml[i] = F.in[IN_N2G][i] * (1.0f + mb[4096 + i]); gml[DM + i] = mb[3072 + i]; } }
    if (tid < 96) F.MISC[32 + tid] = 0u;
    __syncthreads();
    for (int tb0 = wid * 16; tb0 < tpw; tb0 += NWAVES * 16) {
        const int t = t0 + tb0 + l15; const float* xr = x1 + (size_t)t * DM + 8 * kq; unsigned char* hr = h2 + (size_t)t * DM + 8 * kq;
        float ss = 0.f;
#pragma unroll 8
        for (int s2 = 0; s2 < 32; ++s2) { const f32x4 a = *(const f32x4*)(xr + 32 * s2), bq = *(const f32x4*)(xr + 32 * s2 + 4);
            ss += (a[0] * a[0] + a[1] * a[1]) + (a[2] * a[2] + a[3] * a[3]) + (bq[0] * bq[0] + bq[1] * bq[1]) + (bq[2] * bq[2] + bq[3] * bq[3]); }
        ss += __shfl_xor(ss, 16); ss += __shfl_xor(ss, 32);
        const float rstd = __builtin_amdgcn_rsqf(ss * (1.f / DM) + EPS);
        f32x4 acc[2] = {(f32x4){0.f, 0.f, 0.f, 0.f}, (f32x4){0.f, 0.f, 0.f, 0.f}};
#pragma unroll 4
        for (int s2 = 0; s2 < 32; ++s2) {
            const f32x4 a = *(const f32x4*)(xr + 32 * s2), bq = *(const f32x4*)(xr + 32 * s2 + 4);
            const LAS f32x4* gp = (const LAS f32x4*)(gml + 32 * s2 + 8 * kq); const f32x4 g0 = gp[0], g1 = gp[1], h0 = gp[DM / 4], h1 = gp[DM / 4 + 1];
            const f32x4 v0 = a * rstd * g0 + h0, v1 = bq * rstd * g1 + h1;
            u32x2 f8; f8.x = pk4_fp8(v0[0], v0[1], v0[2], v0[3]); f8.y = pk4_fp8(v1[0], v1[1], v1[2], v1[3]); *(u32x2*)(hr + 32 * s2) = f8;
            u32x4 hi4, lo4;
            hi4[0] = cvtpk(v0[0], v0[1]); hi4[1] = cvtpk(v0[2], v0[3]); hi4[2] = cvtpk(v1[0], v1[1]); hi4[3] = cvtpk(v1[2], v1[3]);
            lo4[0] = cvtpk(v0[0] - bflo(hi4[0]), v0[1] - bfhi(hi4[0])); lo4[1] = cvtpk(v0[2] - bflo(hi4[1]), v0[3] - bfhi(hi4[1]));
            lo4[2] = cvtpk(v1[0] - bflo(hi4[2]), v1[1] - bfhi(hi4[2])); lo4[3] = cvtpk(v1[2] - bflo(hi4[3]), v1[3] - bfhi(hi4[3]));
            const bf16x8 ah = __builtin_bit_cast(bf16x8, hi4), al = __builtin_bit_cast(bf16x8, lo4);
#pragma unroll
            for (int j = 0; j < 2; ++j) { const int e = l15 + 16 * j; const LAS unsigned char* bp = rwl + e * 2048 + (((4 * s2 + kq) ^ (e & 15)) << 4);
                const bf16x8 bh = *(const LAS bf16x8*)bp, bl = *(const LAS bf16x8*)(bp + 65536);
                acc[j] = mfma16(ah, bh, acc[j]); acc[j] = mfma16(al, bh, acc[j]); acc[j] = mfma16(ah, bl, acc[j]); }
        }
        const float rb0 = F.in[IN_RB][l15], rb1 = F.in[IN_RB][l15 + 16];
#pragma unroll
        for (int r = 0; r < 4; ++r) {
            float v0 = acc[0][r] + rb0, v1 = acc[1][r] + rb1; float tv[4]; int ti[4];
#pragma unroll
            for (int k = 0; k < 4; ++k) { float bv = v0; int bi = l15; if (v1 > v0) { bv = v1; bi = l15 + 16; }
#pragma unroll
                for (int o = 1; o < 16; o <<= 1) { const float ov = __shfl_xor(bv, o); const int oi = __shfl_xor(bi, o); if (ov > bv || (ov == bv && oi < bi)) { bv = ov; bi = oi; } }
                tv[k] = bv; ti[k] = bi; if (bi == l15) v0 = -INFINITY; if (bi == l15 + 16) v1 = -INFINITY; }
            const float e1 = __expf(tv[1] - tv[0]), e2 = __expf(tv[2] - tv[0]), e3 = __expf(tv[3] - tv[0]), inv = 1.0f / (1.0f + e1 + e2 + e3);
            if (l15 < 4) { const int tt = t0 + tb0 + 4 * kq + r; const int e = (l15 == 0) ? ti[0] : (l15 == 1) ? ti[1] : (l15 == 2) ? ti[2] : ti[3];
                const float w = ((l15 == 0) ? 1.0f : (l15 == 1) ? e1 : (l15 == 2) ? e2 : e3) * inv;
                const int lp = __hip_atomic_fetch_add((LAS int*)(F.lds + MISC_OFF) + 32 + e, 1, __ATOMIC_RELAXED, __HIP_MEMORY_SCOPE_WORKGROUP);
                tke[tt * 4 + l15] = e; tkw[tt * 4 + l15] = w; tkp[tt * 4 + l15] = lp; }
        }
    }
    __syncthreads();
    if (tid < 32) { const int n = (int)F.MISC[32 + tid]; int base = 0; if (n > 0) base = (int)__hip_atomic_fetch_add(F.ctl + CW_CNT + 4096 * rep + 64 * tid, (unsigned)n, RLX_AGENT); F.MISC[64 + tid] = (unsigned)base; }
    VM_WAIT(); __syncthreads();
    for (int i = tid; i < tpw * 4; i += NWAVES * 64) { const int t = t0 + (i >> 2), e = tke[t * 4 + (i & 3)], p = tkp[t * 4 + (i & 3)] + (int)F.MISC[64 + e]; tkp[t * 4 + (i & 3)] = p; lst[(size_t)e * T + p] = t; }
}
__device__ __forceinline__ void moe_tables(Frame& F) {
    if (F.tid < 32) F.MISC[192 + F.tid] = __hip_atomic_load(F.ctl + CW_CNT + 64 * F.tid, RLX_AGENT);
    __syncthreads();
    if (F.tid == 0) { unsigned s = 0; for (int e = 0; e < 32; ++e) { F.MISC[128 + e] = s; s += (F.MISC[192 + e] + 255u) >> 8; } F.MISC[160] = s; }
    __syncthreads();
    for (int mt = F.tid; mt < 576; mt += NWAVES * 64) { int e = 0; while (e < 31 && F.MISC[128 + e + 1] <= (unsigned)mt) ++e; F.MISC[2304 + mt] = (unsigned)e; }
    __syncthreads();
}
__device__ __forceinline__ void p10_combine(Frame& F) {
    const int gw = F.vcu * NWAVES + F.wave, NGW = F.G * NWAVES, lane = F.lane;
    const float* x1 = WSP(float, WS_X1); const float* mod = WSP(float, WS_MOD); const unsigned char* y = WSP(unsigned char, WS_Y);
    const int* tke = WSP(int, WS_TKE); const float* tkw = WSP(float, WS_TKW); const int* tkp = WSP(int, WS_TKP);
    constexpr int R = 2;
    for (int m0 = gw; m0 < T; m0 += R * NGW) {
        u32x2 y0[R][4], y1[R][4]; float w[R][4]; f32x4 xv[R][4];
#pragma unroll
        for (int r = 0; r < R; ++r) { const int m = (m0 + r * NGW < T) ? m0 + r * NGW : m0;
            const i32x4q e4 = *(const i32x4q*)(tke + m * 4), p4 = *(const i32x4q*)(tkp + m * 4); const f32x4 w4 = *(const f32x4*)(tkw + m * 4);
#pragma unroll
            for (int k = 0; k < 4; ++k) { const size_t row = (size_t)F.MISC[128 + e4[k]] * 256 + p4[k]; w[r][k] = w4[k];
                y0[r][k] = *(const u32x2*)(y + row * DM + 8 * lane); y1[r][k] = *(const u32x2*)(y + row * DM + 512 + 8 * lane); }
#pragma unroll
            for (int q = 0; q < 4; ++q) xv[r][q] = *(const f32x4*)(x1 + (size_t)m * DM + (q >> 1) * 512 + 8 * lane + 4 * (q & 1)); }
#pragma unroll
        for (int r = 0; r < R; ++r) { const int m = m0 + r * NGW; if (m >= T) continue;
            float a[16];
#pragma unroll
            for (int i = 0; i < 16; ++i) a[i] = 0.f;
#pragma unroll
            for (int k = 0; k < 4; ++k)
#pragma unroll
                for (int i = 0; i < 2; ++i) { const f32x2 l0 = __builtin_amdgcn_cvt_pk_f32_fp8((int)y0[r][k][i], false), h0 = __builtin_amdgcn_cvt_pk_f32_fp8((int)y0[r][k][i], true);
                    const f32x2 l1 = __builtin_amdgcn_cvt_pk_f32_fp8((int)y1[r][k][i], false), h1 = __builtin_amdgcn_cvt_pk_f32_fp8((int)y1[r][k][i], true);
                    a[4 * i] += w[r][k] * l0[0]; a[4 * i + 1] += w[r][k] * l0[1]; a[4 * i + 2] += w[r][k] * h0[0]; a[4 * i + 3] += w[r][k] * h0[1];
                    a[8 + 4 * i] += w[r][k] * l1[0]; a[8 + 4 * i + 1] += w[r][k] * l1[1]; a[8 + 4 * i + 2] += w[r][k] * h1[0]; a[8 + 4 * i + 3] += w[r][k] * h1[1]; }
            const float* mb = mod + (size_t)(m / SEQ) * 6144 + 5120; float ss = 0.f; f32x4 v[4];
#pragma unroll
            for (int q = 0; q < 4; ++q) { const int col = (q >> 1) * 512 + 8 * lane + 4 * (q & 1); const f32x4 gt = *(const f32x4*)(mb + col);
#pragma unroll
                for (int i = 0; i < 4; ++i) { v[q][i] = xv[r][q][i] + gt[i] * a[(q >> 1) * 8 + 4 * (q & 1) + i]; ss += v[q][i] * v[q][i]; } }
            const float rstd = __builtin_amdgcn_rsqf(wave_sum(ss) * (1.f / DM) + EPS);
#pragma unroll
            for (int q = 0; q < 4; ++q) { const int col = (q >> 1) * 512 + 8 * lane + 4 * (q & 1); const f32x4 fg = *(const f32x4*)(F.in[IN_FG] + col);
                *(f32x4*)(F.out + (size_t)m * DM + col) = v[q] * rstd * fg; } }
    }
}
__device__ __forceinline__ void dbg_final(Frame& F, const float* src) {
    const int gw = F.vcu * NWAVES + F.wave, NGW = F.G * NWAVES;
    for (int m = gw; m < T; m += NGW) {
        const f32x4* xr = (const f32x4*)(src + (size_t)m * DM) + F.lane; f32x4 v[4]; float s = 0.f;
#pragma unroll
        for (int j = 0; j < 4; ++j) { v[j] = xr[64 * j]; s += (v[j][0] * v[j][0] + v[j][1] * v[j][1]) + (v[j][2] * v[j][2] + v[j][3] * v[j][3]); }
        const float rstd = __builtin_amdgcn_rsqf(wave_sum(s) * (1.f / DM) + EPS);
#pragma unroll
        for (int j = 0; j < 4; ++j) { const int col = 4 * (F.lane + 64 * j); *(f32x4*)(F.out + (size_t)m * DM + col) = v[j] * rstd * *(const f32x4*)(F.in[IN_FG] + col); }
    }
}


__device__ __forceinline__ void dbg_dump_bf16(Frame& F, const bf16_t* src, int ld, int c0, int n) {
    for (size_t i = (size_t)blockIdx.x * NWAVES * 64 + F.tid; i < (size_t)T * n; i += (size_t)F.G * NWAVES * 64) { const size_t t = i / n; const int c = (int)(i % n); F.out[t * DM + c0 + c] = bf2f(src[t * ld + c]); }
}
#define DBG_DUMP(k, ...) do { if (DBG_STAGE == (k)) { xcd_barrier(bar); __VA_ARGS__; return; } } while (0)
#ifndef DBG_STAGE
#define DBG_STAGE (-1)
#endif

constexpr int N_PHASES = 13;
struct Args { const float* in[N_IN]; float* out; unsigned char* ws; int ph_lo, ph_hi; };
__global__ void __launch_bounds__(NWAVES * 64, 2) fwd_kernel(Args args) {
    extern __shared__ __attribute__((aligned(16))) unsigned char lds[];
    Frame F;
    F.lds = (LAS unsigned char*)lds; F.MISC = (volatile LAS unsigned*)(F.lds + MISC_OFF);
    F.tid = threadIdx.x; F.lane = F.tid & 63; F.wave = __builtin_amdgcn_readfirstlane(F.tid >> 6);
    F.G = gridDim.x; { const int bx = blockIdx.x; F.vcu = (F.G % 8 == 0) ? (bx % 8) * (F.G / 8) + bx / 8 : bx; }
    F.ws = args.ws; F.ctl = (unsigned*)(args.ws + WS_CTL); F.out = args.out;
#pragma unroll
    for (int i = 0; i < N_IN; ++i) F.in[i] = args.in[i];
    for (int u = F.tid; u < (LDS_BYTES - MISC_OFF) / 4; u += NWAVES * 64) ((LAS unsigned*)(F.lds + MISC_OFF))[u] = 0u;
    __syncthreads();
    XcdBarrier bar; bar.bar = F.ctl + CW_BAR; bar.x = 0; bar.st = nullptr;
    if (!N_LAUNCH_PER_PHASE) bar = xcd_barrier_post(F.ctl + CW_BAR, F.MISC + 8);
    const int lo = args.ph_lo, hi = args.ph_hi;
#ifndef REP_PHASE
#define REP_PHASE (-1)
#endif
#define NREP(k) ((REP_PHASE == (k)) ? 2 : 1)
#define REPLOOP(k) _Pragma("unroll") for (int rep = 0; rep < NREP(k); ++rep)
#ifndef PH_MASK
#define PH_MASK 0xFFFFu
#endif
#define IN(k) ((((PH_MASK) >> (k)) & 1u) && lo <= (k) && (k) < hi)
#ifndef TPROBE
#define TPROBE (-2)
#endif
    unsigned long long tp0 = (TPROBE == 0) ? __builtin_amdgcn_s_memrealtime() : 0ull, tpd = 0ull;
#define SEAM(k) do { if (IN(k) && IN((k) + 1)) xcd_barrier(bar); if (TPROBE == (k)) tpd = __builtin_amdgcn_s_memrealtime() - tp0; if (TPROBE == (k) + 1) tp0 = __builtin_amdgcn_s_memrealtime(); } while (0)

#if defined(DBG_BASE)
    dbg_final(F, F.in[IN_X]); return;
#endif
    if (IN(0)) REPLOOP(0) { p0_mod(F); __syncthreads(); p0_weights(F); __syncthreads(); }
    SEAM(0);
    if (IN(1)) REPLOOP(1) norm_rows(F, F.in[IN_X], F.in[IN_N1G], 0, 1024, WSP(bf16_t, WS_H));
    SEAM(1);
    if (IN(2)) REPLOOP(2) {
        pg::Gemm g{WSP(bf16_t, WS_H), WSP(bf16_t, WS_WIN), DM * 2, DM * 2, nullptr}; pg::StaticOrder S; S.init(T, NPROJ, F.G, (int)blockIdx.x);
        EpiProj E{WSP(bf16_t, WS_PROJ), WSP(float, WS_PART)};
        pg::gemm_phase<EpiProj, pg::StaticOrder, false, true>(F.lds, g, S, E);
    }
    DBG_DUMP(2, dbg_dump_bf16(F, WSP(bf16_t, WS_PROJ), NPROJ, 0, 1024));
    SEAM(2);
    if (IN(4)) REPLOOP(4) {
#ifndef NO_QG
        { pg::Gemm g{WSP(bf16_t, WS_PROJ) + C_QLAT, WSP(bf16_t, WS_WQ), NPROJ * 2, QLORA * 2, nullptr}; pg::StaticOrder S; S.init(T, 768, F.G, (int)blockIdx.x);
          EpiQ E{WSP(bf16_t, WS_Q), WSP(float, WS_PART), WSP(float, WS_CS), 0.10206207261596575f * 1.4426950408889634f};
          pg::gemm_phase<EpiQ, pg::StaticOrder, false, true>(F.lds, g, S, E); }
#endif
#ifndef NO_KVG
        { pg::Gemm g{WSP(bf16_t, WS_PROJ) + C_KVLAT, WSP(bf16_t, WS_WKV), NPROJ * 2, KVLORA * 2, nullptr}; pg::StaticOrder S; S.init(T, 1024, F.G, (int)(F.G - 1 - blockIdx.x));
          EpiKV E{WSP(bf16_t, WS_K), WSP(bf16_t, WS_V), WSP(float, WS_PART), WSP(bf16_t, WS_PROJ), WSP(float, WS_CS)};
          pg::gemm_phase<EpiKV, pg::StaticOrder, false, true>(F.lds, g, S, E); }
#endif
    }
    DBG_DUMP(4, dbg_dump_bf16(F, WSP(bf16_t, WS_Q), 768, 0, 768); dbg_dump_bf16(F, WSP(bf16_t, WS_K), 768, 768, 256));
    SEAM(4);
    unsigned long long g1acc = 0ull;
    if (IN(5)) REPLOOP(5) { for (int u = blockIdx.x; u < BATCH * GH * NCH / 4; u += F.G) g1_unit(F, u, g1acc); }
    if (G1PROBE >= 0) tpd = g1acc;
    SEAM(5);
#ifndef NCONV
#define NCONV 56
#endif
    if (IN(6)) {
        if (F.tid == 0) F.MISC[17] = __hip_atomic_fetch_add(F.ctl + CW_Q + 320, 1u, RLX_AGENT);
        for (;;) {
            if (F.tid == 0) F.MISC[16] = __hip_atomic_fetch_add(F.ctl + CW_Q, 1u, RLX_AGENT);
            __syncthreads();
            const int item = (int)F.MISC[16];
            __syncthreads();
            if (item >= 32) break;
            g2_item(F, item);
        }
        const int ticket = (int)F.MISC[17];
#define CONV_LOOP() for (;;) { if (F.tid == 0) F.MISC[16] = __hip_atomic_fetch_add(F.ctl + CW_Q + 256, 1u, RLX_AGENT); __syncthreads(); const int item = (int)F.MISC[16]; __syncthreads(); \
            if (item >= MOE_CONV_ITEMS) break; moe_conv_item(F, item); }
        if (ticket >= 32 && ticket < 32 + NCONV) CONV_LOOP();
        for (;;) {
            if (F.tid == 0) F.MISC[16] = __hip_atomic_fetch_add(F.ctl + CW_Q + 64, 1u, RLX_AGENT);
            __syncthreads();
            const int item = (int)F.MISC[16];
            __syncthreads();
            if (item >= BATCH * NH * 16) break;
            const int qb = 15 - (item >> 6), bh = item & 63; attn_unit(F, bh >> 3, bh & 7, qb);
        }
        CONV_LOOP();
#undef CONV_LOOP
    }
    DBG_DUMP(6, dbg_dump_bf16(F, WSP(bf16_t, DBG_SUB ? WS_OG : WS_OA), 512, 0, 512); dbg_dump_bf16(F, WSP(bf16_t, DBG_SUB ? WS_OG : WS_OA), 512, 512, 512));
    SEAM(6);
    if (IN(7)) REPLOOP(7) p4b_rows(F);
    SEAM(7);
    if (IN(8)) REPLOOP(8) {
        pg::Gemm g{WSP(bf16_t, WS_H), WSP(bf16_t, WS_WO), DM * 2, DM * 2, nullptr}; pg::StaticOrder S; S.init(T, DM, F.G, (int)blockIdx.x);
        EpiX1 E{F.in[IN_X], WSP(float, WS_MOD), WSP(float, WS_X1)};
        pg::gemm_phase<EpiX1, pg::StaticOrder, false, true>(F.lds, g, S, E);
    }
#if defined(DBG_STOP_X1)
    xcd_barrier(bar); dbg_final(F, WSP(float, WS_X1)); return;
#endif
    SEAM(8);
    if (IN(9)) REPLOOP(9) { p6_router(F, rep); __syncthreads(); }
    SEAM(9);
    if (IN(10)) REPLOOP(10) {
        moe_tables(F);
        pg::Gemm g{WSP(unsigned char, WS_H), WSP(unsigned char, WS_WGU), DM, DM, WSP(int, WS_LIST)};
#if defined(EPIPROBE) && EPIPROBE == 10
        g.tacc = &tpd;
#endif
        pg::MoeOrder S{(const LAS int*)(F.lds + MISC_OFF) + 128, (const LAS int*)(F.lds + MISC_OFF) + 192, 8, 2048, F.G, (int)blockIdx.x, 0};
        EpiGU E{WSP(unsigned char, WS_ACT), F.in[IN_BGU]};
        pg::gemm_phase<EpiGU, pg::MoeOrder, true, true, true>(F.lds, g, S, E);
    }
    SEAM(10);
    if (IN(11)) REPLOOP(11) {
        moe_tables(F);
        pg::Gemm g{WSP(unsigned char, WS_ACT), WSP(unsigned char, WS_WDN), DE, DE, nullptr};
#if defined(EPIPROBE) && EPIPROBE == 11
        g.tacc = &tpd;
#endif
        pg::MoeOrder S{(const LAS int*)(F.lds + MISC_OFF) + 128, (const LAS int*)(F.lds + MISC_OFF) + 192, 4, 1024, F.G, (int)blockIdx.x, 1};
        EpiDN E{WSP(unsigned char, WS_Y), F.in[IN_BDN]};
        pg::gemm_phase<EpiDN, pg::MoeOrder, false, true, true>(F.lds, g, S, E);
    }
    SEAM(11);
    if (IN(12)) REPLOOP(12) { moe_tables(F); p10_combine(F); }
#ifdef EPIPROBE
    const bool epiprobe_ = true;
#else
    const bool epiprobe_ = false;
#endif
    if (TPROBE >= 0 || G1PROBE >= 0 || epiprobe_) { if (TPROBE == 12) { VM_WAIT(); tpd = __builtin_amdgcn_s_memrealtime() - tp0; }
        if (blockIdx.x == 0) { const unsigned long long t_ = __builtin_amdgcn_s_memrealtime(); while (__builtin_amdgcn_s_memrealtime() - t_ < 10ull * tpd) __builtin_amdgcn_s_sleep(8); } }
#undef IN
#undef SEAM
}

extern "C" void kernel_launch(void* const* d_in, const int* in_sizes, int n_in, void* d_out, int out_size, void* d_ws, size_t ws_size, hipStream_t stream) {
    static int grid = 0;
    if (grid == 0) {
        if (n_in != N_IN || out_size != T * DM || ws_size < WS_END) { fprintf(stderr, "kernel_launch: unexpected shapes (n_in %d, out %d, ws %zu)\n", n_in, out_size, ws_size); grid = -1; return; }
        int dev = 0, cus = 0;
        if (hipGetDevice(&dev) != hipSuccess || hipDeviceGetAttribute(&cus, hipDeviceAttributeMultiprocessorCount, dev) != hipSuccess) { grid = -1; return; }
        if (hipFuncSetAttribute((const void*)fwd_kernel, hipFuncAttributeMaxDynamicSharedMemorySize, LDS_BYTES) != hipSuccess) { grid = -1; return; }
        int per_cu = 0;
        if (hipOccupancyMaxActiveBlocksPerMultiprocessor(&per_cu, (const void*)fwd_kernel, NWAVES * 64, LDS_BYTES) != hipSuccess || per_cu < 1) fprintf(stderr, "kernel_launch: occupancy query says %d\n", per_cu);
        (void)hipGetLastError();
        grid = cus;
        while (grid > 8 && (T % grid) != 0) grid -= 8;
    }
    if (grid < 0) return;
    (void)hipMemsetAsync((char*)d_ws + WS_CTL, 0, CTL_BYTES, stream);
    Args a{};
    for (int i = 0; i < N_IN; ++i) a.in[i] = (const float*)d_in[i];
    a.out = (float*)d_out; a.ws = (unsigned char*)d_ws;
#if N_LAUNCH_PER_PHASE
    for (int p = 0; p < N_PHASES; ++p) { a.ph_lo = p; a.ph_hi = p + 1; hipLaunchKernelGGL(fwd_kernel, dim3(grid), dim3(NWAVES * 64), LDS_BYTES, stream, a); }
#else
    a.ph_lo = 0; a.ph_hi = N_PHASES;
    hipLaunchKernelGGL(fwd_kernel, dim3(grid), dim3(NWAVES * 64), LDS_BYTES, stream, a);
#endif
}
```

```cpp
#include <hip/hip_runtime.h>
#include <cstdio>
#include <cstdint>


#define DBG_SUB 0
#ifndef N_LAUNCH_PER_PHASE
#define N_LAUNCH_PER_PHASE 0
#endif

#define GAS __attribute__((address_space(1)))
#define LAS __attribute__((address_space(3)))
typedef unsigned short bf16_t;
typedef short bf16x8 __attribute__((ext_vector_type(8)));
typedef short s16x4 __attribute__((ext_vector_type(4)));
typedef float f32x4 __attribute__((ext_vector_type(4)));
typedef float f32x2 __attribute__((ext_vector_type(2)));
typedef float f32x16 __attribute__((ext_vector_type(16)));
typedef unsigned u32x4 __attribute__((ext_vector_type(4)));
typedef unsigned u32x2 __attribute__((ext_vector_type(2)));
typedef __bf16 bf16x2_t __attribute__((ext_vector_type(2)));
typedef int i32x4q __attribute__((ext_vector_type(4)));

constexpr int BATCH = 8, SEQ = 4096, DM = 1024, T = BATCH * SEQ;
constexpr int NH = 8, QK = 96, NOPE = 64, ROPE = 32, VD = 64, QLORA = 384, KVLORA = 256;
constexpr int GH = 8, GDK = 64, GDV = 64;
constexpr int IN_DIM = 2736, NPROJ = 2816;
constexpr int C_QLAT = 0, C_KVLAT = 384, C_KPE = 640, C_GQ = 672, C_GK = 1184, C_GV = 1696, C_GZ = 2208, C_GA = 2720, C_GB = 2728;
constexpr int NE = 32, TOPK = 4, DE = 1024;
constexpr float EPS = 1e-6f;
constexpr float W8 = 32.0f;
constexpr int GC = 32, NCH = SEQ / GC;
constexpr int MAXROWS = T * TOPK + NE * 256;

constexpr size_t MiB = 1u << 20;
constexpr size_t WS_CTL = 0, CTL_BYTES = 1 * MiB;
constexpr size_t WS_MOD = 1 * MiB;
constexpr size_t WS_RSQ = 2 * MiB;
constexpr size_t WS_RSKV = WS_RSQ + 128 * 1024;
constexpr size_t WS_CS = 3 * MiB;
constexpr size_t WS_TKE = 7 * MiB;
constexpr size_t WS_TKW = WS_TKE + 512 * 1024;
constexpr size_t WS_TKP = WS_TKW + 512 * 1024;
constexpr size_t WS_LIST = 9 * MiB;
constexpr size_t WS_RWT = 13 * MiB;
constexpr size_t WS_PART = 13 * MiB + 256 * 1024;
constexpr size_t WS_WIN = 16 * MiB;
constexpr size_t WS_WQ = WS_WIN + (size_t)NPROJ * DM * 2;
constexpr size_t WS_WKV = WS_WQ + (size_t)768 * 384 * 2;
constexpr size_t WS_WO = WS_WKV + (size_t)1024 * 256 * 2;
constexpr size_t WS_WGU = 32 * MiB;
constexpr size_t WS_WDN = WS_WGU + (size_t)NE * 2048 * 1024 * 2;
constexpr size_t WS_H = 224 * MiB;
constexpr size_t WS_X1 = 288 * MiB;
constexpr size_t WS_PROJ = 416 * MiB;
constexpr size_t WS_Q = 592 * MiB;
constexpr size_t WS_K = 640 * MiB;
constexpr size_t WS_V = 688 * MiB;
constexpr size_t WS_OA = 720 * MiB;
constexpr size_t WS_OG = 752 * MiB;
constexpr size_t WS_GD = 784 * MiB;
constexpr size_t WS_ACT = 416 * MiB;
constexpr size_t WS_Y = 688 * MiB;
constexpr size_t WS_END = 976 * MiB;
static_assert(WS_WO + (size_t)1024 * 1024 * 2 <= WS_WGU && WS_WDN + (size_t)NE * 1024 * 1024 * 2 <= WS_H, "weights");
static_assert(WS_ACT + (size_t)MAXROWS * 1024 * 2 <= WS_Y && WS_Y + (size_t)MAXROWS * 1024 * 2 <= WS_END, "moe rows");
static_assert(WS_GD + (size_t)BATCH * GH * NCH * 24576 <= WS_END, "gdn");
constexpr int CW_BAR = 4096;
constexpr int CW_Q = 8192;
constexpr int CW_CNT = 12288;

constexpr int RING_BYTES = 131072;
constexpr int MISC_OFF = RING_BYTES;
constexpr int LDS_BYTES = 147456;

#define LDS_WAIT() asm volatile("s_waitcnt lgkmcnt(0)" ::: "memory")
#define LBAR() asm volatile("s_waitcnt lgkmcnt(0)\n\ts_barrier" ::: "memory")
#define VM_WAIT() asm volatile("s_waitcnt vmcnt(0)" ::: "memory")
#define RLX_AGENT __ATOMIC_RELAXED, __HIP_MEMORY_SCOPE_AGENT

__device__ __forceinline__ unsigned cvtpk(float lo, float hi) { f32x2 v = {lo, hi}; bf16x2_t b = __builtin_convertvector(v, bf16x2_t); return __builtin_bit_cast(unsigned, b); }
__device__ __forceinline__ bf16_t f2bf(float f) { return (bf16_t)(cvtpk(f, 0.f) & 0xffffu); }
__device__ __forceinline__ float bf2f(unsigned short h) { return __uint_as_float((unsigned)h << 16); }
__device__ __forceinline__ float bflo(unsigned w) { return __uint_as_float(w << 16); }
__device__ __forceinline__ float bfhi(unsigned w) { return __uint_as_float(w & 0xffff0000u); }
__device__ __forceinline__ float wave_sum(float v) {
#pragma unroll
    for (int o = 1; o < 64; o <<= 1) v += __shfl_xor(v, o);
    return v;
}
__device__ __forceinline__ unsigned pk4_fp8(float a, float b, float c, float d) { int w = 0; w = __builtin_amdgcn_cvt_pk_fp8_f32(a, b, w, false); w = __builtin_amdgcn_cvt_pk_fp8_f32(c, d, w, true); return (unsigned)w; }
__device__ __forceinline__ float siluf(float x) { return x / (1.f + __expf(-x)); }

#define XB_TMO      128
#define XB_XCNT(j)  (256  + 64 * (j))
#define XB_XSUB(j)  (1280 + 64 * (j))
#define XB_XGEN(j)  (2304 + 64 * (j))
#define XB_TOP      3328
#define XB_TOPGEN   3392
#define XCD_BAR_WORDS 3456
#define XB_SPIN_CAP (1u << 18)
__device__ __forceinline__ unsigned xb_ld(unsigned* p)              { return __hip_atomic_load(p, __ATOMIC_RELAXED, __HIP_MEMORY_SCOPE_AGENT); }
__device__ __forceinline__ unsigned xb_add(unsigned* p, unsigned v) { return __hip_atomic_fetch_add(p, v, __ATOMIC_RELAXED, __HIP_MEMORY_SCOPE_AGENT); }
__device__ __forceinline__ unsigned xb_xcc_id() { return (unsigned)__builtin_amdgcn_s_getreg((3 << 11) | 20) & 0xFu; }
#define XB_SPIN(cond, bar) do { unsigned _sp = 0; while (cond) { __builtin_amdgcn_s_sleep(1); \
    if ((++_sp & 255u) == 0u) { if (xb_ld(&(bar)[XB_TMO])) break; if (_sp > XB_SPIN_CAP) { atomicAdd(&(bar)[XB_TMO], 1u); break; } } } } while (0)
struct XcdBarrier { unsigned* bar; unsigned x; volatile LAS unsigned* st; };
__device__ __forceinline__ XcdBarrier xcd_barrier_post(unsigned* bar, volatile LAS unsigned* st) {
    XcdBarrier b; b.bar = bar; b.x = xb_xcc_id(); b.st = st;
    if (threadIdx.x == 0) (void)xb_add(&bar[XB_XCNT(b.x)], 1u);
    return b;
}
__device__ __forceinline__ void xcd_barrier_complete(unsigned* bar, unsigned x, unsigned& nloc, unsigned& nx) {
    const unsigned G = gridDim.x * gridDim.y * gridDim.z;
    unsigned sum, cnt, mine, sp = 0u;
    for (;;) {
        sum = 0u; cnt = 0u; mine = 0u;
#pragma unroll
        for (unsigned j = 0; j < 16; ++j) { const unsigned c = xb_ld(&bar[XB_XCNT(j)]); sum += c; cnt += (c > 0u) ? 1u : 0u; mine = (j == x) ? c : mine; }
        if (sum == G) break;
        __builtin_amdgcn_s_sleep(1);
        if ((++sp & 255u) == 0u) { if (xb_ld(&bar[XB_TMO])) break; if (sp > XB_SPIN_CAP) { atomicAdd(&bar[XB_TMO], 1u); break; } }
    }
    nloc = mine > 0u ? mine : 1u; nx = cnt > 0u ? cnt : 1u;
}
__device__ __forceinline__ void xcd_barrier(const XcdBarrier& b) {
    asm volatile("s_waitcnt vmcnt(0)" ::: "memory");
    __syncthreads();
    if (threadIdx.x == 0) {
        unsigned* bar = b.bar;
        __builtin_amdgcn_s_waitcnt(0);
        unsigned nloc = b.st[0], nx = b.st[1];
        if (nloc == 0u) { xcd_barrier_complete(bar, b.x, nloc, nx); b.st[0] = nloc; b.st[1] = nx; }
        const unsigned old = xb_add(&bar[XB_XSUB(b.x)], 1u);
        const unsigned gen = old / nloc;
        if (old + 1u == (gen + 1u) * nloc) {
            __builtin_amdgcn_fence(__ATOMIC_RELEASE, "agent");
            asm volatile("s_waitcnt vmcnt(0)" ::: "memory");
            const unsigned og = xb_add(&bar[XB_TOP], 1u);
            const unsigned tg = og / nx;
            if (og + 1u == (tg + 1u) * nx) xb_add(&bar[XB_TOPGEN], 1u);
            else XB_SPIN(xb_ld(&bar[XB_TOPGEN]) == tg, bar);
            __builtin_amdgcn_fence(__ATOMIC_ACQUIRE, "agent");
            xb_add(&bar[XB_XGEN(b.x)], 1u);
            asm volatile("s_waitcnt vmcnt(0)" ::: "memory");
        } else {
            XB_SPIN(xb_ld(&bar[XB_XGEN(b.x)]) == gen, bar);
            __builtin_amdgcn_fence(__ATOMIC_ACQUIRE, "agent");
            asm volatile("s_waitcnt vmcnt(0)" ::: "memory");
        }
    }
    __syncthreads();
}

namespace pg {
constexpr int BM = 256, BK = 64, HALF = 128, HTB = HALF * BK * 2, STAGE_BYTES = 8 * HTB, NXCD = 8, WGM = 8;
__host__ __device__ __forceinline__ int lds_byte(int r, int c) { const int st = (r >> 4) * 2 + (c >> 5), rr = r & 15, cc = c & 31, ob = rr * 64 + cc * 2; return st * 1024 + (ob ^ (((ob >> 9) & 1) << 5)); }
__host__ __device__ __forceinline__ void stage_rc(int b, int& R, int& C) { const int st = b / 1024, sb = b % 1024, swz = sb ^ (((sb >> 9) & 1) << 5); R = (st >> 1) * 16 + swz / 64; C = (st & 1) * 32 + (swz % 64) / 2; }
__host__ __device__ __forceinline__ int perm32(int rho) { const int n = rho >> 4, i = rho & 15; return 8 * (i >> 2) + 4 * n + (i & 3); }

struct Unit { int pm, pn, arow, brow, nvalid, e; };
struct Gemm { const void* A; const void* Bt; int lda, K; const int* list; unsigned long long* tacc = nullptr; };

struct StaticOrder {
    int nM, nN, nwg, G, c;
    __device__ __forceinline__ void init(int M, int N, int G_, int c_) { nM = M / BM; nN = N / BM; nwg = nM * nN; G = G_; c = c_; }
    __device__ __forceinline__ bool next(int i, Unit& u) const {
        const long L = (long)i * G + c; if (L >= nwg) return false;
        int wgid = (int)L; { const int q = nwg / NXCD, r = nwg % NXCD, xcd = wgid % NXCD, off = wgid / NXCD; wgid = (xcd < r ? xcd * (q + 1) : r * (q + 1) + (xcd - r) * q) + off; }
        const int nig = WGM * nN, gid = wgid / nig, fm = gid * WGM, gsz = (nM - fm) < WGM ? (nM - fm) : WGM;
        u.pm = fm + ((wgid % nig) % gsz); u.pn = (wgid % nig) / gsz; u.arow = u.pm * BM; u.brow = u.pn * BM; u.nvalid = BM; u.e = 0; return true;
    }
};
struct MoeOrder {
    const LAS int* pre;
    const LAS int* cnt;
    int NT, Nrows, G, c, contig;
    __device__ __forceinline__ bool next(int i, Unit& u) const {
        const int xcd = c & 7, j = c >> 3, q = i * (G >> 3) + j, mq = q / NT, nt = q - mq * NT, mt = mq * 8 + xcd;
        if (mt >= pre[32]) return false;
        const int e = pre[2176 + mt];
        const int row0 = (mt - pre[e]) * BM;
        u.pm = mt; u.pn = nt; u.e = e; u.nvalid = cnt[e] - row0; u.arow = contig ? mt * BM : row0; u.brow = e * Nrows + nt * BM; return true;
    }
};

__device__ __forceinline__ void glds16s(const void* sbase, unsigned voff, unsigned ldsdst) { unsigned keep;
    asm volatile("s_mov_b32 %0, m0\n\ts_mov_b32 m0, %3\n\ts_nop 0\n\tglobal_load_lds_dwordx4 %1, %2\n\ts_mov_b32 m0, %0" : "=&s"(keep) : "v"(voff), "s"(sbase), "s"(ldsdst) : "memory"); }
typedef int i32x8 __attribute__((ext_vector_type(8)));
typedef int i32x4 __attribute__((ext_vector_type(4)));
template <class Epi, class Sched, bool GATHER, bool ALIGN_EPI, bool FP8 = false>
__device__ __forceinline__ void gemm_phase(LAS unsigned char* lds, const Gemm g, const Sched& S, const Epi& E) {
    const int tid = threadIdx.x, wid = __builtin_amdgcn_readfirstlane(tid >> 6), lane = tid & 63, wr = wid >> 2, wc = wid & 3, fr = lane & 15, fq = lane >> 4;
    const int K = g.K, nt = K / (BK * 2), lda = g.lda;
    unsigned voffB[2], voffA[2];
#pragma unroll
    for (int i = 0; i < 2; ++i) { int R, C; stage_rc(tid * 16 + i * 8192, R, C); const int Rb = Epi::PERM ? ((R & ~31) + perm32(R & 31)) : R; voffB[i] = (unsigned)(Rb * K + C * 2); voffA[i] = (unsigned)(R * lda + C * 2); }
    const size_t kstep = (size_t)(BK * 2);
    const size_t hstep = (size_t)HALF * K;
    const unsigned ldsw = (unsigned)wid * 1024u;
    const unsigned ldsa = (unsigned)__builtin_amdgcn_readfirstlane((int)((unsigned)(uintptr_t)lds + ldsw));
    const int aoff = lds_byte(wr * 64 + fr, fq * 8), boff = lds_byte(wc * 32 + fr, fq * 8);
#define PG_SA(b, h) (((b) * 2 + (h)) * HTB)
#define PG_SB(b, h) ((4 + (b) * 2 + (h)) * HTB)
#define PG_STAGE(bufoff, gbase, voff) do { _Pragma("unroll") for (int _i = 0; _i < 2; ++_i) \
        glds16s((const void*)(gbase), (voff)[_i], ldsa + (unsigned)(bufoff) + (unsigned)(_i * 8192)); } while (0)
#define PG_LDA(dst, b, h) do { _Pragma("unroll") for (int m = 0; m < 4; ++m) { if constexpr (FP8) { dst##8[m] = __builtin_shufflevector(*(const LAS i32x4*)(lds + PG_SA(b, h) + aoff + m * 2048), *(const LAS i32x4*)(lds + PG_SA(b, h) + aoff + m * 2048 + 1024), 0, 1, 2, 3, 4, 5, 6, 7); } \
        else { _Pragma("unroll") for (int k = 0; k < 2; ++k) dst[m][k] = *(const LAS bf16x8*)(lds + PG_SA(b, h) + aoff + m * 2048 + k * 1024); } } } while (0)
#define PG_LDB(dst, b, h) do { _Pragma("unroll") for (int n = 0; n < 2; ++n) { if constexpr (FP8) { dst##8[n] = __builtin_shufflevector(*(const LAS i32x4*)(lds + PG_SB(b, h) + boff + n * 2048), *(const LAS i32x4*)(lds + PG_SB(b, h) + boff + n * 2048 + 1024), 0, 1, 2, 3, 4, 5, 6, 7); } \
        else { _Pragma("unroll") for (int k = 0; k < 2; ++k) dst[n][k] = *(const LAS bf16x8*)(lds + PG_SB(b, h) + boff + n * 2048 + k * 1024); } } } while (0)
#define PG_MMA(ai, bj, At, Bt) do { __builtin_amdgcn_s_setprio(1); if constexpr (FP8) { _Pragma("unroll") for (int m = 0; m < 4; ++m) _Pragma("unroll") for (int n = 0; n < 2; ++n) \
        asm volatile("v_mfma_scale_f32_16x16x128_f8f6f4 %0, %1, %2, %0, %3, %3 op_sel_hi:[0,0,0]" : "+v"(acc[ai][bj][m][n]) : "v"(Bt##8[n]), "v"(At##8[m]), "v"(scl1)); } \
        else { _Pragma("unroll") for (int m = 0; m < 4; ++m) _Pragma("unroll") for (int n = 0; n < 2; ++n) _Pragma("unroll") for (int k = 0; k < 2; ++k) \
        acc[ai][bj][m][n] = __builtin_amdgcn_mfma_f32_16x16x32_bf16(Bt[n][k], At[m][k], acc[ai][bj][m][n], 0, 0, 0); } __builtin_amdgcn_s_setprio(0); } while (0)
#define PG_WAIT_V(n) asm volatile("s_waitcnt vmcnt(" #n ")" ::: "memory")
#define PG_WAIT_L(n) asm volatile("s_waitcnt lgkmcnt(" #n ")" ::: "memory")
#define PG_BAR __builtin_amdgcn_s_barrier()
#define PG_SCHED __builtin_amdgcn_sched_barrier(0)
#define PG_SETA(v, u) do { _Pragma("unroll") for (int _h = 0; _h < 2; ++_h) _Pragma("unroll") for (int _i = 0; _i < 2; ++_i) { int _R, _C; stage_rc(tid * 16 + _i * 8192, _R, _C); const int _r = _h * HALF + _R; \
        const int _rr = _r < (u).nvalid ? _r : (u).nvalid - 1; const int _tok = g.list[(size_t)(u).e * T + (u).arow + _rr]; v[_h][_i] = (unsigned)(_tok * lda + _C * 2); } } while (0)
#define PG_STA(bufoff, kb, h, NX) do { if constexpr (GATHER) { unsigned _vs[2]; _vs[0] = (NX) ? vN[h][0] : vA[h][0]; _vs[1] = (NX) ? vN[h][1] : vA[h][1]; PG_STAGE(bufoff, (const char*)g.A + (kb), _vs); } \
        else PG_STAGE(bufoff, ((NX) ? nA : cA) + (kb) + (h) * hstepA, voffA); } while (0)
    Unit cur, nxt; int ui = 0;
    if (!S.next(0, cur)) return;
    f32x4 acc[2][2][4][2];
#pragma unroll
    for (int a = 0; a < 2; ++a)
#pragma unroll
        for (int b = 0; b < 2; ++b)
#pragma unroll
            for (int m = 0; m < 4; ++m)
#pragma unroll
                for (int n = 0; n < 2; ++n) acc[a][b][m][n] = (f32x4){0.f, 0.f, 0.f, 0.f};
    const int scl1 = 0x7F7F7F7F;
    bf16x8 At[4][2], B0[2][2], B1[2][2]; i32x8 At8[4], B08[2], B18[2];
    unsigned vN[2][2] = {{0u, 0u}, {0u, 0u}};
    unsigned vA[2][2];
    LAS u32x4* const vnl = (LAS u32x4*)(lds + STAGE_BYTES + 1024) + tid;
    const size_t hstepA = (size_t)HALF * lda;
    if constexpr (GATHER) { PG_SETA(vA, cur); PG_WAIT_V(0); }
    const char* cA = (const char*)g.A + (GATHER ? (size_t)0 : (size_t)cur.arow * lda); const char* nA = cA;
    const char* cB = (const char*)g.Bt + (size_t)cur.brow * K;
    PG_STAGE(PG_SB(0, 0), cB, voffB); PG_STAGE(PG_SB(0, 1), cB + hstep, voffB); PG_STA(PG_SA(0, 0), 0, 0, false); PG_STA(PG_SA(0, 1), 0, 1, false);
    if (wr == 1) PG_BAR;
    PG_WAIT_V(2); PG_BAR;
    PG_STAGE(PG_SB(1, 0), cB + kstep, voffB); PG_STA(PG_SA(1, 0), kstep, 0, false); PG_STAGE(PG_SB(1, 1), cB + hstep + kstep, voffB);
    PG_WAIT_V(6); PG_BAR;
    for (;;) {
        const bool has_next = S.next(ui + 1, nxt);
        if constexpr (GATHER) {
            unsigned vT[2][2];
            if (has_next) { PG_SETA(vT, nxt); PG_WAIT_V(0); }
            else {
#pragma unroll
                for (int h = 0; h < 2; ++h)
#pragma unroll
                    for (int i = 0; i < 2; ++i) vT[h][i] = vA[h][i]; }
            *vnl = (u32x4){vT[0][0], vT[0][1], vT[1][0], vT[1][1]};
        } else nA = has_next ? (const char*)g.A + (size_t)nxt.arow * lda : cA;
        const char* nB = has_next ? (const char*)g.Bt + (size_t)nxt.brow * K : cB;
#pragma unroll 1
        for (int t = 0; t < nt; t += 2) {
            const bool last = (t == nt - 2);
            if constexpr (GATHER) { if (last) { const u32x4 q_ = *vnl; vN[0][0] = q_.x; vN[0][1] = q_.y; vN[1][0] = q_.z; vN[1][1] = q_.w; } else { vN[0][0] = vA[0][0]; vN[0][1] = vA[0][1]; vN[1][0] = vA[1][0]; vN[1][1] = vA[1][1]; } }
            const size_t k1 = (size_t)(t + 1) * kstep, k2 = last ? (size_t)0 : (size_t)(t + 2) * kstep, k3 = k2 + kstep;
            const char* b2 = last ? nB : cB + (size_t)(t + 2) * kstep; const char* b3 = b2 + kstep;
            PG_LDB(B0, 0, 0); PG_LDB(B1, 0, 1); PG_SCHED; PG_LDA(At, 0, 0); PG_STA(PG_SA(1, 1), k1, 1, false);
            PG_WAIT_V(8); PG_WAIT_L(0); PG_BAR; PG_MMA(0, 0, At, B0); PG_MMA(0, 1, At, B1); PG_BAR; PG_SCHED;
            PG_LDA(At, 0, 1); PG_STAGE(PG_SB(0, 0), b2, voffB); PG_STAGE(PG_SB(0, 1), b2 + hstep, voffB); PG_STA(PG_SA(0, 0), k2, 0, last);
            PG_WAIT_V(8); PG_WAIT_L(0); PG_BAR; PG_MMA(1, 0, At, B0); PG_MMA(1, 1, At, B1); PG_BAR; PG_SCHED;
            PG_LDB(B0, 1, 0); PG_LDB(B1, 1, 1); PG_SCHED; PG_LDA(At, 1, 0); PG_STA(PG_SA(0, 1), k2, 1, last);
            PG_WAIT_V(8); PG_WAIT_L(0); PG_BAR; PG_MMA(0, 0, At, B0); PG_MMA(0, 1, At, B1); PG_BAR; PG_SCHED;
            PG_LDA(At, 1, 1); PG_STAGE(PG_SB(1, 0), b3, voffB); PG_STAGE(PG_SB(1, 1), b3 + hstep, voffB); PG_STA(PG_SA(1, 0), k3, 0, last);
            PG_WAIT_V(8); PG_WAIT_L(0); PG_BAR; PG_MMA(1, 0, At, B0); PG_MMA(1, 1, At, B1); PG_BAR; PG_SCHED;
        }
        if constexpr (ALIGN_EPI) { if (wr == 0) PG_BAR; }
        if constexpr (FP8) asm volatile("s_nop 15\n\ts_nop 15" ::: "memory");
#ifdef EPIPROBE
        const unsigned long long te0_ = __builtin_amdgcn_s_memrealtime();
#endif
        E(acc, cur, wr, wc, fr, fq);
#ifdef EPIPROBE
        if (g.tacc) { asm volatile("s_waitcnt vmcnt(0)" ::: "memory"); *g.tacc += __builtin_amdgcn_s_memrealtime() - te0_; }
#endif
        if (!has_next) break;
#pragma unroll
        for (int a = 0; a < 2; ++a)
#pragma unroll
            for (int b = 0; b < 2; ++b)
#pragma unroll
                for (int m = 0; m < 4; ++m)
#pragma unroll
                    for (int n = 0; n < 2; ++n) acc[a][b][m][n] = (f32x4){0.f, 0.f, 0.f, 0.f};
        cur = nxt; cB = nB; cA = nA; ++ui;
        if constexpr (GATHER) { const u32x4 q_ = *vnl; vA[0][0] = q_.x; vA[0][1] = q_.y; vA[1][0] = q_.z; vA[1][1] = q_.w; }
        if constexpr (ALIGN_EPI) { if (wr == 1) PG_BAR; }
    }
    PG_WAIT_V(0);
    if constexpr (!ALIGN_EPI) { if (wr == 0) PG_BAR; }
    PG_BAR;
#undef PG_SA
#undef PG_SB
#undef PG_STAGE
#undef PG_LDA
#undef PG_LDB
#undef PG_MMA
#undef PG_WAIT_V
#undef PG_WAIT_L
#undef PG_BAR
#undef PG_SCHED
#undef PG_SETA
#undef PG_STA
}
}

typedef f32x4 AccT[2][2][4][2];
__device__ __forceinline__ float ssq8(u32x4 a) { float s = 0.f;
#pragma unroll
    for (int i = 0; i < 4; ++i) { const float lo = bflo(a[i]), hi = bfhi(a[i]); s += lo * lo + hi * hi; } return s; }

__device__ __forceinline__ u32x4 pack8(f32x4 a, f32x4 b) { u32x4 w; w.x = cvtpk(a[0], a[1]); w.y = cvtpk(a[2], a[3]); w.z = cvtpk(b[0], b[1]); w.w = cvtpk(b[2], b[3]); return w; }

struct EpiProj {
    static constexpr bool PERM = true; bf16_t* O; float* part;
    __device__ __forceinline__ void operator()(const AccT& acc, const pg::Unit& u, int wr, int wc, int fr, int fq) const {
        const int row0 = u.pm * 256 + wr * 64 + fr, col0 = u.pn * 256 + wc * 32 + 8 * fq;
#pragma unroll
        for (int ai = 0; ai < 2; ++ai)
#pragma unroll
            for (int m = 0; m < 4; ++m) { const int row = row0 + ai * 128 + m * 16; bf16_t* rowp = O + (size_t)row * NPROJ + col0;
#pragma unroll
                for (int bj = 0; bj < 2; ++bj) { const u32x4 w = pack8(acc[ai][bj][m][0], acc[ai][bj][m][1]); *(u32x4*)(rowp + bj * 128) = w;
                    const int grp = 8 * u.pn + 4 * bj + wc;
                    if (grp < 20) {
                        float sq = ssq8(w); sq += __shfl_xor(sq, 16); sq += __shfl_xor(sq, 32);
                        if (fq == 0) part[(size_t)row * 20 + grp] = sq; } } }
    }
};
struct EpiQ {
    static constexpr bool PERM = true; bf16_t* O; const float* part; const float* cs; float scale;
    __device__ __forceinline__ void operator()(const AccT& acc, const pg::Unit& u, int wr, int wc, int fr, int fq) const {
        const int row0 = u.pm * 256 + wr * 64 + fr;
#pragma unroll
        for (int ai = 0; ai < 2; ++ai)
#pragma unroll
            for (int m = 0; m < 4; ++m) { const int row = row0 + ai * 128 + m * 16; const f32x4* pp = (const f32x4*)(part + (size_t)row * 20); const f32x4 s0 = pp[0], s1 = pp[1], s2 = pp[2];
                const float rs = __builtin_amdgcn_rsqf((((s0[0] + s0[1]) + (s0[2] + s0[3])) + ((s1[0] + s1[1]) + (s1[2] + s1[3])) + ((s2[0] + s2[1]) + (s2[2] + s2[3]))) * (1.f / QLORA) + EPS) * scale;
#pragma unroll
                for (int bj = 0; bj < 2; ++bj) { const int G = 8 * u.pn + 4 * bj + wc;
                    f32x4 v0 = acc[ai][bj][m][0] * rs, v1 = acc[ai][bj][m][1] * rs;
                    if ((G % 3) == 2) {
                        f32x4 p0, p1;
#pragma unroll
                        for (int j = 0; j < 4; ++j) { p0[j] = __shfl_xor(v0[j], 32); p1[j] = __shfl_xor(v1[j], 32); }
                        const float* cr = cs + (size_t)row * 32 + 8 * (fq & 1);
                        const f32x4 c0 = *(const f32x4*)cr, c1 = *(const f32x4*)(cr + 4), s0 = *(const f32x4*)(cr + 16), s1 = *(const f32x4*)(cr + 20);
                        if (fq < 2) { v0 = v0 * c0 - p0 * s0; v1 = v1 * c1 - p1 * s1; } else { v0 = v0 * c0 + p0 * s0; v1 = v1 * c1 + p1 * s1; }
                    }
                    *(u32x4*)(O + (size_t)row * 768 + 32 * G + 8 * fq) = pack8(v0, v1); }
                asm volatile("" ::: "memory"); }
    }
};
struct EpiKV {
    static constexpr bool PERM = true; bf16_t* Ko; bf16_t* Vo; const float* part; const bf16_t* proj; const float* cs;
    __device__ __forceinline__ void operator()(const AccT& acc, const pg::Unit& u, int wr, int wc, int fr, int fq) const {
        const int row0 = u.pm * 256 + wr * 64 + fr;
#pragma unroll
        for (int ai = 0; ai < 2; ++ai)
#pragma unroll
            for (int m = 0; m < 4; ++m) { const int row = row0 + ai * 128 + m * 16; const f32x4* pp = (const f32x4*)(part + (size_t)row * 20 + 12); const f32x4 s0 = pp[0], s1 = pp[1];
                const float rs = __builtin_amdgcn_rsqf((((s0[0] + s0[1]) + (s0[2] + s0[3])) + ((s1[0] + s1[1]) + (s1[2] + s1[3]))) * (1.f / KVLORA) + EPS);
#pragma unroll
                for (int bj = 0; bj < 2; ++bj) { const int G = 8 * u.pn + 4 * bj + wc, head = G >> 2, sub = G & 3;
                    bf16_t* dst = (sub < 2) ? Ko + (size_t)row * 768 + head * 96 + 32 * sub + 8 * fq : Vo + (size_t)row * 512 + head * 64 + 32 * (sub - 2) + 8 * fq;
                    *(u32x4*)dst = pack8(acc[ai][bj][m][0] * rs, acc[ai][bj][m][1] * rs); } }
        if (u.pn == 0) {
            const int lane = fq * 16 + fr, tid = (wr * 4 + wc) * 64 + lane, row = u.pm * 256 + (tid >> 1), half = tid & 1;
            const u32x4* src = (const u32x4*)(proj + (size_t)row * NPROJ + C_KPE + 16 * half); const u32x4 a = src[0], b = src[1];
            const f32x4* cp = (const f32x4*)(cs + (size_t)row * 32);
            float xv[16], pv[16], cc[16], ss[16];
#pragma unroll
            for (int i = 0; i < 4; ++i) { xv[2 * i] = bflo(a[i]); xv[2 * i + 1] = bfhi(a[i]); xv[8 + 2 * i] = bflo(b[i]); xv[8 + 2 * i + 1] = bfhi(b[i]);
                const f32x4 c4 = cp[i], s4 = cp[4 + i]; cc[4 * i] = c4[0]; cc[4 * i + 1] = c4[1]; cc[4 * i + 2] = c4[2]; cc[4 * i + 3] = c4[3]; ss[4 * i] = s4[0]; ss[4 * i + 1] = s4[1]; ss[4 * i + 2] = s4[2]; ss[4 * i + 3] = s4[3]; }
#pragma unroll
            for (int j = 0; j < 16; ++j) pv[j] = __shfl_xor(xv[j], 1);
            float o[16];
#pragma unroll
            for (int j = 0; j < 16; ++j) o[j] = (half == 0) ? xv[j] * cc[j] - pv[j] * ss[j] : xv[j] * cc[j] + pv[j] * ss[j];
            u32x4 w0, w1;
#pragma unroll
            for (int i = 0; i < 4; ++i) { w0[i] = cvtpk(o[2 * i], o[2 * i + 1]); w1[i] = cvtpk(o[8 + 2 * i], o[8 + 2 * i + 1]); }
#pragma unroll
            for (int h = 0; h < NH; ++h) { bf16_t* d = Ko + (size_t)row * 768 + h * 96 + 64 + 16 * half; *(u32x4*)d = w0; *(u32x4*)(d + 8) = w1; }
        }
    }
};
struct EpiX1 {
    static constexpr bool PERM = false; const float* x; const float* mod; float* O;
    __device__ __forceinline__ void operator()(const AccT& acc, const pg::Unit& u, int wr, int wc, int fr, int fq) const {
        const int row0 = u.pm * 256 + wr * 64 + fr, col0 = u.pn * 256 + wc * 32 + 4 * fq;
        const float* gt = mod + (size_t)(u.pm * 256 / SEQ) * 6144 + 2048 + col0;
        f32x4 gv[2][2];
#pragma unroll
        for (int bj = 0; bj < 2; ++bj)
#pragma unroll
            for (int n = 0; n < 2; ++n) gv[bj][n] = *(const f32x4*)(gt + bj * 128 + n * 16);
#pragma unroll
        for (int ai = 0; ai < 2; ++ai)
#pragma unroll
            for (int m = 0; m < 4; ++m) { const size_t off = (size_t)(row0 + ai * 128 + m * 16) * DM + col0;
#pragma unroll
                for (int bj = 0; bj < 2; ++bj)
#pragma unroll
                    for (int n = 0; n < 2; ++n) { const f32x4 xv = *(const f32x4*)(x + off + bj * 128 + n * 16); *(f32x4*)(O + off + bj * 128 + n * 16) = xv + gv[bj][n] * acc[ai][bj][m][n]; } }
    }
};
struct EpiGU {
    static constexpr bool PERM = true; unsigned char* O; const float* bias;
    __device__ __forceinline__ void operator()(const AccT& acc, const pg::Unit& u, int wr, int wc, int fr, int fq) const {
        const int row0 = u.pm * 256 + wr * 64 + fr, gcol = u.pn * 128 + wc * 32 + 8 * fq;
        const float* bp = bias + (size_t)u.e * 2048 + gcol;
        const f32x4 bg0 = *(const f32x4*)bp, bg1 = *(const f32x4*)(bp + 4), bu0 = *(const f32x4*)(bp + 1024), bu1 = *(const f32x4*)(bp + 1028);
#pragma unroll
        for (int ai = 0; ai < 2; ++ai)
#pragma unroll
            for (int m = 0; m < 4; ++m) {
                f32x4 r[2];
#pragma unroll
                for (int n = 0; n < 2; ++n) { const f32x4 g4 = acc[ai][0][m][n] * (1.0f / W8) + (n ? bg1 : bg0), u4 = acc[ai][1][m][n] * (1.0f / W8) + (n ? bu1 : bu0);
#pragma unroll
                    for (int j = 0; j < 4; ++j) { const float g = fminf(g4[j], 7.0f), up = fminf(fmaxf(u4[j], -7.0f), 7.0f);
                        r[n][j] = (up + 1.0f) * g * __builtin_amdgcn_rcpf(1.0f + __expf(-1.702f * g)); } }
                u32x2 w; w.x = pk4_fp8(r[0][0], r[0][1], r[0][2], r[0][3]); w.y = pk4_fp8(r[1][0], r[1][1], r[1][2], r[1][3]); *(u32x2*)(O + (size_t)(row0 + ai * 128 + m * 16) * DE + gcol) = w; }
    }
};
struct EpiDN {
    static constexpr bool PERM = true; unsigned char* O; const float* bias;
    __device__ __forceinline__ void operator()(const AccT& acc, const pg::Unit& u, int wr, int wc, int fr, int fq) const {
        const int row0 = u.pm * 256 + wr * 64 + fr, col0 = u.pn * 256 + wc * 32 + 8 * fq;
        const float* bp = bias + (size_t)u.e * DM + col0;
        f32x4 bv[2][2];
#pragma unroll
        for (int bj = 0; bj < 2; ++bj) { bv[bj][0] = *(const f32x4*)(bp + bj * 128); bv[bj][1] = *(const f32x4*)(bp + bj * 128 + 4); }
#pragma unroll
        for (int ai = 0; ai < 2; ++ai)
#pragma unroll
            for (int m = 0; m < 4; ++m) { unsigned char* rowp = O + (size_t)(row0 + ai * 128 + m * 16) * DM + col0;
#pragma unroll
                for (int bj = 0; bj < 2; ++bj) { const f32x4 v0 = acc[ai][bj][m][0] * (1.0f / W8) + bv[bj][0], v1 = acc[ai][bj][m][1] * (1.0f / W8) + bv[bj][1];
                    u32x2 w; w.x = pk4_fp8(v0[0], v0[1], v0[2], v0[3]); w.y = pk4_fp8(v1[0], v1[1], v1[2], v1[3]); *(u32x2*)(rowp + bj * 128) = w; } }
    }
};

constexpr int NWAVES = 8;
enum { IN_X = 0, IN_C, IN_POS, IN_ADAW, IN_ADAB, IN_N1G, IN_WIN, IN_QNG, IN_WQB, IN_KVNG, IN_WKVB, IN_MLAOG, IN_CONVW, IN_ALOG, IN_DTB, IN_GDNG, IN_WOUT, IN_N2G, IN_RW, IN_RB, IN_WGU, IN_BGU, IN_WDN, IN_BDN, IN_FG, N_IN };
struct Frame {
    LAS unsigned char* lds; volatile LAS unsigned* MISC; unsigned* ctl; unsigned char* ws;
    int tid, lane, wave, G, vcu;
    const float* in[N_IN]; float* out;
};
#define WSP(T_, off) ((T_*)(F.ws + (off)))

__device__ __forceinline__ void p0_mod(Frame& F) {
    LAS float* cact = (LAS float*)F.lds;
    LAS float* red = (LAS float*)(F.lds + 32768);
    if ((int)blockIdx.x >= 96) return;
    const float* c = F.in[IN_C];
    for (int i = F.tid; i < BATCH * DM; i += NWAVES * 64) cact[i] = siluf(c[i]);
    __syncthreads();
    float* mod = WSP(float, WS_MOD);
    for (int it = blockIdx.x; it < 96; it += F.G) {
        const int j = it * 64 + F.lane; float a[8];
#pragma unroll
        for (int b = 0; b < 8; ++b) a[b] = 0.f;
        const float* w = F.in[IN_ADAW] + j;
#pragma unroll 4
        for (int k = F.wave * 128; k < F.wave * 128 + 128; ++k) { const float wv = w[(size_t)k * 6144];
#pragma unroll
            for (int b = 0; b < 8; ++b) a[b] += cact[b * DM + k] * wv; }
#pragma unroll
        for (int b = 0; b < 8; ++b) red[(F.wave * 8 + b) * 64 + F.lane] = a[b];
        __syncthreads();
        { const int b = F.tid >> 6, col = F.tid & 63; float s = 0.f;
#pragma unroll
          for (int w8 = 0; w8 < 8; ++w8) s += red[(w8 * 8 + b) * 64 + col];
          mod[b * 6144 + it * 64 + col] = s + F.in[IN_ADAB][it * 64 + col]; }
        __syncthreads();
    }
}
template <int MAP, bool FP8 = false>
__device__ __forceinline__ void p0_tr_item(const float* W, int K, int N, int NP, void* WTv, const float* ksc, LAS float* scr, int item, int lane) {
    bf16_t* WT = (bf16_t*)WTv;
    const int nblk = NP / 32, kb = item / nblk, nb = item % nblk, k0 = 64 * kb, n0 = 32 * nb;
    f32x4 ld[8];
#pragma unroll
    for (int j = 0; j < 8; ++j) { const int idx = j * 64 + lane, kk = idx >> 3, nn = n0 + 4 * (idx & 7); ld[j] = (nn < N) ? *(const f32x4*)(W + (size_t)(k0 + kk) * N + nn) : (f32x4){0.f, 0.f, 0.f, 0.f}; }
#pragma unroll
    for (int j = 0; j < 8; ++j) { const int idx = j * 64 + lane, kk = idx >> 3, c4 = idx & 7; f32x4 v = ld[j]; if (ksc) v = v * ksc[k0 + kk];
        LAS float* d = scr + kk * 33 + 4 * c4; d[0] = v[0]; d[1] = v[1]; d[2] = v[2]; d[3] = v[3]; }
    LDS_WAIT(); asm volatile("" ::: "memory");
    const int c = lane & 7;
#pragma unroll
    for (int j = 0; j < 4; ++j) { const int n = (lane >> 3) + 8 * j; const LAS float* s = scr + (8 * c) * 33 + n;
        u32x4 o; o.x = cvtpk(s[0 * 33], s[1 * 33]); o.y = cvtpk(s[2 * 33], s[3 * 33]); o.z = cvtpk(s[4 * 33], s[5 * 33]); o.w = cvtpk(s[6 * 33], s[7 * 33]);
        int dn = n0 + n;
        if (MAP == 1) { const int half = dn >> 10, r = dn & 1023; dn = ((r >> 7) << 8) + (half << 7) + (r & 127); }
        if constexpr (FP8) { u32x2 o8; o8.x = pk4_fp8(s[0 * 33] * W8, s[1 * 33] * W8, s[2 * 33] * W8, s[3 * 33] * W8); o8.y = pk4_fp8(s[4 * 33] * W8, s[5 * 33] * W8, s[6 * 33] * W8, s[7 * 33] * W8);
            *(GAS u32x2*)((unsigned char*)WTv + (size_t)dn * K + k0 + 8 * c) = o8; }
        else *(GAS u32x4*)(WT + (size_t)dn * K + k0 + 8 * c) = o; }
    LDS_WAIT(); asm volatile("" ::: "memory");
}
__device__ __forceinline__ void p0_weights(Frame& F) {
    LAS float* scr = (LAS float*)(F.lds + 49152 + F.wave * 8704);
    const int gw = F.vcu * NWAVES + F.wave, NGW = F.G * NWAVES;
    constexpr int I_IN = (DM / 64) * (NPROJ / 32), I_Q = (QLORA / 64) * (768 / 32), I_KV = (KVLORA / 64) * (1024 / 32), I_O = (DM / 64) * (DM / 32);
    constexpr int I_GU = (DM / 64) * (2048 / 32), I_DN = (DE / 64) * (DM / 32);
    constexpr int P_GU = I_GU / 2, P_DN = I_DN / 2;
    constexpr int NITEMS = I_IN + I_Q + I_KV + I_O;
    for (int it = gw; it < NITEMS; it += NGW) {
        int r = it;
        if (r < I_IN) { p0_tr_item<0>(F.in[IN_WIN], DM, IN_DIM, NPROJ, WSP(bf16_t, WS_WIN), nullptr, scr, r, F.lane); continue; } r -= I_IN;
        if (r < I_Q) { p0_tr_item<0>(F.in[IN_WQB], QLORA, 768, 768, WSP(bf16_t, WS_WQ), F.in[IN_QNG], scr, r, F.lane); continue; } r -= I_Q;
        if (r < I_KV) { p0_tr_item<0>(F.in[IN_WKVB], KVLORA, 1024, 1024, WSP(bf16_t, WS_WKV), F.in[IN_KVNG], scr, r, F.lane); continue; } r -= I_KV;
        if (r < I_O) { p0_tr_item<0>(F.in[IN_WOUT], DM, DM, DM, WSP(bf16_t, WS_WO), nullptr, scr, r, F.lane); continue; } r -= I_O;
        (void)scr;
    }
    float* rwt = WSP(float, WS_RWT);
    for (int i = (int)blockIdx.x * NWAVES * 64 + F.tid; i < NE * DM; i += F.G * NWAVES * 64) { const int e = i >> 10, k = i & 1023; rwt[i] = F.in[IN_RW][k * NE + e]; }
}

template <int MAP>
__device__ __forceinline__ void p0_tr_pair8(const float* W, int K, int N, unsigned char* WT8, LAS float* scr, int kp, int nb, int lane) {
    const int k0 = 128 * kp, n0 = 32 * nb;
    f32x4 ld[16];
#pragma unroll
    for (int j = 0; j < 16; ++j) { const int idx = j * 64 + lane, kk = idx >> 3, nn = n0 + 4 * (idx & 7); ld[j] = *(const f32x4*)(W + (size_t)(k0 + kk) * N + nn); }
#pragma unroll
    for (int hk = 0; hk < 2; ++hk) {
#pragma unroll
        for (int j = 0; j < 8; ++j) { const int idx = j * 64 + lane, kk = idx >> 3, c4 = idx & 7; const f32x4 v = ld[hk * 8 + j];
            LAS float* d = scr + kk * 33 + 4 * c4; d[0] = v[0]; d[1] = v[1]; d[2] = v[2]; d[3] = v[3]; }
        LDS_WAIT(); asm volatile("" ::: "memory");
        const int c = lane & 7;
#pragma unroll
        for (int j = 0; j < 4; ++j) { const int n = (lane >> 3) + 8 * j; const LAS float* s = scr + (8 * c) * 33 + n;
            int dn = n0 + n;
            if (MAP == 1) { const int half = dn >> 10, r = dn & 1023; dn = ((r >> 7) << 8) + (half << 7) + (r & 127); }
            u32x2 o8; o8.x = pk4_fp8(s[0 * 33] * W8, s[1 * 33] * W8, s[2 * 33] * W8, s[3 * 33] * W8); o8.y = pk4_fp8(s[4 * 33] * W8, s[5 * 33] * W8, s[6 * 33] * W8, s[7 * 33] * W8);
            *(GAS u32x2*)(WT8 + (size_t)dn * K + k0 + 64 * hk + 8 * c) = o8; }
        LDS_WAIT(); asm volatile("" ::: "memory");
    }
}
constexpr int MOE_CONV_ITEMS = (NE * (DM / 64) * (2048 / 32) / 2 + NE * (DE / 64) * (DM / 32) / 2) / 64;
__device__ __forceinline__ void moe_conv_item(Frame& F, int item) {
    LAS float* scr = (LAS float*)(F.lds + F.wave * 8704);
    constexpr int P_GU = (DM / 64) * (2048 / 32) / 2, P_DN = (DE / 64) * (DM / 32) / 2;
#pragma unroll 1
    for (int j = 0; j < 8; ++j) {
        int r = item * 64 + j * 8 + F.wave;
        if (r < NE * P_GU) { const int e = r / P_GU, p = r - e * P_GU, nb = p % 64, kp = p / 64;
            p0_tr_pair8<1>(F.in[IN_WGU] + (size_t)e * DM * 2048, DM, 2048, WSP(unsigned char, WS_WGU) + (size_t)e * 2048 * DM, scr, kp, nb, F.lane);
        } else { r -= NE * P_GU; const int e = r / P_DN, p = r - e * P_DN, nb = p % 32, kp = p / 32;
            p0_tr_pair8<0>(F.in[IN_WDN] + (size_t)e * DE * DM, DE, DM, WSP(unsigned char, WS_WDN) + (size_t)e * DM * DE, scr, kp, nb, F.lane); }
    }
}

__device__ const float ROPE_INVF[16] = {1.0f, 0.5623413251903491f, 0.31622776601683794f, 0.1778279410038923f, 0.1f, 0.05623413251903491f, 0.03162277660168379f, 0.01778279410038923f,
    0.01f, 0.005623413251903491f, 0.003162277660168379f, 0.0017782794100389228f, 0.001f, 0.0005623413251903491f, 0.00031622776601683794f, 0.00017782794100389227f};
__device__ __forceinline__ void norm_rows(Frame& F, const float* x, const float* gain, int SH, int SC, bf16_t* outp) {
    const int gw = F.vcu * NWAVES + F.wave, NGW = F.G * NWAVES;
    const float* mod = WSP(float, WS_MOD);
    constexpr int R = 4;
    for (int m0 = gw; m0 < T; m0 += R * NGW) {
        f32x4 v[R][4]; float s[R];
#pragma unroll
        for (int r = 0; r < R; ++r) { const int m = m0 + r * NGW; s[r] = 0.f; if (m < T) { const f32x4* xr = (const f32x4*)(x + (size_t)m * DM) + F.lane;
#pragma unroll
            for (int j = 0; j < 4; ++j) v[r][j] = xr[64 * j]; } else {
#pragma unroll
            for (int j = 0; j < 4; ++j) v[r][j] = (f32x4){0.f, 0.f, 0.f, 0.f}; } }
#pragma unroll
        for (int r = 0; r < R; ++r)
#pragma unroll
            for (int j = 0; j < 4; ++j) s[r] += (v[r][j][0] * v[r][j][0] + v[r][j][1] * v[r][j][1]) + (v[r][j][2] * v[r][j][2] + v[r][j][3] * v[r][j][3]);
#pragma unroll
        for (int o = 1; o < 64; o <<= 1)
#pragma unroll
            for (int r = 0; r < R; ++r) s[r] += __shfl_xor(s[r], o);
#pragma unroll
        for (int r = 0; r < R; ++r) { const int m = m0 + r * NGW; if (m >= T) continue;
            {
              const float ang = (float)((const int*)F.in[IN_POS])[m] * ROPE_INVF[F.lane & 15];
              const double rev = (double)ang * 0.15915494309189535; const float fr_ = (float)(rev - __builtin_rint(rev));
              if (F.lane < 16) { float* cs = WSP(float, WS_CS) + (size_t)m * 32; cs[F.lane] = __builtin_amdgcn_cosf(fr_); cs[16 + F.lane] = __builtin_amdgcn_sinf(fr_); } }
            const float rstd = __builtin_amdgcn_rsqf(s[r] * (1.f / DM) + EPS); const float* mb = mod + (size_t)(m / SEQ) * 6144;
            u32x2* o8 = (u32x2*)(outp + (size_t)m * DM) + F.lane;
#pragma unroll
            for (int j = 0; j < 4; ++j) { const int col = 4 * (F.lane + 64 * j);
                const f32x4 g = *(const f32x4*)(gain + col), sc = *(const f32x4*)(mb + SC + col), sh = *(const f32x4*)(mb + SH + col);
                const f32x4 h = v[r][j] * rstd * g * (sc + 1.0f) + sh; u32x2 w; w.x = cvtpk(h[0], h[1]); w.y = cvtpk(h[2], h[3]); o8[64 * j] = w; } }
    }
}

__device__ __forceinline__ void p3a_rows(Frame& F) {
    const int gw = F.vcu * NWAVES + F.wave, NGW = F.G * NWAVES, lane = F.lane;
    const bf16_t* proj = WSP(bf16_t, WS_PROJ); float* rsq = WSP(float, WS_RSQ); float* rskv = WSP(float, WS_RSKV); float* cs = WSP(float, WS_CS); bf16_t* Kb = WSP(bf16_t, WS_K);
    const int* pos = (const int*)F.in[IN_POS];
    constexpr int R = 4;
    for (int m0 = gw; m0 < T; m0 += R * NGW) {
        u32x4 a[R], b[R]; int ps[R];
#pragma unroll
        for (int r = 0; r < R; ++r) { const int m = (m0 + r * NGW < T) ? m0 + r * NGW : m0; const u32x4* pr = (const u32x4*)(proj + (size_t)m * NPROJ);
            a[r] = pr[lane]; b[r] = (u32x4){0u, 0u, 0u, 0u}; if (lane < 20) b[r] = pr[64 + lane]; ps[r] = pos[m]; }
#pragma unroll
        for (int r = 0; r < R; ++r) { const int m = m0 + r * NGW; if (m >= T) continue;
            const float sa = ssq8(a[r]), sb = ssq8(b[r]);
            const float sq = wave_sum(lane < 48 ? sa : 0.f), skv = wave_sum((lane >= 48 ? sa : 0.f) + (lane < 16 ? sb : 0.f));
            if (lane == 0) { rsq[m] = __builtin_amdgcn_rsqf(sq * (1.f / QLORA) + EPS); rskv[m] = __builtin_amdgcn_rsqf(skv * (1.f / KVLORA) + EPS); }
            const float ang = (float)ps[r] * ROPE_INVF[lane & 15];
            const double rev = (double)ang * 0.15915494309189535; const float fr = (float)(rev - __builtin_rint(rev));
            const float cv = __builtin_amdgcn_cosf(fr), sv = __builtin_amdgcn_sinf(fr);
            if (lane < 16) { cs[(size_t)m * 32 + lane] = cv; cs[(size_t)m * 32 + 16 + lane] = sv; }
            float xv[8], pv[8], cc[8], ss[8];
#pragma unroll
            for (int i = 0; i < 4; ++i) { xv[2 * i] = bflo(b[r][i]); xv[2 * i + 1] = bfhi(b[r][i]); }
            const int i0 = 8 * (lane & 1);
#pragma unroll
            for (int j = 0; j < 8; ++j) { pv[j] = __shfl_xor(xv[j], 2); cc[j] = __shfl(cv, i0 + j); ss[j] = __shfl(sv, i0 + j); }
            if (lane >= 16 && lane < 20) {
                float o[8];
#pragma unroll
                for (int j = 0; j < 8; ++j) o[j] = (lane < 18) ? xv[j] * cc[j] - pv[j] * ss[j] : xv[j] * cc[j] + pv[j] * ss[j];
                u32x4 w; w.x = cvtpk(o[0], o[1]); w.y = cvtpk(o[2], o[3]); w.z = cvtpk(o[4], o[5]); w.w = cvtpk(o[6], o[7]);
#pragma unroll
                for (int h = 0; h < NH; ++h) *(u32x4*)(Kb + (size_t)m * 768 + h * 96 + 64 + 8 * (lane - 16)) = w;
            } }
    }
}

__device__ __forceinline__ int crow(int r, int hi) { return (r & 3) + 8 * (r >> 2) + 4 * hi; }
typedef short v4i16_t __attribute__((ext_vector_type(4)));
constexpr int AT_KROW = 208, AT_VROW = 144, AT_KBUF = 64 * AT_KROW, AT_VBUF = 64 * AT_VROW, AT_V0 = 2 * AT_KBUF, AT_WS = AT_V0 + 2 * AT_VBUF;
__device__ __forceinline__ void attn_unit(Frame& F, int b, int h, int qb) {
    const int tid = F.tid, lane = F.lane, wid = F.wave, r32 = lane & 31, hi = lane >> 5;
    const bf16_t* Qg = WSP(bf16_t, WS_Q); const bf16_t* Kg = WSP(bf16_t, WS_K); const bf16_t* Vg = WSP(bf16_t, WS_V); bf16_t* Og = WSP(bf16_t, WS_OA);
    LAS unsigned char* Kl = F.lds; LAS unsigned char* Vl = F.lds + AT_V0; LAS float* wsf = (LAS float*)(F.lds + AT_WS) + wid * 64;
    const size_t tb = (size_t)b * SEQ; const int q0 = qb * 256, NT = 4 * qb + 4;
    bf16x8 qr[6];
    { const bf16_t* Qp = Qg + (tb + q0 + wid * 32 + r32) * 768 + h * 96 + hi * 8;
#pragma unroll
      for (int d0 = 0; d0 < 6; ++d0) qr[d0] = *(const bf16x8*)(Qp + d0 * 16); }
    unsigned kvo[2], vvo[2];
#pragma unroll
    for (int i = 0; i < 2; ++i) { const int ok = (wid + 8 * i) * 1024 + 16 * lane, kr = ok / AT_KROW, kc = (ok % AT_KROW) >> 4; kvo[i] = (unsigned)((kr < 64 ? kr : 63) * 1536 + (kc < 12 ? kc : 0) * 16);
        const int ov = (wid + 8 * i) * 1024 + 16 * lane, vr = ov / AT_VROW, vc = (ov % AT_VROW) >> 4; vvo[i] = (unsigned)((vr < 64 ? vr : 63) * 1024 + (vc < 8 ? vc : 0) * 16); }
    const unsigned kl0 = (unsigned)__builtin_amdgcn_readfirstlane((int)((unsigned)(uintptr_t)Kl + (unsigned)wid * 1024u)), vl0 = (unsigned)__builtin_amdgcn_readfirstlane((int)((unsigned)(uintptr_t)Vl + (unsigned)wid * 1024u));
    const char* kg0 = (const char*)(Kg + tb * 768 + h * 96); const char* vg0 = (const char*)(Vg + tb * 512 + h * 64);
#define AT_DMAK(t, bf) do { pg::glds16s(kg0 + (size_t)(t) * 64 * 1536, kvo[0], kl0 + (unsigned)((bf) * AT_KBUF)); if (wid < 5) pg::glds16s(kg0 + (size_t)(t) * 64 * 1536, kvo[1], kl0 + (unsigned)((bf) * AT_KBUF + 8192)); } while (0)
#define AT_DMAV(t, bf) do { pg::glds16s(vg0 + (size_t)(t) * 64 * 1024, vvo[0], vl0 + (unsigned)((bf) * AT_VBUF)); if (wid == 0) pg::glds16s(vg0 + (size_t)(t) * 64 * 1024, vvo[1], vl0 + (unsigned)((bf) * AT_VBUF + 8192)); } while (0)
#define AT_QK(P0, P1, bf) do { _Pragma("unroll") for (int r = 0; r < 16; ++r) { P0[r] = 0.f; P1[r] = 0.f; } \
        const LAS unsigned char* kb_ = Kl + (bf) * AT_KBUF + r32 * AT_KROW + hi * 16; \
        _Pragma("unroll") for (int d0 = 0; d0 < 6; ++d0) { const bf16x8 k0 = *(const LAS bf16x8*)(kb_ + d0 * 32), k1 = *(const LAS bf16x8*)(kb_ + 32 * AT_KROW + d0 * 32); \
            P0 = __builtin_amdgcn_mfma_f32_32x32x16_bf16(k0, qr[d0], P0, 0, 0, 0); P1 = __builtin_amdgcn_mfma_f32_32x32x16_bf16(k1, qr[d0], P1, 0, 0, 0); } } while (0)
#define AT_SPV(P0, P1, t, bf) do { \
        if ((t) >= NT - 4) { _Pragma("unroll") for (int r = 0; r < 16; ++r) { const int kv = 64 * (t) + crow(r, hi); if (kv > qpos) P0[r] = -INFINITY; if (kv + 32 > qpos) P1[r] = -INFINITY; } } \
        float mx = fmaxf(P0[0], P1[0]); \
        _Pragma("unroll") for (int r = 1; r < 16; ++r) mx = fmaxf(mx, fmaxf(P0[r], P1[r])); \
        mx = fmaxf(mx, __shfl_xor(mx, 32)); \
        const float m_new = fmaxf(m_run, mx); \
        if (__any(m_new > m_run)) { const float f = __builtin_amdgcn_exp2f(m_run - m_new); l_run *= f; m_run = m_new; \
            if (hi == 0) wsf[r32] = f; float fr_[16]; \
            _Pragma("unroll") for (int r = 0; r < 16; ++r) fr_[r] = wsf[crow(r, hi)]; \
            _Pragma("unroll") for (int r = 0; r < 16; ++r) { o[0][r] *= fr_[r]; o[1][r] *= fr_[r]; } } \
        float rs = 0.f; \
        _Pragma("unroll") for (int r = 0; r < 16; ++r) { P0[r] = __builtin_amdgcn_exp2f(P0[r] - m_run); P1[r] = __builtin_amdgcn_exp2f(P1[r] - m_run); rs += P0[r] + P1[r]; } \
        l_run += rs; bf16x8 pa[4]; \
        _Pragma("unroll") for (int ks = 0; ks < 4; ++ks) { u32x4 w_; \
            _Pragma("unroll") for (int i = 0; i < 4; ++i) { const int r = (ks & 1) * 8 + 2 * i; w_[i] = (ks < 2) ? cvtpk(P0[r], P0[r + 1]) : cvtpk(P1[r], P1[r + 1]); } \
            pa[ks] = __builtin_bit_cast(bf16x8, w_); } \
        const LAS unsigned char* vb_ = Vl + (bf) * AT_VBUF + (4 * hi + ((lane & 15) >> 2)) * AT_VROW + (((lane >> 4) & 1) * 16 + (lane & 3) * 4) * 2; \
        _Pragma("unroll") for (int d0 = 0; d0 < 2; ++d0) _Pragma("unroll") for (int ks = 0; ks < 4; ++ks) { \
            const v4i16_t lo = __builtin_amdgcn_ds_read_tr16_b64_v4i16((LAS v4i16_t*)(vb_ + ks * 16 * AT_VROW + d0 * 64)); \
            const v4i16_t hv = __builtin_amdgcn_ds_read_tr16_b64_v4i16((LAS v4i16_t*)(vb_ + ks * 16 * AT_VROW + 8 * AT_VROW + d0 * 64)); \
            const bf16x8 vf = (bf16x8){lo[0], lo[1], lo[2], lo[3], hv[0], hv[1], hv[2], hv[3]}; \
            o[d0] = __builtin_amdgcn_mfma_f32_32x32x16_bf16(pa[ks], vf, o[d0], 0, 0, 0); } } while (0)
#define AT_STEP(C0, C1, N0, N1, t) do { \
        if ((t) + 2 < NT) AT_DMAK((t) + 2, (t) & 1); if ((t) + 1 < NT) AT_DMAV((t) + 1, ((t) + 1) & 1); \
        if ((t) + 1 < NT && 64 * ((t) + 1) <= qmax) AT_QK(N0, N1, ((t) + 1) & 1); \
        if (64 * (t) <= qmax) AT_SPV(C0, C1, t, (t) & 1); \
        VM_WAIT(); __syncthreads(); } while (0)
    AT_DMAK(0, 0); AT_DMAV(0, 0); AT_DMAK(1, 1); VM_WAIT(); __syncthreads();
    float m_run = -INFINITY, l_run = 0.f; f32x16 o[2];
#pragma unroll
    for (int r = 0; r < 16; ++r) { o[0][r] = 0.f; o[1][r] = 0.f; }
    const int qmax = q0 + wid * 32 + 31, qpos = q0 + wid * 32 + r32;
    f32x16 sA0, sA1, sB0, sB1;
    AT_QK(sA0, sA1, 0);
    LBAR();
    for (int t = 0; t < NT; t += 2) {
        AT_STEP(sA0, sA1, sB0, sB1, t);
        AT_STEP(sB0, sB1, sA0, sA1, t + 1);
    }
    { float lt = l_run + __shfl_xor(l_run, 32);
      if (hi == 0) wsf[32 + r32] = lt;
      bf16_t* Ow = Og + (tb + q0 + wid * 32) * 512 + h * 64 + r32;
#pragma unroll
      for (int r = 0; r < 16; ++r) { const int qr_ = crow(r, hi); const float inv = 1.0f / wsf[32 + qr_];
          Ow[(size_t)qr_ * 512] = f2bf(o[0][r] * inv); Ow[(size_t)qr_ * 512 + 32] = f2bf(o[1][r] * inv); } }
#undef AT_DMAK
#undef AT_DMAV
#undef AT_QK
#undef AT_SPV
#undef AT_STEP
}

__device__ __forceinline__ void p4b_rows(Frame& F) {
    const int gw = F.vcu * NWAVES + F.wave, NGW = F.G * NWAVES, lane = F.lane;
    const bf16_t* oa = WSP(bf16_t, WS_OA); const bf16_t* og = WSP(bf16_t, WS_OG); const bf16_t* proj = WSP(bf16_t, WS_PROJ); bf16_t* mx = WSP(bf16_t, WS_H);
    const float* ga = F.in[IN_MLAOG] + 8 * lane; const float* gg = F.in[IN_GDNG] + 8 * (lane & 7);
    constexpr int R = 4;
    for (int m0 = gw; m0 < T; m0 += R * NGW) {
        u32x4 a[R], g[R], z[R];
#pragma unroll
        for (int r = 0; r < R; ++r) { const int m = (m0 + r * NGW < T) ? m0 + r * NGW : m0;
            a[r] = *(const u32x4*)(oa + (size_t)m * 512 + 8 * lane); g[r] = *(const u32x4*)(og + (size_t)m * 512 + 8 * lane); z[r] = *(const u32x4*)(proj + (size_t)m * NPROJ + C_GZ + 8 * lane); }
#pragma unroll
        for (int r = 0; r < R; ++r) { const int m = m0 + r * NGW; if (m >= T) continue;
            const float ra = __builtin_amdgcn_rsqf(wave_sum(ssq8(a[r])) * (1.f / 512) + EPS);
            float sg = ssq8(g[r]); sg += __shfl_xor(sg, 1); sg += __shfl_xor(sg, 2); sg += __shfl_xor(sg, 4);
            const float rg = __builtin_amdgcn_rsqf(sg * (1.f / 64) + EPS);
            float oa8[8], og8[8];
#pragma unroll
            for (int i = 0; i < 4; ++i) { oa8[2 * i] = bflo(a[r][i]) * ra * ga[2 * i]; oa8[2 * i + 1] = bfhi(a[r][i]) * ra * ga[2 * i + 1];
                og8[2 * i] = bflo(g[r][i]) * rg * gg[2 * i] * siluf(bflo(z[r][i])); og8[2 * i + 1] = bfhi(g[r][i]) * rg * gg[2 * i + 1] * siluf(bfhi(z[r][i])); }
            u32x4 wa, wg;
#pragma unroll
            for (int i = 0; i < 4; ++i) { wa[i] = cvtpk(oa8[2 * i], oa8[2 * i + 1]); wg[i] = cvtpk(og8[2 * i], og8[2 * i + 1]); }
            *(u32x4*)(mx + (size_t)m * DM + 8 * lane) = wa; *(u32x4*)(mx + (size_t)m * DM + 512 + 8 * lane) = wg; }
    }
}

constexpr int G1_KRM = 0, G1_QRM = 4608, G1_AM = 9216, G1_QK = 13440, G1_UT = 16000, G1_WT = 21120, G1_KT = 26240, G1_GT = 31360, G1_SLOT = 32000, G1_CW = 4 * G1_SLOT;
static_assert(G1_CW + 3072 <= RING_BYTES, "G1 LDS");
__device__ __forceinline__ f32x4 mfma16(bf16x8 a, bf16x8 b, f32x4 c) { return __builtin_amdgcn_mfma_f32_16x16x32_bf16(a, b, c, 0, 0, 0); }

__device__ __forceinline__ float silu_fast(float x) { return x * __builtin_amdgcn_rcpf(1.0f + __expf(-x)); }
#ifndef G1PROBE
#define G1PROBE (-1)
#endif
#define G1T(k) do { if (G1PROBE >= 0) { const unsigned long long n_ = __builtin_amdgcn_s_memrealtime(); if (G1PROBE == (k)) g1acc += n_ - g1t; g1t = n_; } } while (0)
__device__ __forceinline__ void g1_unit(Frame& F, int unit, unsigned long long& g1acc) {
    unsigned long long g1t = (G1PROBE >= 0) ? __builtin_amdgcn_s_memrealtime() : 0ull;
    const int tid = F.tid, lane = F.lane, wid = F.wave;
    const int bh = unit >> 5, c0 = (unit & 31) * 4, b = bh >> 3, h = bh & 7;
    const bf16_t* proj = WSP(bf16_t, WS_PROJ);
    LAS unsigned char* L = F.lds; LAS float* cw = (LAS float*)(L + G1_CW);
    const size_t tb = (size_t)b * SEQ;
    for (int i = tid; i < 768; i += NWAVES * 64) { const int x = i >> 8, w = (i >> 6) & 3, ch = i & 63; cw[i] = F.in[IN_CONVW][w * 1536 + x * 512 + h * 64 + ch]; }
    LBAR(); G1T(0);
    { const int tk = tid >> 2, part = tid & 3, s = tk >> 5, i = tk & 31, isk = part >> 1, chb = (part & 1) * 32;
      const int sp = (c0 + s) * GC + i;
      const bf16_t* src = proj + (tb + sp) * NPROJ + (isk ? C_GK : C_GQ) + h * 64 + chb;
      float ain = 0.f, bin = 0.f;
      if (part == 0) { ain = bf2f(proj[(tb + sp) * NPROJ + C_GA + h]); bin = bf2f(proj[(tb + sp) * NPROJ + C_GB + h]); }
      float v[32];
#pragma unroll
      for (int c = 0; c < 32; ++c) v[c] = 0.f;
#pragma unroll
      for (int w = 0; w < 4; ++w) { if (sp - 3 + w >= 0) { const bf16_t* rp = src - (ptrdiff_t)(3 - w) * NPROJ;
#pragma unroll
          for (int q4 = 0; q4 < 4; ++q4) { const u32x4 d = *(const u32x4*)(rp + 8 * q4); const LAS f32x4* wp = (const LAS f32x4*)(cw + (isk * 4 + w) * 64 + chb + 8 * q4); const f32x4 w0 = wp[0], w1 = wp[1];
              v[8 * q4 + 0] += bflo(d[0]) * w0[0]; v[8 * q4 + 1] += bfhi(d[0]) * w0[1]; v[8 * q4 + 2] += bflo(d[1]) * w0[2]; v[8 * q4 + 3] += bfhi(d[1]) * w0[3];
              v[8 * q4 + 4] += bflo(d[2]) * w1[0]; v[8 * q4 + 5] += bfhi(d[2]) * w1[1]; v[8 * q4 + 6] += bflo(d[3]) * w1[2]; v[8 * q4 + 7] += bfhi(d[3]) * w1[3]; } } }
      float ss = 0.f;
#pragma unroll
      for (int c = 0; c < 32; ++c) { v[c] = silu_fast(v[c]); ss += v[c] * v[c]; }
      ss += __shfl_xor(ss, 1);
      const float rn = __builtin_amdgcn_rsqf(ss + EPS) * (isk ? 1.0f : 0.125f);
      LAS bf16_t* dst = (LAS bf16_t*)(L + s * G1_SLOT + (isk ? G1_KRM : G1_QRM)) + i * 72 + chb;
#pragma unroll
      for (int q4 = 0; q4 < 4; ++q4) { u32x4 w;
#pragma unroll
          for (int e = 0; e < 4; ++e) w[e] = cvtpk(v[8 * q4 + 2 * e] * rn, v[8 * q4 + 2 * e + 1] * rn);
          *(LAS u32x4*)(dst + 8 * q4) = w; }
      if (part == 0) { LAS float* gt = (LAS float*)(L + s * G1_SLOT + G1_GT);
          const float xs = ain + F.in[IN_DTB][h], sp_ = xs > 20.f ? xs : __logf(1.0f + __expf(xs));
          gt[i] = 1.0f / (1.0f + __expf(-bin));
          gt[32 + i] = -__expf(F.in[IN_ALOG][h]) * sp_; }
    }
    LBAR(); G1T(1);
    if (wid < 2) { LAS float* gt = (LAS float*)(L + (2 * wid + (lane >> 5)) * G1_SLOT + G1_GT); const int i = lane & 31; float c = gt[32 + i];
#pragma unroll
        for (int o = 1; o < 32; o <<= 1) { const float t = __shfl_up(c, o, 32); if (i >= o) c += t; }
        const float last = __shfl(c, 31, 32);
        gt[64 + i] = c; gt[96 + i] = __expf(c); gt[128 + i] = __expf(last - c); }
    LBAR(); G1T(2);
    const int s = wid >> 1, sub = wid & 1, l15 = lane & 15, kq = lane >> 4;
    LAS unsigned char* Ls = L + s * G1_SLOT; LAS float* gt = (LAS float*)(Ls + G1_GT);
    unsigned short vraw[35];
    if (sub == 0) { const int sp0 = (c0 + s) * GC; const bf16_t* src = proj + (tb + sp0) * NPROJ + C_GV + h * 64 + lane;
#pragma unroll
        for (int i = 0; i < 35; ++i) vraw[i] = (sp0 + i - 3 >= 0) ? src[((ptrdiff_t)i - 3) * NPROJ] : (unsigned short)0; }
    else {
#pragma unroll
        for (int i = 0; i < 35; ++i) vraw[i] = 0; }
    { const LAS bf16_t* X = (const LAS bf16_t*)(Ls + (sub ? G1_QRM : G1_KRM)); const LAS bf16_t* Kr = (const LAS bf16_t*)(Ls + G1_KRM);
#pragma unroll
      for (int it = 0; it < 2; ++it)
#pragma unroll
          for (int jt = 0; jt < 2; ++jt) { f32x4 acc = (f32x4){0.f, 0.f, 0.f, 0.f};
#pragma unroll
              for (int ks = 0; ks < 2; ++ks) acc = mfma16(*(const LAS bf16x8*)(X + (16 * it + l15) * 72 + 32 * ks + 8 * kq), *(const LAS bf16x8*)(Kr + (16 * jt + l15) * 72 + 32 * ks + 8 * kq), acc);
              const int j = 16 * jt + l15; const float gj = gt[64 + j];
#pragma unroll
              for (int r = 0; r < 4; ++r) { const int i = 16 * it + 4 * kq + r; const float gi = gt[64 + i];
                  if (sub == 0) { const float val = (i > j) ? acc[r] * gt[i] * __expf(gi - gj) : 0.f; ((LAS float*)(Ls + G1_AM))[i * 33 + j] = val; }
                  else { const float val = (i >= j) ? acc[r] * __expf(gi - gj) : 0.f; ((LAS bf16_t*)(Ls + G1_QK))[i * 40 + j] = f2bf(val); } } }
    }
    for (int idx = tid; idx < 4 * 64 * 32; idx += NWAVES * 64) { const int s2 = idx >> 11, d = (idx >> 5) & 63, c = idx & 31; LAS unsigned char* L2 = L + s2 * G1_SLOT;
        ((LAS bf16_t*)(L2 + G1_KT))[d * 40 + c] = f2bf(bf2f(((const LAS bf16_t*)(L2 + G1_KRM))[c * 72 + d]) * ((const LAS float*)(L2 + G1_GT))[128 + c]); }
    LBAR(); G1T(3);
    { float sol[32];
      if (sub == 0) {
          const float w0 = cw[(8 + 0) * 64 + lane], w1 = cw[(8 + 1) * 64 + lane], w2 = cw[(8 + 2) * 64 + lane], w3 = cw[(8 + 3) * 64 + lane];
#pragma unroll
          for (int i = 0; i < 32; ++i) sol[i] = silu_fast(w0 * bf2f(vraw[i]) + w1 * bf2f(vraw[i + 1]) + w2 * bf2f(vraw[i + 2]) + w3 * bf2f(vraw[i + 3])) * gt[i];
      } else {
          const LAS bf16_t* Kr = (const LAS bf16_t*)(Ls + G1_KRM);
#pragma unroll
          for (int i = 0; i < 32; ++i) sol[i] = bf2f(Kr[i * 72 + lane]) * gt[i] * gt[96 + i];
      }
      const LAS float* Am = (const LAS float*)(Ls + G1_AM);
#pragma unroll
      for (int i = 1; i < 32; ++i) { const float arow = Am[i * 33 + (lane & 31)]; float a = sol[i];
#pragma unroll
          for (int j = 0; j < i; ++j) a -= __uint_as_float(__builtin_amdgcn_readlane(__float_as_uint(arow), j)) * sol[j];
          sol[i] = a; }
      LAS bf16_t* dst = (LAS bf16_t*)(Ls + (sub ? G1_WT : G1_UT)) + lane * 40;
#pragma unroll
      for (int q4 = 0; q4 < 4; ++q4) { u32x4 w;
#pragma unroll
          for (int e = 0; e < 4; ++e) w[e] = cvtpk(sol[8 * q4 + 2 * e], sol[8 * q4 + 2 * e + 1]);
          *(LAS u32x4*)(dst + 8 * q4) = w; }
    }
    LBAR(); G1T(4);
        { unsigned char* gd = F.ws + WS_GD + (size_t)(bh * NCH + c0 + s) * 24576;
          const LAS bf16_t* uT = (const LAS bf16_t*)(Ls + G1_UT); const LAS bf16_t* wT = (const LAS bf16_t*)(Ls + G1_WT); const LAS bf16_t* kT = (const LAS bf16_t*)(Ls + G1_KT);
          const LAS bf16_t* qk = (const LAS bf16_t*)(Ls + G1_QK); const LAS bf16_t* qr = (const LAS bf16_t*)(Ls + G1_QRM);
          const f32x4 z4 = (f32x4){0.f, 0.f, 0.f, 0.f}; const float cd = gt[96 + 31];
          if (sub == 0) {
#pragma unroll
              for (int mp = 0; mp < 2; ++mp) {
                  const bf16x8 af0 = *(const LAS bf16x8*)(wT + (32 * mp + l15) * 40 + 8 * kq), af1 = *(const LAS bf16x8*)(wT + (32 * mp + 16 + l15) * 40 + 8 * kq);
#pragma unroll
                  for (int nt = 0; nt < 4; ++nt) {
                      const bf16x8 bfr = *(const LAS bf16x8*)(kT + (16 * nt + l15) * 40 + 8 * kq);
                      const f32x4 a0 = mfma16(af0, bfr, z4), a1 = mfma16(af1, bfr, z4); const int dout = 16 * nt + l15; u32x4 w; float o8[8];
#pragma unroll
                      for (int r = 0; r < 4; ++r) { const int din = 32 * mp + 4 * kq + r; o8[r] = ((din == dout) ? cd : 0.f) - a0[r]; o8[4 + r] = ((din + 16 == dout) ? cd : 0.f) - a1[r]; }
                      w.x = cvtpk(o8[0], o8[1]); w.y = cvtpk(o8[2], o8[3]); w.z = cvtpk(o8[4], o8[5]); w.w = cvtpk(o8[6], o8[7]);
                      *(u32x4*)(gd + ((nt * 2 + mp) * 64 + kq * 16 + l15) * 16) = w; }
#pragma unroll
                  for (int ct = 0; ct < 2; ++ct) {
                      const bf16x8 bfr = *(const LAS bf16x8*)(qk + (16 * ct + l15) * 40 + 8 * kq);
                      const f32x4 a0 = mfma16(af0, bfr, z4), a1 = mfma16(af1, bfr, z4); const int c = 16 * ct + l15; const float eg = gt[96 + c];
                      const u32x2 q0 = *(const LAS u32x2*)(qr + c * 72 + 32 * mp + 4 * kq), q1 = *(const LAS u32x2*)(qr + c * 72 + 32 * mp + 16 + 4 * kq); u32x4 w;
                      w.x = cvtpk(bflo(q0.x) * eg - a0[0], bfhi(q0.x) * eg - a0[1]); w.y = cvtpk(bflo(q0.y) * eg - a0[2], bfhi(q0.y) * eg - a0[3]);
                      w.z = cvtpk(bflo(q1.x) * eg - a1[0], bfhi(q1.x) * eg - a1[1]); w.w = cvtpk(bflo(q1.y) * eg - a1[2], bfhi(q1.y) * eg - a1[3]);
                      *(u32x4*)(gd + 8192 + ((ct * 2 + mp) * 64 + kq * 16 + l15) * 16) = w; } }
          } else {
#pragma unroll
              for (int et = 0; et < 4; ++et) { const bf16x8 bfr = *(const LAS bf16x8*)(uT + (16 * et + l15) * 40 + 8 * kq);
#pragma unroll
                  for (int dt = 0; dt < 4; ++dt) {
                      const f32x4 acc = mfma16(*(const LAS bf16x8*)(kT + (16 * dt + l15) * 40 + 8 * kq), bfr, z4); u32x2 w; w.x = cvtpk(acc[0], acc[1]); w.y = cvtpk(acc[2], acc[3]);
                      *(u32x2*)(gd + 12288 + ((dt * 4 + et) * 64 + lane) * 8) = w; }
#pragma unroll
                  for (int ct = 0; ct < 2; ++ct) {
                      const f32x4 acc = mfma16(*(const LAS bf16x8*)(qk + (16 * ct + l15) * 40 + 8 * kq), bfr, z4); u32x2 w; w.x = cvtpk(acc[0], acc[1]); w.y = cvtpk(acc[2], acc[3]);
                      *(u32x2*)(gd + 20480 + ((ct * 4 + et) * 64 + lane) * 8) = w; } }
          }
        }
    LBAR(); G1T(5);
}

__device__ __forceinline__ void g2_item(Frame& F, int item) {
    const int lane = F.lane, wid = F.wave, bh = item * 2 + (wid >> 2), es = wid & 3, b = bh >> 3, h = bh & 7, l15 = lane & 15, kq = lane >> 4;
    const unsigned char* gd = F.ws + WS_GD + (size_t)bh * NCH * 24576;
    bf16_t* og = WSP(bf16_t, WS_OG) + ((size_t)b * SEQ) * 512 + h * 64 + 16 * es + l15;
    f32x4 S[4];
#pragma unroll
    for (int m = 0; m < 4; ++m) S[m] = (f32x4){0.f, 0.f, 0.f, 0.f};
    bf16x8 Mf[4][2], Pf[2][2]; u32x2 Nv[4], Rv[2];
#define G2_LOAD(c) do { const unsigned char* p_ = gd + (size_t)(c) * 24576; \
        _Pragma("unroll") for (int m = 0; m < 4; ++m) _Pragma("unroll") for (int s2 = 0; s2 < 2; ++s2) Mf[m][s2] = *(const bf16x8*)(p_ + ((m * 2 + s2) * 64 + lane) * 16); \
        _Pragma("unroll") for (int ct = 0; ct < 2; ++ct) _Pragma("unroll") for (int s2 = 0; s2 < 2; ++s2) Pf[ct][s2] = *(const bf16x8*)(p_ + 8192 + ((ct * 2 + s2) * 64 + lane) * 16); \
        _Pragma("unroll") for (int m = 0; m < 4; ++m) Nv[m] = *(const u32x2*)(p_ + 12288 + ((m * 4 + es) * 64 + lane) * 8); \
        _Pragma("unroll") for (int ct = 0; ct < 2; ++ct) Rv[ct] = *(const u32x2*)(p_ + 20480 + ((ct * 4 + es) * 64 + lane) * 8); } while (0)
    G2_LOAD(0);
    for (int c = 0; c < NCH; ++c) {
        bf16x8 cM[4][2], cP[2][2]; u32x2 cN[4], cR[2];
#pragma unroll
        for (int m = 0; m < 4; ++m) { cM[m][0] = Mf[m][0]; cM[m][1] = Mf[m][1]; cN[m] = Nv[m]; }
#pragma unroll
        for (int ct = 0; ct < 2; ++ct) { cP[ct][0] = Pf[ct][0]; cP[ct][1] = Pf[ct][1]; cR[ct] = Rv[ct]; }
        if (c + 1 < NCH) G2_LOAD(c + 1);
        bf16x8 Bs[2];
#pragma unroll
        for (int s2 = 0; s2 < 2; ++s2) { u32x4 w; w.x = cvtpk(S[2 * s2][0], S[2 * s2][1]); w.y = cvtpk(S[2 * s2][2], S[2 * s2][3]); w.z = cvtpk(S[2 * s2 + 1][0], S[2 * s2 + 1][1]); w.w = cvtpk(S[2 * s2 + 1][2], S[2 * s2 + 1][3]);
            Bs[s2] = __builtin_bit_cast(bf16x8, w); }
#pragma unroll
        for (int ct = 0; ct < 2; ++ct) { f32x4 o = (f32x4){bflo(cR[ct].x), bfhi(cR[ct].x), bflo(cR[ct].y), bfhi(cR[ct].y)};
            o = mfma16(cP[ct][0], Bs[0], o); o = mfma16(cP[ct][1], Bs[1], o);
            bf16_t* op = og + (size_t)(c * GC + 16 * ct + 4 * kq) * 512;
#pragma unroll
            for (int r = 0; r < 4; ++r) op[(size_t)r * 512] = f2bf(o[r]); }
#pragma unroll
        for (int m = 0; m < 4; ++m) { f32x4 a = (f32x4){bflo(cN[m].x), bfhi(cN[m].x), bflo(cN[m].y), bfhi(cN[m].y)};
            a = mfma16(cM[m][0], Bs[0], a); S[m] = mfma16(cM[m][1], Bs[1], a); }
    }
#undef G2_LOAD
}

constexpr int P6_RW = 0, P6_TK = 131072;
__device__ __forceinline__ void p6_router(Frame& F, int rep) {
    const int lane = F.lane, wid = F.wave, tid = F.tid, l15 = lane & 15, kq = lane >> 4;
    LAS unsigned char* rwl = F.lds;
    LAS float* gml = (LAS float*)(F.lds + MISC_OFF + 1024);
    const float* x1 = WSP(float, WS_X1); const float* mod = WSP(float, WS_MOD); unsigned char* h2 = WSP(unsigned char, WS_H);
    const size_t ro = rep ? WS_END : 0;
    int* tke = WSP(int, ro + WS_TKE); float* tkw = WSP(float, ro + WS_TKW); int* tkp = WSP(int, ro + WS_TKP); int* lst = WSP(int, ro + WS_LIST);
    const int tpw = T / F.G, t0 = (int)blockIdx.x * tpw;
    { const float* rwt = WSP(float, WS_RWT);
      for (int idx = tid; idx < NE * 128; idx += NWAVES * 64) { const int e = idx >> 7, c = idx & 127; const f32x4 a = *(const f32x4*)(rwt + e * DM + 8 * c), bq = *(const f32x4*)(rwt + e * DM + 8 * c + 4);
          u32x4 hi4, lo4; float v[8] = {a[0], a[1], a[2], a[3], bq[0], bq[1], bq[2], bq[3]};
#pragma unroll
          for (int i = 0; i < 4; ++i) { const unsigned hw = cvtpk(v[2 * i], v[2 * i + 1]); hi4[i] = hw; lo4[i] = cvtpk(v[2 * i] - bflo(hw), v[2 * i + 1] - bfhi(hw)); }
          const int off = e * 2048 + ((c ^ (e & 15)) << 4);
          *(LAS u32x4*)(rwl + off) = hi4; *(LAS u32x4*)(rwl + 65536 + off) = lo4; }
      const float* mb = mod + (size_t)(t0 / SEQ) * 6144;
      for (int i = tid; i < DM; i += NWAVES * 64) { gml[i] = F.in[IN_N2G][i] * (1.0f + mb[4096 + i]); gml[DM + i] = mb[3072 + i]; } }
    if (tid < 96) F.MISC[32 + tid] = 0u;
    __syncthreads();
    for (int tb0 = wid * 16; tb0 < tpw; tb0 += NWAVES * 16) {
        const int t = t0 + tb0 + l15; const float* xr = x1 + (size_t)t * DM + 8 * kq; unsigned char* hr = h2 + (size_t)t * DM + 8 * kq;
        float ss = 0.f;
#pragma unroll 8
        for (int s2 = 0; s2 < 32; ++s2) { const f32x4 a = *(const f32x4*)(xr + 32 * s2), bq = *(const f32x4*)(xr + 32 * s2 + 4);
            ss += (a[0] * a[0] + a[1] * a[1]) + (a[2] * a[2] + a[3] * a[3]) + (bq[0] * bq[0] + bq[1] * bq[1]) + (bq[2] * bq[2] + bq[3] * bq[3]); }
        ss += __shfl_xor(ss, 16); ss += __shfl_xor(ss, 32);
        const float rstd = __builtin_amdgcn_rsqf(ss * (1.f / DM) + EPS);
        f32x4 acc[2] = {(f32x4){0.f, 0.f, 0.f, 0.f}, (f32x4){0.f, 0.f, 0.f, 0.f}};
#pragma unroll 4
        for (int s2 = 0; s2 < 32; ++s2) {
            const f32x4 a = *(const f32x4*)(xr + 32 * s2), bq = *(const f32x4*)(xr + 32 * s2 + 4);
            const LAS f32x4* gp = (const LAS f32x4*)(gml + 32 * s2 + 8 * kq); const f32x4 g0 = gp[0], g1 = gp[1], h0 = gp[DM / 4], h1 = gp[DM / 4 + 1];
            const f32x4 v0 = a * rstd * g0 + h0, v1 = bq * rstd * g1 + h1;
            u32x2 f8; f8.x = pk4_fp8(v0[0], v0[1], v0[2], v0[3]); f8.y = pk4_fp8(v1[0], v1[1], v1[2], v1[3]); *(u32x2*)(hr + 32 * s2) = f8;
            u32x4 hi4, lo4;
            hi4[0] = cvtpk(v0[0], v0[1]); hi4[1] = cvtpk(v0[2], v0[3]); hi4[2] = cvtpk(v1[0], v1[1]); hi4[3] = cvtpk(v1[2], v1[3]);
            lo4[0] = cvtpk(v0[0] - bflo(hi4[0]), v0[1] - bfhi(hi4[0])); lo4[1] = cvtpk(v0[2] - bflo(hi4[1]), v0[3] - bfhi(hi4[1]));
            lo4[2] = cvtpk(v1[0] - bflo(hi4[2]), v1[1] - bfhi(hi4[2])); lo4[3] = cvtpk(v1[2] - bflo(hi4[3]), v1[3] - bfhi(hi4[3]));
            const bf16x8 ah = __builtin_bit_cast(bf16x8, hi4), al = __builtin_bit_cast(bf16x8, lo4);
#pragma unroll
            for (int j = 0; j < 2; ++j) { const int e = l15 + 16 * j; const LAS unsigned char* bp = rwl + e * 2048 + (((4 * s2 + kq) ^ (e & 15)) << 4);
                const bf16x8 bh = *(const LAS bf16x8*)bp, bl = *(const LAS bf16x8*)(bp + 65536);
                acc[j] = mfma16(ah, bh, acc[j]); acc[j] = mfma16(al, bh, acc[j]); acc[j] = mfma16(ah, bl, acc[j]); }
        }
        const float rb0 = F.in[IN_RB][l15], rb1 = F.in[IN_RB][l15 + 16];
#pragma unroll
        for (int r = 0; r < 4; ++r) {
            float v0 = acc[0][r] + rb0, v1 = acc[1][r] + rb1; float tv[4]; int ti[4];
#pragma unroll
            for (int k = 0; k < 4; ++k) { float bv = v0; int bi = l15; if (v1 > v0) { bv = v1; bi = l15 + 16; }
#pragma unroll
                for (int o = 1; o < 16; o <<= 1) { const float ov = __shfl_xor(bv, o); const int oi = __shfl_xor(bi, o); if (ov > bv || (ov == bv && oi < bi)) { bv = ov; bi = oi; } }
                tv[k] = bv; ti[k] = bi; if (bi == l15) v0 = -INFINITY; if (bi == l15 + 16) v1 = -INFINITY; }
            const float e1 = __expf(tv[1] - tv[0]), e2 = __expf(tv[2] - tv[0]), e3 = __expf(tv[3] - tv[0]), inv = 1.0f / (1.0f + e1 + e2 + e3);
            if (l15 < 4) { const int tt = t0 + tb0 + 4 * kq + r; const int e = (l15 == 0) ? ti[0] : (l15 == 1) ? ti[1] : (l15 == 2) ? ti[2] : ti[3];
                const float w = ((l15 == 0) ? 1.0f : (l15 == 1) ? e1 : (l15 == 2) ? e2 : e3) * inv;
                const int lp = __hip_atomic_fetch_add((LAS int*)(F.lds + MISC_OFF) + 32 + e, 1, __ATOMIC_RELAXED, __HIP_MEMORY_SCOPE_WORKGROUP);
                tke[tt * 4 + l15] = e; tkw[tt * 4 + l15] = w; tkp[tt * 4 + l15] = lp; }
        }
    }
    __syncthreads();
    if (tid < 32) { const int n = (int)F.MISC[32 + tid]; int base = 0; if (n > 0) base = (int)__hip_atomic_fetch_add(F.ctl + CW_CNT + 4096 * rep + 64 * tid, (unsigned)n, RLX_AGENT); F.MISC[64 + tid] = (unsigned)base; }
    VM_WAIT(); __syncthreads();
    for (int i = tid; i < tpw * 4; i += NWAVES * 64) { const int t = t0 + (i >> 2), e = tke[t * 4 + (i & 3)], p = tkp[t * 4 + (i & 3)] + (int)F.MISC[64 + e]; tkp[t * 4 + (i & 3)] = p; lst[(size_t)e * T + p] = t; }
}
__device__ __forceinline__ void moe_tables(Frame& F) {
    if (F.tid < 32) F.MISC[192 + F.tid] = __hip_atomic_load(F.ctl + CW_CNT + 64 * F.tid, RLX_AGENT);
    __syncthreads();
    if (F.tid == 0) { unsigned s = 0; for (int e = 0; e < 32; ++e) { F.MISC[128 + e] = s; s += (F.MISC[192 + e] + 255u) >> 8; } F.MISC[160] = s; }
    __syncthreads();
    for (int mt = F.tid; mt < 576; mt += NWAVES * 64) { int e = 0; while (e < 31 && F.MISC[128 + e + 1] <= (unsigned)mt) ++e; F.MISC[2304 + mt] = (unsigned)e; }
    __syncthreads();
}
__device__ __forceinline__ void p10_combine(Frame& F) {
    const int gw = F.vcu * NWAVES + F.wave, NGW = F.G * NWAVES, lane = F.lane;
    const float* x1 = WSP(float, WS_X1); const float* mod = WSP(float, WS_MOD); const unsigned char* y = WSP(unsigned char, WS_Y);
    const int* tke = WSP(int, WS_TKE); const float* tkw = WSP(float, WS_TKW); const int* tkp = WSP(int, WS_TKP);
    constexpr int R = 2;
    for (int m0 = gw; m0 < T; m0 += R * NGW) {
        u32x2 y0[R][4], y1[R][4]; float w[R][4]; f32x4 xv[R][4];
#pragma unroll
        for (int r = 0; r < R; ++r) { const int m = (m0 + r * NGW < T) ? m0 + r * NGW : m0;
            const i32x4q e4 = *(const i32x4q*)(tke + m * 4), p4 = *(const i32x4q*)(tkp + m * 4); const f32x4 w4 = *(const f32x4*)(tkw + m * 4);
#pragma unroll
            for (int k = 0; k < 4; ++k) { const size_t row = (size_t)F.MISC[128 + e4[k]] * 256 + p4[k]; w[r][k] = w4[k];
                y0[r][k] = *(const u32x2*)(y + row * DM + 8 * lane); y1[r][k] = *(const u32x2*)(y + row * DM + 512 + 8 * lane); }
#pragma unroll
            for (int q = 0; q < 4; ++q) xv[r][q] = *(const f32x4*)(x1 + (size_t)m * DM + (q >> 1) * 512 + 8 * lane + 4 * (q & 1)); }
#pragma unroll
        for (int r = 0; r < R; ++r) { const int m = m0 + r * NGW; if (m >= T) continue;
            float a[16];
#pragma unroll
            for (int i = 0; i < 16; ++i) a[i] = 0.f;
#pragma unroll
            for (int k = 0; k < 4; ++k)
#pragma unroll
                for (int i = 0; i < 2; ++i) { const f32x2 l0 = __builtin_amdgcn_cvt_pk_f32_fp8((int)y0[r][k][i], false), h0 = __builtin_amdgcn_cvt_pk_f32_fp8((int)y0[r][k][i], true);
                    const f32x2 l1 = __builtin_amdgcn_cvt_pk_f32_fp8((int)y1[r][k][i], false), h1 = __builtin_amdgcn_cvt_pk_f32_fp8((int)y1[r][k][i], true);
                    a[4 * i] += w[r][k] * l0[0]; a[4 * i + 1] += w[r][k] * l0[1]; a[4 * i + 2] += w[r][k] * h0[0]; a[4 * i + 3] += w[r][k] * h0[1];
                    a[8 + 4 * i] += w[r][k] * l1[0]; a[8 + 4 * i + 1] += w[r][k] * l1[1]; a[8 + 4 * i + 2] += w[r][k] * h1[0]; a[8 + 4 * i + 3] += w[r][k] * h1[1]; }
            const float* mb = mod + (size_t)(m / SEQ) * 6144 + 5120; float ss = 0.f; f32x4 v[4];
#pragma unroll
            for (int q = 0; q < 4; ++q) { const int col = (q >> 1) * 512 + 8 * lane + 4 * (q & 1); const f32x4 gt = *(const f32x4*)(mb + col);
#pragma unroll
                for (int i = 0; i < 4; ++i) { v[q][i] = xv[r][q][i] + gt[i] * a[(q >> 1) * 8 + 4 * (q & 1) + i]; ss += v[q][i] * v[q][i]; } }
            const float rstd = __builtin_amdgcn_rsqf(wave_sum(ss) * (1.f / DM) + EPS);
#pragma unroll
            for (int q = 0; q < 4; ++q) { const int col = (q >> 1) * 512 + 8 * lane + 4 * (q & 1); const f32x4 fg = *(const f32x4*)(F.in[IN_FG] + col);
                *(f32x4*)(F.out + (size_t)m * DM + col) = v[q] * rstd * fg; } }
    }
}
__device__ __forceinline__ void dbg_final(Frame& F, const float* src) {
    const int gw = F.vcu * NWAVES + F.wave, NGW = F.G * NWAVES;
    for (int m = gw; m < T; m += NGW) {
        const f32x4* xr = (const f32x4*)(src + (size_t)m * DM) + F.lane; f32x4 v[4]; float s = 0.f;
#pragma unroll
        for (int j = 0; j < 4; ++j) { v[j] = xr[64 * j]; s += (v[j][0] * v[j][0] + v[j][1] * v[j][1]) + (v[j][2] * v[j][2] + v[j][3] * v[j][3]); }
        const float rstd = __builtin_amdgcn_rsqf(wave_sum(s) * (1.f / DM) + EPS);
#pragma unroll
        for (int j = 0; j < 4; ++j) { const int col = 4 * (F.lane + 64 * j); *(f32x4*)(F.out + (size_t)m * DM + col) = v[j] * rstd * *(const f32x4*)(F.in[IN_FG] + col); }
    }
}


__device__ __forceinline__ void dbg_dump_bf16(Frame& F, const bf16_t* src, int ld, int c0, int n) {
    for (size_t i = (size_t)blockIdx.x * NWAVES * 64 + F.tid; i < (size_t)T * n; i += (size_t)F.G * NWAVES * 64) { const size_t t = i / n; const int c = (int)(i % n); F.out[t * DM + c0 + c] = bf2f(src[t * ld + c]); }
}
#define DBG_DUMP(k, ...) do { if (DBG_STAGE == (k)) { xcd_barrier(bar); __VA_ARGS__; return; } } while (0)
#ifndef DBG_STAGE
#define DBG_STAGE (-1)
#endif

constexpr int N_PHASES = 13;
struct Args { const float* in[N_IN]; float* out; unsigned char* ws; int ph_lo, ph_hi; };
__global__ void __launch_bounds__(NWAVES * 64, 2) fwd_kernel(Args args) {
    extern __shared__ __attribute__((aligned(16))) unsigned char lds[];
    Frame F;
    F.lds = (LAS unsigned char*)lds; F.MISC = (volatile LAS unsigned*)(F.lds + MISC_OFF);
    F.tid = threadIdx.x; F.lane = F.tid & 63; F.wave = __builtin_amdgcn_readfirstlane(F.tid >> 6);
    F.G = gridDim.x; { const int bx = blockIdx.x; F.vcu = (F.G % 8 == 0) ? (bx % 8) * (F.G / 8) + bx / 8 : bx; }
    F.ws = args.ws; F.ctl = (unsigned*)(args.ws + WS_CTL); F.out = args.out;
#pragma unroll
    for (int i = 0; i < N_IN; ++i) F.in[i] = args.in[i];
    for (int u = F.tid; u < (LDS_BYTES - MISC_OFF) / 4; u += NWAVES * 64) ((LAS unsigned*)(F.lds + MISC_OFF))[u] = 0u;
    __syncthreads();
    XcdBarrier bar; bar.bar = F.ctl + CW_BAR; bar.x = 0; bar.st = nullptr;
    if (!N_LAUNCH_PER_PHASE) bar = xcd_barrier_post(F.ctl + CW_BAR, F.MISC + 8);
    const int lo = args.ph_lo, hi = args.ph_hi;
#ifndef REP_PHASE
#define REP_PHASE (-1)
#endif
#define NREP(k) ((REP_PHASE == (k)) ? 2 : 1)
#define REPLOOP(k) _Pragma("unroll") for (int rep = 0; rep < NREP(k); ++rep)
#ifndef PH_MASK
#define PH_MASK 0xFFFFu
#endif
#define IN(k) ((((PH_MASK) >> (k)) & 1u) && lo <= (k) && (k) < hi)
#ifndef TPROBE
#define TPROBE (-2)
#endif
    unsigned long long tp0 = (TPROBE == 0) ? __builtin_amdgcn_s_memrealtime() : 0ull, tpd = 0ull;
#define SEAM(k) do { if (IN(k) && IN((k) + 1)) xcd_barrier(bar); if (TPROBE == (k)) tpd = __builtin_amdgcn_s_memrealtime() - tp0; if (TPROBE == (k) + 1) tp0 = __builtin_amdgcn_s_memrealtime(); } while (0)

#if defined(DBG_BASE)
    dbg_final(F, F.in[IN_X]); return;
#endif
    if (IN(0)) REPLOOP(0) { p0_mod(F); __syncthreads(); p0_weights(F); __syncthreads(); }
    SEAM(0);
    if (IN(1)) REPLOOP(1) norm_rows(F, F.in[IN_X], F.in[IN_N1G], 0, 1024, WSP(bf16_t, WS_H));
    SEAM(1);
    if (IN(2)) REPLOOP(2) {
        pg::Gemm g{WSP(bf16_t, WS_H), WSP(bf16_t, WS_WIN), DM * 2, DM * 2, nullptr}; pg::StaticOrder S; S.init(T, NPROJ, F.G, (int)blockIdx.x);
        EpiProj E{WSP(bf16_t, WS_PROJ), WSP(float, WS_PART)};
        pg::gemm_phase<EpiProj, pg::StaticOrder, false, true>(F.lds, g, S, E);
    }
    DBG_DUMP(2, dbg_dump_bf16(F, WSP(bf16_t, WS_PROJ), NPROJ, 0, 1024));
    SEAM(2);
    if (IN(4)) REPLOOP(4) {
#ifndef NO_QG
        { pg::Gemm g{WSP(bf16_t, WS_PROJ) + C_QLAT, WSP(bf16_t, WS_WQ), NPROJ * 2, QLORA * 2, nullptr}; pg::StaticOrder S; S.init(T, 768, F.G, (int)blockIdx.x);
          EpiQ E{WSP(bf16_t, WS_Q), WSP(float, WS_PART), WSP(float, WS_CS), 0.10206207261596575f * 1.4426950408889634f};
          pg::gemm_phase<EpiQ, pg::StaticOrder, false, true>(F.lds, g, S, E); }
#endif
#ifndef NO_KVG
        { pg::Gemm g{WSP(bf16_t, WS_PROJ) + C_KVLAT, WSP(bf16_t, WS_WKV), NPROJ * 2, KVLORA * 2, nullptr}; pg::StaticOrder S; S.init(T, 1024, F.G, (int)(F.G - 1 - blockIdx.x));
          EpiKV E{WSP(bf16_t, WS_K), WSP(bf16_t, WS_V), WSP(float, WS_PART), WSP(bf16_t, WS_PROJ), WSP(float, WS_CS)};
          pg::gemm_phase<EpiKV, pg::StaticOrder, false, true>(F.lds, g, S, E); }
#endif
    }
    DBG_DUMP(4, dbg_dump_bf16(F, WSP(bf16_t, WS_Q), 768, 0, 768); dbg_dump_bf16(F, WSP(bf16_t, WS_K), 768, 768, 256));
    SEAM(4);
    unsigned long long g1acc = 0ull;
    if (IN(5)) REPLOOP(5) { for (int u = blockIdx.x; u < BATCH * GH * NCH / 4; u += F.G) g1_unit(F, u, g1acc); }
    if (G1PROBE >= 0) tpd = g1acc;
    SEAM(5);
#ifndef NCONV
#define NCONV 56
#endif
    if (IN(6)) {
        if (F.tid == 0) F.MISC[17] = __hip_atomic_fetch_add(F.ctl + CW_Q + 320, 1u, RLX_AGENT);
        for (;;) {
            if (F.tid == 0) F.MISC[16] = __hip_atomic_fetch_add(F.ctl + CW_Q, 1u, RLX_AGENT);
            __syncthreads();
            const int item = (int)F.MISC[16];
            __syncthreads();
            if (item >= 32) break;
            g2_item(F, item);
        }
        const int ticket = (int)F.MISC[17];
#define CONV_LOOP() for (;;) { if (F.tid == 0) F.MISC[16] = __hip_atomic_fetch_add(F.ctl + CW_Q + 256, 1u, RLX_AGENT); __syncthreads(); const int item = (int)F.MISC[16]; __syncthreads(); \
            if (item >= MOE_CONV_ITEMS) break; moe_conv_item(F, item); }
        if (ticket >= 32 && ticket < 32 + NCONV) CONV_LOOP();
        for (;;) {
            if (F.tid == 0) F.MISC[16] = __hip_atomic_fetch_add(F.ctl + CW_Q + 64, 1u, RLX_AGENT);
            __syncthreads();
            const int item = (int)F.MISC[16];
            __syncthreads();
            if (item >= BATCH * NH * 16) break;
            const int qb = 15 - (item >> 6), bh = item & 63; attn_unit(F, bh >> 3, bh & 7, qb);
        }
        CONV_LOOP();
#undef CONV_LOOP
    }
    DBG_DUMP(6, dbg_dump_bf16(F, WSP(bf16_t, DBG_SUB ? WS_OG : WS_OA), 512, 0, 512); dbg_dump_bf16(F, WSP(bf16_t, DBG_SUB ? WS_OG : WS_OA), 512, 512, 512));
    SEAM(6);
    if (IN(7)) REPLOOP(7) p4b_rows(F);
    SEAM(7);
    if (IN(8)) REPLOOP(8) {
        pg::Gemm g{WSP(bf16_t, WS_H), WSP(bf16_t, WS_WO), DM * 2, DM * 2, nullptr}; pg::StaticOrder S; S.init(T, DM, F.G, (int)blockIdx.x);
        EpiX1 E{F.in[IN_X], WSP(float, WS_MOD), WSP(float, WS_X1)};
        pg::gemm_phase<EpiX1, pg::StaticOrder, false, true>(F.lds, g, S, E);
    }
#if defined(DBG_STOP_X1)
    xcd_barrier(bar); dbg_final(F, WSP(float, WS_X1)); return;
#endif
    SEAM(8);
    if (IN(9)) REPLOOP(9) { p6_router(F, rep); __syncthreads(); }
    SEAM(9);
    if (IN(10)) REPLOOP(10) {
        moe_tables(F);
        pg::Gemm g{WSP(unsigned char, WS_H), WSP(unsigned char, WS_WGU), DM, DM, WSP(int, WS_LIST)};
#if defined(EPIPROBE) && EPIPROBE == 10
        g.tacc = &tpd;
#endif
        pg::MoeOrder S{(const LAS int*)(F.lds + MISC_OFF) + 128, (const LAS int*)(F.lds + MISC_OFF) + 192, 8, 2048, F.G, (int)blockIdx.x, 0};
        EpiGU E{WSP(unsigned char, WS_ACT), F.in[IN_BGU]};
        pg::gemm_phase<EpiGU, pg::MoeOrder, true, true, true>(F.lds, g, S, E);
    }
    SEAM(10);
    if (IN(11)) REPLOOP(11) {
        moe_tables(F);
        pg::Gemm g{WSP(unsigned char, WS_ACT), WSP(unsigned char, WS_WDN), DE, DE, nullptr};
#if defined(EPIPROBE) && EPIPROBE == 11
        g.tacc = &tpd;
#endif
        pg::MoeOrder S{(const LAS int*)(F.lds + MISC_OFF) + 128, (const LAS int*)(F.lds + MISC_OFF) + 192, 4, 1024, F.G, (int)blockIdx.x, 1};
        EpiDN E{WSP(unsigned char, WS_Y), F.in[IN_BDN]};
        pg::gemm_phase<EpiDN, pg::MoeOrder, false, true, true>(F.lds, g, S, E);
    }
    SEAM(11);
    if (IN(12)) REPLOOP(12) { moe_tables(F); p10_combine(F); }
#ifdef EPIPROBE
    const bool epiprobe_ = true;
#else
    const bool epiprobe_ = false;
#endif
    if (TPROBE >= 0 || G1PROBE >= 0 || epiprobe_) { if (TPROBE == 12) { VM_WAIT(); tpd = __builtin_amdgcn_s_memrealtime() - tp0; }
        if (blockIdx.x == 0) { const unsigned long long t_ = __builtin_amdgcn_s_memrealtime(); while (__builtin_amdgcn_s_memrealtime() - t_ < 10ull * tpd) __builtin_amdgcn_s_sleep(8); } }
#undef IN
#undef SEAM
}

extern "C" void kernel_launch(void* const* d_in, const int* in_sizes, int n_in, void* d_out, int out_size, void* d_ws, size_t ws_size, hipStream_t stream) {
    static int grid = 0;
    if (grid == 0) {
        if (n_in != N_IN || out_size != T * DM || ws_size < WS_END) { fprintf(stderr, "kernel_launch: unexpected shapes (n_in %d, out %d, ws %zu)\n", n_in, out_size, ws_size); grid = -1; return; }
        int dev = 0, cus = 0;
        if (hipGetDevice(&dev) != hipSuccess || hipDeviceGetAttribute(&cus, hipDeviceAttributeMultiprocessorCount, dev) != hipSuccess) { grid = -1; return; }
        if (hipFuncSetAttribute((const void*)fwd_kernel, hipFuncAttributeMaxDynamicSharedMemorySize, LDS_BYTES) != hipSuccess) { grid = -1; return; }
        int per_cu = 0;
        if (hipOccupancyMaxActiveBlocksPerMultiprocessor(&per_cu, (const void*)fwd_kernel, NWAVES * 64, LDS_BYTES) != hipSuccess || per_cu < 1) fprintf(stderr, "kernel_launch: occupancy query says %d\n", per_cu);
        (void)hipGetLastError();
        grid = cus;
        while (grid > 8 && (T % grid) != 0) grid -= 8;
    }
    if (grid < 0) return;
    (void)hipMemsetAsync((char*)d_ws + WS_CTL, 0, CTL_BYTES, stream);
    Args a{};
    for (int i = 0; i < N_IN; ++i) a.in[i] = (const float*)d_in[i];
    a.out = (float*)d_out; a.ws = (unsigned char*)d_ws;
#if N_LAUNCH_PER_PHASE
    for (int p = 0; p < N_PHASES; ++p) { a.ph_lo = p; a.ph_hi = p + 1; hipLaunchKernelGGL(fwd_kernel, dim3(grid), dim3(NWAVES * 64), LDS_BYTES, stream, a); }
#else
    a.ph_lo = 0; a.ph_hi = N_PHASES;
    hipLaunchKernelGGL(fwd_kernel, dim3(grid), dim3(NWAVES * 64), LDS_BYTES, stream, a);
#endif
}
```

```cpp
#include <hip/hip_runtime.h>
#include <cstdio>
#include <cstdint>


#define DBG_SUB 0
#ifndef N_LAUNCH_PER_PHASE
#define N_LAUNCH_PER_PHASE 0
#endif

#define GAS __attribute__((address_space(1)))
#define LAS __attribute__((address_space(3)))
typedef unsigned short bf16_t;
typedef short bf16x8 __attribute__((ext_vector_type(8)));
typedef short s16x4 __attribute__((ext_vector_type(4)));
typedef float f32x4 __attribute__((ext_vector_type(4)));
typedef float f32x2 __attribute__((ext_vector_type(2)));
typedef float f32x16 __attribute__((ext_vector_type(16)));
typedef unsigned u32x4 __attribute__((ext_vector_type(4)));
typedef unsigned u32x2 __attribute__((ext_vector_type(2)));
typedef __bf16 bf16x2_t __attribute__((ext_vector_type(2)));
typedef int i32x4q __attribute__((ext_vector_type(4)));

constexpr int BATCH = 8, SEQ = 4096, DM = 1024, T = BATCH * SEQ;
constexpr int NH = 8, QK = 96, NOPE = 64, ROPE = 32, VD = 64, QLORA = 384, KVLORA = 256;
constexpr int GH = 8, GDK = 64, GDV = 64;
constexpr int IN_DIM = 2736, NPROJ = 2816;
constexpr int C_QLAT = 0, C_KVLAT = 384, C_KPE = 640, C_GQ = 672, C_GK = 1184, C_GV = 1696, C_GZ = 2208, C_GA = 2720, C_GB = 2728;
constexpr int NE = 32, TOPK = 4, DE = 1024;
constexpr float EPS = 1e-6f;
constexpr float W8 = 32.0f;
constexpr int GC = 32, NCH = SEQ / GC;
constexpr int MAXROWS = T * TOPK + NE * 256;

constexpr size_t MiB = 1u << 20;
constexpr size_t WS_CTL = 0, CTL_BYTES = 1 * MiB;
constexpr size_t WS_MOD = 1 * MiB;
constexpr size_t WS_RSQ = 2 * MiB;
constexpr size_t WS_RSKV = WS_RSQ + 128 * 1024;
constexpr size_t WS_CS = 3 * MiB;
constexpr size_t WS_TKE = 7 * MiB;
constexpr size_t WS_TKW = WS_TKE + 512 * 1024;
constexpr size_t WS_TKP = WS_TKW + 512 * 1024;
constexpr size_t WS_LIST = 9 * MiB;
constexpr size_t WS_RWT = 13 * MiB;
constexpr size_t WS_PART = 13 * MiB + 256 * 1024;
constexpr size_t WS_WIN = 16 * MiB;
constexpr size_t WS_WQ = WS_WIN + (size_t)NPROJ * DM * 2;
constexpr size_t WS_WKV = WS_WQ + (size_t)768 * 384 * 2;
constexpr size_t WS_WO = WS_WKV + (size_t)1024 * 256 * 2;
constexpr size_t WS_WGU = 32 * MiB;
constexpr size_t WS_WDN = WS_WGU + (size_t)NE * 2048 * 1024 * 2;
constexpr size_t WS_H = 224 * MiB;
constexpr size_t WS_X1 = 288 * MiB;
constexpr size_t WS_PROJ = 416 * MiB;
constexpr size_t WS_Q = 592 * MiB;
constexpr size_t WS_K = 640 * MiB;
constexpr size_t WS_V = 688 * MiB;
constexpr size_t WS_OA = 720 * MiB;
constexpr size_t WS_OG = 752 * MiB;
constexpr size_t WS_GD = 784 * MiB;
constexpr size_t WS_ACT = 416 * MiB;
constexpr size_t WS_Y = 688 * MiB;
constexpr size_t WS_END = 976 * MiB;
static_assert(WS_WO + (size_t)1024 * 1024 * 2 <= WS_WGU && WS_WDN + (size_t)NE * 1024 * 1024 * 2 <= WS_H, "weights");
static_assert(WS_ACT + (size_t)MAXROWS * 1024 * 2 <= WS_Y && WS_Y + (size_t)MAXROWS * 1024 * 2 <= WS_END, "moe rows");
static_assert(WS_GD + (size_t)BATCH * GH * NCH * 24576 <= WS_END, "gdn");
constexpr int CW_BAR = 4096;
constexpr int CW_Q = 8192;
constexpr int CW_CNT = 12288;

constexpr int RING_BYTES = 131072;
constexpr int MISC_OFF = RING_BYTES;
constexpr int LDS_BYTES = 147456;

#define LDS_WAIT() asm volatile("s_waitcnt lgkmcnt(0)" ::: "memory")
#define LBAR() asm volatile("s_waitcnt lgkmcnt(0)\n\ts_barrier" ::: "memory")
#define VM_WAIT() asm volatile("s_waitcnt vmcnt(0)" ::: "memory")
#define RLX_AGENT __ATOMIC_RELAXED, __HIP_MEMORY_SCOPE_AGENT

__device__ __forceinline__ unsigned cvtpk(float lo, float hi) { f32x2 v = {lo, hi}; bf16x2_t b = __builtin_convertvector(v, bf16x2_t); return __builtin_bit_cast(unsigned, b); }
__device__ __forceinline__ bf16_t f2bf(float f) { return (bf16_t)(cvtpk(f, 0.f) & 0xffffu); }
__device__ __forceinline__ float bf2f(unsigned short h) { return __uint_as_float((unsigned)h << 16); }
__device__ __forceinline__ float bflo(unsigned w) { return __uint_as_float(w << 16); }
__device__ __forceinline__ float bfhi(unsigned w) { return __uint_as_float(w & 0xffff0000u); }
__device__ __forceinline__ float wave_sum(float v) {
#pragma unroll
    for (int o = 1; o < 64; o <<= 1) v += __shfl_xor(v, o);
    return v;
}
__device__ __forceinline__ unsigned pk4_fp8(float a, float b, float c, float d) { int w = 0; w = __builtin_amdgcn_cvt_pk_fp8_f32(a, b, w, false); w = __builtin_amdgcn_cvt_pk_fp8_f32(c, d, w, true); return (unsigned)w; }
__device__ __forceinline__ float siluf(float x) { return x / (1.f + __expf(-x)); }

#define XB_TMO      128
#define XB_XCNT(j)  (256  + 64 * (j))
#define XB_XSUB(j)  (1280 + 64 * (j))
#define XB_XGEN(j)  (2304 + 64 * (j))
#define XB_TOP      3328
#define XB_TOPGEN   3392
#define XCD_BAR_WORDS 3456
#define XB_SPIN_CAP (1u << 18)
__device__ __forceinline__ unsigned xb_ld(unsigned* p)              { return __hip_atomic_load(p, __ATOMIC_RELAXED, __HIP_MEMORY_SCOPE_AGENT); }
__device__ __forceinline__ unsigned xb_add(unsigned* p, unsigned v) { return __hip_atomic_fetch_add(p, v, __ATOMIC_RELAXED, __HIP_MEMORY_SCOPE_AGENT); }
__device__ __forceinline__ unsigned xb_xcc_id() { return (unsigned)__builtin_amdgcn_s_getreg((3 << 11) | 20) & 0xFu; }
#define XB_SPIN(cond, bar) do { unsigned _sp = 0; while (cond) { __builtin_amdgcn_s_sleep(1); \
    if ((++_sp & 255u) == 0u) { if (xb_ld(&(bar)[XB_TMO])) break; if (_sp > XB_SPIN_CAP) { atomicAdd(&(bar)[XB_TMO], 1u); break; } } } } while (0)
struct XcdBarrier { unsigned* bar; unsigned x; volatile LAS unsigned* st; };
__device__ __forceinline__ XcdBarrier xcd_barrier_post(unsigned* bar, volatile LAS unsigned* st) {
    XcdBarrier b; b.bar = bar; b.x = xb_xcc_id(); b.st = st;
    if (threadIdx.x == 0) (void)xb_add(&bar[XB_XCNT(b.x)], 1u);
    return b;
}
__device__ __forceinline__ void xcd_barrier_complete(unsigned* bar, unsigned x, unsigned& nloc, unsigned& nx) {
    const unsigned G = gridDim.x * gridDim.y * gridDim.z;
    unsigned sum, cnt, mine, sp = 0u;
    for (;;) {
        sum = 0u; cnt = 0u; mine = 0u;
#pragma unroll
        for (unsigned j = 0; j < 16; ++j) { const unsigned c = xb_ld(&bar[XB_XCNT(j)]); sum += c; cnt += (c > 0u) ? 1u : 0u; mine = (j == x) ? c : mine; }
        if (sum == G) break;
        __builtin_amdgcn_s_sleep(1);
        if ((++sp & 255u) == 0u) { if (xb_ld(&bar[XB_TMO])) break; if (sp > XB_SPIN_CAP) { atomicAdd(&bar[XB_TMO], 1u); break; } }
    }
    nloc = mine > 0u ? mine : 1u; nx = cnt > 0u ? cnt : 1u;
}
__device__ __forceinline__ void xcd_barrier(const XcdBarrier& b) {
    asm volatile("s_waitcnt vmcnt(0)" ::: "memory");
    __syncthreads();
    if (threadIdx.x == 0) {
        unsigned* bar = b.bar;
        __builtin_amdgcn_s_waitcnt(0);
        unsigned nloc = b.st[0], nx = b.st[1];
        if (nloc == 0u) { xcd_barrier_complete(bar, b.x, nloc, nx); b.st[0] = nloc; b.st[1] = nx; }
        const unsigned old = xb_add(&bar[XB_XSUB(b.x)], 1u);
        const unsigned gen = old / nloc;
        if (old + 1u == (gen + 1u) * nloc) {
            __builtin_amdgcn_fence(__ATOMIC_RELEASE, "agent");
            asm volatile("s_waitcnt vmcnt(0)" ::: "memory");
            const unsigned og = xb_add(&bar[XB_TOP], 1u);
            const unsigned tg = og / nx;
            if (og + 1u == (tg + 1u) * nx) xb_add(&bar[XB_TOPGEN], 1u);
            else XB_SPIN(xb_ld(&bar[XB_TOPGEN]) == tg, bar);
            __builtin_amdgcn_fence(__ATOMIC_ACQUIRE, "agent");
            xb_add(&bar[XB_XGEN(b.x)], 1u);
            asm volatile("s_waitcnt vmcnt(0)" ::: "memory");
        } else {
            XB_SPIN(xb_ld(&bar[XB_XGEN(b.x)]) == gen, bar);
            __builtin_amdgcn_fence(__ATOMIC_ACQUIRE, "agent");
            asm volatile("s_waitcnt vmcnt(0)" ::: "memory");
        }
    }
    __syncthreads();
}

namespace pg {
constexpr int BM = 256, BK = 64, HALF = 128, HTB = HALF * BK * 2, STAGE_BYTES = 8 * HTB, NXCD = 8, WGM = 8;
__host__ __device__ __forceinline__ int lds_byte(int r, int c) { const int st = (r >> 4) * 2 + (c >> 5), rr = r & 15, cc = c & 31, ob = rr * 64 + cc * 2; return st * 1024 + (ob ^ (((ob >> 9) & 1) << 5)); }
__host__ __device__ __forceinline__ void stage_rc(int b, int& R, int& C) { const int st = b / 1024, sb = b % 1024, swz = sb ^ (((sb >> 9) & 1) << 5); R = (st >> 1) * 16 + swz / 64; C = (st & 1) * 32 + (swz % 64) / 2; }
__host__ __device__ __forceinline__ int perm32(int rho) { const int n = rho >> 4, i = rho & 15; return 8 * (i >> 2) + 4 * n + (i & 3); }

struct Unit { int pm, pn, arow, brow, nvalid, e; };
struct Gemm { const void* A; const void* Bt; int lda, K; const int* list; unsigned long long* tacc = nullptr; };

struct StaticOrder {
    int nM, nN, nwg, G, c;
    __device__ __forceinline__ void init(int M, int N, int G_, int c_) { nM = M / BM; nN = N / BM; nwg = nM * nN; G = G_; c = c_; }
    __device__ __forceinline__ bool next(int i, Unit& u) const {
        const long L = (long)i * G + c; if (L >= nwg) return false;
        int wgid = (int)L; { const int q = nwg / NXCD, r = nwg % NXCD, xcd = wgid % NXCD, off = wgid / NXCD; wgid = (xcd < r ? xcd * (q + 1) : r * (q + 1) + (xcd - r) * q) + off; }
        const int nig = WGM * nN, gid = wgid / nig, fm = gid * WGM, gsz = (nM - fm) < WGM ? (nM - fm) : WGM;
        u.pm = fm + ((wgid % nig) % gsz); u.pn = (wgid % nig) / gsz; u.arow = u.pm * BM; u.brow = u.pn * BM; u.nvalid = BM; u.e = 0; return true;
    }
};
struct MoeOrder {
    const LAS int* pre;
    const LAS int* cnt;
    int NT, Nrows, G, c, contig;
    __device__ __forceinline__ bool next(int i, Unit& u) const {
        const int xcd = c & 7, j = c >> 3, q = i * (G >> 3) + j, mq = q / NT, nt = q - mq * NT, mt = mq * 8 + xcd;
        if (mt >= pre[32]) return false;
        const int e = pre[2176 + mt];
        const int row0 = (mt - pre[e]) * BM;
        u.pm = mt; u.pn = nt; u.e = e; u.nvalid = cnt[e] - row0; u.arow = contig ? mt * BM : row0; u.brow = e * Nrows + nt * BM; return true;
    }
};

__device__ __forceinline__ void glds16s(const void* sbase, unsigned voff, unsigned ldsdst) { unsigned keep;
    asm volatile("s_mov_b32 %0, m0\n\ts_mov_b32 m0, %3\n\ts_nop 0\n\tglobal_load_lds_dwordx4 %1, %2\n\ts_mov_b32 m0, %0" : "=&s"(keep) : "v"(voff), "s"(sbase), "s"(ldsdst) : "memory"); }
typedef int i32x8 __attribute__((ext_vector_type(8)));
typedef int i32x4 __attribute__((ext_vector_type(4)));
template <class Epi, class Sched, bool GATHER, bool ALIGN_EPI, bool FP8 = false>
__device__ __forceinline__ void gemm_phase(LAS unsigned char* lds, const Gemm g, const Sched& S, const Epi& E) {
    const int tid = threadIdx.x, wid = __builtin_amdgcn_readfirstlane(tid >> 6), lane = tid & 63, wr = wid >> 2, wc = wid & 3, fr = lane & 15, fq = lane >> 4;
    const int K = g.K, nt = K / (BK * 2), lda = g.lda;
    unsigned voffB[2], voffA[2];
#pragma unroll
    for (int i = 0; i < 2; ++i) { int R, C; stage_rc(tid * 16 + i * 8192, R, C); const int Rb = Epi::PERM ? ((R & ~31) + perm32(R & 31)) : R; voffB[i] = (unsigned)(Rb * K + C * 2); voffA[i] = (unsigned)(R * lda + C * 2); }
    const size_t kstep = (size_t)(BK * 2);
    const size_t hstep = (size_t)HALF * K;
    const unsigned ldsw = (unsigned)wid * 1024u;
    const unsigned ldsa = (unsigned)__builtin_amdgcn_readfirstlane((int)((unsigned)(uintptr_t)lds + ldsw));
    const int aoff = lds_byte(wr * 64 + fr, fq * 8), boff = lds_byte(wc * 32 + fr, fq * 8);
#define PG_SA(b, h) (((b) * 2 + (h)) * HTB)
#define PG_SB(b, h) ((4 + (b) * 2 + (h)) * HTB)
#define PG_STAGE(bufoff, gbase, voff) do { _Pragma("unroll") for (int _i = 0; _i < 2; ++_i) \
        glds16s((const void*)(gbase), (voff)[_i], ldsa + (unsigned)(bufoff) + (unsigned)(_i * 8192)); } while (0)
#define PG_LDA(dst, b, h) do { _Pragma("unroll") for (int m = 0; m < 4; ++m) { if constexpr (FP8) { dst##8[m] = __builtin_shufflevector(*(const LAS i32x4*)(lds + PG_SA(b, h) + aoff + m * 2048), *(const LAS i32x4*)(lds + PG_SA(b, h) + aoff + m * 2048 + 1024), 0, 1, 2, 3, 4, 5, 6, 7); } \
        else { _Pragma("unroll") for (int k = 0; k < 2; ++k) dst[m][k] = *(const LAS bf16x8*)(lds + PG_SA(b, h) + aoff + m * 2048 + k * 1024); } } } while (0)
#define PG_LDB(dst, b, h) do { _Pragma("unroll") for (int n = 0; n < 2; ++n) { if constexpr (FP8) { dst##8[n] = __builtin_shufflevector(*(const LAS i32x4*)(lds + PG_SB(b, h) + boff + n * 2048), *(const LAS i32x4*)(lds + PG_SB(b, h) + boff + n * 2048 + 1024), 0, 1, 2, 3, 4, 5, 6, 7); } \
        else { _Pragma("unroll") for (int k = 0; k < 2; ++k) dst[n][k] = *(const LAS bf16x8*)(lds + PG_SB(b, h) + boff + n * 2048 + k * 1024); } } } while (0)
#define PG_MMA(ai, bj, At, Bt) do { __builtin_amdgcn_s_setprio(1); if constexpr (FP8) { _Pragma("unroll") for (int m = 0; m < 4; ++m) _Pragma("unroll") for (int n = 0; n < 2; ++n) \
        asm volatile("v_mfma_scale_f32_16x16x128_f8f6f4 %0, %1, %2, %0, %3, %3 op_sel_hi:[0,0,0]" : "+v"(acc[ai][bj][m][n]) : "v"(Bt##8[n]), "v"(At##8[m]), "v"(scl1)); } \
        else { _Pragma("unroll") for (int m = 0; m < 4; ++m) _Pragma("unroll") for (int n = 0; n < 2; ++n) _Pragma("unroll") for (int k = 0; k < 2; ++k) \
        acc[ai][bj][m][n] = __builtin_amdgcn_mfma_f32_16x16x32_bf16(Bt[n][k], At[m][k], acc[ai][bj][m][n], 0, 0, 0); } __builtin_amdgcn_s_setprio(0); } while (0)
#define PG_WAIT_V(n) asm volatile("s_waitcnt vmcnt(" #n ")" ::: "memory")
#define PG_WAIT_L(n) asm volatile("s_waitcnt lgkmcnt(" #n ")" ::: "memory")
#define PG_BAR __builtin_amdgcn_s_barrier()
#define PG_SCHED __builtin_amdgcn_sched_barrier(0)
#define PG_SETA(v, u) do { _Pragma("unroll") for (int _h = 0; _h < 2; ++_h) _Pragma("unroll") for (int _i = 0; _i < 2; ++_i) { int _R, _C; stage_rc(tid * 16 + _i * 8192, _R, _C); const int _r = _h * HALF + _R; \
        const int _rr = _r < (u).nvalid ? _r : (u).nvalid - 1; const int _tok = g.list[(size_t)(u).e * T + (u).arow + _rr]; v[_h][_i] = (unsigned)(_tok * lda + _C * 2); } } while (0)
#define PG_STA(bufoff, kb, h, NX) do { if constexpr (GATHER) { unsigned _vs[2]; _vs[0] = (NX) ? vN[h][0] : vA[h][0]; _vs[1] = (NX) ? vN[h][1] : vA[h][1]; PG_STAGE(bufoff, (const char*)g.A + (kb), _vs); } \
        else PG_STAGE(bufoff, ((NX) ? nA : cA) + (kb) + (h) * hstepA, voffA); } while (0)
    Unit cur, nxt; int ui = 0;
    if (!S.next(0, cur)) return;
    f32x4 acc[2][2][4][2];
#pragma unroll
    for (int a = 0; a < 2; ++a)
#pragma unroll
        for (int b = 0; b < 2; ++b)
#pragma unroll
            for (int m = 0; m < 4; ++m)
#pragma unroll
                for (int n = 0; n < 2; ++n) acc[a][b][m][n] = (f32x4){0.f, 0.f, 0.f, 0.f};
    const int scl1 = 0x7F7F7F7F;
    bf16x8 At[4][2], B0[2][2], B1[2][2]; i32x8 At8[4], B08[2], B18[2];
    unsigned vN[2][2] = {{0u, 0u}, {0u, 0u}};
    unsigned vA[2][2];
    LAS u32x4* const vnl = (LAS u32x4*)(lds + STAGE_BYTES + 1024) + tid;
    const size_t hstepA = (size_t)HALF * lda;
    if constexpr (GATHER) { PG_SETA(vA, cur); PG_WAIT_V(0); }
    const char* cA = (const char*)g.A + (GATHER ? (size_t)0 : (size_t)cur.arow * lda); const char* nA = cA;
    const char* cB = (const char*)g.Bt + (size_t)cur.brow * K;
    PG_STAGE(PG_SB(0, 0), cB, voffB); PG_STAGE(PG_SB(0, 1), cB + hstep, voffB); PG_STA(PG_SA(0, 0), 0, 0, false); PG_STA(PG_SA(0, 1), 0, 1, false);
    if (wr == 1) PG_BAR;
    PG_WAIT_V(2); PG_BAR;
    PG_STAGE(PG_SB(1, 0), cB + kstep, voffB); PG_STA(PG_SA(1, 0), kstep, 0, false); PG_STAGE(PG_SB(1, 1), cB + hstep + kstep, voffB);
    PG_WAIT_V(6); PG_BAR;
    for (;;) {
        const bool has_next = S.next(ui + 1, nxt);
        if constexpr (GATHER) {
            unsigned vT[2][2];
            if (has_next) { PG_SETA(vT, nxt); PG_WAIT_V(0); }
            else {
#pragma unroll
                for (int h = 0; h < 2; ++h)
#pragma unroll
                    for (int i = 0; i < 2; ++i) vT[h][i] = vA[h][i]; }
            *vnl = (u32x4){vT[0][0], vT[0][1], vT[1][0], vT[1][1]};
        } else nA = has_next ? (const char*)g.A + (size_t)nxt.arow * lda : cA;
        const char* nB = has_next ? (const char*)g.Bt + (size_t)nxt.brow * K : cB;
#pragma unroll 1
        for (int t = 0; t < nt; t += 2) {
            const bool last = (t == nt - 2);
            if constexpr (GATHER) { if (last) { const u32x4 q_ = *vnl; vN[0][0] = q_.x; vN[0][1] = q_.y; vN[1][0] = q_.z; vN[1][1] = q_.w; } else { vN[0][0] = vA[0][0]; vN[0][1] = vA[0][1]; vN[1][0] = vA[1][0]; vN[1][1] = vA[1][1]; } }
            const size_t k1 = (size_t)(t + 1) * kstep, k2 = last ? (size_t)0 : (size_t)(t + 2) * kstep, k3 = k2 + kstep;
            const char* b2 = last ? nB : cB + (size_t)(t + 2) * kstep; const char* b3 = b2 + kstep;
            PG_LDB(B0, 0, 0); PG_LDB(B1, 0, 1); PG_SCHED; PG_LDA(At, 0, 0); PG_STA(PG_SA(1, 1), k1, 1, false);
            PG_WAIT_V(8); PG_WAIT_L(0); PG_BAR; PG_MMA(0, 0, At, B0); PG_MMA(0, 1, At, B1); PG_BAR; PG_SCHED;
            PG_LDA(At, 0, 1); PG_STAGE(PG_SB(0, 0), b2, voffB); PG_STAGE(PG_SB(0, 1), b2 + hstep, voffB); PG_STA(PG_SA(0, 0), k2, 0, last);
            PG_WAIT_V(8); PG_WAIT_L(0); PG_BAR; PG_MMA(1, 0, At, B0); PG_MMA(1, 1, At, B1); PG_BAR; PG_SCHED;
            PG_LDB(B0, 1, 0); PG_LDB(B1, 1, 1); PG_SCHED; PG_LDA(At, 1, 0); PG_STA(PG_SA(0, 1), k2, 1, last);
            PG_WAIT_V(8); PG_WAIT_L(0); PG_BAR; PG_MMA(0, 0, At, B0); PG_MMA(0, 1, At, B1); PG_BAR; PG_SCHED;
            PG_LDA(At, 1, 1); PG_STAGE(PG_SB(1, 0), b3, voffB); PG_STAGE(PG_SB(1, 1), b3 + hstep, voffB); PG_STA(PG_SA(1, 0), k3, 0, last);
            PG_WAIT_V(8); PG_WAIT_L(0); PG_BAR; PG_MMA(1, 0, At, B0); PG_MMA(1, 1, At, B1); PG_BAR; PG_SCHED;
        }
        if constexpr (ALIGN_EPI) { if (wr == 0) PG_BAR; }
        if constexpr (FP8) asm volatile("s_nop 15\n\ts_nop 15" ::: "memory");
#ifdef EPIPROBE
        const unsigned long long te0_ = __builtin_amdgcn_s_memrealtime();
#endif
        E(acc, cur, wr, wc, fr, fq);
#ifdef EPIPROBE
        if (g.tacc) { asm volatile("s_waitcnt vmcnt(0)" ::: "memory"); *g.tacc += __builtin_amdgcn_s_memrealtime() - te0_; }
#endif
        if (!has_next) break;
#pragma unroll
        for (int a = 0; a < 2; ++a)
#pragma unroll
            for (int b = 0; b < 2; ++b)
#pragma unroll
                for (int m = 0; m < 4; ++m)
#pragma unroll
                    for (int n = 0; n < 2; ++n) acc[a][b][m][n] = (f32x4){0.f, 0.f, 0.f, 0.f};
        cur = nxt; cB = nB; cA = nA; ++ui;
        if constexpr (GATHER) { const u32x4 q_ = *vnl; vA[0][0] = q_.x; vA[0][1] = q_.y; vA[1][0] = q_.z; vA[1][1] = q_.w; }
        if constexpr (ALIGN_EPI) { if (wr == 1) PG_BAR; }
    }
    PG_WAIT_V(0);
    if constexpr (!ALIGN_EPI) { if (wr == 0) PG_BAR; }
    PG_BAR;
#undef PG_SA
#undef PG_SB
#undef PG_STAGE
#undef PG_LDA
#undef PG_LDB
#undef PG_MMA
#undef PG_WAIT_V
#undef PG_WAIT_L
#undef PG_BAR
#undef PG_SCHED
#undef PG_SETA
#undef PG_STA
}
}

typedef f32x4 AccT[2][2][4][2];
__device__ __forceinline__ float ssq8(u32x4 a) { float s = 0.f;
#pragma unroll
    for (int i = 0; i < 4; ++i) { const float lo = bflo(a[i]), hi = bfhi(a[i]); s += lo * lo + hi * hi; } return s; }

__device__ __forceinline__ u32x4 pack8(f32x4 a, f32x4 b) { u32x4 w; w.x = cvtpk(a[0], a[1]); w.y = cvtpk(a[2], a[3]); w.z = cvtpk(b[0], b[1]); w.w = cvtpk(b[2], b[3]); return w; }

struct EpiProj {
    static constexpr bool PERM = true; bf16_t* O; float* part;
    __device__ __forceinline__ void operator()(const AccT& acc, const pg::Unit& u, int wr, int wc, int fr, int fq) const {
        const int row0 = u.pm * 256 + wr * 64 + fr, col0 = u.pn * 256 + wc * 32 + 8 * fq;
#pragma unroll
        for (int ai = 0; ai < 2; ++ai)
#pragma unroll
            for (int m = 0; m < 4; ++m) { const int row = row0 + ai * 128 + m * 16; bf16_t* rowp = O + (size_t)row * NPROJ + col0;
#pragma unroll
                for (int bj = 0; bj < 2; ++bj) { const u32x4 w = pack8(acc[ai][bj][m][0], acc[ai][bj][m][1]); *(u32x4*)(rowp + bj * 128) = w;
                    const int grp = 8 * u.pn + 4 * bj + wc;
                    if (grp < 20) {
                        float sq = ssq8(w); sq += __shfl_xor(sq, 16); sq += __shfl_xor(sq, 32);
                        if (fq == 0) part[(size_t)row * 20 + grp] = sq; } } }
    }
};
struct EpiQ {
    static constexpr bool PERM = true; bf16_t* O; const float* part; const float* cs; float scale;
    __device__ __forceinline__ void operator()(const AccT& acc, const pg::Unit& u, int wr, int wc, int fr, int fq) const {
        const int row0 = u.pm * 256 + wr * 64 + fr;
#pragma unroll
        for (int ai = 0; ai < 2; ++ai)
#pragma unroll
            for (int m = 0; m < 4; ++m) { const int row = row0 + ai * 128 + m * 16; const f32x4* pp = (const f32x4*)(part + (size_t)row * 20); const f32x4 s0 = pp[0], s1 = pp[1], s2 = pp[2];
                const float rs = __builtin_amdgcn_rsqf((((s0[0] + s0[1]) + (s0[2] + s0[3])) + ((s1[0] + s1[1]) + (s1[2] + s1[3])) + ((s2[0] + s2[1]) + (s2[2] + s2[3]))) * (1.f / QLORA) + EPS) * scale;
#pragma unroll
                for (int bj = 0; bj < 2; ++bj) { const int G = 8 * u.pn + 4 * bj + wc;
                    f32x4 v0 = acc[ai][bj][m][0] * rs, v1 = acc[ai][bj][m][1] * rs;
                    if ((G % 3) == 2) {
                        f32x4 p0, p1;
#pragma unroll
                        for (int j = 0; j < 4; ++j) { p0[j] = __shfl_xor(v0[j], 32); p1[j] = __shfl_xor(v1[j], 32); }
                        const float* cr = cs + (size_t)row * 32 + 8 * (fq & 1);
                        const f32x4 c0 = *(const f32x4*)cr, c1 = *(const f32x4*)(cr + 4), s0 = *(const f32x4*)(cr + 16), s1 = *(const f32x4*)(cr + 20);
                        if (fq < 2) { v0 = v0 * c0 - p0 * s0; v1 = v1 * c1 - p1 * s1; } else { v0 = v0 * c0 + p0 * s0; v1 = v1 * c1 + p1 * s1; }
                    }
                    *(u32x4*)(O + (size_t)row * 768 + 32 * G + 8 * fq) = pack8(v0, v1); }
                asm volatile("" ::: "memory"); }
    }
};
struct EpiKV {
    static constexpr bool PERM = true; bf16_t* Ko; bf16_t* Vo; const float* part; const bf16_t* proj; const float* cs;
    __device__ __forceinline__ void operator()(const AccT& acc, const pg::Unit& u, int wr, int wc, int fr, int fq) const {
        const int row0 = u.pm * 256 + wr * 64 + fr;
#pragma unroll
        for (int ai = 0; ai < 2; ++ai)
#pragma unroll
            for (int m = 0; m < 4; ++m) { const int row = row0 + ai * 128 + m * 16; const f32x4* pp = (const f32x4*)(part + (size_t)row * 20 + 12); const f32x4 s0 = pp[0], s1 = pp[1];
                const float rs = __builtin_amdgcn_rsqf((((s0[0] + s0[1]) + (s0[2] + s0[3])) + ((s1[0] + s1[1]) + (s1[2] + s1[3]))) * (1.f / KVLORA) + EPS);
#pragma unroll
                for (int bj = 0; bj < 2; ++bj) { const int G = 8 * u.pn + 4 * bj + wc, head = G >> 2, sub = G & 3;
                    bf16_t* dst = (sub < 2) ? Ko + (size_t)row * 768 + head * 96 + 32 * sub + 8 * fq : Vo + (size_t)row * 512 + head * 64 + 32 * (sub - 2) + 8 * fq;
                    *(u32x4*)dst = pack8(acc[ai][bj][m][0] * rs, acc[ai][bj][m][1] * rs); } }
        if (u.pn == 0) {
            const int lane = fq * 16 + fr, tid = (wr * 4 + wc) * 64 + lane, row = u.pm * 256 + (tid >> 1), half = tid & 1;
            const u32x4* src = (const u32x4*)(proj + (size_t)row * NPROJ + C_KPE + 16 * half); const u32x4 a = src[0], b = src[1];
            const f32x4* cp = (const f32x4*)(cs + (size_t)row * 32);
            float xv[16], pv[16], cc[16], ss[16];
#pragma unroll
            for (int i = 0; i < 4; ++i) { xv[2 * i] = bflo(a[i]); xv[2 * i + 1] = bfhi(a[i]); xv[8 + 2 * i] = bflo(b[i]); xv[8 + 2 * i + 1] = bfhi(b[i]);
                const f32x4 c4 = cp[i], s4 = cp[4 + i]; cc[4 * i] = c4[0]; cc[4 * i + 1] = c4[1]; cc[4 * i + 2] = c4[2]; cc[4 * i + 3] = c4[3]; ss[4 * i] = s4[0]; ss[4 * i + 1] = s4[1]; ss[4 * i + 2] = s4[2]; ss[4 * i + 3] = s4[3]; }
#pragma unroll
            for (int j = 0; j < 16; ++j) pv[j] = __shfl_xor(xv[j], 1);
            float o[16];
#pragma unroll
            for (int j = 0; j < 16; ++j) o[j] = (half == 0) ? xv[j] * cc[j] - pv[j] * ss[j] : xv[j] * cc[j] + pv[j] * ss[j];
            u32x4 w0, w1;
#pragma unroll
            for (int i = 0; i < 4; ++i) { w0[i] = cvtpk(o[2 * i], o[2 * i + 1]); w1[i] = cvtpk(o[8 + 2 * i], o[8 + 2 * i + 1]); }
#pragma unroll
            for (int h = 0; h < NH; ++h) { bf16_t* d = Ko + (size_t)row * 768 + h * 96 + 64 + 16 * half; *(u32x4*)d = w0; *(u32x4*)(d + 8) = w1; }
        }
    }
};
struct EpiX1 {
    static constexpr bool PERM = false; const float* x; const float* mod; float* O;
    __device__ __forceinline__ void operator()(const AccT& acc, const pg::Unit& u, int wr, int wc, int fr, int fq) const {
        const int row0 = u.pm * 256 + wr * 64 + fr, col0 = u.pn * 256 + wc * 32 + 4 * fq;
        const float* gt = mod + (size_t)(u.pm * 256 / SEQ) * 6144 + 2048 + col0;
        f32x4 gv[2][2];
#pragma unroll
        for (int bj = 0; bj < 2; ++bj)
#pragma unroll
            for (int n = 0; n < 2; ++n) gv[bj][n] = *(const f32x4*)(gt + bj * 128 + n * 16);
#pragma unroll
        for (int ai = 0; ai < 2; ++ai)
#pragma unroll
            for (int m = 0; m < 4; ++m) { const size_t off = (size_t)(row0 + ai * 128 + m * 16) * DM + col0;
#pragma unroll
                for (int bj = 0; bj < 2; ++bj)
#pragma unroll
                    for (int n = 0; n < 2; ++n) { const f32x4 xv = *(const f32x4*)(x + off + bj * 128 + n * 16); *(f32x4*)(O + off + bj * 128 + n * 16) = xv + gv[bj][n] * acc[ai][bj][m][n]; } }
    }
};
struct EpiGU {
    static constexpr bool PERM = true; unsigned char* O; const float* bias;
    __device__ __forceinline__ void operator()(const AccT& acc, const pg::Unit& u, int wr, int wc, int fr, int fq) const {
        const int row0 = u.pm * 256 + wr * 64 + fr, gcol = u.pn * 128 + wc * 32 + 8 * fq;
        const float* bp = bias + (size_t)u.e * 2048 + gcol;
        const f32x4 bg0 = *(const f32x4*)bp, bg1 = *(const f32x4*)(bp + 4), bu0 = *(const f32x4*)(bp + 1024), bu1 = *(const f32x4*)(bp + 1028);
#pragma unroll
        for (int ai = 0; ai < 2; ++ai)
#pragma unroll
            for (int m = 0; m < 4; ++m) {
                f32x4 r[2];
#pragma unroll
                for (int n = 0; n < 2; ++n) { const f32x4 g4 = acc[ai][0][m][n] * (1.0f / W8) + (n ? bg1 : bg0), u4 = acc[ai][1][m][n] * (1.0f / W8) + (n ? bu1 : bu0);
#pragma unroll
                    for (int j = 0; j < 4; ++j) { const float g = fminf(g4[j], 7.0f), up = fminf(fmaxf(u4[j], -7.0f), 7.0f);
                        r[n][j] = (up + 1.0f) * g * __builtin_amdgcn_rcpf(1.0f + __expf(-1.702f * g)); } }
                u32x2 w; w.x = pk4_fp8(r[0][0], r[0][1], r[0][2], r[0][3]); w.y = pk4_fp8(r[1][0], r[1][1], r[1][2], r[1][3]); *(u32x2*)(O + (size_t)(row0 + ai * 128 + m * 16) * DE + gcol) = w; }
    }
};
struct EpiDN {
    static constexpr bool PERM = true; unsigned char* O; const float* bias;
    __device__ __forceinline__ void operator()(const AccT& acc, const pg::Unit& u, int wr, int wc, int fr, int fq) const {
        const int row0 = u.pm * 256 + wr * 64 + fr, col0 = u.pn * 256 + wc * 32 + 8 * fq;
        const float* bp = bias + (size_t)u.e * DM + col0;
        f32x4 bv[2][2];
#pragma unroll
        for (int bj = 0; bj < 2; ++bj) { bv[bj][0] = *(const f32x4*)(bp + bj * 128); bv[bj][1] = *(const f32x4*)(bp + bj * 128 + 4); }
#pragma unroll
        for (int ai = 0; ai < 2; ++ai)
#pragma unroll
            for (int m = 0; m < 4; ++m) { unsigned char* rowp = O + (size_t)(row0 + ai * 128 + m * 16) * DM + col0;
#pragma unroll
                for (int bj = 0; bj < 2; ++bj) { const f32x4 v0 = acc[ai][bj][m][0] * (1.0f / W8) + bv[bj][0], v1 = acc[ai][bj][m][1] * (1.0f / W8) + bv[bj][1];
                    u32x2 w; w.x = pk4_fp8(v0[0], v0[1], v0[2], v0[3]); w.y = pk4_fp8(v1[0], v1[1], v1[2], v1[3]); *(u32x2*)(rowp + bj * 128) = w; } }
    }
};

constexpr int NWAVES = 8;
enum { IN_X = 0, IN_C, IN_POS, IN_ADAW, IN_ADAB, IN_N1G, IN_WIN, IN_QNG, IN_WQB, IN_KVNG, IN_WKVB, IN_MLAOG, IN_CONVW, IN_ALOG, IN_DTB, IN_GDNG, IN_WOUT, IN_N2G, IN_RW, IN_RB, IN_WGU, IN_BGU, IN_WDN, IN_BDN, IN_FG, N_IN };
struct Frame {
    LAS unsigned char* lds; volatile LAS unsigned* MISC; unsigned* ctl; unsigned char* ws;
    int tid, lane, wave, G, vcu;
    const float* in[N_IN]; float* out;
};
#define WSP(T_, off) ((T_*)(F.ws + (off)))

__device__ __forceinline__ void p0_mod(Frame& F) {
    LAS float* cact = (LAS float*)F.lds;
    LAS float* red = (LAS float*)(F.lds + 32768);
    if ((int)blockIdx.x >= 96) return;
    const float* c = F.in[IN_C];
    for (int i = F.tid; i < BATCH * DM; i += NWAVES * 64) cact[i] = siluf(c[i]);
    __syncthreads();
    float* mod = WSP(float, WS_MOD);
    for (int it = blockIdx.x; it < 96; it += F.G) {
        const int j = it * 64 + F.lane; float a[8];
#pragma unroll
        for (int b = 0; b < 8; ++b) a[b] = 0.f;
        const float* w = F.in[IN_ADAW] + j;
#pragma unroll 4
        for (int k = F.wave * 128; k < F.wave * 128 + 128; ++k) { const float wv = w[(size_t)k * 6144];
#pragma unroll
            for (int b = 0; b < 8; ++b) a[b] += cact[b * DM + k] * wv; }
#pragma unroll
        for (int b = 0; b < 8; ++b) red[(F.wave * 8 + b) * 64 + F.lane] = a[b];
        __syncthreads();
        { const int b = F.tid >> 6, col = F.tid & 63; float s = 0.f;
#pragma unroll
          for (int w8 = 0; w8 < 8; ++w8) s += red[(w8 * 8 + b) * 64 + col];
          mod[b * 6144 + it * 64 + col] = s + F.in[IN_ADAB][it * 64 + col]; }
        __syncthreads();
    }
}
template <int MAP, bool FP8 = false>
__device__ __forceinline__ void p0_tr_item(const float* W, int K, int N, int NP, void* WTv, const float* ksc, LAS float* scr, int item, int lane) {
    bf16_t* WT = (bf16_t*)WTv;
    const int nblk = NP / 32, kb = item / nblk, nb = item % nblk, k0 = 64 * kb, n0 = 32 * nb;
    f32x4 ld[8];
#pragma unroll
    for (int j = 0; j < 8; ++j) { const int idx = j * 64 + lane, kk = idx >> 3, nn = n0 + 4 * (idx & 7); ld[j] = (nn < N) ? *(const f32x4*)(W + (size_t)(k0 + kk) * N + nn) : (f32x4){0.f, 0.f, 0.f, 0.f}; }
#pragma unroll
    for (int j = 0; j < 8; ++j) { const int idx = j * 64 + lane, kk = idx >> 3, c4 = idx & 7; f32x4 v = ld[j]; if (ksc) v = v * ksc[k0 + kk];
        LAS float* d = scr + kk * 33 + 4 * c4; d[0] = v[0]; d[1] = v[1]; d[2] = v[2]; d[3] = v[3]; }
    LDS_WAIT(); asm volatile("" ::: "memory");
    const int c = lane & 7;
#pragma unroll
    for (int j = 0; j < 4; ++j) { const int n = (lane >> 3) + 8 * j; const LAS float* s = scr + (8 * c) * 33 + n;
        u32x4 o; o.x = cvtpk(s[0 * 33], s[1 * 33]); o.y = cvtpk(s[2 * 33], s[3 * 33]); o.z = cvtpk(s[4 * 33], s[5 * 33]); o.w = cvtpk(s[6 * 33], s[7 * 33]);
        int dn = n0 + n;
        if (MAP == 1) { const int half = dn >> 10, r = dn & 1023; dn = ((r >> 7) << 8) + (half << 7) + (r & 127); }
        if constexpr (FP8) { u32x2 o8; o8.x = pk4_fp8(s[0 * 33] * W8, s[1 * 33] * W8, s[2 * 33] * W8, s[3 * 33] * W8); o8.y = pk4_fp8(s[4 * 33] * W8, s[5 * 33] * W8, s[6 * 33] * W8, s[7 * 33] * W8);
            *(GAS u32x2*)((unsigned char*)WTv + (size_t)dn * K + k0 + 8 * c) = o8; }
        else *(GAS u32x4*)(WT + (size_t)dn * K + k0 + 8 * c) = o; }
    LDS_WAIT(); asm volatile("" ::: "memory");
}
__device__ __forceinline__ void p0_weights(Frame& F) {
    LAS float* scr = (LAS float*)(F.lds + 49152 + F.wave * 8704);
    const int gw = F.vcu * NWAVES + F.wave, NGW = F.G * NWAVES;
    constexpr int I_IN = (DM / 64) * (NPROJ / 32), I_Q = (QLORA / 64) * (768 / 32), I_KV = (KVLORA / 64) * (1024 / 32), I_O = (DM / 64) * (DM / 32);
    constexpr int I_GU = (DM / 64) * (2048 / 32), I_DN = (DE / 64) * (DM / 32);
    constexpr int P_GU = I_GU / 2, P_DN = I_DN / 2;
    constexpr int NITEMS = I_IN + I_Q + I_KV + I_O;
    for (int it = gw; it < NITEMS; it += NGW) {
        int r = it;
        if (r < I_IN) { p0_tr_item<0>(F.in[IN_WIN], DM, IN_DIM, NPROJ, WSP(bf16_t, WS_WIN), nullptr, scr, r, F.lane); continue; } r -= I_IN;
        if (r < I_Q) { p0_tr_item<0>(F.in[IN_WQB], QLORA, 768, 768, WSP(bf16_t, WS_WQ), F.in[IN_QNG], scr, r, F.lane); continue; } r -= I_Q;
        if (r < I_KV) { p0_tr_item<0>(F.in[IN_WKVB], KVLORA, 1024, 1024, WSP(bf16_t, WS_WKV), F.in[IN_KVNG], scr, r, F.lane); continue; } r -= I_KV;
        if (r < I_O) { p0_tr_item<0>(F.in[IN_WOUT], DM, DM, DM, WSP(bf16_t, WS_WO), nullptr, scr, r, F.lane); continue; } r -= I_O;
        (void)scr;
    }
    float* rwt = WSP(float, WS_RWT);
    for (int i = (int)blockIdx.x * NWAVES * 64 + F.tid; i < NE * DM; i += F.G * NWAVES * 64) { const int e = i >> 10, k = i & 1023; rwt[i] = F.in[IN_RW][k * NE + e]; }
}

template <int MAP>
__device__ __forceinline__ void p0_tr_pair8(const float* W, int K, int N, unsigned char* WT8, LAS float* scr, int kp, int nb, int lane) {
    const int k0 = 128 * kp, n0 = 32 * nb;
    f32x4 ld[16];
#pragma unroll
    for (int j = 0; j < 16; ++j) { const int idx = j * 64 + lane, kk = idx >> 3, nn = n0 + 4 * (idx & 7); ld[j] = *(const f32x4*)(W + (size_t)(k0 + kk) * N + nn); }
#pragma unroll
    for (int hk = 0; hk < 2; ++hk) {
#pragma unroll
        for (int j = 0; j < 8; ++j) { const int idx = j * 64 + lane, kk = idx >> 3, c4 = idx & 7; const f32x4 v = ld[hk * 8 + j];
            LAS float* d = scr + kk * 33 + 4 * c4; d[0] = v[0]; d[1] = v[1]; d[2] = v[2]; d[3] = v[3]; }
        LDS_WAIT(); asm volatile("" ::: "memory");
        const int c = lane & 7;
#pragma unroll
        for (int j = 0; j < 4; ++j) { const int n = (lane >> 3) + 8 * j; const LAS float* s = scr + (8 * c) * 33 + n;
            int dn = n0 + n;
            if (MAP == 1) { const int half = dn >> 10, r = dn & 1023; dn = ((r >> 7) << 8) + (half << 7) + (r & 127); }
            u32x2 o8; o8.x = pk4_fp8(s[0 * 33] * W8, s[1 * 33] * W8, s[2 * 33] * W8, s[3 * 33] * W8); o8.y = pk4_fp8(s[4 * 33] * W8, s[5 * 33] * W8, s[6 * 33] * W8, s[7 * 33] * W8);
            *(GAS u32x2*)(WT8 + (size_t)dn * K + k0 + 64 * hk + 8 * c) = o8; }
        LDS_WAIT(); asm volatile("" ::: "memory");
    }
}
constexpr int MOE_CONV_ITEMS = (NE * (DM / 64) * (2048 / 32) / 2 + NE * (DE / 64) * (DM / 32) / 2) / 64;
__device__ __forceinline__ void moe_conv_item(Frame& F, int item) {
    LAS float* scr = (LAS float*)(F.lds + F.wave * 8704);
    constexpr int P_GU = (DM / 64) * (2048 / 32) / 2, P_DN = (DE / 64) * (DM / 32) / 2;
#pragma unroll 1
    for (int j = 0; j < 8; ++j) {
        int r = item * 64 + j * 8 + F.wave;
        if (r < NE * P_GU) { const int e = r / P_GU, p = r - e * P_GU, nb = p % 64, kp = p / 64;
            p0_tr_pair8<1>(F.in[IN_WGU] + (size_t)e * DM * 2048, DM, 2048, WSP(unsigned char, WS_WGU) + (size_t)e * 2048 * DM, scr, kp, nb, F.lane);
        } else { r -= NE * P_GU; const int e = r / P_DN, p = r - e * P_DN, nb = p % 32, kp = p / 32;
            p0_tr_pair8<0>(F.in[IN_WDN] + (size_t)e * DE * DM, DE, DM, WSP(unsigned char, WS_WDN) + (size_t)e * DM * DE, scr, kp, nb, F.lane); }
    }
}

__device__ const float ROPE_INVF[16] = {1.0f, 0.5623413251903491f, 0.31622776601683794f, 0.1778279410038923f, 0.1f, 0.05623413251903491f, 0.03162277660168379f, 0.01778279410038923f,
    0.01f, 0.005623413251903491f, 0.003162277660168379f, 0.0017782794100389228f, 0.001f, 0.0005623413251903491f, 0.00031622776601683794f, 0.00017782794100389227f};
__device__ __forceinline__ void norm_rows(Frame& F, const float* x, const float* gain, int SH, int SC, bf16_t* outp) {
    const int gw = F.vcu * NWAVES + F.wave, NGW = F.G * NWAVES;
    const float* mod = WSP(float, WS_MOD);
    constexpr int R = 4;
    for (int m0 = gw; m0 < T; m0 += R * NGW) {
        f32x4 v[R][4]; float s[R];
#pragma unroll
        for (int r = 0; r < R; ++r) { const int m = m0 + r * NGW; s[r] = 0.f; if (m < T) { const f32x4* xr = (const f32x4*)(x + (size_t)m * DM) + F.lane;
#pragma unroll
            for (int j = 0; j < 4; ++j) v[r][j] = xr[64 * j]; } else {
#pragma unroll
            for (int j = 0; j < 4; ++j) v[r][j] = (f32x4){0.f, 0.f, 0.f, 0.f}; } }
#pragma unroll
        for (int r = 0; r < R; ++r)
#pragma unroll
            for (int j = 0; j < 4; ++j) s[r] += (v[r][j][0] * v[r][j][0] + v[r][j][1] * v[r][j][1]) + (v[r][j][2] * v[r][j][2] + v[r][j][3] * v[r][j][3]);
#pragma unroll
        for (int o = 1; o < 64; o <<= 1)
#pragma unroll
            for (int r = 0; r < R; ++r) s[r] += __shfl_xor(s[r], o);
#pragma unroll
        for (int r = 0; r < R; ++r) { const int m = m0 + r * NGW; if (m >= T) continue;
            {
              const float ang = (float)((const int*)F.in[IN_POS])[m] * ROPE_INVF[F.lane & 15];
              const double rev = (double)ang * 0.15915494309189535; const float fr_ = (float)(rev - __builtin_rint(rev));
              if (F.lane < 16) { float* cs = WSP(float, WS_CS) + (size_t)m * 32; cs[F.lane] = __builtin_amdgcn_cosf(fr_); cs[16 + F.lane] = __builtin_amdgcn_sinf(fr_); } }
            const float rstd = __builtin_amdgcn_rsqf(s[r] * (1.f / DM) + EPS); const float* mb = mod + (size_t)(m / SEQ) * 6144;
            u32x2* o8 = (u32x2*)(outp + (size_t)m * DM) + F.lane;
#pragma unroll
            for (int j = 0; j < 4; ++j) { const int col = 4 * (F.lane + 64 * j);
                const f32x4 g = *(const f32x4*)(gain + col), sc = *(const f32x4*)(mb + SC + col), sh = *(const f32x4*)(mb + SH + col);
                const f32x4 h = v[r][j] * rstd * g * (sc + 1.0f) + sh; u32x2 w; w.x = cvtpk(h[0], h[1]); w.y = cvtpk(h[2], h[3]); o8[64 * j] = w; } }
    }
}

__device__ __forceinline__ void p3a_rows(Frame& F) {
    const int gw = F.vcu * NWAVES + F.wave, NGW = F.G * NWAVES, lane = F.lane;
    const bf16_t* proj = WSP(bf16_t, WS_PROJ); float* rsq = WSP(float, WS_RSQ); float* rskv = WSP(float, WS_RSKV); float* cs = WSP(float, WS_CS); bf16_t* Kb = WSP(bf16_t, WS_K);
    const int* pos = (const int*)F.in[IN_POS];
    constexpr int R = 4;
    for (int m0 = gw; m0 < T; m0 += R * NGW) {
        u32x4 a[R], b[R]; int ps[R];
#pragma unroll
        for (int r = 0; r < R; ++r) { const int m = (m0 + r * NGW < T) ? m0 + r * NGW : m0; const u32x4* pr = (const u32x4*)(proj + (size_t)m * NPROJ);
            a[r] = pr[lane]; b[r] = (u32x4){0u, 0u, 0u, 0u}; if (lane < 20) b[r] = pr[64 + lane]; ps[r] = pos[m]; }
#pragma unroll
        for (int r = 0; r < R; ++r) { const int m = m0 + r * NGW; if (m >= T) continue;
            const float sa = ssq8(a[r]), sb = ssq8(b[r]);
            const float sq = wave_sum(lane < 48 ? sa : 0.f), skv = wave_sum((lane >= 48 ? sa : 0.f) + (lane < 16 ? sb : 0.f));
            if (lane == 0) { rsq[m] = __builtin_amdgcn_rsqf(sq * (1.f / QLORA) + EPS); rskv[m] = __builtin_amdgcn_rsqf(skv * (1.f / KVLORA) + EPS); }
            const float ang = (float)ps[r] * ROPE_INVF[lane & 15];
            const double rev = (double)ang * 0.15915494309189535; const float fr = (float)(rev - __builtin_rint(rev));
            const float cv = __builtin_amdgcn_cosf(fr), sv = __builtin_amdgcn_sinf(fr);
            if (lane < 16) { cs[(size_t)m * 32 + lane] = cv; cs[(size_t)m * 32 + 16 + lane] = sv; }
            float xv[8], pv[8], cc[8], ss[8];
#pragma unroll
            for (int i = 0; i < 4; ++i) { xv[2 * i] = bflo(b[r][i]); xv[2 * i + 1] = bfhi(b[r][i]); }
            const int i0 = 8 * (lane & 1);
#pragma unroll
            for (int j = 0; j < 8; ++j) { pv[j] = __shfl_xor(xv[j], 2); cc[j] = __shfl(cv, i0 + j); ss[j] = __shfl(sv, i0 + j); }
            if (lane >= 16 && lane < 20) {
                float o[8];
#pragma unroll
                for (int j = 0; j < 8; ++j) o[j] = (lane < 18) ? xv[j] * cc[j] - pv[j] * ss[j] : xv[j] * cc[j] + pv[j] * ss[j];
                u32x4 w; w.x = cvtpk(o[0], o[1]); w.y = cvtpk(o[2], o[3]); w.z = cvtpk(o[4], o[5]); w.w = cvtpk(o[6], o[7]);
#pragma unroll
                for (int h = 0; h < NH; ++h) *(u32x4*)(Kb + (size_t)m * 768 + h * 96 + 64 + 8 * (lane - 16)) = w;
            } }
    }
}

__device__ __forceinline__ int crow(int r, int hi) { return (r & 3) + 8 * (r >> 2) + 4 * hi; }
__device__ __forceinline__ float max3f(float a, float b, float c) { float r; asm("v_max3_f32 %0, %1, %2, %3" : "=v"(r) : "v"(a), "v"(b), "v"(c)); return r; }
typedef short v4i16_t __attribute__((ext_vector_type(4)));
constexpr int AT_KROW = 208, AT_VROW = 144, AT_KBUF = 64 * AT_KROW, AT_VBUF = 64 * AT_VROW, AT_V0 = 2 * AT_KBUF, AT_WS = AT_V0 + 2 * AT_VBUF;
__device__ __forceinline__ void attn_unit(Frame& F, int b, int h, int qb) {
    const int tid = F.tid, lane = F.lane, wid = F.wave, r32 = lane & 31, hi = lane >> 5;
    const bf16_t* Qg = WSP(bf16_t, WS_Q); const bf16_t* Kg = WSP(bf16_t, WS_K); const bf16_t* Vg = WSP(bf16_t, WS_V); bf16_t* Og = WSP(bf16_t, WS_OA);
    LAS unsigned char* Kl = F.lds; LAS unsigned char* Vl = F.lds + AT_V0; LAS float* wsf = (LAS float*)(F.lds + AT_WS) + wid * 64;
    const size_t tb = (size_t)b * SEQ; const int q0 = qb * 256, NT = 4 * qb + 4;
    bf16x8 qr[6];
    { const bf16_t* Qp = Qg + (tb + q0 + wid * 32 + r32) * 768 + h * 96 + hi * 8;
#pragma unroll
      for (int d0 = 0; d0 < 6; ++d0) qr[d0] = *(const bf16x8*)(Qp + d0 * 16); }
    unsigned kvo[2], vvo[2];
#pragma unroll
    for (int i = 0; i < 2; ++i) { const int ok = (wid + 8 * i) * 1024 + 16 * lane, kr = ok / AT_KROW, kc = (ok % AT_KROW) >> 4; kvo[i] = (unsigned)((kr < 64 ? kr : 63) * 1536 + (kc < 12 ? kc : 0) * 16);
        const int ov = (wid + 8 * i) * 1024 + 16 * lane, vr = ov / AT_VROW, vc = (ov % AT_VROW) >> 4; vvo[i] = (unsigned)((vr < 64 ? vr : 63) * 1024 + (vc < 8 ? vc : 0) * 16); }
    const unsigned kl0 = (unsigned)__builtin_amdgcn_readfirstlane((int)((unsigned)(uintptr_t)Kl + (unsigned)wid * 1024u)), vl0 = (unsigned)__builtin_amdgcn_readfirstlane((int)((unsigned)(uintptr_t)Vl + (unsigned)wid * 1024u));
    const char* kg0 = (const char*)(Kg + tb * 768 + h * 96); const char* vg0 = (const char*)(Vg + tb * 512 + h * 64);
#define AT_DMAK(t, bf) do { pg::glds16s(kg0 + (size_t)(t) * 64 * 1536, kvo[0], kl0 + (unsigned)((bf) * AT_KBUF)); if (wid < 5) pg::glds16s(kg0 + (size_t)(t) * 64 * 1536, kvo[1], kl0 + (unsigned)((bf) * AT_KBUF + 8192)); } while (0)
#define AT_DMAV(t, bf) do { pg::glds16s(vg0 + (size_t)(t) * 64 * 1024, vvo[0], vl0 + (unsigned)((bf) * AT_VBUF)); if (wid == 0) pg::glds16s(vg0 + (size_t)(t) * 64 * 1024, vvo[1], vl0 + (unsigned)((bf) * AT_VBUF + 8192)); } while (0)
#define AT_QK(P0, P1, bf) do { _Pragma("unroll") for (int r = 0; r < 16; ++r) { P0[r] = 0.f; P1[r] = 0.f; } \
        const LAS unsigned char* kb_ = Kl + (bf) * AT_KBUF + r32 * AT_KROW + hi * 16; \
        _Pragma("unroll") for (int d0 = 0; d0 < 6; ++d0) { const bf16x8 k0 = *(const LAS bf16x8*)(kb_ + d0 * 32), k1 = *(const LAS bf16x8*)(kb_ + 32 * AT_KROW + d0 * 32); \
            P0 = __builtin_amdgcn_mfma_f32_32x32x16_bf16(k0, qr[d0], P0, 0, 0, 0); P1 = __builtin_amdgcn_mfma_f32_32x32x16_bf16(k1, qr[d0], P1, 0, 0, 0); } } while (0)
#define AT_SPV(P0, P1, t, bf) do { \
        if ((t) >= NT - 4) { _Pragma("unroll") for (int r = 0; r < 16; ++r) { const int kv = 64 * (t) + crow(r, hi); if (kv > qpos) P0[r] = -INFINITY; if (kv + 32 > qpos) P1[r] = -INFINITY; } } \
        float mx; { float a_ = max3f(P0[0], P0[1], P1[0]), b_ = max3f(P0[2], P0[3], P1[1]); a_ = max3f(a_, P1[2], P1[3]); \
            _Pragma("unroll") for (int r = 4; r < 16; r += 4) { a_ = max3f(a_, P0[r], P0[r + 1]); b_ = max3f(b_, P0[r + 2], P0[r + 3]); a_ = max3f(a_, P1[r], P1[r + 1]); b_ = max3f(b_, P1[r + 2], P1[r + 3]); } \
            mx = max3f(a_, b_, b_); mx = max3f(mx, __shfl_xor(mx, 32), mx); }        \
        const float m_new = fmaxf(m_run, mx); \
        if (__any(m_new > m_run)) { const float f = __builtin_amdgcn_exp2f(m_run - m_new); l_run *= f; m_run = m_new; \
            if (hi == 0) wsf[r32] = f; float fr_[16]; \
            _Pragma("unroll") for (int r = 0; r < 16; ++r) fr_[r] = wsf[crow(r, hi)]; \
            _Pragma("unroll") for (int r = 0; r < 16; ++r) { o[0][r] *= fr_[r]; o[1][r] *= fr_[r]; } } \
        float rs = 0.f; \
        _Pragma("unroll") for (int r = 0; r < 16; ++r) { P0[r] = __builtin_amdgcn_exp2f(P0[r] - m_run); P1[r] = __builtin_amdgcn_exp2f(P1[r] - m_run); rs += P0[r] + P1[r]; } \
        l_run += rs; bf16x8 pa[4]; \
        _Pragma("unroll") for (int ks = 0; ks < 4; ++ks) { u32x4 w_; \
            _Pragma("unroll") for (int i = 0; i < 4; ++i) { const int r = (ks & 1) * 8 + 2 * i; w_[i] = (ks < 2) ? cvtpk(P0[r], P0[r + 1]) : cvtpk(P1[r], P1[r + 1]); } \
            pa[ks] = __builtin_bit_cast(bf16x8, w_); } \
        const LAS unsigned char* vb_ = Vl + (bf) * AT_VBUF + (4 * hi + ((lane & 15) >> 2)) * AT_VROW + (((lane >> 4) & 1) * 16 + (lane & 3) * 4) * 2; \
        _Pragma("unroll") for (int d0 = 0; d0 < 2; ++d0) _Pragma("unroll") for (int ks = 0; ks < 4; ++ks) { \
            const v4i16_t lo = __builtin_amdgcn_ds_read_tr16_b64_v4i16((LAS v4i16_t*)(vb_ + ks * 16 * AT_VROW + d0 * 64)); \
            const v4i16_t hv = __builtin_amdgcn_ds_read_tr16_b64_v4i16((LAS v4i16_t*)(vb_ + ks * 16 * AT_VROW + 8 * AT_VROW + d0 * 64)); \
            const bf16x8 vf = (bf16x8){lo[0], lo[1], lo[2], lo[3], hv[0], hv[1], hv[2], hv[3]}; \
            o[d0] = __builtin_amdgcn_mfma_f32_32x32x16_bf16(pa[ks], vf, o[d0], 0, 0, 0); } } while (0)
#define AT_STEP(C0, C1, N0, N1, t) do { \
        if ((t) + 2 < NT) AT_DMAK((t) + 2, (t) & 1); if ((t) + 1 < NT) AT_DMAV((t) + 1, ((t) + 1) & 1); \
        if ((t) + 1 < NT && 64 * ((t) + 1) <= qmax) AT_QK(N0, N1, ((t) + 1) & 1); \
        if (64 * (t) <= qmax) AT_SPV(C0, C1, t, (t) & 1); \
        VM_WAIT(); __syncthreads(); } while (0)
    AT_DMAK(0, 0); AT_DMAV(0, 0); AT_DMAK(1, 1); VM_WAIT(); __syncthreads();
    float m_run = -INFINITY, l_run = 0.f; f32x16 o[2];
#pragma unroll
    for (int r = 0; r < 16; ++r) { o[0][r] = 0.f; o[1][r] = 0.f; }
    const int qmax = q0 + wid * 32 + 31, qpos = q0 + wid * 32 + r32;
    f32x16 sA0, sA1, sB0, sB1;
    AT_QK(sA0, sA1, 0);
    asm volatile("s_nop 15\n\ts_nop 15" : "+v"(sA0), "+v"(sA1));
    LBAR();
    for (int t = 0; t < NT; t += 2) {
        AT_STEP(sA0, sA1, sB0, sB1, t);
        AT_STEP(sB0, sB1, sA0, sA1, t + 1);
    }
    { float lt = l_run + __shfl_xor(l_run, 32);
      if (hi == 0) wsf[32 + r32] = lt;
      bf16_t* Ow = Og + (tb + q0 + wid * 32) * 512 + h * 64 + r32;
#pragma unroll
      for (int r = 0; r < 16; ++r) { const int qr_ = crow(r, hi); const float inv = 1.0f / wsf[32 + qr_];
          Ow[(size_t)qr_ * 512] = f2bf(o[0][r] * inv); Ow[(size_t)qr_ * 512 + 32] = f2bf(o[1][r] * inv); } }
#undef AT_DMAK
#undef AT_DMAV
#undef AT_QK
#undef AT_SPV
#undef AT_STEP
}

__device__ __forceinline__ void p4b_rows(Frame& F) {
    const int gw = F.vcu * NWAVES + F.wave, NGW = F.G * NWAVES, lane = F.lane;
    const bf16_t* oa = WSP(bf16_t, WS_OA); const bf16_t* og = WSP(bf16_t, WS_OG); const bf16_t* proj = WSP(bf16_t, WS_PROJ); bf16_t* mx = WSP(bf16_t, WS_H);
    const float* ga = F.in[IN_MLAOG] + 8 * lane; const float* gg = F.in[IN_GDNG] + 8 * (lane & 7);
    constexpr int R = 4;
    for (int m0 = gw; m0 < T; m0 += R * NGW) {
        u32x4 a[R], g[R], z[R];
#pragma unroll
        for (int r = 0; r < R; ++r) { const int m = (m0 + r * NGW < T) ? m0 + r * NGW : m0;
            a[r] = *(const u32x4*)(oa + (size_t)m * 512 + 8 * lane); g[r] = *(const u32x4*)(og + (size_t)m * 512 + 8 * lane); z[r] = *(const u32x4*)(proj + (size_t)m * NPROJ + C_GZ + 8 * lane); }
#pragma unroll
        for (int r = 0; r < R; ++r) { const int m = m0 + r * NGW; if (m >= T) continue;
            const float ra = __builtin_amdgcn_rsqf(wave_sum(ssq8(a[r])) * (1.f / 512) + EPS);
            float sg = ssq8(g[r]); sg += __shfl_xor(sg, 1); sg += __shfl_xor(sg, 2); sg += __shfl_xor(sg, 4);
            const float rg = __builtin_amdgcn_rsqf(sg * (1.f / 64) + EPS);
            float oa8[8], og8[8];
#pragma unroll
            for (int i = 0; i < 4; ++i) { oa8[2 * i] = bflo(a[r][i]) * ra * ga[2 * i]; oa8[2 * i + 1] = bfhi(a[r][i]) * ra * ga[2 * i + 1];
                og8[2 * i] = bflo(g[r][i]) * rg * gg[2 * i] * siluf(bflo(z[r][i])); og8[2 * i + 1] = bfhi(g[r][i]) * rg * gg[2 * i + 1] * siluf(bfhi(z[r][i])); }
            u32x4 wa, wg;
#pragma unroll
            for (int i = 0; i < 4; ++i) { wa[i] = cvtpk(oa8[2 * i], oa8[2 * i + 1]); wg[i] = cvtpk(og8[2 * i], og8[2 * i + 1]); }
            *(u32x4*)(mx + (size_t)m * DM + 8 * lane) = wa; *(u32x4*)(mx + (size_t)m * DM + 512 + 8 * lane) = wg; }
    }
}

constexpr int G1_KRM = 0, G1_QRM = 4608, G1_AM = 9216, G1_QK = 13440, G1_UT = 16000, G1_WT = 21120, G1_KT = 26240, G1_GT = 31360, G1_SLOT = 32000, G1_CW = 4 * G1_SLOT;
static_assert(G1_CW + 3072 <= RING_BYTES, "G1 LDS");
__device__ __forceinline__ f32x4 mfma16(bf16x8 a, bf16x8 b, f32x4 c) { return __builtin_amdgcn_mfma_f32_16x16x32_bf16(a, b, c, 0, 0, 0); }

__device__ __forceinline__ float silu_fast(float x) { return x * __builtin_amdgcn_rcpf(1.0f + __expf(-x)); }
#ifndef G1PROBE
#define G1PROBE (-1)
#endif
#define G1T(k) do { if (G1PROBE >= 0) { const unsigned long long n_ = __builtin_amdgcn_s_memrealtime(); if (G1PROBE == (k)) g1acc += n_ - g1t; g1t = n_; } } while (0)
__device__ __forceinline__ void g1_unit(Frame& F, int unit, unsigned long long& g1acc) {
    unsigned long long g1t = (G1PROBE >= 0) ? __builtin_amdgcn_s_memrealtime() : 0ull;
    const int tid = F.tid, lane = F.lane, wid = F.wave;
    const int bh = unit >> 5, c0 = (unit & 31) * 4, b = bh >> 3, h = bh & 7;
    const bf16_t* proj = WSP(bf16_t, WS_PROJ);
    LAS unsigned char* L = F.lds; LAS float* cw = (LAS float*)(L + G1_CW);
    const size_t tb = (size_t)b * SEQ;
    for (int i = tid; i < 768; i += NWAVES * 64) { const int x = i >> 8, w = (i >> 6) & 3, ch = i & 63; cw[i] = F.in[IN_CONVW][w * 1536 + x * 512 + h * 64 + ch]; }
    LBAR(); G1T(0);
    { const int tk = tid >> 2, part = tid & 3, s = tk >> 5, i = tk & 31, isk = part >> 1, chb = (part & 1) * 32;
      const int sp = (c0 + s) * GC + i;
      const bf16_t* src = proj + (tb + sp) * NPROJ + (isk ? C_GK : C_GQ) + h * 64 + chb;
      float ain = 0.f, bin = 0.f;
      if (part == 0) { ain = bf2f(proj[(tb + sp) * NPROJ + C_GA + h]); bin = bf2f(proj[(tb + sp) * NPROJ + C_GB + h]); }
      float v[32];
#pragma unroll
      for (int c = 0; c < 32; ++c) v[c] = 0.f;
#pragma unroll
      for (int w = 0; w < 4; ++w) { if (sp - 3 + w >= 0) { const bf16_t* rp = src - (ptrdiff_t)(3 - w) * NPROJ;
#pragma unroll
          for (int q4 = 0; q4 < 4; ++q4) { const u32x4 d = *(const u32x4*)(rp + 8 * q4); const LAS f32x4* wp = (const LAS f32x4*)(cw + (isk * 4 + w) * 64 + chb + 8 * q4); const f32x4 w0 = wp[0], w1 = wp[1];
              v[8 * q4 + 0] += bflo(d[0]) * w0[0]; v[8 * q4 + 1] += bfhi(d[0]) * w0[1]; v[8 * q4 + 2] += bflo(d[1]) * w0[2]; v[8 * q4 + 3] += bfhi(d[1]) * w0[3];
              v[8 * q4 + 4] += bflo(d[2]) * w1[0]; v[8 * q4 + 5] += bfhi(d[2]) * w1[1]; v[8 * q4 + 6] += bflo(d[3]) * w1[2]; v[8 * q4 + 7] += bfhi(d[3]) * w1[3]; } } }
      float ss = 0.f;
#pragma unroll
      for (int c = 0; c < 32; ++c) { v[c] = silu_fast(v[c]); ss += v[c] * v[c]; }
      ss += __shfl_xor(ss, 1);
      const float rn = __builtin_amdgcn_rsqf(ss + EPS) * (isk ? 1.0f : 0.125f);
      LAS bf16_t* dst = (LAS bf16_t*)(L + s * G1_SLOT + (isk ? G1_KRM : G1_QRM)) + i * 72 + chb;
#pragma unroll
      for (int q4 = 0; q4 < 4; ++q4) { u32x4 w;
#pragma unroll
          for (int e = 0; e < 4; ++e) w[e] = cvtpk(v[8 * q4 + 2 * e] * rn, v[8 * q4 + 2 * e + 1] * rn);
          *(LAS u32x4*)(dst + 8 * q4) = w; }
      if (part == 0) { LAS float* gt = (LAS float*)(L + s * G1_SLOT + G1_GT);
          const float xs = ain + F.in[IN_DTB][h], sp_ = xs > 20.f ? xs : __logf(1.0f + __expf(xs));
          gt[i] = 1.0f / (1.0f + __expf(-bin));
          gt[32 + i] = -__expf(F.in[IN_ALOG][h]) * sp_; }
    }
    LBAR(); G1T(1);
    if (wid < 2) { LAS float* gt = (LAS float*)(L + (2 * wid + (lane >> 5)) * G1_SLOT + G1_GT); const int i = lane & 31; float c = gt[32 + i];
#pragma unroll
        for (int o = 1; o < 32; o <<= 1) { const float t = __shfl_up(c, o, 32); if (i >= o) c += t; }
        const float last = __shfl(c, 31, 32);
        gt[64 + i] = c; gt[96 + i] = __expf(c); gt[128 + i] = __expf(last - c); }
    LBAR(); G1T(2);
    const int s = wid >> 1, sub = wid & 1, l15 = lane & 15, kq = lane >> 4;
    LAS unsigned char* Ls = L + s * G1_SLOT; LAS float* gt = (LAS float*)(Ls + G1_GT);
    unsigned short vraw[35];
    if (sub == 0) { const int sp0 = (c0 + s) * GC; const bf16_t* src = proj + (tb + sp0) * NPROJ + C_GV + h * 64 + lane;
#pragma unroll
        for (int i = 0; i < 35; ++i) vraw[i] = (sp0 + i - 3 >= 0) ? src[((ptrdiff_t)i - 3) * NPROJ] : (unsigned short)0; }
    else {
#pragma unroll
        for (int i = 0; i < 35; ++i) vraw[i] = 0; }
    { const LAS bf16_t* X = (const LAS bf16_t*)(Ls + (sub ? G1_QRM : G1_KRM)); const LAS bf16_t* Kr = (const LAS bf16_t*)(Ls + G1_KRM);
#pragma unroll
      for (int it = 0; it < 2; ++it)
#pragma unroll
          for (int jt = 0; jt < 2; ++jt) { f32x4 acc = (f32x4){0.f, 0.f, 0.f, 0.f};
#pragma unroll
              for (int ks = 0; ks < 2; ++ks) acc = mfma16(*(const LAS bf16x8*)(X + (16 * it + l15) * 72 + 32 * ks + 8 * kq), *(const LAS bf16x8*)(Kr + (16 * jt + l15) * 72 + 32 * ks + 8 * kq), acc);
              const int j = 16 * jt + l15; const float gj = gt[64 + j];
#pragma unroll
              for (int r = 0; r < 4; ++r) { const int i = 16 * it + 4 * kq + r; const float gi = gt[64 + i];
                  if (sub == 0) { const float val = (i > j) ? acc[r] * gt[i] * __expf(gi - gj) : 0.f; ((LAS float*)(Ls + G1_AM))[i * 33 + j] = val; }
                  else { const float val = (i >= j) ? acc[r] * __expf(gi - gj) : 0.f; ((LAS bf16_t*)(Ls + G1_QK))[i * 40 + j] = f2bf(val); } } }
    }
    for (int idx = tid; idx < 4 * 64 * 32; idx += NWAVES * 64) { const int s2 = idx >> 11, d = (idx >> 5) & 63, c = idx & 31; LAS unsigned char* L2 = L + s2 * G1_SLOT;
        ((LAS bf16_t*)(L2 + G1_KT))[d * 40 + c] = f2bf(bf2f(((const LAS bf16_t*)(L2 + G1_KRM))[c * 72 + d]) * ((const LAS float*)(L2 + G1_GT))[128 + c]); }
    LBAR(); G1T(3);
    { float sol[32];
      if (sub == 0) {
          const float w0 = cw[(8 + 0) * 64 + lane], w1 = cw[(8 + 1) * 64 + lane], w2 = cw[(8 + 2) * 64 + lane], w3 = cw[(8 + 3) * 64 + lane];
#pragma unroll
          for (int i = 0; i < 32; ++i) sol[i] = silu_fast(w0 * bf2f(vraw[i]) + w1 * bf2f(vraw[i + 1]) + w2 * bf2f(vraw[i + 2]) + w3 * bf2f(vraw[i + 3])) * gt[i];
      } else {
          const LAS bf16_t* Kr = (const LAS bf16_t*)(Ls + G1_KRM);
#pragma unroll
          for (int i = 0; i < 32; ++i) sol[i] = bf2f(Kr[i * 72 + lane]) * gt[i] * gt[96 + i];
      }
      const LAS float* Am = (const LAS float*)(Ls + G1_AM);
#pragma unroll
      for (int i = 1; i < 32; ++i) { const float arow = Am[i * 33 + (lane & 31)]; float a = sol[i];
#pragma unroll
          for (int j = 0; j < i; ++j) a -= __uint_as_float(__builtin_amdgcn_readlane(__float_as_uint(arow), j)) * sol[j];
          sol[i] = a; }
      LAS bf16_t* dst = (LAS bf16_t*)(Ls + (sub ? G1_WT : G1_UT)) + lane * 40;
#pragma unroll
      for (int q4 = 0; q4 < 4; ++q4) { u32x4 w;
#pragma unroll
          for (int e = 0; e < 4; ++e) w[e] = cvtpk(sol[8 * q4 + 2 * e], sol[8 * q4 + 2 * e + 1]);
          *(LAS u32x4*)(dst + 8 * q4) = w; }
    }
    LBAR(); G1T(4);
        { unsigned char* gd = F.ws + WS_GD + (size_t)(bh * NCH + c0 + s) * 24576;
          const LAS bf16_t* uT = (const LAS bf16_t*)(Ls + G1_UT); const LAS bf16_t* wT = (const LAS bf16_t*)(Ls + G1_WT); const LAS bf16_t* kT = (const LAS bf16_t*)(Ls + G1_KT);
          const LAS bf16_t* qk = (const LAS bf16_t*)(Ls + G1_QK); const LAS bf16_t* qr = (const LAS bf16_t*)(Ls + G1_QRM);
          const f32x4 z4 = (f32x4){0.f, 0.f, 0.f, 0.f}; const float cd = gt[96 + 31];
          if (sub == 0) {
#pragma unroll
              for (int mp = 0; mp < 2; ++mp) {
                  const bf16x8 af0 = *(const LAS bf16x8*)(wT + (32 * mp + l15) * 40 + 8 * kq), af1 = *(const LAS bf16x8*)(wT + (32 * mp + 16 + l15) * 40 + 8 * kq);
#pragma unroll
                  for (int nt = 0; nt < 4; ++nt) {
                      const bf16x8 bfr = *(const LAS bf16x8*)(kT + (16 * nt + l15) * 40 + 8 * kq);
                      const f32x4 a0 = mfma16(af0, bfr, z4), a1 = mfma16(af1, bfr, z4); const int dout = 16 * nt + l15; u32x4 w; float o8[8];
#pragma unroll
                      for (int r = 0; r < 4; ++r) { const int din = 32 * mp + 4 * kq + r; o8[r] = ((din == dout) ? cd : 0.f) - a0[r]; o8[4 + r] = ((din + 16 == dout) ? cd : 0.f) - a1[r]; }
                      w.x = cvtpk(o8[0], o8[1]); w.y = cvtpk(o8[2], o8[3]); w.z = cvtpk(o8[4], o8[5]); w.w = cvtpk(o8[6], o8[7]);
                      *(u32x4*)(gd + ((nt * 2 + mp) * 64 + kq * 16 + l15) * 16) = w; }
#pragma unroll
                  for (int ct = 0; ct < 2; ++ct) {
                      const bf16x8 bfr = *(const LAS bf16x8*)(qk + (16 * ct + l15) * 40 + 8 * kq);
                      const f32x4 a0 = mfma16(af0, bfr, z4), a1 = mfma16(af1, bfr, z4); const int c = 16 * ct + l15; const float eg = gt[96 + c];
                      const u32x2 q0 = *(const LAS u32x2*)(qr + c * 72 + 32 * mp + 4 * kq), q1 = *(const LAS u32x2*)(qr + c * 72 + 32 * mp + 16 + 4 * kq); u32x4 w;
                      w.x = cvtpk(bflo(q0.x) * eg - a0[0], bfhi(q0.x) * eg - a0[1]); w.y = cvtpk(bflo(q0.y) * eg - a0[2], bfhi(q0.y) * eg - a0[3]);
                      w.z = cvtpk(bflo(q1.x) * eg - a1[0], bfhi(q1.x) * eg - a1[1]); w.w = cvtpk(bflo(q1.y) * eg - a1[2], bfhi(q1.y) * eg - a1[3]);
                      *(u32x4*)(gd + 8192 + ((ct * 2 + mp) * 64 + kq * 16 + l15) * 16) = w; } }
          } else {
#pragma unroll
              for (int et = 0; et < 4; ++et) { const bf16x8 bfr = *(const LAS bf16x8*)(uT + (16 * et + l15) * 40 + 8 * kq);
#pragma unroll
                  for (int dt = 0; dt < 4; ++dt) {
                      const f32x4 acc = mfma16(*(const LAS bf16x8*)(kT + (16 * dt + l15) * 40 + 8 * kq), bfr, z4); u32x2 w; w.x = cvtpk(acc[0], acc[1]); w.y = cvtpk(acc[2], acc[3]);
                      *(u32x2*)(gd + 12288 + ((dt * 4 + et) * 64 + lane) * 8) = w; }
#pragma unroll
                  for (int ct = 0; ct < 2; ++ct) {
                      const f32x4 acc = mfma16(*(const LAS bf16x8*)(qk + (16 * ct + l15) * 40 + 8 * kq), bfr, z4); u32x2 w; w.x = cvtpk(acc[0], acc[1]); w.y = cvtpk(acc[2], acc[3]);
                      *(u32x2*)(gd + 20480 + ((ct * 4 + et) * 64 + lane) * 8) = w; } }
          }
        }
    LBAR(); G1T(5);
}

__device__ __forceinline__ void g2_item(Frame& F, int item) {
    const int lane = F.lane, wid = F.wave, bh = item * 2 + (wid >> 2), es = wid & 3, b = bh >> 3, h = bh & 7, l15 = lane & 15, kq = lane >> 4;
    const unsigned char* gd = F.ws + WS_GD + (size_t)bh * NCH * 24576;
    bf16_t* og = WSP(bf16_t, WS_OG) + ((size_t)b * SEQ) * 512 + h * 64 + 16 * es + l15;
    f32x4 S[4];
#pragma unroll
    for (int m = 0; m < 4; ++m) S[m] = (f32x4){0.f, 0.f, 0.f, 0.f};
    bf16x8 Mf[4][2], Pf[2][2]; u32x2 Nv[4], Rv[2];
#define G2_LOAD(c) do { const unsigned char* p_ = gd + (size_t)(c) * 24576; \
        _Pragma("unroll") for (int m = 0; m < 4; ++m) _Pragma("unroll") for (int s2 = 0; s2 < 2; ++s2) Mf[m][s2] = *(const bf16x8*)(p_ + ((m * 2 + s2) * 64 + lane) * 16); \
        _Pragma("unroll") for (int ct = 0; ct < 2; ++ct) _Pragma("unroll") for (int s2 = 0; s2 < 2; ++s2) Pf[ct][s2] = *(const bf16x8*)(p_ + 8192 + ((ct * 2 + s2) * 64 + lane) * 16); \
        _Pragma("unroll") for (int m = 0; m < 4; ++m) Nv[m] = *(const u32x2*)(p_ + 12288 + ((m * 4 + es) * 64 + lane) * 8); \
        _Pragma("unroll") for (int ct = 0; ct < 2; ++ct) Rv[ct] = *(const u32x2*)(p_ + 20480 + ((ct * 4 + es) * 64 + lane) * 8); } while (0)
    G2_LOAD(0);
    for (int c = 0; c < NCH; ++c) {
        bf16x8 cM[4][2], cP[2][2]; u32x2 cN[4], cR[2];
#pragma unroll
        for (int m = 0; m < 4; ++m) { cM[m][0] = Mf[m][0]; cM[m][1] = Mf[m][1]; cN[m] = Nv[m]; }
#pragma unroll
        for (int ct = 0; ct < 2; ++ct) { cP[ct][0] = Pf[ct][0]; cP[ct][1] = Pf[ct][1]; cR[ct] = Rv[ct]; }
        if (c + 1 < NCH) G2_LOAD(c + 1);
        bf16x8 Bs[2];
#pragma unroll
        for (int s2 = 0; s2 < 2; ++s2) { u32x4 w; w.x = cvtpk(S[2 * s2][0], S[2 * s2][1]); w.y = cvtpk(S[2 * s2][2], S[2 * s2][3]); w.z = cvtpk(S[2 * s2 + 1][0], S[2 * s2 + 1][1]); w.w = cvtpk(S[2 * s2 + 1][2], S[2 * s2 + 1][3]);
            Bs[s2] = __builtin_bit_cast(bf16x8, w); }
#pragma unroll
        for (int ct = 0; ct < 2; ++ct) { f32x4 o = (f32x4){bflo(cR[ct].x), bfhi(cR[ct].x), bflo(cR[ct].y), bfhi(cR[ct].y)};
            o = mfma16(cP[ct][0], Bs[0], o); o = mfma16(cP[ct][1], Bs[1], o);
            bf16_t* op = og + (size_t)(c * GC + 16 * ct + 4 * kq) * 512;
#pragma unroll
            for (int r = 0; r < 4; ++r) op[(size_t)r * 512] = f2bf(o[r]); }
#pragma unroll
        for (int m = 0; m < 4; ++m) { f32x4 a = (f32x4){bflo(cN[m].x), bfhi(cN[m].x), bflo(cN[m].y), bfhi(cN[m].y)};
            a = mfma16(cM[m][0], Bs[0], a); S[m] = mfma16(cM[m][1], Bs[1], a); }
    }
#undef G2_LOAD
}

constexpr int P6_RW = 0, P6_TK = 131072;
__device__ __forceinline__ void p6_router(Frame& F, int rep) {
    const int lane = F.lane, wid = F.wave, tid = F.tid, l15 = lane & 15, kq = lane >> 4;
    LAS unsigned char* rwl = F.lds;
    LAS float* gml = (LAS float*)(F.lds + MISC_OFF + 1024);
    const float* x1 = WSP(float, WS_X1); const float* mod = WSP(float, WS_MOD); unsigned char* h2 = WSP(unsigned char, WS_H);
    const size_t ro = rep ? WS_END : 0;
    int* tke = WSP(int, ro + WS_TKE); float* tkw = WSP(float, ro + WS_TKW); int* tkp = WSP(int, ro + WS_TKP); int* lst = WSP(int, ro + WS_LIST);
    const int tpw = T / F.G, t0 = (int)blockIdx.x * tpw;
    { const float* rwt = WSP(float, WS_RWT);
      for (int idx = tid; idx < NE * 128; idx += NWAVES * 64) { const int e = idx >> 7, c = idx & 127; const f32x4 a = *(const f32x4*)(rwt + e * DM + 8 * c), bq = *(const f32x4*)(rwt + e * DM + 8 * c + 4);
          u32x4 hi4, lo4; float v[8] = {a[0], a[1], a[2], a[3], bq[0], bq[1], bq[2], bq[3]};
#pragma unroll
          for (int i = 0; i < 4; ++i) { const unsigned hw = cvtpk(v[2 * i], v[2 * i + 1]); hi4[i] = hw; lo4[i] = cvtpk(v[2 * i] - bflo(hw), v[2 * i + 1] - bfhi(hw)); }
          const int off = e * 2048 + ((c ^ (e & 15)) << 4);
          *(LAS u32x4*)(rwl + off) = hi4; *(LAS u32x4*)(rwl + 65536 + off) = lo4; }
      const float* mb = mod + (size_t)(t0 / SEQ) * 6144;
      for (int i = tid; i < DM; i += NWAVES * 64) { gml[i] = F.in[IN_N2G][i] * (1.0f + mb[4096 + i]); gml[DM + i] = mb[3072 + i]; } }
    if (tid < 96) F.MISC[32 + tid] = 0u;
    __syncthreads();
    for (int tb0 = wid * 16; tb0 < tpw; tb0 += NWAVES * 16) {
        const int t = t0 + tb0 + l15; const float* xr = x1 + (size_t)t * DM + 8 * kq; unsigned char* hr = h2 + (size_t)t * DM + 8 * kq;
        float ss = 0.f;
#pragma unroll 8
        for (int s2 = 0; s2 < 32; ++s2) { const f32x4 a = *(const f32x4*)(xr + 32 * s2), bq = *(const f32x4*)(xr + 32 * s2 + 4);
            ss += (a[0] * a[0] + a[1] * a[1]) + (a[2] * a[2] + a[3] * a[3]) + (bq[0] * bq[0] + bq[1] * bq[1]) + (bq[2] * bq[2] + bq[3] * bq[3]); }
        ss += __shfl_xor(ss, 16); ss += __shfl_xor(ss, 32);
        const float rstd = __builtin_amdgcn_rsqf(ss * (1.f / DM) + EPS);
        f32x4 acc[2] = {(f32x4){0.f, 0.f, 0.f, 0.f}, (f32x4){0.f, 0.f, 0.f, 0.f}};
#pragma unroll 4
        for (int s2 = 0; s2 < 32; ++s2) {
            const f32x4 a = *(const f32x4*)(xr + 32 * s2), bq = *(const f32x4*)(xr + 32 * s2 + 4);
            const LAS f32x4* gp = (const LAS f32x4*)(gml + 32 * s2 + 8 * kq); const f32x4 g0 = gp[0], g1 = gp[1], h0 = gp[DM / 4], h1 = gp[DM / 4 + 1];
            const f32x4 v0 = a * rstd * g0 + h0, v1 = bq * rstd * g1 + h1;
            u32x2 f8; f8.x = pk4_fp8(v0[0], v0[1], v0[2], v0[3]); f8.y = pk4_fp8(v1[0], v1[1], v1[2], v1[3]); *(u32x2*)(hr + 32 * s2) = f8;
            u32x4 hi4, lo4;
            hi4[0] = cvtpk(v0[0], v0[1]); hi4[1] = cvtpk(v0[2], v0[3]); hi4[2] = cvtpk(v1[0], v1[1]); hi4[3] = cvtpk(v1[2], v1[3]);
            lo4[0] = cvtpk(v0[0] - bflo(hi4[0]), v0[1] - bfhi(hi4[0])); lo4[1] = cvtpk(v0[2] - bflo(hi4[1]), v0[3] - bfhi(hi4[1]));
            lo4[2] = cvtpk(v1[0] - bflo(hi4[2]), v1[1] - bfhi(hi4[2])); lo4[3] = cvtpk(v1[2] - bflo(hi4[3]), v1[3] - bfhi(hi4[3]));
            const bf16x8 ah = __builtin_bit_cast(bf16x8, hi4), al = __builtin_bit_cast(bf16x8, lo4);
#pragma unroll
            for (int j = 0; j < 2; ++j) { const int e = l15 + 16 * j; const LAS unsigned char* bp = rwl + e * 2048 + (((4 * s2 + kq) ^ (e & 15)) << 4);
                const bf16x8 bh = *(const LAS bf16x8*)bp, bl = *(const LAS bf16x8*)(bp + 65536);
                acc[j] = mfma16(ah, bh, acc[j]); acc[j] = mfma16(al, bh, acc[j]); acc[j] = mfma16(ah, bl, acc[j]); }
        }
        const float rb0 = F.in[IN_RB][l15], rb1 = F.in[IN_RB][l15 + 16];
#pragma unroll
        for (int r = 0; r < 4; ++r) {
            float v0 = acc[0][r] + rb0, v1 = acc[1][r] + rb1; float tv[4]; int ti[4];
#pragma unroll
            for (int k = 0; k < 4; ++k) { float bv = v0; int bi = l15; if (v1 > v0) { bv = v1; bi = l15 + 16; }
#pragma unroll
                for (int o = 1; o < 16; o <<= 1) { const float ov = __shfl_xor(bv, o); const int oi = __shfl_xor(bi, o); if (ov > bv || (ov == bv && oi < bi)) { bv = ov; bi = oi; } }
                tv[k] = bv; ti[k] = bi; if (bi == l15) v0 = -INFINITY; if (bi == l15 + 16) v1 = -INFINITY; }
            const float e1 = __expf(tv[1] - tv[0]), e2 = __expf(tv[2] - tv[0]), e3 = __expf(tv[3] - tv[0]), inv = 1.0f / (1.0f + e1 + e2 + e3);
            if (l15 < 4) { const int tt = t0 + tb0 + 4 * kq + r; const int e = (l15 == 0) ? ti[0] : (l15 == 1) ? ti[1] : (l15 == 2) ? ti[2] : ti[3];
                const float w = ((l15 == 0) ? 1.0f : (l15 == 1) ? e1 : (l15 == 2) ? e2 : e3) * inv;
                const int lp = __hip_atomic_fetch_add((LAS int*)(F.lds + MISC_OFF) + 32 + e, 1, __ATOMIC_RELAXED, __HIP_MEMORY_SCOPE_WORKGROUP);
                tke[tt * 4 + l15] = e; tkw[tt * 4 + l15] = w; tkp[tt * 4 + l15] = lp; }
        }
    }
    __syncthreads();
    if (tid < 32) { const int n = (int)F.MISC[32 + tid]; int base = 0; if (n > 0) base = (int)__hip_atomic_fetch_add(F.ctl + CW_CNT + 4096 * rep + 64 * tid, (unsigned)n, RLX_AGENT); F.MISC[64 + tid] = (unsigned)base; }
    VM_WAIT(); __syncthreads();
    for (int i = tid; i < tpw * 4; i += NWAVES * 64) { const int t = t0 + (i >> 2), e = tke[t * 4 + (i & 3)], p = tkp[t * 4 + (i & 3)] + (int)F.MISC[64 + e]; tkp[t * 4 + (i & 3)] = p; lst[(size_t)e * T + p] = t; }
}
__device__ __forceinline__ void moe_tables(Frame& F) {
    if (F.tid < 32) F.MISC[192 + F.tid] = __hip_atomic_load(F.ctl + CW_CNT + 64 * F.tid, RLX_AGENT);
    __syncthreads();
    if (F.tid == 0) { unsigned s = 0; for (int e = 0; e < 32; ++e) { F.MISC[128 + e] = s; s += (F.MISC[192 + e] + 255u) >> 8; } F.MISC[160] = s; }
    __syncthreads();
    for (int mt = F.tid; mt < 576; mt += NWAVES * 64) { int e = 0; while (e < 31 && F.MISC[128 + e + 1] <= (unsigned)mt) ++e; F.MISC[2304 + mt] = (unsigned)e; }
    __syncthreads();
}
__device__ __forceinline__ void p10_combine(Frame& F) {
    const int gw = F.vcu * NWAVES + F.wave, NGW = F.G * NWAVES, lane = F.lane;
    const float* x1 = WSP(float, WS_X1); const float* mod = WSP(float, WS_MOD); const unsigned char* y = WSP(unsigned char, WS_Y);
    const int* tke = WSP(int, WS_TKE); const float* tkw = WSP(float, WS_TKW); const int* tkp = WSP(int, WS_TKP);
    constexpr int R = 2;
    for (int m0 = gw; m0 < T; m0 += R * NGW) {
        u32x2 y0[R][4], y1[R][4]; float w[R][4]; f32x4 xv[R][4];
#pragma unroll
        for (int r = 0; r < R; ++r) { const int m = (m0 + r * NGW < T) ? m0 + r * NGW : m0;
            const i32x4q e4 = *(const i32x4q*)(tke + m * 4), p4 = *(const i32x4q*)(tkp + m * 4); const f32x4 w4 = *(const f32x4*)(tkw + m * 4);
#pragma unroll
            for (int k = 0; k < 4; ++k) { const size_t row = (size_t)F.MISC[128 + e4[k]] * 256 + p4[k]; w[r][k] = w4[k];
                y0[r][k] = *(const u32x2*)(y + row * DM + 8 * lane); y1[r][k] = *(const u32x2*)(y + row * DM + 512 + 8 * lane); }
#pragma unroll
            for (int q = 0; q < 4; ++q) xv[r][q] = *(const f32x4*)(x1 + (size_t)m * DM + (q >> 1) * 512 + 8 * lane + 4 * (q & 1)); }
#pragma unroll
        for (int r = 0; r < R; ++r) { const int m = m0 + r * NGW; if (m >= T) continue;
            float a[16];
#pragma unroll
            for (int i = 0; i < 16; ++i) a[i] = 0.f;
#pragma unroll
            for (int k = 0; k < 4; ++k)
#pragma unroll
                for (int i = 0; i < 2; ++i) { const f32x2 l0 = __builtin_amdgcn_cvt_pk_f32_fp8((int)y0[r][k][i], false), h0 = __builtin_amdgcn_cvt_pk_f32_fp8((int)y0[r][k][i], true);
                    const f32x2 l1 = __builtin_amdgcn_cvt_pk_f32_fp8((int)y1[r][k][i], false), h1 = __builtin_amdgcn_cvt_pk_f32_fp8((int)y1[r][k][i], true);
                    a[4 * i] += w[r][k] * l0[0]; a[4 * i + 1] += w[r][k] * l0[1]; a[4 * i + 2] += w[r][k] * h0[0]; a[4 * i + 3] += w[r][k] * h0[1];
                    a[8 + 4 * i] += w[r][k] * l1[0]; a[8 + 4 * i + 1] += w[r][k] * l1[1]; a[8 + 4 * i + 2] += w[r][k] * h1[0]; a[8 + 4 * i + 3] += w[r][k] * h1[1]; }
            const float* mb = mod + (size_t)(m / SEQ) * 6144 + 5120; float ss = 0.f; f32x4 v[4];
#pragma unroll
            for (int q = 0; q < 4; ++q) { const int col = (q >> 1) * 512 + 8 * lane + 4 * (q & 1); const f32x4 gt = *(const f32x4*)(mb + col);
#pragma unroll
                for (int i = 0; i < 4; ++i) { v[q][i] = xv[r][q][i] + gt[i] * a[(q >> 1) * 8 + 4 * (q & 1) + i]; ss += v[q][i] * v[q][i]; } }
            const float rstd = __builtin_amdgcn_rsqf(wave_sum(ss) * (1.f / DM) + EPS);
#pragma unroll
            for (int q = 0; q < 4; ++q) { const int col = (q >> 1) * 512 + 8 * lane + 4 * (q & 1); const f32x4 fg = *(const f32x4*)(F.in[IN_FG] + col);
                *(f32x4*)(F.out + (size_t)m * DM + col) = v[q] * rstd * fg; } }
    }
}
__device__ __forceinline__ void dbg_final(Frame& F, const float* src) {
    const int gw = F.vcu * NWAVES + F.wave, NGW = F.G * NWAVES;
    for (int m = gw; m < T; m += NGW) {
        const f32x4* xr = (const f32x4*)(src + (size_t)m * DM) + F.lane; f32x4 v[4]; float s = 0.f;
#pragma unroll
        for (int j = 0; j < 4; ++j) { v[j] = xr[64 * j]; s += (v[j][0] * v[j][0] + v[j][1] * v[j][1]) + (v[j][2] * v[j][2] + v[j][3] * v[j][3]); }
        const float rstd = __builtin_amdgcn_rsqf(wave_sum(s) * (1.f / DM) + EPS);
#pragma unroll
        for (int j = 0; j < 4; ++j) { const int col = 4 * (F.lane + 64 * j); *(f32x4*)(F.out + (size_t)m * DM + col) = v[j] * rstd * *(const f32x4*)(F.in[IN_FG] + col); }
    }
}


__device__ __forceinline__ void dbg_dump_bf16(Frame& F, const bf16_t* src, int ld, int c0, int n) {
    for (size_t i = (size_t)blockIdx.x * NWAVES * 64 + F.tid; i < (size_t)T * n; i += (size_t)F.G * NWAVES * 64) { const size_t t = i / n; const int c = (int)(i % n); F.out[t * DM + c0 + c] = bf2f(src[t * ld + c]); }
}
#define DBG_DUMP(k, ...) do { if (DBG_STAGE == (k)) { xcd_barrier(bar); __VA_ARGS__; return; } } while (0)
#ifndef DBG_STAGE
#define DBG_STAGE (-1)
#endif

constexpr int N_PHASES = 13;
struct Args { const float* in[N_IN]; float* out; unsigned char* ws; int ph_lo, ph_hi; };
__global__ void __launch_bounds__(NWAVES * 64, 2) fwd_kernel(Args args) {
    extern __shared__ __attribute__((aligned(16))) unsigned char lds[];
    Frame F;
    F.lds = (LAS unsigned char*)lds; F.MISC = (volatile LAS unsigned*)(F.lds + MISC_OFF);
    F.tid = threadIdx.x; F.lane = F.tid & 63; F.wave = __builtin_amdgcn_readfirstlane(F.tid >> 6);
    F.G = gridDim.x; { const int bx = blockIdx.x; F.vcu = (F.G % 8 == 0) ? (bx % 8) * (F.G / 8) + bx / 8 : bx; }
    F.ws = args.ws; F.ctl = (unsigned*)(args.ws + WS_CTL); F.out = args.out;
#pragma unroll
    for (int i = 0; i < N_IN; ++i) F.in[i] = args.in[i];
    for (int u = F.tid; u < (LDS_BYTES - MISC_OFF) / 4; u += NWAVES * 64) ((LAS unsigned*)(F.lds + MISC_OFF))[u] = 0u;
    __syncthreads();
    XcdBarrier bar; bar.bar = F.ctl + CW_BAR; bar.x = 0; bar.st = nullptr;
    if (!N_LAUNCH_PER_PHASE) bar = xcd_barrier_post(F.ctl + CW_BAR, F.MISC + 8);
    const int lo = args.ph_lo, hi = args.ph_hi;
#ifndef REP_PHASE
#define REP_PHASE (-1)
#endif
#define NREP(k) ((REP_PHASE == (k)) ? 2 : 1)
#define REPLOOP(k) _Pragma("unroll") for (int rep = 0; rep < NREP(k); ++rep)
#ifndef PH_MASK
#define PH_MASK 0xFFFFu
#endif
#define IN(k) ((((PH_MASK) >> (k)) & 1u) && lo <= (k) && (k) < hi)
#ifndef TPROBE
#define TPROBE (-2)
#endif
    unsigned long long tp0 = (TPROBE == 0) ? __builtin_amdgcn_s_memrealtime() : 0ull, tpd = 0ull;
#define SEAM(k) do { if (IN(k) && IN((k) + 1)) xcd_barrier(bar); if (TPROBE == (k)) tpd = __builtin_amdgcn_s_memrealtime() - tp0; if (TPROBE == (k) + 1) tp0 = __builtin_amdgcn_s_memrealtime(); } while (0)

#if defined(DBG_BASE)
    dbg_final(F, F.in[IN_X]); return;
#endif
    if (IN(0)) REPLOOP(0) { p0_mod(F); __syncthreads(); p0_weights(F); __syncthreads(); }
    SEAM(0);
    if (IN(1)) REPLOOP(1) norm_rows(F, F.in[IN_X], F.in[IN_N1G], 0, 1024, WSP(bf16_t, WS_H));
    SEAM(1);
    if (IN(2)) REPLOOP(2) {
        pg::Gemm g{WSP(bf16_t, WS_H), WSP(bf16_t, WS_WIN), DM * 2, DM * 2, nullptr}; pg::StaticOrder S; S.init(T, NPROJ, F.G, (int)blockIdx.x);
        EpiProj E{WSP(bf16_t, WS_PROJ), WSP(float, WS_PART)};
        pg::gemm_phase<EpiProj, pg::StaticOrder, false, true>(F.lds, g, S, E);
    }
    DBG_DUMP(2, dbg_dump_bf16(F, WSP(bf16_t, WS_PROJ), NPROJ, 0, 1024));
    SEAM(2);
    if (IN(4)) REPLOOP(4) {
#ifndef NO_QG
        { pg::Gemm g{WSP(bf16_t, WS_PROJ) + C_QLAT, WSP(bf16_t, WS_WQ), NPROJ * 2, QLORA * 2, nullptr}; pg::StaticOrder S; S.init(T, 768, F.G, (int)blockIdx.x);
          EpiQ E{WSP(bf16_t, WS_Q), WSP(float, WS_PART), WSP(float, WS_CS), 0.10206207261596575f * 1.4426950408889634f};
          pg::gemm_phase<EpiQ, pg::StaticOrder, false, true>(F.lds, g, S, E); }
#endif
#ifndef NO_KVG
        { pg::Gemm g{WSP(bf16_t, WS_PROJ) + C_KVLAT, WSP(bf16_t, WS_WKV), NPROJ * 2, KVLORA * 2, nullptr}; pg::StaticOrder S; S.init(T, 1024, F.G, (int)(F.G - 1 - blockIdx.x));
          EpiKV E{WSP(bf16_t, WS_K), WSP(bf16_t, WS_V), WSP(float, WS_PART), WSP(bf16_t, WS_PROJ), WSP(float, WS_CS)};
          pg::gemm_phase<EpiKV, pg::StaticOrder, false, true>(F.lds, g, S, E); }
#endif
    }
    DBG_DUMP(4, dbg_dump_bf16(F, WSP(bf16_t, WS_Q), 768, 0, 768); dbg_dump_bf16(F, WSP(bf16_t, WS_K), 768, 768, 256));
    SEAM(4);
    unsigned long long g1acc = 0ull;
    if (IN(5)) REPLOOP(5) { for (int u = blockIdx.x; u < BATCH * GH * NCH / 4; u += F.G) g1_unit(F, u, g1acc); }
    if (G1PROBE >= 0) tpd = g1acc;
    SEAM(5);
#ifndef NCONV
#define NCONV 56
#endif
    if (IN(6)) {
        if (F.tid == 0) F.MISC[17] = __hip_atomic_fetch_add(F.ctl + CW_Q + 320, 1u, RLX_AGENT);
        for (;;) {
            if (F.tid == 0) F.MISC[16] = __hip_atomic_fetch_add(F.ctl + CW_Q, 1u, RLX_AGENT);
            __syncthreads();
            const int item = (int)F.MISC[16];
            __syncthreads();
            if (item >= 32) break;
            g2_item(F, item);
        }
        const int ticket = (int)F.MISC[17];
#define CONV_LOOP() for (;;) { if (F.tid == 0) F.MISC[16] = __hip_atomic_fetch_add(F.ctl + CW_Q + 256, 1u, RLX_AGENT); __syncthreads(); const int item = (int)F.MISC[16]; __syncthreads(); \
            if (item >= MOE_CONV_ITEMS) break; moe_conv_item(F, item); }
        if (ticket >= 32 && ticket < 32 + NCONV) CONV_LOOP();
        for (;;) {
            if (F.tid == 0) F.MISC[16] = __hip_atomic_fetch_add(F.ctl + CW_Q + 64, 1u, RLX_AGENT);
            __syncthreads();
            const int item = (int)F.MISC[16];
            __syncthreads();
            if (item >= BATCH * NH * 16) break;
            const int qb = 15 - (item >> 6), bh = item & 63; attn_unit(F, bh >> 3, bh & 7, qb);
        }
        CONV_LOOP();
#undef CONV_LOOP
    }
    DBG_DUMP(6, dbg_dump_bf16(F, WSP(bf16_t, DBG_SUB ? WS_OG : WS_OA), 512, 0, 512); dbg_dump_bf16(F, WSP(bf16_t, DBG_SUB ? WS_OG : WS_OA), 512, 512, 512));
    SEAM(6);
    if (IN(7)) REPLOOP(7) p4b_rows(F);
    SEAM(7);
    if (IN(8)) REPLOOP(8) {
        pg::Gemm g{WSP(bf16_t, WS_H), WSP(bf16_t, WS_WO), DM * 2, DM * 2, nullptr}; pg::StaticOrder S; S.init(T, DM, F.G, (int)blockIdx.x);
        EpiX1 E{F.in[IN_X], WSP(float, WS_MOD), WSP(float, WS_X1)};
        pg::gemm_phase<EpiX1, pg::StaticOrder, false, true>(F.lds, g, S, E);
    }
#if defined(DBG_STOP_X1)
    xcd_barrier(bar); dbg_final(F, WSP(float, WS_X1)); return;
#endif
    SEAM(8);
    if (IN(9)) REPLOOP(9) { p6_router(F, rep); __syncthreads(); }
    SEAM(9);
    if (IN(10)) REPLOOP(10) {
        moe_tables(F);
        pg::Gemm g{WSP(unsigned char, WS_H), WSP(unsigned char, WS_WGU), DM, DM, WSP(int, WS_LIST)};
#if defined(EPIPROBE) && EPIPROBE == 10
        g.tacc = &tpd;
#endif
        pg::MoeOrder S{(const LAS int*)(F.lds + MISC_OFF) + 128, (const LAS int*)(F.lds + MISC_OFF) + 192, 8, 2048, F.G, (int)blockIdx.x, 0};
        EpiGU E{WSP(unsigned char, WS_ACT), F.in[IN_BGU]};
        pg::gemm_phase<EpiGU, pg::MoeOrder, true, true, true>(F.lds, g, S, E);
    }
    SEAM(10);
    if (IN(11)) REPLOOP(11) {
        moe_tables(F);
        pg::Gemm g{WSP(unsigned char, WS_ACT), WSP(unsigned char, WS_WDN), DE, DE, nullptr};
#if defined(EPIPROBE) && EPIPROBE == 11
        g.tacc = &tpd;
#endif
        pg::MoeOrder S{(const LAS int*)(F.lds + MISC_OFF) + 128, (const LAS int*)(F.lds + MISC_OFF) + 192, 4, 1024, F.G, (int)blockIdx.x, 1};
        EpiDN E{WSP(unsigned char, WS_Y), F.in[IN_BDN]};
        pg::gemm_phase<EpiDN, pg::MoeOrder, false, true, true>(F.lds, g, S, E);
    }
    SEAM(11);
    if (IN(12)) REPLOOP(12) { moe_tables(F); p10_combine(F); }
#ifdef EPIPROBE
    const bool epiprobe_ = true;
#else
    const bool epiprobe_ = false;
#endif
    if (TPROBE >= 0 || G1PROBE >= 0 || epiprobe_) { if (TPROBE == 12) { VM_WAIT(); tpd = __builtin_amdgcn_s_memrealtime() - tp0; }
        if (blockIdx.x == 0) { const unsigned long long t_ = __builtin_amdgcn_s_memrealtime(); while (__builtin_amdgcn_s_memrealtime() - t_ < 10ull * tpd) __builtin_amdgcn_s_sleep(8); } }
#undef IN
#undef SEAM
}

extern "C" void kernel_launch(void* const* d_in, const int* in_sizes, int n_in, void* d_out, int out_size, void* d_ws, size_t ws_size, hipStream_t stream) {
    static int grid = 0;
    if (grid == 0) {
        if (n_in != N_IN || out_size != T * DM || ws_size < WS_END) { fprintf(stderr, "kernel_launch: unexpected shapes (n_in %d, out %d, ws %zu)\n", n_in, out_size, ws_size); grid = -1; return; }
        int dev = 0, cus = 0;
        if (hipGetDevice(&dev) != hipSuccess || hipDeviceGetAttribute(&cus, hipDeviceAttributeMultiprocessorCount, dev) != hipSuccess) { grid = -1; return; }
        if (hipFuncSetAttribute((const void*)fwd_kernel, hipFuncAttributeMaxDynamicSharedMemorySize, LDS_BYTES) != hipSuccess) { grid = -1; return; }
        int per_cu = 0;
        if (hipOccupancyMaxActiveBlocksPerMultiprocessor(&per_cu, (const void*)fwd_kernel, NWAVES * 64, LDS_BYTES) != hipSuccess || per_cu < 1) fprintf(stderr, "kernel_launch: occupancy query says %d\n", per_cu);
        (void)hipGetLastError();
        grid = cus;
        while (grid > 8 && (T % grid) != 0) grid -= 8;
    }
    if (grid < 0) return;
    (void)hipMemsetAsync((char*)d_ws + WS_CTL, 0, CTL_BYTES, stream);
    Args a{};
    for (int i = 0; i < N_IN; ++i) a.in[i] = (const float*)d_in[i];
    a.out = (float*)d_out; a.ws = (unsigned char*)d_ws;
#if N_LAUNCH_PER_PHASE
    for (int p = 0; p < N_PHASES; ++p) { a.ph_lo = p; a.ph_hi = p + 1; hipLaunchKernelGGL(fwd_kernel, dim3(grid), dim3(NWAVES * 64), LDS_BYTES, stream, a); }
#else
    a.ph_lo = 0; a.ph_hi = N_PHASES;
    hipLaunchKernelGGL(fwd_kernel, dim3(grid), dim3(NWAVES * 64), LDS_BYTES, stream, a);
#endif
}
```

```cpp
#include <hip/hip_runtime.h>
#include <cstdio>
#include <cstdint>


#define DBG_SUB 0
#ifndef N_LAUNCH_PER_PHASE
#define N_LAUNCH_PER_PHASE 0
#endif

#define GAS __attribute__((address_space(1)))
#define LAS __attribute__((address_space(3)))
typedef unsigned short bf16_t;
typedef short bf16x8 __attribute__((ext_vector_type(8)));
typedef short s16x4 __attribute__((ext_vector_type(4)));
typedef float f32x4 __attribute__((ext_vector_type(4)));
typedef float f32x2 __attribute__((ext_vector_type(2)));
typedef float f32x16 __attribute__((ext_vector_type(16)));
typedef unsigned u32x4 __attribute__((ext_vector_type(4)));
typedef unsigned u32x2 __attribute__((ext_vector_type(2)));
typedef __bf16 bf16x2_t __attribute__((ext_vector_type(2)));
typedef int i32x4q __attribute__((ext_vector_type(4)));

constexpr int BATCH = 8, SEQ = 4096, DM = 1024, T = BATCH * SEQ;
constexpr int NH = 8, QK = 96, NOPE = 64, ROPE = 32, VD = 64, QLORA = 384, KVLORA = 256;
constexpr int GH = 8, GDK = 64, GDV = 64;
constexpr int IN_DIM = 2736, NPROJ = 2816;
constexpr int C_QLAT = 0, C_KVLAT = 384, C_KPE = 640, C_GQ = 672, C_GK = 1184, C_GV = 1696, C_GZ = 2208, C_GA = 2720, C_GB = 2728;
constexpr int NE = 32, TOPK = 4, DE = 1024;
constexpr float EPS = 1e-6f;
constexpr float W8 = 32.0f;
constexpr int GC = 32, NCH = SEQ / GC;
constexpr int MAXROWS = T * TOPK + NE * 256;

constexpr size_t MiB = 1u << 20;
constexpr size_t WS_CTL = 0, CTL_BYTES = 1 * MiB;
constexpr size_t WS_MOD = 1 * MiB;
constexpr size_t WS_RSQ = 2 * MiB;
constexpr size_t WS_PARTO = 2 * MiB;
constexpr size_t WS_RSKV = WS_RSQ + 128 * 1024;
constexpr size_t WS_CS = 3 * MiB;
constexpr size_t WS_TKE = 7 * MiB;
constexpr size_t WS_TKW = WS_TKE + 512 * 1024;
constexpr size_t WS_TKP = WS_TKW + 512 * 1024;
constexpr size_t WS_LIST = 9 * MiB;
constexpr size_t WS_RWT = 13 * MiB;
constexpr size_t WS_PART = 13 * MiB + 256 * 1024;
constexpr size_t WS_WIN = 16 * MiB;
constexpr size_t WS_WQ = WS_WIN + (size_t)NPROJ * DM * 2;
constexpr size_t WS_WKV = WS_WQ + (size_t)768 * 384 * 2;
constexpr size_t WS_WO = WS_WKV + (size_t)1024 * 256 * 2;
constexpr size_t WS_WGU = 32 * MiB;
constexpr size_t WS_WDN = WS_WGU + (size_t)NE * 2048 * 1024 * 2;
constexpr size_t WS_H = 224 * MiB;
constexpr size_t WS_X1 = 288 * MiB;
constexpr size_t WS_PROJ = 416 * MiB;
constexpr size_t WS_Q = 592 * MiB;
constexpr size_t WS_K = 640 * MiB;
constexpr size_t WS_V = 688 * MiB;
constexpr size_t WS_OA = 720 * MiB;
constexpr size_t WS_OG = 752 * MiB;
constexpr size_t WS_GD = 784 * MiB;
constexpr size_t WS_ACT = 416 * MiB;
constexpr size_t WS_Y = 688 * MiB;
constexpr size_t WS_END = 976 * MiB;
static_assert(WS_WO + (size_t)1024 * 1024 * 2 <= WS_WGU && WS_WDN + (size_t)NE * 1024 * 1024 * 2 <= WS_H, "weights");
static_assert(WS_ACT + (size_t)MAXROWS * 1024 * 2 <= WS_Y && WS_Y + (size_t)MAXROWS * 1024 * 2 <= WS_END, "moe rows");
static_assert(WS_GD + (size_t)BATCH * GH * NCH * 24576 <= WS_END, "gdn");
constexpr int CW_BAR = 4096;
constexpr int CW_Q = 8192;
constexpr int CW_CNT = 12288;

constexpr int RING_BYTES = 131072;
constexpr int MISC_OFF = RING_BYTES;
constexpr int LDS_BYTES = 147456;

#define LDS_WAIT() asm volatile("s_waitcnt lgkmcnt(0)" ::: "memory")
#define LBAR() asm volatile("s_waitcnt lgkmcnt(0)\n\ts_barrier" ::: "memory")
#define VM_WAIT() asm volatile("s_waitcnt vmcnt(0)" ::: "memory")
#define RLX_AGENT __ATOMIC_RELAXED, __HIP_MEMORY_SCOPE_AGENT

__device__ __forceinline__ unsigned cvtpk(float lo, float hi) { f32x2 v = {lo, hi}; bf16x2_t b = __builtin_convertvector(v, bf16x2_t); return __builtin_bit_cast(unsigned, b); }
__device__ __forceinline__ bf16_t f2bf(float f) { return (bf16_t)(cvtpk(f, 0.f) & 0xffffu); }
__device__ __forceinline__ float bf2f(unsigned short h) { return __uint_as_float((unsigned)h << 16); }
__device__ __forceinline__ float bflo(unsigned w) { return __uint_as_float(w << 16); }
__device__ __forceinline__ float bfhi(unsigned w) { return __uint_as_float(w & 0xffff0000u); }
__device__ __forceinline__ float wave_sum(float v) {
#pragma unroll
    for (int o = 1; o < 64; o <<= 1) v += __shfl_xor(v, o);
    return v;
}
template <int CTRL> __device__ __forceinline__ float dpp_f(float v) { return __int_as_float(__builtin_amdgcn_update_dpp(0, __float_as_int(v), CTRL, 0xF, 0xF, true)); }
template <int CTRL> __device__ __forceinline__ int dpp_i(int v) { return __builtin_amdgcn_update_dpp(0, v, CTRL, 0xF, 0xF, true); }
constexpr int DPP_X1 = 0xB1, DPP_X2 = 0x4E, DPP_HM = 0x141, DPP_RM = 0x140;
__device__ __forceinline__ unsigned pk4_fp8(float a, float b, float c, float d) { int w = 0; w = __builtin_amdgcn_cvt_pk_fp8_f32(a, b, w, false); w = __builtin_amdgcn_cvt_pk_fp8_f32(c, d, w, true); return (unsigned)w; }
__device__ __forceinline__ float siluf(float x) { return x / (1.f + __expf(-x)); }

#define XB_TMO      128
#define XB_XCNT(j)  (256  + 64 * (j))
#define XB_XSUB(j)  (1280 + 64 * (j))
#define XB_XGEN(j)  (2304 + 64 * (j))
#define XB_TOP      3328
#define XB_TOPGEN   3392
#define XCD_BAR_WORDS 3456
#define XB_SPIN_CAP (1u << 18)
__device__ __forceinline__ unsigned xb_ld(unsigned* p)              { return __hip_atomic_load(p, __ATOMIC_RELAXED, __HIP_MEMORY_SCOPE_AGENT); }
__device__ __forceinline__ unsigned xb_add(unsigned* p, unsigned v) { return __hip_atomic_fetch_add(p, v, __ATOMIC_RELAXED, __HIP_MEMORY_SCOPE_AGENT); }
__device__ __forceinline__ unsigned xb_xcc_id() { return (unsigned)__builtin_amdgcn_s_getreg((3 << 11) | 20) & 0xFu; }
#define XB_SPIN(cond, bar) do { unsigned _sp = 0; while (cond) { __builtin_amdgcn_s_sleep(1); \
    if ((++_sp & 255u) == 0u) { if (xb_ld(&(bar)[XB_TMO])) break; if (_sp > XB_SPIN_CAP) { atomicAdd(&(bar)[XB_TMO], 1u); break; } } } } while (0)
struct XcdBarrier { unsigned* bar; unsigned x; volatile LAS unsigned* st; };
__device__ __forceinline__ XcdBarrier xcd_barrier_post(unsigned* bar, volatile LAS unsigned* st) {
    XcdBarrier b; b.bar = bar; b.x = xb_xcc_id(); b.st = st;
    if (threadIdx.x == 0) (void)xb_add(&bar[XB_XCNT(b.x)], 1u);
    return b;
}
__device__ __forceinline__ void xcd_barrier_complete(unsigned* bar, unsigned x, unsigned& nloc, unsigned& nx) {
    const unsigned G = gridDim.x * gridDim.y * gridDim.z;
    unsigned sum, cnt, mine, sp = 0u;
    for (;;) {
        sum = 0u; cnt = 0u; mine = 0u;
#pragma unroll
        for (unsigned j = 0; j < 16; ++j) { const unsigned c = xb_ld(&bar[XB_XCNT(j)]); sum += c; cnt += (c > 0u) ? 1u : 0u; mine = (j == x) ? c : mine; }
        if (sum == G) break;
        __builtin_amdgcn_s_sleep(1);
        if ((++sp & 255u) == 0u) { if (xb_ld(&bar[XB_TMO])) break; if (sp > XB_SPIN_CAP) { atomicAdd(&bar[XB_TMO], 1u); break; } }
    }
    nloc = mine > 0u ? mine : 1u; nx = cnt > 0u ? cnt : 1u;
}
__device__ __forceinline__ void xcd_barrier(const XcdBarrier& b) {
    asm volatile("s_waitcnt vmcnt(0)" ::: "memory");
    __syncthreads();
    if (threadIdx.x == 0) {
        unsigned* bar = b.bar;
        __builtin_amdgcn_s_waitcnt(0);
        unsigned nloc = b.st[0], nx = b.st[1];
        if (nloc == 0u) { xcd_barrier_complete(bar, b.x, nloc, nx); b.st[0] = nloc; b.st[1] = nx; }
        const unsigned old = xb_add(&bar[XB_XSUB(b.x)], 1u);
        const unsigned gen = old / nloc;
        if (old + 1u == (gen + 1u) * nloc) {
            __builtin_amdgcn_fence(__ATOMIC_RELEASE, "agent");
            asm volatile("s_waitcnt vmcnt(0)" ::: "memory");
            const unsigned og = xb_add(&bar[XB_TOP], 1u);
            const unsigned tg = og / nx;
            if (og + 1u == (tg + 1u) * nx) xb_add(&bar[XB_TOPGEN], 1u);
            else XB_SPIN(xb_ld(&bar[XB_TOPGEN]) == tg, bar);
            __builtin_amdgcn_fence(__ATOMIC_ACQUIRE, "agent");
            xb_add(&bar[XB_XGEN(b.x)], 1u);
            asm volatile("s_waitcnt vmcnt(0)" ::: "memory");
        } else {
            XB_SPIN(xb_ld(&bar[XB_XGEN(b.x)]) == gen, bar);
            __builtin_amdgcn_fence(__ATOMIC_ACQUIRE, "agent");
            asm volatile("s_waitcnt vmcnt(0)" ::: "memory");
        }
    }
    __syncthreads();
}

namespace pg {
constexpr int BM = 256, BK = 64, HALF = 128, HTB = HALF * BK * 2, STAGE_BYTES = 8 * HTB, NXCD = 8, WGM = 8;
__host__ __device__ __forceinline__ int lds_byte(int r, int c) { const int st = (r >> 4) * 2 + (c >> 5), rr = r & 15, cc = c & 31, ob = rr * 64 + cc * 2; return st * 1024 + (ob ^ (((ob >> 9) & 1) << 5)); }
__host__ __device__ __forceinline__ void stage_rc(int b, int& R, int& C) { const int st = b / 1024, sb = b % 1024, swz = sb ^ (((sb >> 9) & 1) << 5); R = (st >> 1) * 16 + swz / 64; C = (st & 1) * 32 + (swz % 64) / 2; }
__host__ __device__ __forceinline__ int perm32(int rho) { const int n = rho >> 4, i = rho & 15; return 8 * (i >> 2) + 4 * n + (i & 3); }

struct Unit { int pm, pn, arow, brow, nvalid, e; };
struct Gemm { const void* A; const void* Bt; int lda, K; const int* list; unsigned long long* tacc = nullptr; const float* rowsq = nullptr; };

struct StaticOrder {
    int nM, nN, nwg, G, c;
    __device__ __forceinline__ void init(int M, int N, int G_, int c_) { nM = M / BM; nN = N / BM; nwg = nM * nN; G = G_; c = c_; }
    __device__ __forceinline__ bool next(int i, Unit& u) const {
        const long L = (long)i * G + c; if (L >= nwg) return false;
        int wgid = (int)L; { const int q = nwg / NXCD, r = nwg % NXCD, xcd = wgid % NXCD, off = wgid / NXCD; wgid = (xcd < r ? xcd * (q + 1) : r * (q + 1) + (xcd - r) * q) + off; }
        const int nig = WGM * nN, gid = wgid / nig, fm = gid * WGM, gsz = (nM - fm) < WGM ? (nM - fm) : WGM;
        u.pm = fm + ((wgid % nig) % gsz); u.pn = (wgid % nig) / gsz; u.arow = u.pm * BM; u.brow = u.pn * BM; u.nvalid = BM; u.e = 0; return true;
    }
};
struct MoeOrder {
    const LAS int* pre;
    const LAS int* cnt;
    int NT, Nrows, G, c, contig;
    __device__ __forceinline__ bool next(int i, Unit& u) const {
        const int xcd = c & 7, j = c >> 3, q = i * (G >> 3) + j, mq = q / NT, nt = q - mq * NT, per = (pre[32] + 7) >> 3, mt = xcd * per + mq;
        if (mq >= per || mt >= pre[32]) return false;
        const int e = pre[2176 + mt];
        const int row0 = (mt - pre[e]) * BM;
        u.pm = mt; u.pn = nt; u.e = e; u.nvalid = cnt[e] - row0; u.arow = contig ? mt * BM : row0; u.brow = e * Nrows + nt * BM; return true;
    }
};

__device__ __forceinline__ void glds16s(const void* sbase, unsigned voff, unsigned ldsdst) { unsigned keep;
    asm volatile("s_mov_b32 %0, m0\n\ts_mov_b32 m0, %3\n\ts_nop 0\n\tglobal_load_lds_dwordx4 %1, %2\n\ts_mov_b32 m0, %0" : "=&s"(keep) : "v"(voff), "s"(sbase), "s"(ldsdst) : "memory"); }
typedef int i32x8 __attribute__((ext_vector_type(8)));
typedef int i32x4 __attribute__((ext_vector_type(4)));
template <class Epi, class Sched, bool GATHER, bool ALIGN_EPI, bool FP8 = false, bool MIDK = false>
__device__ __forceinline__ void gemm_phase(LAS unsigned char* lds, const Gemm g, const Sched& S, const Epi& E) {
    const int tid = threadIdx.x, wid = __builtin_amdgcn_readfirstlane(tid >> 6), lane = tid & 63, wr = wid >> 2, wc = wid & 3, fr = lane & 15, fq = lane >> 4;
    const int K = g.K, nt = K / (BK * 2), lda = g.lda;
    unsigned voffB[2], voffA[2];
#pragma unroll
    for (int i = 0; i < 2; ++i) { int R, C; stage_rc(tid * 16 + i * 8192, R, C); const int Rb = Epi::PERM ? ((R & ~31) + perm32(R & 31)) : R; voffB[i] = (unsigned)(Rb * K + C * 2); voffA[i] = (unsigned)(R * lda + C * 2); }
    const size_t kstep = (size_t)(BK * 2);
    const size_t hstep = (size_t)HALF * K;
    const unsigned ldsw = (unsigned)wid * 1024u;
    const unsigned ldsa = (unsigned)__builtin_amdgcn_readfirstlane((int)((unsigned)(uintptr_t)lds + ldsw));
    const int aoff = lds_byte(wr * 64 + fr, fq * 8), boff = lds_byte(wc * 32 + fr, fq * 8);
#define PG_SA(b, h) (((b) * 2 + (h)) * HTB)
#define PG_SB(b, h) ((4 + (b) * 2 + (h)) * HTB)
#define PG_STAGE(bufoff, gbase, voff) do { _Pragma("unroll") for (int _i = 0; _i < 2; ++_i) \
        glds16s((const void*)(gbase), (voff)[_i], ldsa + (unsigned)(bufoff) + (unsigned)(_i * 8192)); } while (0)
#define PG_LDA(dst, b, h) do { _Pragma("unroll") for (int m = 0; m < 4; ++m) { if constexpr (FP8) { dst##8[m] = __builtin_shufflevector(*(const LAS i32x4*)(lds + PG_SA(b, h) + aoff + m * 2048), *(const LAS i32x4*)(lds + PG_SA(b, h) + aoff + m * 2048 + 1024), 0, 1, 2, 3, 4, 5, 6, 7); } \
        else { _Pragma("unroll") for (int k = 0; k < 2; ++k) dst[m][k] = *(const LAS bf16x8*)(lds + PG_SA(b, h) + aoff + m * 2048 + k * 1024); } } } while (0)
#define PG_LDB(dst, b, h) do { _Pragma("unroll") for (int n = 0; n < 2; ++n) { if constexpr (FP8) { dst##8[n] = __builtin_shufflevector(*(const LAS i32x4*)(lds + PG_SB(b, h) + boff + n * 2048), *(const LAS i32x4*)(lds + PG_SB(b, h) + boff + n * 2048 + 1024), 0, 1, 2, 3, 4, 5, 6, 7); } \
        else { _Pragma("unroll") for (int k = 0; k < 2; ++k) dst[n][k] = *(const LAS bf16x8*)(lds + PG_SB(b, h) + boff + n * 2048 + k * 1024); } } } while (0)
#define PG_MMA(ai, bj, At, Bt) do { __builtin_amdgcn_s_setprio(1); if constexpr (FP8) { _Pragma("unroll") for (int m = 0; m < 4; ++m) _Pragma("unroll") for (int n = 0; n < 2; ++n) \
        asm volatile("v_mfma_scale_f32_16x16x128_f8f6f4 %0, %1, %2, %0, %3, %3 op_sel_hi:[0,0,0]" : "+v"(acc[ai][bj][m][n]) : "v"(Bt##8[n]), "v"(At##8[m]), "v"(scl1)); } \
        else { _Pragma("unroll") for (int m = 0; m < 4; ++m) _Pragma("unroll") for (int n = 0; n < 2; ++n) _Pragma("unroll") for (int k = 0; k < 2; ++k) \
        acc[ai][bj][m][n] = __builtin_amdgcn_mfma_f32_16x16x32_bf16(Bt[n][k], At[m][k], acc[ai][bj][m][n], 0, 0, 0); } __builtin_amdgcn_s_setprio(0); } while (0)
#define PG_WAIT_V(n) asm volatile("s_waitcnt vmcnt(" #n ")" ::: "memory")
#define PG_WAIT_L(n) asm volatile("s_waitcnt lgkmcnt(" #n ")" ::: "memory")
#define PG_BAR __builtin_amdgcn_s_barrier()
#define PG_SCHED __builtin_amdgcn_sched_barrier(0)
#define PG_SETA(v, u) do { _Pragma("unroll") for (int _h = 0; _h < 2; ++_h) _Pragma("unroll") for (int _i = 0; _i < 2; ++_i) { int _R, _C; stage_rc(tid * 16 + _i * 8192, _R, _C); const int _r = _h * HALF + _R; \
        const int _rr = _r < (u).nvalid ? _r : (u).nvalid - 1; const int _tok = g.list[(size_t)(u).e * T + (u).arow + _rr]; v[_h][_i] = (unsigned)(_tok * lda + _C * 2); } } while (0)
#define PG_STA(bufoff, kb, h, NX) do { if constexpr (GATHER) { unsigned _vs[2]; _vs[0] = (NX) ? vN[h][0] : vA[h][0]; _vs[1] = (NX) ? vN[h][1] : vA[h][1]; PG_STAGE(bufoff, (const char*)g.A + (kb), _vs); } \
        else PG_STAGE(bufoff, ((NX) ? nA : cA) + (kb) + (h) * hstepA, voffA); } while (0)
    Unit cur, nxt; int ui = 0;
    if (!S.next(0, cur)) return;
    f32x4 acc[2][2][4][2];
#pragma unroll
    for (int a = 0; a < 2; ++a)
#pragma unroll
        for (int b = 0; b < 2; ++b)
#pragma unroll
            for (int m = 0; m < 4; ++m)
#pragma unroll
                for (int n = 0; n < 2; ++n) acc[a][b][m][n] = (f32x4){0.f, 0.f, 0.f, 0.f};
    const int scl1 = 0x7F7F7F7F;
    bf16x8 At[4][2], B0[2][2], B1[2][2]; i32x8 At8[4], B08[2], B18[2];
    unsigned vN[2][2] = {{0u, 0u}, {0u, 0u}};
    unsigned vA[2][2];
    LAS u32x4* const vnl = (LAS u32x4*)(lds + STAGE_BYTES + 1024) + tid;
    const size_t hstepA = (size_t)HALF * lda;
    if constexpr (GATHER) { PG_SETA(vA, cur); PG_WAIT_V(0); }
    const char* cA = (const char*)g.A + (GATHER ? (size_t)0 : (size_t)cur.arow * lda); const char* nA = cA;
    const char* cB = (const char*)g.Bt + (size_t)cur.brow * K;
    PG_STAGE(PG_SB(0, 0), cB, voffB); PG_STAGE(PG_SB(0, 1), cB + hstep, voffB); PG_STA(PG_SA(0, 0), 0, 0, false); PG_STA(PG_SA(0, 1), 0, 1, false);
    if (wr == 1) PG_BAR;
    PG_WAIT_V(2); PG_BAR;
    PG_STAGE(PG_SB(1, 0), cB + kstep, voffB); PG_STA(PG_SA(1, 0), kstep, 0, false); PG_STAGE(PG_SB(1, 1), cB + hstep + kstep, voffB);
    PG_WAIT_V(6); PG_BAR;
    for (;;) {
        const bool has_next = S.next(ui + 1, nxt);
        if constexpr (GATHER) {
            unsigned vT[2][2];
            if (has_next) { PG_SETA(vT, nxt); PG_WAIT_V(0); }
            else {
#pragma unroll
                for (int h = 0; h < 2; ++h)
#pragma unroll
                    for (int i = 0; i < 2; ++i) vT[h][i] = vA[h][i]; }
            *vnl = (u32x4){vT[0][0], vT[0][1], vT[1][0], vT[1][1]};
        } else nA = has_next ? (const char*)g.A + (size_t)nxt.arow * lda : cA;
        const char* nB = has_next ? (const char*)g.Bt + (size_t)nxt.brow * K : cB;
#pragma unroll 1
        for (int t = 0; t < nt; t += 2) {
            const bool last = (t == nt - 2);
            if constexpr (MIDK) { if (t == nt / 2) {
#pragma unroll
                for (int ai = 0; ai < 2; ++ai)
#pragma unroll
                    for (int m = 0; m < 4; ++m) { const f32x4* pp = (const f32x4*)(g.rowsq + (size_t)(cur.pm * BM + ai * HALF + wr * 64 + m * 16 + fr) * 8); const f32x4 s0 = pp[0], s1 = pp[1];
                        const float rs = __builtin_amdgcn_rsqf((((s0[0] + s0[1]) + (s0[2] + s0[3])) + ((s1[0] + s1[1]) + (s1[2] + s1[3]))) * (1.f / 512) + EPS);
#pragma unroll
                        for (int bj = 0; bj < 2; ++bj)
#pragma unroll
                            for (int n = 0; n < 2; ++n) acc[ai][bj][m][n] = acc[ai][bj][m][n] * rs; } } }
            if constexpr (GATHER) { if (last) { const u32x4 q_ = *vnl; vN[0][0] = q_.x; vN[0][1] = q_.y; vN[1][0] = q_.z; vN[1][1] = q_.w; } else { vN[0][0] = vA[0][0]; vN[0][1] = vA[0][1]; vN[1][0] = vA[1][0]; vN[1][1] = vA[1][1]; } }
            const size_t k1 = (size_t)(t + 1) * kstep, k2 = last ? (size_t)0 : (size_t)(t + 2) * kstep, k3 = k2 + kstep;
            const char* b2 = last ? nB : cB + (size_t)(t + 2) * kstep; const char* b3 = b2 + kstep;
            PG_LDB(B0, 0, 0); PG_LDB(B1, 0, 1); PG_SCHED; PG_LDA(At, 0, 0); PG_STA(PG_SA(1, 1), k1, 1, false);
            PG_WAIT_V(8); PG_WAIT_L(0); PG_BAR; PG_MMA(0, 0, At, B0); PG_MMA(0, 1, At, B1); PG_BAR; PG_SCHED;
            PG_LDA(At, 0, 1); PG_STAGE(PG_SB(0, 0), b2, voffB); PG_STAGE(PG_SB(0, 1), b2 + hstep, voffB); PG_STA(PG_SA(0, 0), k2, 0, last);
            PG_WAIT_V(8); PG_WAIT_L(0); PG_BAR; PG_MMA(1, 0, At, B0); PG_MMA(1, 1, At, B1); PG_BAR; PG_SCHED;
            PG_LDB(B0, 1, 0); PG_LDB(B1, 1, 1); PG_SCHED; PG_LDA(At, 1, 0); PG_STA(PG_SA(0, 1), k2, 1, last);
            PG_WAIT_V(8); PG_WAIT_L(0); PG_BAR; PG_MMA(0, 0, At, B0); PG_MMA(0, 1, At, B1); PG_BAR; PG_SCHED;
            PG_LDA(At, 1, 1); PG_STAGE(PG_SB(1, 0), b3, voffB); PG_STAGE(PG_SB(1, 1), b3 + hstep, voffB); PG_STA(PG_SA(1, 0), k3, 0, last);
            PG_WAIT_V(8); PG_WAIT_L(0); PG_BAR; PG_MMA(1, 0, At, B0); PG_MMA(1, 1, At, B1); PG_BAR; PG_SCHED;
        }
        if constexpr (ALIGN_EPI) { if (wr == 0) PG_BAR; }
        if constexpr (FP8) asm volatile("s_nop 15\n\ts_nop 15" ::: "memory");
#ifdef EPIPROBE
        const unsigned long long te0_ = __builtin_amdgcn_s_memrealtime();
#endif
        E(acc, cur, wr, wc, fr, fq);
#ifdef EPIPROBE
        if (g.tacc) { asm volatile("s_waitcnt vmcnt(0)" ::: "memory"); *g.tacc += __builtin_amdgcn_s_memrealtime() - te0_; }
#endif
        if (!has_next) break;
#pragma unroll
        for (int a = 0; a < 2; ++a)
#pragma unroll
            for (int b = 0; b < 2; ++b)
#pragma unroll
                for (int m = 0; m < 4; ++m)
#pragma unroll
                    for (int n = 0; n < 2; ++n) acc[a][b][m][n] = (f32x4){0.f, 0.f, 0.f, 0.f};
        cur = nxt; cB = nB; cA = nA; ++ui;
        if constexpr (GATHER) { const u32x4 q_ = *vnl; vA[0][0] = q_.x; vA[0][1] = q_.y; vA[1][0] = q_.z; vA[1][1] = q_.w; }
        if constexpr (ALIGN_EPI) { if (wr == 1) PG_BAR; }
    }
    PG_WAIT_V(0);
    if constexpr (!ALIGN_EPI) { if (wr == 0) PG_BAR; }
    PG_BAR;
#undef PG_SA
#undef PG_SB
#undef PG_STAGE
#undef PG_LDA
#undef PG_LDB
#undef PG_MMA
#undef PG_WAIT_V
#undef PG_WAIT_L
#undef PG_BAR
#undef PG_SCHED
#undef PG_SETA
#undef PG_STA
}
}

typedef f32x4 AccT[2][2][4][2];
__device__ __forceinline__ float ssq8(u32x4 a) { float s = 0.f;
#pragma unroll
    for (int i = 0; i < 4; ++i) { const float lo = bflo(a[i]), hi = bfhi(a[i]); s += lo * lo + hi * hi; } return s; }

__device__ __forceinline__ u32x4 pack8(f32x4 a, f32x4 b) { u32x4 w; w.x = cvtpk(a[0], a[1]); w.y = cvtpk(a[2], a[3]); w.z = cvtpk(b[0], b[1]); w.w = cvtpk(b[2], b[3]); return w; }

struct EpiProj {
    static constexpr bool PERM = true; bf16_t* O; float* part;
    __device__ __forceinline__ void operator()(const AccT& acc, const pg::Unit& u, int wr, int wc, int fr, int fq) const {
        const int row0 = u.pm * 256 + wr * 64 + fr, col0 = u.pn * 256 + wc * 32 + 8 * fq;
#pragma unroll
        for (int ai = 0; ai < 2; ++ai)
#pragma unroll
            for (int m = 0; m < 4; ++m) { const int row = row0 + ai * 128 + m * 16; bf16_t* rowp = O + (size_t)row * NPROJ + col0;
#pragma unroll
                for (int bj = 0; bj < 2; ++bj) { const u32x4 w = pack8(acc[ai][bj][m][0], acc[ai][bj][m][1]); *(u32x4*)(rowp + bj * 128) = w;
                    const int grp = 8 * u.pn + 4 * bj + wc;
                    if (grp < 20) {
                        float sq = ssq8(w); sq += __shfl_xor(sq, 16); sq += __shfl_xor(sq, 32);
                        if (fq == 0) part[(size_t)row * 20 + grp] = sq; } } }
    }
};
struct EpiQ {
    static constexpr bool PERM = true; bf16_t* O; const float* part; const float* cs; float scale; LAS float* rsl;
    __device__ __forceinline__ void operator()(const AccT& acc, const pg::Unit& u, int wr, int wc, int fr, int fq) const {
        const int row0 = u.pm * 256 + wr * 64 + fr;
        { const int t = (wr * 4 + wc) * 64 + fq * 16 + fr;
          if (t < 256) { const f32x4* pp = (const f32x4*)(part + (size_t)(u.pm * 256 + t) * 20); const f32x4 s0 = pp[0], s1 = pp[1], s2 = pp[2];
              rsl[t] = __builtin_amdgcn_rsqf((((s0[0] + s0[1]) + (s0[2] + s0[3])) + ((s1[0] + s1[1]) + (s1[2] + s1[3])) + ((s2[0] + s2[1]) + (s2[2] + s2[3]))) * (1.f / QLORA) + EPS) * scale; }
          asm volatile("s_waitcnt lgkmcnt(0)\n\ts_barrier" ::: "memory"); }
        const bool rope = ((8 * u.pn + wc) % 3) != 0;
        f32x4 cq[4], cn[4];
        if (rope) { const float* cr = cs + (size_t)row0 * 32 + 8 * (fq & 1); cq[0] = *(const f32x4*)cr; cq[1] = *(const f32x4*)(cr + 4); cq[2] = *(const f32x4*)(cr + 16); cq[3] = *(const f32x4*)(cr + 20); }
        else {
#pragma unroll
            for (int i = 0; i < 4; ++i) cq[i] = (f32x4){0.f, 0.f, 0.f, 0.f}; }
#pragma unroll
        for (int ai = 0; ai < 2; ++ai)
#pragma unroll
            for (int m = 0; m < 4; ++m) { const int row = row0 + ai * 128 + m * 16, k = ai * 4 + m;
                if (rope) { const int rn = (k < 7) ? row0 + ((k + 1) >> 2) * 128 + ((k + 1) & 3) * 16 : row; const float* cr = cs + (size_t)rn * 32 + 8 * (fq & 1);
                    cn[0] = *(const f32x4*)cr; cn[1] = *(const f32x4*)(cr + 4); cn[2] = *(const f32x4*)(cr + 16); cn[3] = *(const f32x4*)(cr + 20); }
                else {
#pragma unroll
                    for (int i = 0; i < 4; ++i) cn[i] = cq[i]; }
                const float rs = rsl[ai * 128 + wr * 64 + m * 16 + fr];
#pragma unroll
                for (int bj = 0; bj < 2; ++bj) { const int G = 8 * u.pn + 4 * bj + wc;
                    f32x4 v0 = acc[ai][bj][m][0] * rs, v1 = acc[ai][bj][m][1] * rs;
                    if ((G % 3) == 2) {
                        f32x4 p0, p1;
#pragma unroll
                        for (int j = 0; j < 4; ++j) { p0[j] = __shfl_xor(v0[j], 32); p1[j] = __shfl_xor(v1[j], 32); }
                        const f32x4 c0 = cq[0], c1 = cq[1], s0 = cq[2], s1 = cq[3];
                        if (fq < 2) { v0 = v0 * c0 - p0 * s0; v1 = v1 * c1 - p1 * s1; } else { v0 = v0 * c0 + p0 * s0; v1 = v1 * c1 + p1 * s1; }
                    }
                    *(u32x4*)(O + (size_t)row * 768 + 32 * G + 8 * fq) = pack8(v0, v1); }
#pragma unroll
                for (int i = 0; i < 4; ++i) cq[i] = cn[i];
                asm volatile("" ::: "memory"); }
    }
};
struct EpiKV {
    static constexpr bool PERM = true; bf16_t* Ko; bf16_t* Vo; const float* part; const bf16_t* proj; const float* cs; LAS float* rsl;
    __device__ __forceinline__ void operator()(const AccT& acc, const pg::Unit& u, int wr, int wc, int fr, int fq) const {
        const int row0 = u.pm * 256 + wr * 64 + fr;
        { const int t = (wr * 4 + wc) * 64 + fq * 16 + fr;
          if (t < 256) { const f32x4* pp = (const f32x4*)(part + (size_t)(u.pm * 256 + t) * 20 + 12); const f32x4 s0 = pp[0], s1 = pp[1];
              rsl[t] = __builtin_amdgcn_rsqf((((s0[0] + s0[1]) + (s0[2] + s0[3])) + ((s1[0] + s1[1]) + (s1[2] + s1[3]))) * (1.f / KVLORA) + EPS); }
          asm volatile("s_waitcnt lgkmcnt(0)\n\ts_barrier" ::: "memory"); }
#pragma unroll
        for (int ai = 0; ai < 2; ++ai)
#pragma unroll
            for (int m = 0; m < 4; ++m) { const int row = row0 + ai * 128 + m * 16;
                const float rs = rsl[ai * 128 + wr * 64 + m * 16 + fr];
#pragma unroll
                for (int bj = 0; bj < 2; ++bj) { const int G = 8 * u.pn + 4 * bj + wc, head = G >> 2, sub = G & 3;
                    bf16_t* dst = (sub < 2) ? Ko + (size_t)row * 768 + head * 96 + 32 * sub + 8 * fq : Vo + (size_t)row * 512 + head * 64 + 32 * (sub - 2) + 8 * fq;
                    *(u32x4*)dst = pack8(acc[ai][bj][m][0] * rs, acc[ai][bj][m][1] * rs); } }
        if (u.pn == 0) {
            const int lane = fq * 16 + fr, tid = (wr * 4 + wc) * 64 + lane, row = u.pm * 256 + (tid >> 1), half = tid & 1;
            const u32x4* src = (const u32x4*)(proj + (size_t)row * NPROJ + C_KPE + 16 * half); const u32x4 a = src[0], b = src[1];
            const f32x4* cp = (const f32x4*)(cs + (size_t)row * 32);
            float xv[16], pv[16], cc[16], ss[16];
#pragma unroll
            for (int i = 0; i < 4; ++i) { xv[2 * i] = bflo(a[i]); xv[2 * i + 1] = bfhi(a[i]); xv[8 + 2 * i] = bflo(b[i]); xv[8 + 2 * i + 1] = bfhi(b[i]);
                const f32x4 c4 = cp[i], s4 = cp[4 + i]; cc[4 * i] = c4[0]; cc[4 * i + 1] = c4[1]; cc[4 * i + 2] = c4[2]; cc[4 * i + 3] = c4[3]; ss[4 * i] = s4[0]; ss[4 * i + 1] = s4[1]; ss[4 * i + 2] = s4[2]; ss[4 * i + 3] = s4[3]; }
#pragma unroll
            for (int j = 0; j < 16; ++j) pv[j] = __shfl_xor(xv[j], 1);
            float o[16];
#pragma unroll
            for (int j = 0; j < 16; ++j) o[j] = (half == 0) ? xv[j] * cc[j] - pv[j] * ss[j] : xv[j] * cc[j] + pv[j] * ss[j];
            u32x4 w0, w1;
#pragma unroll
            for (int i = 0; i < 4; ++i) { w0[i] = cvtpk(o[2 * i], o[2 * i + 1]); w1[i] = cvtpk(o[8 + 2 * i], o[8 + 2 * i + 1]); }
#pragma unroll
            for (int h = 0; h < NH; ++h) { bf16_t* d = Ko + (size_t)row * 768 + h * 96 + 64 + 16 * half; *(u32x4*)d = w0; *(u32x4*)(d + 8) = w1; }
        }
    }
};
struct EpiX1 {
    static constexpr bool PERM = false; const float* x; const float* mod; float* O;
    __device__ __forceinline__ void operator()(const AccT& acc, const pg::Unit& u, int wr, int wc, int fr, int fq) const {
        const int row0 = u.pm * 256 + wr * 64 + fr, col0 = u.pn * 256 + wc * 32 + 4 * fq;
        const float* gt = mod + (size_t)(u.pm * 256 / SEQ) * 6144 + 2048 + col0;
        f32x4 gv[2][2];
#pragma unroll
        for (int bj = 0; bj < 2; ++bj)
#pragma unroll
            for (int n = 0; n < 2; ++n) gv[bj][n] = *(const f32x4*)(gt + bj * 128 + n * 16);
#pragma unroll
        for (int ai = 0; ai < 2; ++ai)
#pragma unroll
            for (int m = 0; m < 4; ++m) { const size_t off = (size_t)(row0 + ai * 128 + m * 16) * DM + col0;
#pragma unroll
                for (int bj = 0; bj < 2; ++bj)
#pragma unroll
                    for (int n = 0; n < 2; ++n) { const f32x4 xv = *(const f32x4*)(x + off + bj * 128 + n * 16); *(f32x4*)(O + off + bj * 128 + n * 16) = xv + gv[bj][n] * acc[ai][bj][m][n]; } }
    }
};
__device__ __forceinline__ f32x2 pk_fma(f32x2 a, f32x2 b, f32x2 c) { return __builtin_elementwise_fma(a, b, c); }
__device__ __forceinline__ f32x2 pk_mul(f32x2 a, f32x2 b) { return a * b; }
__device__ __forceinline__ f32x2 pk_add(f32x2 a, f32x2 b) { return a + b; }
__device__ __forceinline__ float vmin_asm(float a, float b) { float r; asm("v_min_f32 %0, %1, %2" : "=v"(r) : "v"(a), "v"(b)); return r; }
__device__ __forceinline__ float vmed3_asm(float a, float b, float c) { float r; asm("v_med3_f32 %0, %1, %2, %3" : "=v"(r) : "v"(a), "v"(b), "v"(c)); return r; }
struct EpiGU {
    static constexpr bool PERM = true; unsigned char* O; const float* bias;
    __device__ __forceinline__ void operator()(const AccT& acc, const pg::Unit& u, int wr, int wc, int fr, int fq) const {
        const int row0 = u.pm * 256 + wr * 64 + fr, gcol = u.pn * 128 + wc * 32 + 8 * fq;
        const float* bp = bias + (size_t)u.e * 2048 + gcol;
        const f32x4 bg0 = *(const f32x4*)bp, bg1 = *(const f32x4*)(bp + 4), bu0 = *(const f32x4*)(bp + 1024) + 1.0f, bu1 = *(const f32x4*)(bp + 1028) + 1.0f;
        const f32x2 kw = {1.0f / W8, 1.0f / W8}, kc = {-1.702f * 1.4426950408889634f, -1.702f * 1.4426950408889634f}, one = {1.0f, 1.0f}; const float c7 = 7.0f, cm6 = -6.0f, c8 = 8.0f;
#pragma unroll
        for (int ai = 0; ai < 2; ++ai) { u32x2 wprev = {0u, 0u};
#pragma unroll
            for (int m = 0; m < 4; ++m) {
                f32x2 r[2][2];
#pragma unroll
                for (int n = 0; n < 2; ++n)
#pragma unroll
                    for (int p = 0; p < 2; ++p) { const f32x4 ag = acc[ai][0][m][n], au = acc[ai][1][m][n], bg = n ? bg1 : bg0, bu = n ? bu1 : bu0;
                        f32x2 g = pk_fma((f32x2){ag[2 * p], ag[2 * p + 1]}, kw, (f32x2){bg[2 * p], bg[2 * p + 1]}), up1 = pk_fma((f32x2){au[2 * p], au[2 * p + 1]}, kw, (f32x2){bu[2 * p], bu[2 * p + 1]});
                        g[0] = vmin_asm(g[0], c7); g[1] = vmin_asm(g[1], c7); up1[0] = vmed3_asm(up1[0], cm6, c8); up1[1] = vmed3_asm(up1[1], cm6, c8);
                        f32x2 e = pk_mul(g, kc); e[0] = __builtin_amdgcn_exp2f(e[0]); e[1] = __builtin_amdgcn_exp2f(e[1]);
                        f32x2 d = pk_add(e, one); d[0] = __builtin_amdgcn_rcpf(d[0]); d[1] = __builtin_amdgcn_rcpf(d[1]);
                        r[n][p] = pk_mul(pk_mul(up1, g), d); }
                u32x2 w; w.x = pk4_fp8(r[0][0][0], r[0][0][1], r[0][1][0], r[0][1][1]); w.y = pk4_fp8(r[1][0][0], r[1][0][1], r[1][1][0], r[1][1][1]);
                if ((m & 1) == 0) wprev = w;
                else { const bool odd = (fq & 1) != 0; const u32x2 give = odd ? wprev : w; u32x2 got; got.x = (unsigned)__shfl_xor((int)give.x, 16); got.y = (unsigned)__shfl_xor((int)give.y, 16);
                    const u32x4 o4 = odd ? (u32x4){got.x, got.y, w.x, w.y} : (u32x4){wprev.x, wprev.y, got.x, got.y};
                    *(u32x4*)(O + (size_t)(row0 + ai * 128 + (odd ? m : m - 1) * 16) * DE + (gcol & ~8)) = o4; } } }
    }
};
struct EpiDN {
    static constexpr bool PERM = true; unsigned char* O; const float* bias;
    __device__ __forceinline__ void operator()(const AccT& acc, const pg::Unit& u, int wr, int wc, int fr, int fq) const {
        const int row0 = u.pm * 256 + wr * 64 + fr, col0 = u.pn * 256 + wc * 32 + 8 * fq;
        const float* bp = bias + (size_t)u.e * DM + col0;
        f32x4 bv[2][2];
#pragma unroll
        for (int bj = 0; bj < 2; ++bj) { bv[bj][0] = *(const f32x4*)(bp + bj * 128); bv[bj][1] = *(const f32x4*)(bp + bj * 128 + 4); }
#pragma unroll
        for (int ai = 0; ai < 2; ++ai) { u32x2 wprev[2] = {{0u, 0u}, {0u, 0u}};
#pragma unroll
            for (int m = 0; m < 4; ++m) {
#pragma unroll
                for (int bj = 0; bj < 2; ++bj) { const f32x4 v0 = acc[ai][bj][m][0] * (1.0f / W8) + bv[bj][0], v1 = acc[ai][bj][m][1] * (1.0f / W8) + bv[bj][1];
                    u32x2 w; w.x = pk4_fp8(v0[0], v0[1], v0[2], v0[3]); w.y = pk4_fp8(v1[0], v1[1], v1[2], v1[3]);
                    if ((m & 1) == 0) wprev[bj] = w;
                    else { const bool odd = (fq & 1) != 0; const u32x2 give = odd ? wprev[bj] : w; u32x2 got; got.x = (unsigned)__shfl_xor((int)give.x, 16); got.y = (unsigned)__shfl_xor((int)give.y, 16);
                        const u32x4 o4 = odd ? (u32x4){got.x, got.y, w.x, w.y} : (u32x4){wprev[bj].x, wprev[bj].y, got.x, got.y};
                        *(u32x4*)(O + (size_t)(row0 + ai * 128 + (odd ? m : m - 1) * 16) * DM + (col0 & ~8) + bj * 128) = o4; } } } }
    }
};

constexpr int NWAVES = 8;
enum { IN_X = 0, IN_C, IN_POS, IN_ADAW, IN_ADAB, IN_N1G, IN_WIN, IN_QNG, IN_WQB, IN_KVNG, IN_WKVB, IN_MLAOG, IN_CONVW, IN_ALOG, IN_DTB, IN_GDNG, IN_WOUT, IN_N2G, IN_RW, IN_RB, IN_WGU, IN_BGU, IN_WDN, IN_BDN, IN_FG, N_IN };
struct Frame {
    LAS unsigned char* lds; volatile LAS unsigned* MISC; unsigned* ctl; unsigned char* ws;
    int tid, lane, wave, G, vcu;
    const float* in[N_IN]; float* out;
};
#define WSP(T_, off) ((T_*)(F.ws + (off)))

constexpr int P0_MODWG = 48;
__device__ __forceinline__ void p0_mod(Frame& F) {
    LAS float* cact = (LAS float*)F.lds;
    LAS float* red = (LAS float*)(F.lds + 32768);
    const float* c = F.in[IN_C];
    int td = F.tid; asm volatile("" : "+v"(td));
    for (int i = td; i < BATCH * DM; i += NWAVES * 64) cact[i] = siluf(c[i]);
    __syncthreads();
    float* mod = WSP(float, WS_MOD);
    int ln = F.lane; asm volatile("" : "+v"(ln));
    const int g = (int)blockIdx.x, w = F.wave, kh = ln >> 5, c4 = ln & 31, kb = 128 * w + 64 * kh;
    const float* wp = F.in[IN_ADAW] + (size_t)kb * 6144 + 128 * g + 4 * c4;
    f32x4 a[8];
#pragma unroll
    for (int b = 0; b < 8; ++b) a[b] = (f32x4){0.f, 0.f, 0.f, 0.f};
#pragma unroll 1
    for (int i0 = 0; i0 < 64; i0 += 8) {
        f32x4 wv[8];
#pragma unroll
        for (int i = 0; i < 8; ++i) wv[i] = *(const f32x4*)(wp + (size_t)(i0 + i) * 6144);
#pragma unroll
        for (int i4 = 0; i4 < 8; i4 += 4)
#pragma unroll
            for (int b = 0; b < 8; ++b) { const f32x4 cv = *(const LAS f32x4*)(cact + b * DM + kb + i0 + i4);
                a[b] += wv[i4] * cv[0]; a[b] += wv[i4 + 1] * cv[1]; a[b] += wv[i4 + 2] * cv[2]; a[b] += wv[i4 + 3] * cv[3]; }
    }
#pragma unroll
    for (int b = 0; b < 8; ++b)
#pragma unroll
        for (int e = 0; e < 4; ++e) a[b][e] += __shfl_xor(a[b][e], 32);
    if (kh == 0) {
#pragma unroll
        for (int b = 0; b < 8; ++b) *(LAS f32x4*)(red + (w * 8 + b) * 128 + 4 * c4) = a[b]; }
    __syncthreads();
    for (int o = td; o < 8 * 128; o += NWAVES * 64) { const int b = o >> 7, col = o & 127; float sum = 0.f;
#pragma unroll
        for (int w8 = 0; w8 < 8; ++w8) sum += red[(w8 * 8 + b) * 128 + col];
        mod[b * 6144 + 128 * g + col] = sum + F.in[IN_ADAB][128 * g + col]; }
}
template <int MAP, bool FP8 = false>
__device__ __forceinline__ void p0_tr_item(const float* W, int K, int N, int NP, void* WTv, const float* ksc, LAS float* scr, int item, int lane, int kscn = 1 << 30) {
    bf16_t* WT = (bf16_t*)WTv;
    const int nblk = NP / 32, kb = item / nblk, nb = item % nblk, k0 = 64 * kb, n0 = 32 * nb;
    f32x4 ld[8];
#pragma unroll
    for (int j = 0; j < 8; ++j) { const int idx = j * 64 + lane, kk = idx >> 3, nn = n0 + 4 * (idx & 7); ld[j] = (nn < N) ? *(const f32x4*)(W + (size_t)(k0 + kk) * N + nn) : (f32x4){0.f, 0.f, 0.f, 0.f}; }
#pragma unroll
    for (int j = 0; j < 8; ++j) { const int idx = j * 64 + lane, kk = idx >> 3, c4 = idx & 7; f32x4 v = ld[j]; if (ksc && k0 + kk < kscn) v = v * ksc[k0 + kk];
        LAS float* d = scr + kk * 33 + 4 * c4; d[0] = v[0]; d[1] = v[1]; d[2] = v[2]; d[3] = v[3]; }
    LDS_WAIT(); asm volatile("" ::: "memory");
    const int c = lane & 7;
#pragma unroll
    for (int j = 0; j < 4; ++j) { const int n = (lane >> 3) + 8 * j; const LAS float* s = scr + (8 * c) * 33 + n;
        u32x4 o; o.x = cvtpk(s[0 * 33], s[1 * 33]); o.y = cvtpk(s[2 * 33], s[3 * 33]); o.z = cvtpk(s[4 * 33], s[5 * 33]); o.w = cvtpk(s[6 * 33], s[7 * 33]);
        int dn = n0 + n;
        if (MAP == 1) { const int half = dn >> 10, r = dn & 1023; dn = ((r >> 7) << 8) + (half << 7) + (r & 127); }
        if constexpr (FP8) { u32x2 o8; o8.x = pk4_fp8(s[0 * 33] * W8, s[1 * 33] * W8, s[2 * 33] * W8, s[3 * 33] * W8); o8.y = pk4_fp8(s[4 * 33] * W8, s[5 * 33] * W8, s[6 * 33] * W8, s[7 * 33] * W8);
            *(GAS u32x2*)((unsigned char*)WTv + (size_t)dn * K + k0 + 8 * c) = o8; }
        else *(GAS u32x4*)(WT + (size_t)dn * K + k0 + 8 * c) = o; }
    LDS_WAIT(); asm volatile("" ::: "memory");
}
__device__ __forceinline__ void p0_weights(Frame& F) {
    LAS float* scr = (LAS float*)(F.lds + 49152 + F.wave * 8704);
    int ln = F.lane, td = F.tid; asm volatile("" : "+v"(ln), "+v"(td));
    const int gw = ((int)blockIdx.x - P0_MODWG) * NWAVES + F.wave, NGW = (F.G - P0_MODWG) * NWAVES;
    constexpr int I_IN = (DM / 64) * (NPROJ / 32), I_Q = (QLORA / 64) * (768 / 32), I_KV = (KVLORA / 64) * (1024 / 32), I_O = (DM / 64) * (DM / 32);
    constexpr int I_GU = (DM / 64) * (2048 / 32), I_DN = (DE / 64) * (DM / 32);
    constexpr int P_GU = I_GU / 2, P_DN = I_DN / 2;
    constexpr int NITEMS = I_IN + I_Q + I_KV + I_O;
    for (int it = gw; it < NITEMS; it += NGW) {
        int r = it;
        if (r < I_IN) { p0_tr_item<0>(F.in[IN_WIN], DM, IN_DIM, NPROJ, WSP(bf16_t, WS_WIN), nullptr, scr, r, ln); continue; } r -= I_IN;
        if (r < I_Q) { p0_tr_item<0>(F.in[IN_WQB], QLORA, 768, 768, WSP(bf16_t, WS_WQ), F.in[IN_QNG], scr, r, ln); continue; } r -= I_Q;
        if (r < I_KV) { p0_tr_item<0>(F.in[IN_WKVB], KVLORA, 1024, 1024, WSP(bf16_t, WS_WKV), F.in[IN_KVNG], scr, r, ln); continue; } r -= I_KV;
        if (r < I_O) { p0_tr_item<0>(F.in[IN_WOUT], DM, DM, DM, WSP(bf16_t, WS_WO), F.in[IN_MLAOG], scr, r, ln, 512); continue; } r -= I_O;
        (void)scr;
    }
    float* rwt = WSP(float, WS_RWT);
    for (int i = ((int)blockIdx.x - P0_MODWG) * NWAVES * 64 + td; i < NE * DM; i += (F.G - P0_MODWG) * NWAVES * 64) { const int e = i >> 10, k = i & 1023; rwt[i] = F.in[IN_RW][k * NE + e]; }
}

template <int MAP>
__device__ __forceinline__ void p0_tr_pair8(const float* W, int K, int N, unsigned char* WT8, LAS float* scr, int kp, int nb, int lane) {
    const int k0 = 128 * kp, n0 = 32 * nb;
    f32x4 ld[16];
#pragma unroll
    for (int j = 0; j < 16; ++j) { const int idx = j * 64 + lane, kk = idx >> 3, nn = n0 + 4 * (idx & 7); ld[j] = *(const f32x4*)(W + (size_t)(k0 + kk) * N + nn); }
#pragma unroll
    for (int hk = 0; hk < 2; ++hk) {
#pragma unroll
        for (int j = 0; j < 8; ++j) { const int idx = j * 64 + lane, kk = idx >> 3, c4 = idx & 7; const f32x4 v = ld[hk * 8 + j];
            LAS float* d = scr + kk * 33 + 4 * c4; d[0] = v[0]; d[1] = v[1]; d[2] = v[2]; d[3] = v[3]; }
        LDS_WAIT(); asm volatile("" ::: "memory");
        const int c = lane & 7;
#pragma unroll
        for (int j = 0; j < 4; ++j) { const int n = (lane >> 3) + 8 * j; const LAS float* s = scr + (8 * c) * 33 + n;
            int dn = n0 + n;
            if (MAP == 1) { const int half = dn >> 10, r = dn & 1023; dn = ((r >> 7) << 8) + (half << 7) + (r & 127); }
            u32x2 o8; o8.x = pk4_fp8(s[0 * 33] * W8, s[1 * 33] * W8, s[2 * 33] * W8, s[3 * 33] * W8); o8.y = pk4_fp8(s[4 * 33] * W8, s[5 * 33] * W8, s[6 * 33] * W8, s[7 * 33] * W8);
            *(GAS u32x2*)(WT8 + (size_t)dn * K + k0 + 64 * hk + 8 * c) = o8; }
        LDS_WAIT(); asm volatile("" ::: "memory");
    }
}
constexpr int MOE_CONV_ITEMS = 2 * (NE * 8 + NE * 4);
__device__ __forceinline__ void moe_conv_item(Frame& F, int hitem) {
    const int lane = F.lane, w = F.wave, item = hitem >> 1, kt0 = (hitem & 1) * 4;
    const float* W; unsigned char* O; int N, n0; bool gu;
    if (item < NE * 8) { const int e = item >> 3, nb = item & 7; W = F.in[IN_WGU] + (size_t)e * DM * 2048; O = WSP(unsigned char, WS_WGU) + (size_t)e * 2048 * DM; N = 2048; n0 = 256 * nb; gu = true; }
    else { const int r = item - NE * 8, e = r >> 2, nb = r & 3; W = F.in[IN_WDN] + (size_t)e * DE * DM; O = WSP(unsigned char, WS_WDN) + (size_t)e * DM * DE; N = 1024; n0 = 256 * nb; gu = false; }
    const float* src = W + (size_t)(16 * w) * N + n0 + 4 * lane;
    f32x4 ra[16], rb[16];
#define CV_LOAD(R, kt) do { _Pragma("unroll") for (int j_ = 0; j_ < 16; ++j_) R[j_] = *(const f32x4*)(src + (size_t)(128 * (kt) + j_) * N); } while (0)
#define CV_PROC(R, kt, buf) do { LAS unsigned char* T_ = F.lds + (buf) * 32768; \
        _Pragma("unroll") for (int e_ = 0; e_ < 4; ++e_) { u32x4 p_; \
            _Pragma("unroll") for (int q_ = 0; q_ < 4; ++q_) p_[q_] = pk4_fp8(R[4 * q_][e_] * W8, R[4 * q_ + 1][e_] * W8, R[4 * q_ + 2][e_] * W8, R[4 * q_ + 3][e_] * W8); \
            *(LAS u32x4*)(T_ + (4 * lane + e_) * 128 + ((w ^ (lane & 7)) << 4)) = p_; } \
        LBAR(); \
        _Pragma("unroll") for (int i_ = 0; i_ < 4; ++i_) { const int n_ = 32 * w + 8 * i_ + (lane >> 3), kb_ = lane & 7; \
            const u32x4 v_ = *(const LAS u32x4*)(T_ + n_ * 128 + ((kb_ ^ ((n_ >> 2) & 7)) << 4)); int dn_ = n0 + n_; \
            if (gu) { const int half_ = dn_ >> 10, r_ = dn_ & 1023; dn_ = ((r_ >> 7) << 8) + (half_ << 7) + (r_ & 127); }        \
            *(u32x4*)(O + (size_t)dn_ * 1024 + 128 * (kt) + 16 * kb_) = v_; } } while (0)
    CV_LOAD(ra, kt0);
#pragma unroll 1
    for (int kt = kt0; kt < kt0 + 4; kt += 2) {
        CV_LOAD(rb, kt + 1); CV_PROC(ra, kt, 0);
        if (kt + 2 < kt0 + 4) CV_LOAD(ra, kt + 2);
        CV_PROC(rb, kt + 1, 1);
    }
#undef CV_LOAD
#undef CV_PROC
}

__device__ const float ROPE_INVF[16] = {1.0f, 0.5623413251903491f, 0.31622776601683794f, 0.1778279410038923f, 0.1f, 0.05623413251903491f, 0.03162277660168379f, 0.01778279410038923f,
    0.01f, 0.005623413251903491f, 0.003162277660168379f, 0.0017782794100389228f, 0.001f, 0.0005623413251903491f, 0.00031622776601683794f, 0.00017782794100389227f};
__device__ __forceinline__ void norm_rows(Frame& F, const float* x, const float* gain, int SH, int SC, bf16_t* outp) {
    const int gw = F.vcu * NWAVES + F.wave, NGW = F.G * NWAVES;
    const float* mod = WSP(float, WS_MOD);
    constexpr int R = 4;
    for (int m0 = gw; m0 < T; m0 += R * NGW) {
        f32x4 v[R][4]; float s[R];
#pragma unroll
        for (int r = 0; r < R; ++r) { const int m = m0 + r * NGW; s[r] = 0.f; if (m < T) { const f32x4* xr = (const f32x4*)(x + (size_t)m * DM) + F.lane;
#pragma unroll
            for (int j = 0; j < 4; ++j) v[r][j] = xr[64 * j]; } else {
#pragma unroll
            for (int j = 0; j < 4; ++j) v[r][j] = (f32x4){0.f, 0.f, 0.f, 0.f}; } }
#pragma unroll
        for (int r = 0; r < R; ++r)
#pragma unroll
            for (int j = 0; j < 4; ++j) s[r] += (v[r][j][0] * v[r][j][0] + v[r][j][1] * v[r][j][1]) + (v[r][j][2] * v[r][j][2] + v[r][j][3] * v[r][j][3]);
#pragma unroll
        for (int o = 1; o < 64; o <<= 1)
#pragma unroll
            for (int r = 0; r < R; ++r) s[r] += __shfl_xor(s[r], o);
#pragma unroll
        for (int r = 0; r < R; ++r) { const int m = m0 + r * NGW; if (m >= T) continue;
            {
              const float ang = (float)((const int*)F.in[IN_POS])[m] * ROPE_INVF[F.lane & 15];
              const double rev = (double)ang * 0.15915494309189535; const float fr_ = (float)(rev - __builtin_rint(rev));
              if (F.lane < 16) { float* cs = WSP(float, WS_CS) + (size_t)m * 32; cs[F.lane] = __builtin_amdgcn_cosf(fr_); cs[16 + F.lane] = __builtin_amdgcn_sinf(fr_); } }
            const float rstd = __builtin_amdgcn_rsqf(s[r] * (1.f / DM) + EPS); const float* mb = mod + (size_t)(m / SEQ) * 6144;
            u32x2* o8 = (u32x2*)(outp + (size_t)m * DM) + F.lane;
#pragma unroll
            for (int j = 0; j < 4; ++j) { const int col = 4 * (F.lane + 64 * j);
                const f32x4 g = *(const f32x4*)(gain + col), sc = *(const f32x4*)(mb + SC + col), sh = *(const f32x4*)(mb + SH + col);
                const f32x4 h = v[r][j] * rstd * g * (sc + 1.0f) + sh; u32x2 w; w.x = cvtpk(h[0], h[1]); w.y = cvtpk(h[2], h[3]); o8[64 * j] = w; } }
    }
}

__device__ __forceinline__ void p1_norm(Frame& F) {
    const int tpw = T / F.G, t0 = (int)blockIdx.x * tpw, lane = F.lane;
    LAS float* gml = (LAS float*)F.lds;
    const float* x = F.in[IN_X]; bf16_t* outp = WSP(bf16_t, WS_H);
    { const float* mb = WSP(float, WS_MOD) + (size_t)(t0 / SEQ) * 6144;
      for (int i = F.tid; i < DM; i += NWAVES * 64) { gml[i] = F.in[IN_N1G][i] * (1.0f + mb[1024 + i]); gml[DM + i] = mb[i]; } }
    constexpr int R = 4;
    const int rpw = tpw / NWAVES, mb0 = t0 + F.wave * rpw, mend = mb0 + rpw;
    f32x4 v[R][4];
#pragma unroll
    for (int r = 0; r < R; ++r) { const int m = (mb0 + r < mend) ? mb0 + r : mb0; const f32x4* xr = (const f32x4*)(x + (size_t)m * DM) + lane;
#pragma unroll
        for (int j = 0; j < 4; ++j) v[r][j] = __builtin_nontemporal_load(xr + 64 * j); }
    __syncthreads();
    for (int m0 = mb0; m0 < mend; m0 += R) {
        f32x4 nv[R][4];
#pragma unroll
        for (int r = 0; r < R; ++r) { const int m = (m0 + R + r < mend) ? m0 + R + r : mb0; const f32x4* xr = (const f32x4*)(x + (size_t)m * DM) + lane;
#pragma unroll
            for (int j = 0; j < 4; ++j) nv[r][j] = __builtin_nontemporal_load(xr + 64 * j); }
        float s[R];
#pragma unroll
        for (int r = 0; r < R; ++r) { s[r] = 0.f;
#pragma unroll
            for (int j = 0; j < 4; ++j) s[r] += (v[r][j][0] * v[r][j][0] + v[r][j][1] * v[r][j][1]) + (v[r][j][2] * v[r][j][2] + v[r][j][3] * v[r][j][3]); }
#pragma unroll
        for (int o = 1; o < 64; o <<= 1)
#pragma unroll
            for (int r = 0; r < R; ++r) s[r] += __shfl_xor(s[r], o);
#pragma unroll
        for (int r = 0; r < R; ++r) { const int m = m0 + r; if (m >= mend) continue;
            {
              const float ang = (float)((const int*)F.in[IN_POS])[m] * ROPE_INVF[lane & 15];
              const double rev = (double)ang * 0.15915494309189535; const float fr_ = (float)(rev - __builtin_rint(rev));
              if (lane < 16) { float* cs = WSP(float, WS_CS) + (size_t)m * 32; cs[lane] = __builtin_amdgcn_cosf(fr_); cs[16 + lane] = __builtin_amdgcn_sinf(fr_); } }
            const float rstd = __builtin_amdgcn_rsqf(s[r] * (1.f / DM) + EPS);
            u32x2* o8 = (u32x2*)(outp + (size_t)m * DM) + lane;
#pragma unroll
            for (int j = 0; j < 4; ++j) { const LAS f32x4* gp = (const LAS f32x4*)gml + lane + 64 * j; const f32x4 g = gp[0], sh = gp[DM / 4];
                const f32x4 h = v[r][j] * rstd * g + sh; u32x2 w; w.x = cvtpk(h[0], h[1]); w.y = cvtpk(h[2], h[3]); o8[64 * j] = w; } }
#pragma unroll
        for (int r = 0; r < R; ++r)
#pragma unroll
            for (int j = 0; j < 4; ++j) v[r][j] = nv[r][j];
    }
    __syncthreads();
}

__device__ __forceinline__ void p3a_rows(Frame& F) {
    const int gw = F.vcu * NWAVES + F.wave, NGW = F.G * NWAVES, lane = F.lane;
    const bf16_t* proj = WSP(bf16_t, WS_PROJ); float* rsq = WSP(float, WS_RSQ); float* rskv = WSP(float, WS_RSKV); float* cs = WSP(float, WS_CS); bf16_t* Kb = WSP(bf16_t, WS_K);
    const int* pos = (const int*)F.in[IN_POS];
    constexpr int R = 4;
    for (int m0 = gw; m0 < T; m0 += R * NGW) {
        u32x4 a[R], b[R]; int ps[R];
#pragma unroll
        for (int r = 0; r < R; ++r) { const int m = (m0 + r * NGW < T) ? m0 + r * NGW : m0; const u32x4* pr = (const u32x4*)(proj + (size_t)m * NPROJ);
            a[r] = pr[lane]; b[r] = (u32x4){0u, 0u, 0u, 0u}; if (lane < 20) b[r] = pr[64 + lane]; ps[r] = pos[m]; }
#pragma unroll
        for (int r = 0; r < R; ++r) { const int m = m0 + r * NGW; if (m >= T) continue;
            const float sa = ssq8(a[r]), sb = ssq8(b[r]);
            const float sq = wave_sum(lane < 48 ? sa : 0.f), skv = wave_sum((lane >= 48 ? sa : 0.f) + (lane < 16 ? sb : 0.f));
            if (lane == 0) { rsq[m] = __builtin_amdgcn_rsqf(sq * (1.f / QLORA) + EPS); rskv[m] = __builtin_amdgcn_rsqf(skv * (1.f / KVLORA) + EPS); }
            const float ang = (float)ps[r] * ROPE_INVF[lane & 15];
            const double rev = (double)ang * 0.15915494309189535; const float fr = (float)(rev - __builtin_rint(rev));
            const float cv = __builtin_amdgcn_cosf(fr), sv = __builtin_amdgcn_sinf(fr);
            if (lane < 16) { cs[(size_t)m * 32 + lane] = cv; cs[(size_t)m * 32 + 16 + lane] = sv; }
            float xv[8], pv[8], cc[8], ss[8];
#pragma unroll
            for (int i = 0; i < 4; ++i) { xv[2 * i] = bflo(b[r][i]); xv[2 * i + 1] = bfhi(b[r][i]); }
            const int i0 = 8 * (lane & 1);
#pragma unroll
            for (int j = 0; j < 8; ++j) { pv[j] = __shfl_xor(xv[j], 2); cc[j] = __shfl(cv, i0 + j); ss[j] = __shfl(sv, i0 + j); }
            if (lane >= 16 && lane < 20) {
                float o[8];
#pragma unroll
                for (int j = 0; j < 8; ++j) o[j] = (lane < 18) ? xv[j] * cc[j] - pv[j] * ss[j] : xv[j] * cc[j] + pv[j] * ss[j];
                u32x4 w; w.x = cvtpk(o[0], o[1]); w.y = cvtpk(o[2], o[3]); w.z = cvtpk(o[4], o[5]); w.w = cvtpk(o[6], o[7]);
#pragma unroll
                for (int h = 0; h < NH; ++h) *(u32x4*)(Kb + (size_t)m * 768 + h * 96 + 64 + 8 * (lane - 16)) = w;
            } }
    }
}

__device__ __forceinline__ int crow(int r, int hi) { return (r & 3) + 8 * (r >> 2) + 4 * hi; }
__device__ __forceinline__ float max3f(float a, float b, float c) { float r; asm("v_max3_f32 %0, %1, %2, %3" : "=v"(r) : "v"(a), "v"(b), "v"(c)); return r; }
typedef short v4i16_t __attribute__((ext_vector_type(4)));
constexpr float AT_THR = 6.0f;
constexpr int AT_KROW = 208, AT_VROW = 144, AT_KBUF = 64 * AT_KROW, AT_VBUF = 64 * AT_VROW, AT_V0 = 2 * AT_KBUF, AT_WS = AT_V0 + 2 * AT_VBUF;
__device__ __forceinline__ void attn_unit(Frame& F, int b, int h, int qb) {
    const int tid = F.tid, lane = F.lane, wid = F.wave, r32 = lane & 31, hi = lane >> 5;
    const bf16_t* Qg = WSP(bf16_t, WS_Q); const bf16_t* Kg = WSP(bf16_t, WS_K); const bf16_t* Vg = WSP(bf16_t, WS_V); bf16_t* Og = WSP(bf16_t, WS_OA);
    LAS unsigned char* Kl = F.lds; LAS unsigned char* Vl = F.lds + AT_V0; LAS float* wsf = (LAS float*)(F.lds + AT_WS) + wid * 64;
    const size_t tb = (size_t)b * SEQ; const int q0 = qb * 256, NT = 4 * qb + 4;
    bf16x8 qr[6];
    { const bf16_t* Qp = Qg + (tb + q0 + wid * 32 + r32) * 768 + h * 96 + hi * 8;
#pragma unroll
      for (int d0 = 0; d0 < 6; ++d0) qr[d0] = *(const bf16x8*)(Qp + d0 * 16); }
    unsigned kvo[2], vvo[2];
#pragma unroll
    for (int i = 0; i < 2; ++i) { const int ok = (wid + 8 * i) * 1024 + 16 * lane, kr = ok / AT_KROW, kc = (ok % AT_KROW) >> 4; kvo[i] = (unsigned)((kr < 64 ? kr : 63) * 1536 + (kc < 12 ? kc : 0) * 16);
        const int ov = (wid + 8 * i) * 1024 + 16 * lane, vr = ov / AT_VROW, vc = (ov % AT_VROW) >> 4; vvo[i] = (unsigned)((vr < 64 ? vr : 63) * 1024 + (vc < 8 ? vc : 0) * 16); }
    const unsigned kl0 = (unsigned)__builtin_amdgcn_readfirstlane((int)((unsigned)(uintptr_t)Kl + (unsigned)wid * 1024u)), vl0 = (unsigned)__builtin_amdgcn_readfirstlane((int)((unsigned)(uintptr_t)Vl + (unsigned)wid * 1024u));
    const char* kg0 = (const char*)(Kg + tb * 768 + h * 96); const char* vg0 = (const char*)(Vg + tb * 512 + h * 64);
#define AT_DMAK(t, bf) do { pg::glds16s(kg0 + (size_t)(t) * 64 * 1536, kvo[0], kl0 + (unsigned)((bf) * AT_KBUF)); if (wid < 5) pg::glds16s(kg0 + (size_t)(t) * 64 * 1536, kvo[1], kl0 + (unsigned)((bf) * AT_KBUF + 8192)); } while (0)
#define AT_DMAV(t, bf) do { pg::glds16s(vg0 + (size_t)(t) * 64 * 1024, vvo[0], vl0 + (unsigned)((bf) * AT_VBUF)); if (wid == 0) pg::glds16s(vg0 + (size_t)(t) * 64 * 1024, vvo[1], vl0 + (unsigned)((bf) * AT_VBUF + 8192)); } while (0)
#define AT_QK(P0, P1, bf) do { _Pragma("unroll") for (int r = 0; r < 16; ++r) { P0[r] = 0.f; P1[r] = 0.f; } \
        const LAS unsigned char* kb_ = Kl + (bf) * AT_KBUF + r32 * AT_KROW + hi * 16; \
        _Pragma("unroll") for (int d0 = 0; d0 < 6; ++d0) { const bf16x8 k0 = *(const LAS bf16x8*)(kb_ + d0 * 32), k1 = *(const LAS bf16x8*)(kb_ + 32 * AT_KROW + d0 * 32); \
            P0 = __builtin_amdgcn_mfma_f32_32x32x16_bf16(k0, qr[d0], P0, 0, 0, 0); P1 = __builtin_amdgcn_mfma_f32_32x32x16_bf16(k1, qr[d0], P1, 0, 0, 0); } } while (0)
#define AT_SPV(P0, P1, t, bf) do { \
        if ((t) >= NT - 4) { _Pragma("unroll") for (int r = 0; r < 16; ++r) { const int kv = 64 * (t) + crow(r, hi); if (kv > qpos) P0[r] = -INFINITY; if (kv + 32 > qpos) P1[r] = -INFINITY; } } \
        float mx; { float a_ = max3f(P0[0], P0[1], P1[0]), b_ = max3f(P0[2], P0[3], P1[1]); a_ = max3f(a_, P1[2], P1[3]); \
            _Pragma("unroll") for (int r = 4; r < 16; r += 4) { a_ = max3f(a_, P0[r], P0[r + 1]); b_ = max3f(b_, P0[r + 2], P0[r + 3]); a_ = max3f(a_, P1[r], P1[r + 1]); b_ = max3f(b_, P1[r + 2], P1[r + 3]); } \
            mx = max3f(a_, b_, b_); mx = max3f(mx, __shfl_xor(mx, 32), mx); }        \
        const float m_new = fmaxf(m_run, mx); \
        if (__any(mx > m_run + AT_THR)) {        \
 const float f = __builtin_amdgcn_exp2f(m_run - m_new); l_run *= f; m_run = m_new; \
            if (hi == 0) wsf[r32] = f; float fr_[16]; \
            _Pragma("unroll") for (int r = 0; r < 16; ++r) fr_[r] = wsf[crow(r, hi)]; \
            _Pragma("unroll") for (int r = 0; r < 16; ++r) { o[0][r] *= fr_[r]; o[1][r] *= fr_[r]; } } \
        float rs = 0.f; \
        _Pragma("unroll") for (int r = 0; r < 16; ++r) { P0[r] = __builtin_amdgcn_exp2f(P0[r] - m_run); P1[r] = __builtin_amdgcn_exp2f(P1[r] - m_run); rs += P0[r] + P1[r]; } \
        l_run += rs; bf16x8 pa[4]; \
        _Pragma("unroll") for (int ks = 0; ks < 4; ++ks) { u32x4 w_; \
            _Pragma("unroll") for (int i = 0; i < 4; ++i) { const int r = (ks & 1) * 8 + 2 * i; w_[i] = (ks < 2) ? cvtpk(P0[r], P0[r + 1]) : cvtpk(P1[r], P1[r + 1]); } \
            pa[ks] = __builtin_bit_cast(bf16x8, w_); } \
        const LAS unsigned char* vb_ = Vl + (bf) * AT_VBUF + (4 * hi + ((lane & 15) >> 2)) * AT_VROW + (((lane >> 4) & 1) * 16 + (lane & 3) * 4) * 2; \
        _Pragma("unroll") for (int d0 = 0; d0 < 2; ++d0) _Pragma("unroll") for (int ks = 0; ks < 4; ++ks) { \
            const v4i16_t lo = __builtin_amdgcn_ds_read_tr16_b64_v4i16((LAS v4i16_t*)(vb_ + ks * 16 * AT_VROW + d0 * 64)); \
            const v4i16_t hv = __builtin_amdgcn_ds_read_tr16_b64_v4i16((LAS v4i16_t*)(vb_ + ks * 16 * AT_VROW + 8 * AT_VROW + d0 * 64)); \
            const bf16x8 vf = (bf16x8){lo[0], lo[1], lo[2], lo[3], hv[0], hv[1], hv[2], hv[3]}; \
            o[d0] = __builtin_amdgcn_mfma_f32_32x32x16_bf16(pa[ks], vf, o[d0], 0, 0, 0); } } while (0)
#define AT_STEP(C0, C1, N0, N1, t) do { \
        if ((t) + 2 < NT) AT_DMAK((t) + 2, (t) & 1); if ((t) + 1 < NT) AT_DMAV((t) + 1, ((t) + 1) & 1); \
        if ((t) + 1 < NT && 64 * ((t) + 1) <= qmax) AT_QK(N0, N1, ((t) + 1) & 1); \
        if (64 * (t) <= qmax) AT_SPV(C0, C1, t, (t) & 1); \
        VM_WAIT(); __syncthreads(); } while (0)
    AT_DMAK(0, 0); AT_DMAV(0, 0); AT_DMAK(1, 1); VM_WAIT(); __syncthreads();
    float m_run = -INFINITY, l_run = 0.f; f32x16 o[2];
#pragma unroll
    for (int r = 0; r < 16; ++r) { o[0][r] = 0.f; o[1][r] = 0.f; }
    const int qmax = q0 + wid * 32 + 31, qpos = q0 + wid * 32 + r32;
    f32x16 sA0, sA1, sB0, sB1;
    AT_QK(sA0, sA1, 0);
    asm volatile("s_nop 15\n\ts_nop 15" : "+v"(sA0), "+v"(sA1));
    LBAR();
    for (int t = 0; t < NT; t += 2) {
        AT_STEP(sA0, sA1, sB0, sB1, t);
        AT_STEP(sB0, sB1, sA0, sA1, t + 1);
    }
    { float lt = l_run + __shfl_xor(l_run, 32);
      if (hi == 0) wsf[32 + r32] = lt;
      bf16_t* Ow = WSP(bf16_t, WS_H) + (tb + q0 + wid * 32) * DM + h * 64 + r32;
      float sq[16];
#pragma unroll
      for (int r = 0; r < 16; ++r) { const int qr_ = crow(r, hi); const float inv = 1.0f / wsf[32 + qr_]; const bf16_t b0 = f2bf(o[0][r] * inv), b1 = f2bf(o[1][r] * inv);
          Ow[(size_t)qr_ * DM] = b0; Ow[(size_t)qr_ * DM + 32] = b1; const float f0 = bf2f(b0), f1 = bf2f(b1); sq[r] = f0 * f0 + f1 * f1; }
      float v8[8], v4[4], v2[2], v1;
      { const bool up = (lane & 16) != 0;
#pragma unroll
        for (int i = 0; i < 8; ++i) { const float keep = up ? sq[i + 8] : sq[i], give = up ? sq[i] : sq[i + 8]; v8[i] = keep + __shfl_xor(give, 16); } }
      { const bool up = (lane & 8) != 0;
#pragma unroll
        for (int i = 0; i < 4; ++i) { const float keep = up ? v8[i + 4] : v8[i], give = up ? v8[i] : v8[i + 4]; v4[i] = keep + __shfl_xor(give, 8); } }
      { const bool up = (lane & 4) != 0;
#pragma unroll
        for (int i = 0; i < 2; ++i) { const float keep = up ? v4[i + 2] : v4[i], give = up ? v4[i] : v4[i + 2]; v2[i] = keep + __shfl_xor(give, 4); } }
      { const bool up = (lane & 2) != 0; const float keep = up ? v2[1] : v2[0], give = up ? v2[0] : v2[1]; v1 = keep + __shfl_xor(give, 2); }
      v1 += __shfl_xor(v1, 1);
      if ((lane & 1) == 0) WSP(float, WS_PARTO)[(tb + q0 + wid * 32 + crow((lane >> 1) & 15, hi)) * 8 + h] = v1; }
#undef AT_DMAK
#undef AT_DMAV
#undef AT_QK
#undef AT_SPV
#undef AT_STEP
}

__device__ __forceinline__ void p4b_rows(Frame& F) {
    const int gw = F.vcu * NWAVES + F.wave, NGW = F.G * NWAVES, lane = F.lane;
    const bf16_t* oa = WSP(bf16_t, WS_OA); const bf16_t* og = WSP(bf16_t, WS_OG); const bf16_t* proj = WSP(bf16_t, WS_PROJ); bf16_t* mx = WSP(bf16_t, WS_H);
    const float* ga = F.in[IN_MLAOG] + 8 * lane; const float* gg = F.in[IN_GDNG] + 8 * (lane & 7);
    constexpr int R = 4;
    for (int m0 = gw; m0 < T; m0 += R * NGW) {
        u32x4 a[R], g[R], z[R];
#pragma unroll
        for (int r = 0; r < R; ++r) { const int m = (m0 + r * NGW < T) ? m0 + r * NGW : m0;
            a[r] = *(const u32x4*)(oa + (size_t)m * 512 + 8 * lane); g[r] = *(const u32x4*)(og + (size_t)m * 512 + 8 * lane); z[r] = *(const u32x4*)(proj + (size_t)m * NPROJ + C_GZ + 8 * lane); }
#pragma unroll
        for (int r = 0; r < R; ++r) { const int m = m0 + r * NGW; if (m >= T) continue;
            const float ra = __builtin_amdgcn_rsqf(wave_sum(ssq8(a[r])) * (1.f / 512) + EPS);
            float sg = ssq8(g[r]); sg += __shfl_xor(sg, 1); sg += __shfl_xor(sg, 2); sg += __shfl_xor(sg, 4);
            const float rg = __builtin_amdgcn_rsqf(sg * (1.f / 64) + EPS);
            float oa8[8], og8[8];
#pragma unroll
            for (int i = 0; i < 4; ++i) { oa8[2 * i] = bflo(a[r][i]) * ra * ga[2 * i]; oa8[2 * i + 1] = bfhi(a[r][i]) * ra * ga[2 * i + 1];
                og8[2 * i] = bflo(g[r][i]) * rg * gg[2 * i] * siluf(bflo(z[r][i])); og8[2 * i + 1] = bfhi(g[r][i]) * rg * gg[2 * i + 1] * siluf(bfhi(z[r][i])); }
            u32x4 wa, wg;
#pragma unroll
            for (int i = 0; i < 4; ++i) { wa[i] = cvtpk(oa8[2 * i], oa8[2 * i + 1]); wg[i] = cvtpk(og8[2 * i], og8[2 * i + 1]); }
            *(u32x4*)(mx + (size_t)m * DM + 8 * lane) = wa; *(u32x4*)(mx + (size_t)m * DM + 512 + 8 * lane) = wg; }
    }
}

constexpr int G1_KRM = 0, G1_QRM = 4608, G1_AM = 9216, G1_QK = 13824, G1_UT = 16384, G1_WT = 21504, G1_KT = 26624, G1_GT = 31744, G1_SLOT = 32384, G1_CW = MISC_OFF + 12288;
static_assert(4 * G1_SLOT <= RING_BYTES && G1_CW + 3072 <= LDS_BYTES, "G1 LDS");
__device__ __forceinline__ f32x4 mfma16(bf16x8 a, bf16x8 b, f32x4 c) { return __builtin_amdgcn_mfma_f32_16x16x32_bf16(a, b, c, 0, 0, 0); }

__device__ __forceinline__ float silu_fast(float x) { return x * __builtin_amdgcn_rcpf(1.0f + __expf(-x)); }
#ifndef G1PROBE
#define G1PROBE (-1)
#endif
#define G1T(k) do { if (G1PROBE >= 0) { const unsigned long long n_ = __builtin_amdgcn_s_memrealtime(); if (G1PROBE == (k)) g1acc += n_ - g1t; g1t = n_; } } while (0)
struct G1Pre { unsigned raw[19]; float cwv[2]; unsigned short ga, gb; };
__device__ __forceinline__ void g1_prefetch(Frame& F, int unit, G1Pre& P) {
    const int tid = F.tid, lane = F.lane, wid = F.wave;
    const int bh = unit >> 5, c0 = (unit & 31) * 4, b = bh >> 3, h = bh & 7, sa = wid >> 1, i0 = (wid & 1) * 16, isk = lane >> 5, c2 = lane & 31;
    const bf16_t* proj = WSP(bf16_t, WS_PROJ);
    const int sp0 = (c0 + sa) * GC + i0;
    const size_t tb = (size_t)b * SEQ;
    const unsigned* src = (const unsigned*)(proj + (tb + sp0) * NPROJ + (isk ? C_GK : C_GQ) + h * 64 + 2 * c2);
#pragma unroll
    for (int r = 0; r < 19; ++r) { const int ro = (r < 3 && sp0 == 0) ? 0 : r - 3; P.raw[r] = src[(ptrdiff_t)ro * (NPROJ / 2)]; }
#pragma unroll
    for (int k = 0; k < 2; ++k) { const int i = tid + k * NWAVES * 64; float v = 0.f; if (i < 768) { const int x = i >> 8, w = (i >> 6) & 3, ch = i & 63; v = F.in[IN_CONVW][w * 1536 + x * 512 + h * 64 + ch]; } P.cwv[k] = v; }
    { const int tk = (lane & 15); const bf16_t* gp = proj + (tb + sp0 + tk) * NPROJ + ((lane & 16) ? C_GB : C_GA) + h; P.ga = (lane < 32) ? *gp : (unsigned short)0; P.gb = 0; }
}
__device__ __forceinline__ void g1_unit(Frame& F, int unit, int unit_next, G1Pre& P, unsigned long long& g1acc) {
    unsigned long long g1t = (G1PROBE >= 0) ? __builtin_amdgcn_s_memrealtime() : 0ull;
    const int tid = F.tid, lane = F.lane, wid = F.wave;
    const int bh = unit >> 5, c0 = (unit & 31) * 4, b = bh >> 3, h = bh & 7;
    const bf16_t* proj = WSP(bf16_t, WS_PROJ);
    LAS unsigned char* L = F.lds; LAS float* cw = (LAS float*)(L + G1_CW);
    const size_t tb = (size_t)b * SEQ;
#pragma unroll
    for (int k = 0; k < 2; ++k) { const int i = tid + k * NWAVES * 64; if (i < 768) cw[i] = P.cwv[k]; }
    LBAR(); G1T(0);
    { const int sa = wid >> 1, hf = wid & 1, i0 = hf * 16, isk = lane >> 5, c2 = lane & 31;
      float wl[4], wh[4];
#pragma unroll
      for (int w = 0; w < 4; ++w) { const f32x2 t = *(const LAS f32x2*)(cw + (isk * 4 + w) * 64 + 2 * c2); wl[w] = t[0]; wh[w] = t[1]; }
      if ((c0 + sa) * GC + i0 == 0) { P.raw[0] = 0u; P.raw[1] = 0u; P.raw[2] = 0u; }
      float v0[16], v1[16], sq[16];
#pragma unroll
      for (int t = 0; t < 16; ++t) { float a0 = 0.f, a1 = 0.f;
#pragma unroll
          for (int w = 0; w < 4; ++w) { a0 += bflo(P.raw[t + w]) * wl[w]; a1 += bfhi(P.raw[t + w]) * wh[w]; }
          v0[t] = silu_fast(a0); v1[t] = silu_fast(a1); sq[t] = v0[t] * v0[t] + v1[t] * v1[t]; }
      float r8[8], r4[4], r2[2], r1;
      { const bool up = (lane & 16) != 0;
#pragma unroll
        for (int jj = 0; jj < 8; ++jj) { const float keep = up ? sq[8 + jj] : sq[jj], send = up ? sq[jj] : sq[8 + jj]; r8[jj] = keep + __shfl_xor(send, 16); } }
      { const bool up = (lane & 8) != 0;
#pragma unroll
        for (int jj = 0; jj < 4; ++jj) { const float keep = up ? r8[4 + jj] : r8[jj], send = up ? r8[jj] : r8[4 + jj]; r4[jj] = keep + __shfl_xor(send, 8); } }
      { const bool up = (lane & 4) != 0;
#pragma unroll
        for (int jj = 0; jj < 2; ++jj) { const float keep = up ? r4[2 + jj] : r4[jj], send = up ? r4[jj] : r4[2 + jj]; r2[jj] = keep + __shfl_xor(send, 4); } }
      { const bool up = (lane & 2) != 0; const float keep = up ? r2[1] : r2[0], send = up ? r2[0] : r2[1]; r1 = keep + __shfl_xor(send, 2); }
      r1 += __shfl_xor(r1, 1);
      LAS float* gts = (LAS float*)(L + sa * G1_SLOT + G1_GT);
      LAS float* rnl = gts + 64 + 32 * hf + 16 * isk;
      if ((lane & 1) == 0) rnl[(lane >> 1) & 15] = __builtin_amdgcn_rsqf(r1 + EPS) * (isk ? 1.0f : 0.125f);
      LDS_WAIT(); asm volatile("" ::: "memory");
      LAS unsigned* dst = (LAS unsigned*)(L + sa * G1_SLOT + (isk ? G1_KRM : G1_QRM)) + i0 * 36 + c2;
#pragma unroll
      for (int t4 = 0; t4 < 4; ++t4) { const f32x4 rn = *(const LAS f32x4*)(rnl + 4 * t4);
#pragma unroll
          for (int e = 0; e < 4; ++e) { const int t = 4 * t4 + e; dst[t * 36] = cvtpk(v0[t] * rn[e], v1[t] * rn[e]); } }
      if (lane < 32) { const int i = i0 + (lane & 15); const float gin = bf2f(P.ga);
          if (lane < 16) { const float xs = gin + F.in[IN_DTB][h], sp_ = xs > 20.f ? xs : __logf(1.0f + __expf(xs)); gts[32 + i] = -__expf(F.in[IN_ALOG][h]) * sp_; }
          else gts[i] = 1.0f / (1.0f + __expf(-gin)); }
    }
    LBAR(); G1T(1);
    if (wid < 2) { LAS float* gt = (LAS float*)(L + (2 * wid + (lane >> 5)) * G1_SLOT + G1_GT); const int i = lane & 31; float c = gt[32 + i];
#pragma unroll
        for (int o = 1; o < 32; o <<= 1) { const float t = __shfl_up(c, o, 32); if (i >= o) c += t; }
        const float last = __shfl(c, 31, 32);
        gt[64 + i] = c; gt[96 + i] = __expf(c); gt[128 + i] = __expf(last - c); }
    LBAR(); G1T(2);
    const int s = wid & 3, sub = wid >> 2, l15 = lane & 15, kq = lane >> 4;
    if (unit_next >= 0) g1_prefetch(F, unit_next, P);
    LAS unsigned char* Ls = L + s * G1_SLOT; LAS float* gt = (LAS float*)(Ls + G1_GT);
    unsigned vraw[35];
    if (sub == 0) { const int sp0 = (c0 + s) * GC; const bf16_t* src = proj + (tb + sp0) * NPROJ + C_GV + h * 64 + lane;
#pragma unroll
        for (int i = 0; i < 35; ++i) { const int ro = (i < 3 && sp0 == 0) ? 0 : i - 3; vraw[i] = src[(ptrdiff_t)ro * NPROJ]; } }
    else {
#pragma unroll
        for (int i = 0; i < 35; ++i) vraw[i] = 0; }
    { const LAS bf16_t* X = (const LAS bf16_t*)(Ls + (sub ? G1_QRM : G1_KRM)); const LAS bf16_t* Kr = (const LAS bf16_t*)(Ls + G1_KRM);
      bf16x8 xf[2][2], kf[2][2];
#pragma unroll
      for (int t2 = 0; t2 < 2; ++t2)
#pragma unroll
          for (int ks = 0; ks < 2; ++ks) { xf[t2][ks] = *(const LAS bf16x8*)(X + (16 * t2 + l15) * 72 + 32 * ks + 8 * kq); kf[t2][ks] = *(const LAS bf16x8*)(Kr + (16 * t2 + l15) * 72 + 32 * ks + 8 * kq); }
      const f32x4 gi4[2] = {*(const LAS f32x4*)(gt + 64 + 4 * kq), *(const LAS f32x4*)(gt + 80 + 4 * kq)}, bt4[2] = {*(const LAS f32x4*)(gt + 4 * kq), *(const LAS f32x4*)(gt + 16 + 4 * kq)};
      const float gj2[2] = {gt[64 + l15], gt[80 + l15]};
      const int s2 = wid >> 1, dp = lane & 31, cb = 2 * (wid & 1) + (lane >> 5);
      LAS unsigned char* L2 = L + s2 * G1_SLOT; const LAS unsigned* kr32 = (const LAS unsigned*)(L2 + G1_KRM) + (8 * cb) * 36 + dp;
      const f32x4 eg0 = *(const LAS f32x4*)((const LAS float*)(L2 + G1_GT) + 128 + 8 * cb), eg1 = *(const LAS f32x4*)((const LAS float*)(L2 + G1_GT) + 132 + 8 * cb);
      unsigned kv[8];
#pragma unroll
      for (int jj = 0; jj < 8; ++jj) kv[jj] = kr32[jj * 36];
      f32x4 acc[2][2];
#pragma unroll
      for (int it = 0; it < 2; ++it)
#pragma unroll
          for (int jt = 0; jt < 2; ++jt) { acc[it][jt] = mfma16(xf[it][0], kf[jt][0], (f32x4){0.f, 0.f, 0.f, 0.f}); acc[it][jt] = mfma16(xf[it][1], kf[jt][1], acc[it][jt]); }
#pragma unroll
      for (int it = 0; it < 2; ++it)
#pragma unroll
          for (int jt = 0; jt < 2; ++jt) { const int j = 16 * jt + l15, ib = 16 * it + 4 * kq;
              if (sub == 0) { f32x4 val;
#pragma unroll
                  for (int r = 0; r < 4; ++r) val[r] = (ib + r > j) ? acc[it][jt][r] * bt4[it][r] * __expf(gi4[it][r] - gj2[jt]) : 0.f;
                  *(LAS f32x4*)((LAS float*)(Ls + G1_AM) + j * 36 + ib) = val; }
              else {
#pragma unroll
                  for (int r = 0; r < 4; ++r) { const float val = (ib + r >= j) ? acc[it][jt][r] * __expf(gi4[it][r] - gj2[jt]) : 0.f; ((LAS bf16_t*)(Ls + G1_QK))[(ib + r) * 40 + j] = f2bf(val); } } }
      { const float e8[8] = {eg0[0], eg0[1], eg0[2], eg0[3], eg1[0], eg1[1], eg1[2], eg1[3]}; u32x4 wlo, whi;
#pragma unroll
        for (int p = 0; p < 4; ++p) { wlo[p] = cvtpk(bflo(kv[2 * p]) * e8[2 * p], bflo(kv[2 * p + 1]) * e8[2 * p + 1]); whi[p] = cvtpk(bfhi(kv[2 * p]) * e8[2 * p], bfhi(kv[2 * p + 1]) * e8[2 * p + 1]); }
        LAS bf16_t* kt = (LAS bf16_t*)(L2 + G1_KT) + (2 * dp) * 40 + 8 * cb; *(LAS u32x4*)kt = wlo; *(LAS u32x4*)(kt + 40) = whi; }
    }
    LBAR(); G1T(3);
#pragma unroll
    for (int i = 0; i < 35; ++i) asm volatile("" : "+v"(vraw[i]));
    { float sol[32];
      if (sub == 0) {
          const float w0 = cw[(8 + 0) * 64 + lane], w1 = cw[(8 + 1) * 64 + lane], w2 = cw[(8 + 2) * 64 + lane], w3 = cw[(8 + 3) * 64 + lane];
          float xv[35]; const float zm = ((c0 + s) == 0) ? 0.f : 1.f;
#pragma unroll
          for (int i = 0; i < 35; ++i) xv[i] = (i < 3) ? __uint_as_float(vraw[i] << 16) * zm : __uint_as_float(vraw[i] << 16);
#pragma unroll
          for (int i = 0; i < 32; ++i) sol[i] = silu_fast(w0 * xv[i] + w1 * xv[i + 1] + w2 * xv[i + 2] + w3 * xv[i + 3]) * gt[i];
      } else {
          const LAS bf16_t* Kr = (const LAS bf16_t*)(Ls + G1_KRM);
#pragma unroll
          for (int i = 0; i < 32; ++i) sol[i] = bf2f(Kr[i * 72 + lane]) * gt[i] * gt[96 + i];
      }
      float arow[32];
      { const LAS f32x4* ap = (const LAS f32x4*)((const LAS float*)(Ls + G1_AM) + (lane & 31) * 36);
#pragma unroll
        for (int q = 0; q < 8; ++q) { const f32x4 t = ap[q]; arow[4 * q] = t[0]; arow[4 * q + 1] = t[1]; arow[4 * q + 2] = t[2]; arow[4 * q + 3] = t[3]; } }
#pragma unroll
      for (int i = 1; i < 32; ++i) { float a = sol[i];
#pragma unroll
          for (int j = 0; j < i; ++j) a -= __uint_as_float(__builtin_amdgcn_readlane(__float_as_uint(arow[i]), j)) * sol[j];
          sol[i] = a; }
      LAS bf16_t* dst = (LAS bf16_t*)(Ls + (sub ? G1_WT : G1_UT)) + lane * 40;
#pragma unroll
      for (int q4 = 0; q4 < 4; ++q4) { u32x4 w;
#pragma unroll
          for (int e = 0; e < 4; ++e) w[e] = cvtpk(sol[8 * q4 + 2 * e], sol[8 * q4 + 2 * e + 1]);
          *(LAS u32x4*)(dst + 8 * q4) = w; }
    }
    LBAR(); G1T(4);
        { unsigned char* gd = F.ws + WS_GD + (size_t)(bh * NCH + c0 + s) * 24576;
          const LAS bf16_t* uT = (const LAS bf16_t*)(Ls + G1_UT); const LAS bf16_t* wT = (const LAS bf16_t*)(Ls + G1_WT); const LAS bf16_t* kT = (const LAS bf16_t*)(Ls + G1_KT);
          const LAS bf16_t* qk = (const LAS bf16_t*)(Ls + G1_QK); const LAS bf16_t* qr = (const LAS bf16_t*)(Ls + G1_QRM);
          const f32x4 z4 = (f32x4){0.f, 0.f, 0.f, 0.f}; const float cd = gt[96 + 31];
          if (sub == 0) {
#pragma unroll
              for (int mp = 0; mp < 2; ++mp) {
                  const bf16x8 af0 = *(const LAS bf16x8*)(wT + (32 * mp + l15) * 40 + 8 * kq), af1 = *(const LAS bf16x8*)(wT + (32 * mp + 16 + l15) * 40 + 8 * kq);
#pragma unroll
                  for (int nt = 0; nt < 4; ++nt) {
                      const bf16x8 bfr = *(const LAS bf16x8*)(kT + (16 * nt + l15) * 40 + 8 * kq);
                      const f32x4 a0 = mfma16(af0, bfr, z4), a1 = mfma16(af1, bfr, z4); const int dout = 16 * nt + l15; u32x4 w; float o8[8];
#pragma unroll
                      for (int r = 0; r < 4; ++r) { const int din = 32 * mp + 4 * kq + r; o8[r] = ((din == dout) ? cd : 0.f) - a0[r]; o8[4 + r] = ((din + 16 == dout) ? cd : 0.f) - a1[r]; }
                      w.x = cvtpk(o8[0], o8[1]); w.y = cvtpk(o8[2], o8[3]); w.z = cvtpk(o8[4], o8[5]); w.w = cvtpk(o8[6], o8[7]);
                      *(u32x4*)(gd + ((nt * 2 + mp) * 64 + kq * 16 + l15) * 16) = w; }
#pragma unroll
                  for (int ct = 0; ct < 2; ++ct) {
                      const bf16x8 bfr = *(const LAS bf16x8*)(qk + (16 * ct + l15) * 40 + 8 * kq);
                      const f32x4 a0 = mfma16(af0, bfr, z4), a1 = mfma16(af1, bfr, z4); const int c = 16 * ct + l15; const float eg = gt[96 + c];
                      const u32x2 q0 = *(const LAS u32x2*)(qr + c * 72 + 32 * mp + 4 * kq), q1 = *(const LAS u32x2*)(qr + c * 72 + 32 * mp + 16 + 4 * kq); u32x4 w;
                      w.x = cvtpk(bflo(q0.x) * eg - a0[0], bfhi(q0.x) * eg - a0[1]); w.y = cvtpk(bflo(q0.y) * eg - a0[2], bfhi(q0.y) * eg - a0[3]);
                      w.z = cvtpk(bflo(q1.x) * eg - a1[0], bfhi(q1.x) * eg - a1[1]); w.w = cvtpk(bflo(q1.y) * eg - a1[2], bfhi(q1.y) * eg - a1[3]);
                      *(u32x4*)(gd + 8192 + ((ct * 2 + mp) * 64 + kq * 16 + l15) * 16) = w; } }
          } else {
#pragma unroll
              for (int et = 0; et < 4; ++et) { const bf16x8 bfr = *(const LAS bf16x8*)(uT + (16 * et + l15) * 40 + 8 * kq);
#pragma unroll
                  for (int dt = 0; dt < 4; ++dt) {
                      const f32x4 acc = mfma16(*(const LAS bf16x8*)(kT + (16 * dt + l15) * 40 + 8 * kq), bfr, z4); u32x2 w; w.x = cvtpk(acc[0], acc[1]); w.y = cvtpk(acc[2], acc[3]);
                      *(u32x2*)(gd + 12288 + ((dt * 4 + et) * 64 + lane) * 8) = w; }
#pragma unroll
                  for (int ct = 0; ct < 2; ++ct) {
                      const f32x4 acc = mfma16(*(const LAS bf16x8*)(qk + (16 * ct + l15) * 40 + 8 * kq), bfr, z4); u32x2 w; w.x = cvtpk(acc[0], acc[1]); w.y = cvtpk(acc[2], acc[3]);
                      *(u32x2*)(gd + 20480 + ((ct * 4 + et) * 64 + lane) * 8) = w; } }
          }
        }
    LBAR(); G1T(5);
}

constexpr int G2_NS = 5, G2_D = 3, G2_SLOT = 24576, G2_ITEMS = BATCH * GH;
__device__ __forceinline__ void g2_item(Frame& F, int bh) {
    const int lane = F.lane, wid = F.wave, es = wid & 3, b = bh >> 3, h = bh & 7, l15 = lane & 15, kq = lane >> 4;
    const unsigned char* gd = F.ws + WS_GD + (size_t)bh * NCH * 24576;
    LAS unsigned char* ring = F.lds;
    LAS float* ob = (LAS float*)(F.lds + 2 * G2_SLOT);
    constexpr int OBSZ = 32 * 68;
    const bool loader = wid >= 4;
    constexpr int G2_DR = 6;
    u32x4 rg[G2_DR][6], zq[G2_DR];
    const unsigned char* gsrc = gd + (size_t)(wid & 3) * 6144 + (size_t)lane * 16;
    LAS unsigned char* ldst = ring + (wid & 3) * 6144 + lane * 16;
    const int tl = (wid & 3) * 64 + lane, prow = tl >> 3, c8 = tl & 7;
    const bf16_t* zsrc = WSP(bf16_t, WS_PROJ) + ((size_t)b * SEQ + prow) * NPROJ + C_GZ + h * 64 + 8 * c8;
    bf16_t* mx = WSP(bf16_t, WS_H) + ((size_t)b * SEQ + prow) * DM + 512 + h * 64 + 8 * c8;
    float gg[8];
#pragma unroll
    for (int i = 0; i < 8; ++i) { gg[i] = F.in[IN_GDNG][8 * c8 + i]; asm volatile("" : "+v"(gg[i])); }
#define G2_LD(R, c) do { _Pragma("unroll") for (int j_ = 0; j_ < 6; ++j_) R[j_] = *(const u32x4*)(gsrc + (size_t)(c) * 24576 + j_ * 1024); } while (0)
#define G2_LZ(Z, c) do { Z = *(const u32x4*)(zsrc + (size_t)(c) * GC * NPROJ); } while (0)
#define G2_ST(R, slot) do { _Pragma("unroll") for (int j_ = 0; j_ < 6; ++j_) *(LAS u32x4*)(ldst + (slot) * G2_SLOT + j_ * 1024) = R[j_]; } while (0)
#define G2_POST(k, Z) do { const LAS float* op_ = ob + ((k) & 1) * OBSZ + prow * 68 + 8 * c8; const f32x4 a_ = *(const LAS f32x4*)op_, b_ = *(const LAS f32x4*)(op_ + 4); \
        float sg_ = ((a_[0] * a_[0] + a_[1] * a_[1]) + (a_[2] * a_[2] + a_[3] * a_[3])) + ((b_[0] * b_[0] + b_[1] * b_[1]) + (b_[2] * b_[2] + b_[3] * b_[3])); \
        sg_ += dpp_f<DPP_X1>(sg_); sg_ += dpp_f<DPP_X2>(sg_); sg_ += dpp_f<DPP_HM>(sg_); \
        const float rn_ = __builtin_amdgcn_rsqf(sg_ * (1.f / 64) + EPS); const float o8_[8] = {a_[0], a_[1], a_[2], a_[3], b_[0], b_[1], b_[2], b_[3]}; u32x4 w_; \
        _Pragma("unroll") for (int i_ = 0; i_ < 4; ++i_) w_[i_] = cvtpk(o8_[2 * i_] * rn_ * gg[2 * i_] * silu_fast(bflo(Z[i_])), o8_[2 * i_ + 1] * rn_ * gg[2 * i_ + 1] * silu_fast(bfhi(Z[i_]))); \
        *(u32x4*)(mx + (size_t)(k) * GC * DM) = w_; } while (0)
    if (loader) {
#pragma unroll
        for (int d = 0; d < G2_DR; ++d) G2_LD(rg[d], d);
#pragma unroll
        for (int d = 0; d < G2_DR - 1; ++d) G2_LZ(zq[d], d);
        zq[G2_DR - 1] = (u32x4){0u, 0u, 0u, 0u};
        G2_ST(rg[0], 0); G2_LD(rg[0], G2_DR);
#pragma unroll 1
        for (int c0 = 0; c0 < NCH; c0 += G2_DR) {
#pragma unroll
          for (int u = 0; u < G2_DR; ++u) { const int c = c0 + u; if (c >= NCH) break;
            LBAR();
            { const int cp = (c >= 1) ? c - 1 : 0; G2_POST(cp, zq[(u + G2_DR - 1) % G2_DR]); }
            { const int cz = (c + G2_DR - 1 < NCH) ? c + G2_DR - 1 : NCH - 1; G2_LZ(zq[(u + G2_DR - 1) % G2_DR], cz); }
            G2_ST(rg[(u + 1) % G2_DR], (c + 1) & 1);
            { const int cn = (c + 1 + G2_DR < NCH) ? c + 1 + G2_DR : NCH - 1; G2_LD(rg[(u + 1) % G2_DR], cn); }
          }
        }
        LBAR();
        G2_POST(NCH - 1, zq[(NCH - 1) % G2_DR]);
    } else {
        __builtin_amdgcn_s_setprio(2);
        f32x4 S[4];
#pragma unroll
        for (int m = 0; m < 4; ++m) S[m] = (f32x4){0.f, 0.f, 0.f, 0.f};
#pragma unroll 2
        for (int c = 0; c < NCH; ++c) { const int slot = c & 1;
            LBAR();
            const LAS unsigned char* p_ = ring + slot * G2_SLOT;
            bf16x8 Bs[2];
#pragma unroll
            for (int s2 = 0; s2 < 2; ++s2) { u32x4 w; w.x = cvtpk(S[2 * s2][0], S[2 * s2][1]); w.y = cvtpk(S[2 * s2][2], S[2 * s2][3]); w.z = cvtpk(S[2 * s2 + 1][0], S[2 * s2 + 1][1]); w.w = cvtpk(S[2 * s2 + 1][2], S[2 * s2 + 1][3]);
                Bs[s2] = __builtin_bit_cast(bf16x8, w); }
#pragma unroll
            for (int ct = 0; ct < 2; ++ct) { const u32x2 rv = *(const LAS u32x2*)(p_ + 20480 + ((ct * 4 + es) * 64 + lane) * 8);
                f32x4 o = (f32x4){bflo(rv.x), bfhi(rv.x), bflo(rv.y), bfhi(rv.y)};
                o = mfma16(*(const LAS bf16x8*)(p_ + 8192 + ((ct * 2 + 0) * 64 + lane) * 16), Bs[0], o); o = mfma16(*(const LAS bf16x8*)(p_ + 8192 + ((ct * 2 + 1) * 64 + lane) * 16), Bs[1], o);
                LAS float* od = ob + slot * OBSZ + (16 * ct + 4 * kq) * 68 + 16 * es + l15;
#pragma unroll
                for (int r = 0; r < 4; ++r) od[r * 68] = o[r]; }
#pragma unroll
            for (int m = 0; m < 4; ++m) { const u32x2 nv = *(const LAS u32x2*)(p_ + 12288 + ((m * 4 + es) * 64 + lane) * 8);
                f32x4 a = (f32x4){bflo(nv.x), bfhi(nv.x), bflo(nv.y), bfhi(nv.y)};
                a = mfma16(*(const LAS bf16x8*)(p_ + ((m * 2 + 0) * 64 + lane) * 16), Bs[0], a); S[m] = mfma16(*(const LAS bf16x8*)(p_ + ((m * 2 + 1) * 64 + lane) * 16), Bs[1], a); }
        }
        LBAR();
    }
    __builtin_amdgcn_s_setprio(0);
    LBAR();
#undef G2_LD
#undef G2_LZ
#undef G2_ST
#undef G2_POST
}

constexpr int P6_RW = 0, P6_TK = 131072;
__device__ __forceinline__ void p6_router(Frame& F, int rep) {
    const int lane = F.lane, wid = F.wave, tid = F.tid, l15 = lane & 15, kq = lane >> 4;
    LAS unsigned char* rwl = F.lds;
    LAS float* gml = (LAS float*)(F.lds + MISC_OFF + 1024);
    const float* x1 = WSP(float, WS_X1); const float* mod = WSP(float, WS_MOD); unsigned char* h2 = WSP(unsigned char, WS_H);
    const size_t ro = rep ? WS_END : 0;
    int* tke = WSP(int, ro + WS_TKE); float* tkw = WSP(float, ro + WS_TKW); int* tkp = WSP(int, ro + WS_TKP); int* lst = WSP(int, ro + WS_LIST);
    const int tpw = T / F.G, t0 = (int)blockIdx.x * tpw;
    { const float* rwt = WSP(float, WS_RWT);
      for (int idx = tid; idx < NE * 128; idx += NWAVES * 64) { const int e = idx >> 7, c = idx & 127; const f32x4 a = *(const f32x4*)(rwt + e * DM + 8 * c), bq = *(const f32x4*)(rwt + e * DM + 8 * c + 4);
          u32x4 hi4, lo4; float v[8] = {a[0], a[1], a[2], a[3], bq[0], bq[1], bq[2], bq[3]};
#pragma unroll
          for (int i = 0; i < 4; ++i) { const unsigned hw = cvtpk(v[2 * i], v[2 * i + 1]); hi4[i] = hw; lo4[i] = cvtpk(v[2 * i] - bflo(hw), v[2 * i + 1] - bfhi(hw)); }
          const int off = e * 2048 + ((c ^ (e & 15)) << 4);
          *(LAS u32x4*)(rwl + off) = hi4; *(LAS u32x4*)(rwl + 65536 + off) = lo4; }
      const float* mb = mod + (size_t)(t0 / SEQ) * 6144;
      for (int i = tid; i < DM; i += NWAVES * 64) { gml[i] = F.in[IN_N2G][i] * (1.0f + mb[4096 + i]); gml[DM + i] = mb[3072 + i]; } }
    if (tid < 96) F.MISC[32 + tid] = 0u;
    __syncthreads();
    for (int tb0 = wid * 16; tb0 < tpw; tb0 += NWAVES * 16) {
        const int t = t0 + tb0 + l15; const float* xr = x1 + (size_t)t * DM + 8 * kq; unsigned char* hr = h2 + (size_t)t * DM + 8 * kq;
        float ss = 0.f;
#pragma unroll 8
        for (int s2 = 0; s2 < 32; ++s2) { const f32x4 a = *(const f32x4*)(xr + 32 * s2), bq = *(const f32x4*)(xr + 32 * s2 + 4);
            ss += (a[0] * a[0] + a[1] * a[1]) + (a[2] * a[2] + a[3] * a[3]) + (bq[0] * bq[0] + bq[1] * bq[1]) + (bq[2] * bq[2] + bq[3] * bq[3]); }
        ss += __shfl_xor(ss, 16); ss += __shfl_xor(ss, 32);
        const float rstd = __builtin_amdgcn_rsqf(ss * (1.f / DM) + EPS);
        f32x4 acc[2] = {(f32x4){0.f, 0.f, 0.f, 0.f}, (f32x4){0.f, 0.f, 0.f, 0.f}};
#pragma unroll 4
        for (int s2 = 0; s2 < 32; ++s2) {
            const f32x4 a = *(const f32x4*)(xr + 32 * s2), bq = *(const f32x4*)(xr + 32 * s2 + 4);
            const LAS f32x4* gp = (const LAS f32x4*)(gml + 32 * s2 + 8 * kq); const f32x4 g0 = gp[0], g1 = gp[1], h0 = gp[DM / 4], h1 = gp[DM / 4 + 1];
            const f32x4 v0 = a * rstd * g0 + h0, v1 = bq * rstd * g1 + h1;
            u32x2 f8; f8.x = pk4_fp8(v0[0], v0[1], v0[2], v0[3]); f8.y = pk4_fp8(v1[0], v1[1], v1[2], v1[3]); *(u32x2*)(hr + 32 * s2) = f8;
            u32x4 hi4, lo4;
            hi4[0] = cvtpk(v0[0], v0[1]); hi4[1] = cvtpk(v0[2], v0[3]); hi4[2] = cvtpk(v1[0], v1[1]); hi4[3] = cvtpk(v1[2], v1[3]);
            lo4[0] = cvtpk(v0[0] - bflo(hi4[0]), v0[1] - bfhi(hi4[0])); lo4[1] = cvtpk(v0[2] - bflo(hi4[1]), v0[3] - bfhi(hi4[1]));
            lo4[2] = cvtpk(v1[0] - bflo(hi4[2]), v1[1] - bfhi(hi4[2])); lo4[3] = cvtpk(v1[2] - bflo(hi4[3]), v1[3] - bfhi(hi4[3]));
            const bf16x8 ah = __builtin_bit_cast(bf16x8, hi4), al = __builtin_bit_cast(bf16x8, lo4);
#pragma unroll
            for (int j = 0; j < 2; ++j) { const int e = l15 + 16 * j; const LAS unsigned char* bp = rwl + e * 2048 + (((4 * s2 + kq) ^ (e & 15)) << 4);
                const bf16x8 bh = *(const LAS bf16x8*)bp, bl = *(const LAS bf16x8*)(bp + 65536);
                acc[j] = mfma16(ah, bh, acc[j]); acc[j] = mfma16(al, bh, acc[j]); acc[j] = mfma16(ah, bl, acc[j]); }
        }
        const float rb0 = F.in[IN_RB][l15], rb1 = F.in[IN_RB][l15 + 16];
#pragma unroll
        for (int r = 0; r < 4; ++r) {
            float v0 = acc[0][r] + rb0, v1 = acc[1][r] + rb1; float tv[4]; int ti[4];
#pragma unroll
            for (int k = 0; k < 4; ++k) { float bv = v0; int bi = l15; if (v1 > v0) { bv = v1; bi = l15 + 16; }
#pragma unroll
                for (int st = 0; st < 4; ++st) { const float ov = (st == 0) ? dpp_f<DPP_X1>(bv) : (st == 1) ? dpp_f<DPP_X2>(bv) : (st == 2) ? dpp_f<DPP_HM>(bv) : dpp_f<DPP_RM>(bv);
                    const int oi = (st == 0) ? dpp_i<DPP_X1>(bi) : (st == 1) ? dpp_i<DPP_X2>(bi) : (st == 2) ? dpp_i<DPP_HM>(bi) : dpp_i<DPP_RM>(bi);
                    if (ov > bv || (ov == bv && oi < bi)) { bv = ov; bi = oi; } }
                tv[k] = bv; ti[k] = bi; if (bi == l15) v0 = -INFINITY; if (bi == l15 + 16) v1 = -INFINITY; }
            const float e1 = __expf(tv[1] - tv[0]), e2 = __expf(tv[2] - tv[0]), e3 = __expf(tv[3] - tv[0]), inv = 1.0f / (1.0f + e1 + e2 + e3);
            if (l15 < 4) { const int tt = t0 + tb0 + 4 * kq + r; const int e = (l15 == 0) ? ti[0] : (l15 == 1) ? ti[1] : (l15 == 2) ? ti[2] : ti[3];
                const float w = ((l15 == 0) ? 1.0f : (l15 == 1) ? e1 : (l15 == 2) ? e2 : e3) * inv;
                const int lp = __hip_atomic_fetch_add((LAS int*)(F.lds + MISC_OFF) + 32 + e, 1, __ATOMIC_RELAXED, __HIP_MEMORY_SCOPE_WORKGROUP);
                tke[tt * 4 + l15] = e; tkw[tt * 4 + l15] = w; tkp[tt * 4 + l15] = lp; }
        }
    }
    __syncthreads();
    if (tid < 32) { const int n = (int)F.MISC[32 + tid]; int base = 0; if (n > 0) base = (int)__hip_atomic_fetch_add(F.ctl + CW_CNT + 4096 * rep + 64 * tid, (unsigned)n, RLX_AGENT); F.MISC[64 + tid] = (unsigned)base; }
    VM_WAIT(); __syncthreads();
    for (int i = tid; i < tpw * 4; i += NWAVES * 64) { const int t = t0 + (i >> 2), e = tke[t * 4 + (i & 3)], p = tkp[t * 4 + (i & 3)] + (int)F.MISC[64 + e]; tkp[t * 4 + (i & 3)] = p; lst[(size_t)e * T + p] = t; }
}
__device__ __forceinline__ void moe_tables(Frame& F) {
    if (F.tid < 32) { const unsigned cnt = __hip_atomic_load(F.ctl + CW_CNT + 64 * F.tid, RLX_AGENT); const int tiles = (int)((cnt + 255u) >> 8); int x = tiles;
#pragma unroll
        for (int o = 1; o < 32; o <<= 1) { const int t = __shfl_up(x, o, 32); if (F.tid >= o) x += t; }
        F.MISC[192 + F.tid] = cnt; F.MISC[128 + F.tid] = (unsigned)(x - tiles); if (F.tid == 31) F.MISC[160] = (unsigned)x;
        for (int mt = x - tiles; mt < x; ++mt) F.MISC[2304 + mt] = (unsigned)F.tid; }
    __syncthreads();
}
__device__ __forceinline__ void p10_combine(Frame& F) {
    const int gw = F.vcu * NWAVES + F.wave, NGW = F.G * NWAVES, lane = F.lane;
    const float* x1 = WSP(float, WS_X1); const float* mod = WSP(float, WS_MOD); const unsigned char* y = WSP(unsigned char, WS_Y);
    const int* tke = WSP(int, WS_TKE); const float* tkw = WSP(float, WS_TKW); const int* tkp = WSP(int, WS_TKP);
    constexpr int R = 2;
    f32x4 fg[4];
#pragma unroll
    for (int q = 0; q < 4; ++q) fg[q] = *(const f32x4*)(F.in[IN_FG] + (q >> 1) * 512 + 8 * lane + 4 * (q & 1));
    for (int m0 = gw; m0 < T; m0 += R * NGW) {
        u32x2 y0[R][4], y1[R][4]; float w[R][4]; f32x4 xv[R][4], gt[R][4];
#pragma unroll
        for (int r = 0; r < R; ++r) { const int m = (m0 + r * NGW < T) ? m0 + r * NGW : m0;
            const i32x4q e4 = *(const i32x4q*)(tke + m * 4), p4 = *(const i32x4q*)(tkp + m * 4); const f32x4 w4 = *(const f32x4*)(tkw + m * 4);
#pragma unroll
            for (int k = 0; k < 4; ++k) { const size_t row = (size_t)F.MISC[128 + e4[k]] * 256 + p4[k]; w[r][k] = w4[k];
                y0[r][k] = *(const u32x2*)(y + row * DM + 8 * lane); y1[r][k] = *(const u32x2*)(y + row * DM + 512 + 8 * lane); }
            const float* mb = mod + (size_t)(m / SEQ) * 6144 + 5120;
#pragma unroll
            for (int q = 0; q < 4; ++q) { const int col = (q >> 1) * 512 + 8 * lane + 4 * (q & 1); xv[r][q] = *(const f32x4*)(x1 + (size_t)m * DM + col); gt[r][q] = *(const f32x4*)(mb + col); } }
        f32x4 v[R][4]; float ss[R];
#pragma unroll
        for (int r = 0; r < R; ++r) {
            float a[16];
#pragma unroll
            for (int i = 0; i < 16; ++i) a[i] = 0.f;
#pragma unroll
            for (int k = 0; k < 4; ++k)
#pragma unroll
                for (int i = 0; i < 2; ++i) { const f32x2 l0 = __builtin_amdgcn_cvt_pk_f32_fp8((int)y0[r][k][i], false), h0 = __builtin_amdgcn_cvt_pk_f32_fp8((int)y0[r][k][i], true);
                    const f32x2 l1 = __builtin_amdgcn_cvt_pk_f32_fp8((int)y1[r][k][i], false), h1 = __builtin_amdgcn_cvt_pk_f32_fp8((int)y1[r][k][i], true);
                    a[4 * i] += w[r][k] * l0[0]; a[4 * i + 1] += w[r][k] * l0[1]; a[4 * i + 2] += w[r][k] * h0[0]; a[4 * i + 3] += w[r][k] * h0[1];
                    a[8 + 4 * i] += w[r][k] * l1[0]; a[8 + 4 * i + 1] += w[r][k] * l1[1]; a[8 + 4 * i + 2] += w[r][k] * h1[0]; a[8 + 4 * i + 3] += w[r][k] * h1[1]; }
            float s_ = 0.f;
#pragma unroll
            for (int q = 0; q < 4; ++q)
#pragma unroll
                for (int i = 0; i < 4; ++i) { v[r][q][i] = xv[r][q][i] + gt[r][q][i] * a[(q >> 1) * 8 + 4 * (q & 1) + i]; s_ += v[r][q][i] * v[r][q][i]; }
            ss[r] = s_; }
#pragma unroll
        for (int r = 0; r < R; ++r) { const int m = m0 + r * NGW; if (m >= T) continue;
            const float rstd = __builtin_amdgcn_rsqf(wave_sum(ss[r]) * (1.f / DM) + EPS);
#pragma unroll
            for (int q = 0; q < 4; ++q) { const int col = (q >> 1) * 512 + 8 * lane + 4 * (q & 1); *(f32x4*)(F.out + (size_t)m * DM + col) = v[r][q] * rstd * fg[q]; } }
    }
}
__device__ __forceinline__ void dbg_final(Frame& F, const float* src) {
    const int gw = F.vcu * NWAVES + F.wave, NGW = F.G * NWAVES;
    for (int m = gw; m < T; m += NGW) {
        const f32x4* xr = (const f32x4*)(src + (size_t)m * DM) + F.lane; f32x4 v[4]; float s = 0.f;
#pragma unroll
        for (int j = 0; j < 4; ++j) { v[j] = xr[64 * j]; s += (v[j][0] * v[j][0] + v[j][1] * v[j][1]) + (v[j][2] * v[j][2] + v[j][3] * v[j][3]); }
        const float rstd = __builtin_amdgcn_rsqf(wave_sum(s) * (1.f / DM) + EPS);
#pragma unroll
        for (int j = 0; j < 4; ++j) { const int col = 4 * (F.lane + 64 * j); *(f32x4*)(F.out + (size_t)m * DM + col) = v[j] * rstd * *(const f32x4*)(F.in[IN_FG] + col); }
    }
}


__device__ __forceinline__ void dbg_dump_bf16(Frame& F, const bf16_t* src, int ld, int c0, int n) {
    for (size_t i = (size_t)blockIdx.x * NWAVES * 64 + F.tid; i < (size_t)T * n; i += (size_t)F.G * NWAVES * 64) { const size_t t = i / n; const int c = (int)(i % n); F.out[t * DM + c0 + c] = bf2f(src[t * ld + c]); }
}
#define DBG_DUMP(k, ...) do { if (DBG_STAGE == (k)) { xcd_barrier(bar); __VA_ARGS__; return; } } while (0)
#ifndef DBG_STAGE
#define DBG_STAGE (-1)
#endif

constexpr int N_PHASES = 13;
struct Args { const float* in[N_IN]; float* out; unsigned char* ws; int ph_lo, ph_hi; };
__global__ void __launch_bounds__(NWAVES * 64, 2) fwd_kernel(Args args) {
    extern __shared__ __attribute__((aligned(16))) unsigned char lds[];
    Frame F;
    F.lds = (LAS unsigned char*)lds; F.MISC = (volatile LAS unsigned*)(F.lds + MISC_OFF);
    F.tid = threadIdx.x; F.lane = F.tid & 63; F.wave = __builtin_amdgcn_readfirstlane(F.tid >> 6);
    F.G = gridDim.x; { const int bx = blockIdx.x; F.vcu = (F.G % 8 == 0) ? (bx % 8) * (F.G / 8) + bx / 8 : bx; }
    F.ws = args.ws; F.ctl = (unsigned*)(args.ws + WS_CTL); F.out = args.out;
#pragma unroll
    for (int i = 0; i < N_IN; ++i) F.in[i] = args.in[i];
    for (int u = F.tid; u < (LDS_BYTES - MISC_OFF) / 4; u += NWAVES * 64) ((LAS unsigned*)(F.lds + MISC_OFF))[u] = 0u;
    __syncthreads();
    XcdBarrier bar; bar.bar = F.ctl + CW_BAR; bar.x = 0; bar.st = nullptr;
    if (!N_LAUNCH_PER_PHASE) bar = xcd_barrier_post(F.ctl + CW_BAR, F.MISC + 8);
    const int lo = args.ph_lo, hi = args.ph_hi;
#ifndef REP_PHASE
#define REP_PHASE (-1)
#endif
#define NREP(k) ((REP_PHASE == (k)) ? 2 : 1)
#define REPLOOP(k) _Pragma("unroll") for (int rep = 0; rep < NREP(k); ++rep)
#ifndef PH_MASK
#define PH_MASK 0xFFFFu
#endif
#define IN(k) ((((PH_MASK) >> (k)) & 1u) && lo <= (k) && (k) < hi)
#ifndef TPROBE
#define TPROBE (-2)
#endif
    unsigned long long tp0 = (TPROBE == 0) ? __builtin_amdgcn_s_memrealtime() : 0ull, tpd = 0ull;
#define SEAM(k) do { if (IN(k) && IN((k) + 1)) xcd_barrier(bar); if (TPROBE == (k)) tpd = __builtin_amdgcn_s_memrealtime() - tp0; if (TPROBE == (k) + 1) tp0 = __builtin_amdgcn_s_memrealtime(); } while (0)

#if defined(DBG_BASE)
    dbg_final(F, F.in[IN_X]); return;
#endif
#define CONV_TAKE(n) do { for (int k_ = 0; k_ < (n); ++k_) { if (F.tid == 0) F.MISC[16] = __hip_atomic_fetch_add(F.ctl + CW_Q + 256, 1u, RLX_AGENT); __syncthreads(); const int it_ = (int)F.MISC[16]; __syncthreads(); \
        if (it_ < MOE_CONV_ITEMS) moe_conv_item(F, it_); } } while (0)
    if (IN(0)) REPLOOP(0) { if ((int)blockIdx.x < P0_MODWG) p0_mod(F); else p0_weights(F); __syncthreads(); }
    SEAM(0);
    if (IN(1)) REPLOOP(1) p1_norm(F);
    SEAM(1);
    if (IN(2)) REPLOOP(2) {
        pg::Gemm g{WSP(bf16_t, WS_H), WSP(bf16_t, WS_WIN), DM * 2, DM * 2, nullptr}; pg::StaticOrder S; S.init(T, NPROJ, F.G, (int)blockIdx.x);
        EpiProj E{WSP(bf16_t, WS_PROJ), WSP(float, WS_PART)};
        pg::gemm_phase<EpiProj, pg::StaticOrder, false, true>(F.lds, g, S, E);
        if ((int)blockIdx.x >= (T / 256 * (NPROJ / 256)) % F.G && (T / 256 * (NPROJ / 256)) % F.G != 0) CONV_TAKE(1);
    }
    DBG_DUMP(2, dbg_dump_bf16(F, WSP(bf16_t, WS_PROJ), NPROJ, 0, 1024));
    SEAM(2);
    if (IN(4)) REPLOOP(4) {
#ifndef NO_QG
        { pg::Gemm g{WSP(bf16_t, WS_PROJ) + C_QLAT, WSP(bf16_t, WS_WQ), NPROJ * 2, QLORA * 2, nullptr}; pg::StaticOrder S; S.init(T, 768, F.G, (int)blockIdx.x);
          EpiQ E{WSP(bf16_t, WS_Q), WSP(float, WS_PART), WSP(float, WS_CS), 0.10206207261596575f * 1.4426950408889634f, (LAS float*)(F.lds + MISC_OFF + 1024)};
          pg::gemm_phase<EpiQ, pg::StaticOrder, false, true>(F.lds, g, S, E); }
#endif
#ifndef NO_KVG
        { pg::Gemm g{WSP(bf16_t, WS_PROJ) + C_KVLAT, WSP(bf16_t, WS_WKV), NPROJ * 2, KVLORA * 2, nullptr}; pg::StaticOrder S; S.init(T, 1024, F.G, (int)(F.G - 1 - blockIdx.x));
          EpiKV E{WSP(bf16_t, WS_K), WSP(bf16_t, WS_V), WSP(float, WS_PART), WSP(bf16_t, WS_PROJ), WSP(float, WS_CS), (LAS float*)(F.lds + MISC_OFF + 2048)};
          pg::gemm_phase<EpiKV, pg::StaticOrder, false, true>(F.lds, g, S, E); }
#endif

    }
    DBG_DUMP(4, dbg_dump_bf16(F, WSP(bf16_t, WS_Q), 768, 0, 768); dbg_dump_bf16(F, WSP(bf16_t, WS_K), 768, 768, 256));
    if (TPROBE == 4) tpd = __builtin_amdgcn_s_memrealtime() - tp0; if (TPROBE == 5) tp0 = __builtin_amdgcn_s_memrealtime();
    unsigned long long g1acc = 0ull;
    if (IN(5)) REPLOOP(5) {
        constexpr int NU = BATCH * GH * NCH / 4; G1Pre gp; unsigned* qh = F.ctl + CW_Q + 192;
        if (F.tid == 0) { F.MISC[18] = __hip_atomic_fetch_add(qh, 1u, RLX_AGENT); F.MISC[19] = __hip_atomic_fetch_add(qh, 1u, RLX_AGENT); }
        __syncthreads();
        int u = (int)F.MISC[18], un = (int)F.MISC[19];
        __syncthreads();
        if (u < NU) g1_prefetch(F, u, gp);
        for (int it = 0; u < NU; ++it) {
            unsigned tk = 0u; if (F.tid == 0) tk = __hip_atomic_fetch_add(qh, 1u, RLX_AGENT);
            g1_unit(F, u, (un < NU) ? un : -1, gp, g1acc);
            if (F.tid == 0) F.MISC[18 + (it & 1)] = tk;
            __syncthreads();
            u = un; un = (int)F.MISC[18 + (it & 1)];
        }
    }
    if (G1PROBE >= 0) tpd = g1acc;
    SEAM(5);
#ifndef NCONV
#define NCONV 34
#endif
    if (IN(6)) {
        if (F.tid == 0) F.MISC[17] = __hip_atomic_fetch_add(F.ctl + CW_Q + 320, 1u, RLX_AGENT);
        for (;;) {
            if (F.tid == 0) F.MISC[16] = __hip_atomic_fetch_add(F.ctl + CW_Q, 1u, RLX_AGENT);
            __syncthreads();
            const int item = (int)F.MISC[16];
            __syncthreads();
            if (item >= G2_ITEMS) break;
            g2_item(F, item);
        }
        const int ticket = (int)F.MISC[17];
#define CONV_LOOP() for (;;) { if (F.tid == 0) F.MISC[16] = __hip_atomic_fetch_add(F.ctl + CW_Q + 256, 1u, RLX_AGENT); __syncthreads(); const int item = (int)F.MISC[16]; __syncthreads(); \
            if (item >= MOE_CONV_ITEMS) break; moe_conv_item(F, item); }
        if (ticket >= G2_ITEMS && ticket < G2_ITEMS + NCONV) CONV_LOOP();
        for (;;) {
            if (F.tid == 0) F.MISC[16] = __hip_atomic_fetch_add(F.ctl + CW_Q + 64, 1u, RLX_AGENT);
            __syncthreads();
            const int item = (int)F.MISC[16];
            __syncthreads();
            if (item >= BATCH * NH * 16) break;
            const int qb = 15 - (item >> 6), bh = item & 63; attn_unit(F, bh >> 3, bh & 7, qb);
        }
        CONV_LOOP();
#undef CONV_LOOP
    }
    DBG_DUMP(6, dbg_dump_bf16(F, WSP(bf16_t, DBG_SUB ? WS_OG : WS_OA), 512, 0, 512); dbg_dump_bf16(F, WSP(bf16_t, DBG_SUB ? WS_OG : WS_OA), 512, 512, 512));
    SEAM(6);
    if (IN(8)) REPLOOP(8) {
        pg::Gemm g{WSP(bf16_t, WS_H), WSP(bf16_t, WS_WO), DM * 2, DM * 2, nullptr}; g.rowsq = WSP(float, WS_PARTO); pg::StaticOrder S; S.init(T, DM, F.G, (int)blockIdx.x);
        EpiX1 E{F.in[IN_X], WSP(float, WS_MOD), WSP(float, WS_X1)};
        pg::gemm_phase<EpiX1, pg::StaticOrder, false, true, false, true>(F.lds, g, S, E);
    }
#if defined(DBG_STOP_X1)
    xcd_barrier(bar); dbg_final(F, WSP(float, WS_X1)); return;
#endif
    SEAM(8);
    if (IN(9)) REPLOOP(9) { p6_router(F, rep); __syncthreads(); }
    SEAM(9);
    if (IN(10)) REPLOOP(10) {
        moe_tables(F);
        pg::Gemm g{WSP(unsigned char, WS_H), WSP(unsigned char, WS_WGU), DM, DM, WSP(int, WS_LIST)};
#if defined(EPIPROBE) && EPIPROBE == 10
        g.tacc = &tpd;
#endif
        pg::MoeOrder S{(const LAS int*)(F.lds + MISC_OFF) + 128, (const LAS int*)(F.lds + MISC_OFF) + 192, 8, 2048, F.G, (int)blockIdx.x, 0};
        EpiGU E{WSP(unsigned char, WS_ACT), F.in[IN_BGU]};
        pg::gemm_phase<EpiGU, pg::MoeOrder, true, true, true>(F.lds, g, S, E);
    }
    SEAM(10);
    if (IN(11)) REPLOOP(11) {
        if (!IN(10)) moe_tables(F);
        pg::Gemm g{WSP(unsigned char, WS_ACT), WSP(unsigned char, WS_WDN), DE, DE, nullptr};
#if defined(EPIPROBE) && EPIPROBE == 11
        g.tacc = &tpd;
#endif
        pg::MoeOrder S{(const LAS int*)(F.lds + MISC_OFF) + 128, (const LAS int*)(F.lds + MISC_OFF) + 192, 4, 1024, F.G, (int)blockIdx.x, 1};
        EpiDN E{WSP(unsigned char, WS_Y), F.in[IN_BDN]};
        pg::gemm_phase<EpiDN, pg::MoeOrder, false, true, true>(F.lds, g, S, E);
    }
    SEAM(11);
    if (IN(12)) REPLOOP(12) { if (!IN(10)) moe_tables(F); p10_combine(F); }
#ifdef EPIPROBE
    const bool epiprobe_ = true;
#else
    const bool epiprobe_ = false;
#endif
    if (TPROBE >= 0 || G1PROBE >= 0 || epiprobe_) { if (TPROBE == 12) { VM_WAIT(); tpd = __builtin_amdgcn_s_memrealtime() - tp0; }
        if (blockIdx.x == 0) { const unsigned long long t_ = __builtin_amdgcn_s_memrealtime(); while (__builtin_amdgcn_s_memrealtime() - t_ < 10ull * tpd) __builtin_amdgcn_s_sleep(8); } }
#undef IN
#undef SEAM
}

extern "C" void kernel_launch(void* const* d_in, const int* in_sizes, int n_in, void* d_out, int out_size, void* d_ws, size_t ws_size, hipStream_t stream) {
    static int grid = 0;
    if (grid == 0) {
        if (n_in != N_IN || out_size != T * DM || ws_size < WS_END) { fprintf(stderr, "kernel_launch: unexpected shapes (n_in %d, out %d, ws %zu)\n", n_in, out_size, ws_size); grid = -1; return; }
        int dev = 0, cus = 0;
        if (hipGetDevice(&dev) != hipSuccess || hipDeviceGetAttribute(&cus, hipDeviceAttributeMultiprocessorCount, dev) != hipSuccess) { grid = -1; return; }
        if (hipFuncSetAttribute((const void*)fwd_kernel, hipFuncAttributeMaxDynamicSharedMemorySize, LDS_BYTES) != hipSuccess) { grid = -1; return; }
        int per_cu = 0;
        if (hipOccupancyMaxActiveBlocksPerMultiprocessor(&per_cu, (const void*)fwd_kernel, NWAVES * 64, LDS_BYTES) != hipSuccess || per_cu < 1) fprintf(stderr, "kernel_launch: occupancy query says %d\n", per_cu);
        (void)hipGetLastError();
        grid = cus;
        while (grid > 8 && (T % grid) != 0) grid -= 8;
    }
    if (grid < 0) return;
    (void)hipMemsetAsync((char*)d_ws + WS_CTL, 0, CTL_BYTES, stream);
    Args a{};
    for (int i = 0; i < N_IN; ++i) a.in[i] = (const float*)d_in[i];
    a.out = (float*)d_out; a.ws = (unsigned char*)d_ws;
#if N_LAUNCH_PER_PHASE
    for (int p = 0; p < N_PHASES; ++p) { a.ph_lo = p; a.ph_hi = p + 1; hipLaunchKernelGGL(fwd_kernel, dim3(grid), dim3(NWAVES * 64), LDS_BYTES, stream, a); }
#else
    a.ph_lo = 0; a.ph_hi = N_PHASES;
    hipLaunchKernelGGL(fwd_kernel, dim3(grid), dim3(NWAVES * 64), LDS_BYTES, stream, a);
#endif
}
```
